# Optimizing an MI355X kernel written in HIP

```python
import math
import jax, jax.numpy as jnp
from jax import lax
import numpy as np

D_MODEL = 2048
BATCH = 8
SEQ = 2048
DEPTH = 2

MIX_W = D_MODEL // 2
DIFF_HEADS = 8
DIFF_HEAD_DIM = MIX_W // DIFF_HEADS // 2
DIFF_V_DIM = 2 * DIFF_HEAD_DIM
CONV_CH = MIX_W
CONV_WIDTH = 31
RET_HEADS = 8
RET_HEAD_DIM = MIX_W // RET_HEADS
N_BRANCH = 3
XATTN_HEADS = 4
XATTN_HEAD_DIM = D_MODEL // XATTN_HEADS
MEM_TOKENS = 256
FFN_HIDDEN = -(-8 * D_MODEL // (3 * 256)) * 256
ROPE_THETA = 10000.0
Q_BLOCK = 128
RET_CHUNK = 128
EPS = 1e-6
NEG_INF = -1e30
IN_SPLITS = [MIX_W, MIX_W, MIX_W,
             2 * CONV_CH,
             MIX_W, MIX_W, MIX_W, MIX_W,
             N_BRANCH * D_MODEL]
IN_COLS = sum(IN_SPLITS)

kernel_name = "hybrid_diffattn_conformer_retention_block"


def rmsnorm(x, g):
    xf = x.astype(jnp.float32)
    y = xf * lax.rsqrt(jnp.mean(xf * xf, axis=-1, keepdims=True) + EPS)
    return (y * g.astype(jnp.float32)).astype(x.dtype)


def layernorm_f32(xf, g, b):
    mu = jnp.mean(xf, axis=-1, keepdims=True)
    var = jnp.mean(jnp.square(xf - mu), axis=-1, keepdims=True)
    return (xf - mu) * lax.rsqrt(var + EPS) * g.astype(jnp.float32) + b.astype(jnp.float32)


def rope_tables(T, dim, inv_freq):
    ang = jnp.arange(T, dtype=jnp.float32)[:, None] * inv_freq[None, :]
    return jnp.cos(ang), jnp.sin(ang)


def apply_rope(x, cos, sin):
    shape = (cos.shape[0],) + (1,) * (x.ndim - 3) + (cos.shape[1],)
    c, s = cos.reshape(shape), sin.reshape(shape)
    xf = x.astype(jnp.float32)
    x1, x2 = jnp.split(xf, 2, axis=-1)
    return jnp.concatenate([x1 * c - x2 * s, x2 * c + x1 * s], axis=-1)


def diff_attention(q, k, v, lam):
    B, T, H = q.shape[:3]
    n_blocks = T // Q_BLOCK
    scale = DIFF_HEAD_DIM ** -0.5
    vf = v.astype(jnp.float32)
    k_pos = jnp.arange(T)

    def one_block(blk):
        start = blk * Q_BLOCK
        qb = lax.dynamic_slice_in_dim(q, start, Q_BLOCK, axis=1)
        logits = jnp.einsum('bqhmd,bkhmd->bmhqk', qb, k) * scale
        q_pos = start + jnp.arange(Q_BLOCK)
        causal = k_pos[None, :] <= q_pos[:, None]
        probs = jax.nn.softmax(jnp.where(causal, logits, NEG_INF), axis=-1)
        weights = probs[:, 0] - lam * probs[:, 1]
        return jnp.einsum('bhqk,bkhe->bqhe', weights, vf)

    out = lax.map(one_block, jnp.arange(n_blocks))
    return jnp.moveaxis(out, 0, 1).reshape(B, T, H, vf.shape[-1])


def retention_chunkwise(q, k, v, log_gamma):
    B, T, H, dk = q.shape
    dv = v.shape[-1]
    N = T // RET_CHUNK
    q = q.reshape(B, N, RET_CHUNK, H, dk) * dk ** -0.5
    k = k.reshape(B, N, RET_CHUNK, H, dk)
    v = v.astype(jnp.float32).reshape(B, N, RET_CHUNK, H, dv)
    idx = jnp.arange(RET_CHUNK, dtype=jnp.float32)
    rel = idx[:, None] - idx[None, :]
    intra_decay = jnp.where(rel >= 0, jnp.exp(log_gamma[:, None, None] * jnp.maximum(rel, 0.0)), 0.0)
    scores = jnp.einsum('bnihd,bnjhd->bnhij', q, k) * intra_decay
    intra = jnp.einsum('bnhij,bnjhe->bnihe', scores, v)
    k_decay = jnp.exp(log_gamma[None, :] * (RET_CHUNK - 1 - idx)[:, None])
    chunk_kv = jnp.einsum('bnjhd,jh,bnjhe->nbhde', k, k_decay, v)
    chunk_decay = jnp.exp(log_gamma * RET_CHUNK)[:, None, None]

    def step(state, kv_n):
        return state * chunk_decay + kv_n, state

    _, states = lax.scan(step, jnp.zeros((B, H, dk, dv), jnp.float32), chunk_kv)
    q_decay = jnp.exp(log_gamma[None, :] * (idx + 1.0)[:, None])
    cross = jnp.einsum('bnihd,ih,nbhde->bnihe', q, q_decay, states)
    return (intra + cross).reshape(B, T, H, dv)


def hybrid_mixer(h, layer_idx, w_in, diff_lambda, diff_subln, conv_w, conv_b, conv_ln_g, conv_ln_b,
                 ret_gn_g, w_branch, w_out, diff_cos, diff_sin, ret_cos, ret_sin):
    B, T, D = h.shape
    proj = h @ w_in
    dq, dk, dv, cin, rq, rk, rv, rg, gates = jnp.split(proj, list(np.cumsum(IN_SPLITS)[:-1]), axis=-1)

    q = apply_rope(dq.reshape(B, T, DIFF_HEADS, 2, DIFF_HEAD_DIM), diff_cos, diff_sin)
    k = apply_rope(dk.reshape(B, T, DIFF_HEADS, 2, DIFF_HEAD_DIM), diff_cos, diff_sin)
    lam_f = diff_lambda.astype(jnp.float32)
    lambda_init = 0.8 - 0.6 * math.exp(-0.3 * layer_idx)
    lam = (jnp.exp(jnp.sum(lam_f[0] * lam_f[1])) - jnp.exp(jnp.sum(lam_f[2] * lam_f[3])) + lambda_init)
    ya = diff_attention(q, k, dv.reshape(B, T, DIFF_HEADS, DIFF_V_DIM), lam)
    ya = ya * lax.rsqrt(jnp.mean(ya * ya, axis=-1, keepdims=True) + EPS) * diff_subln.astype(jnp.float32)
    ya = (ya * (1.0 - lambda_init)).reshape(B, T, MIX_W).astype(h.dtype)

    ca, cb = jnp.split(cin, 2, axis=-1)
    u = ca * jax.nn.sigmoid(cb)
    yc = lax.conv_general_dilated(u, conv_w[:, None, :].astype(u.dtype), window_strides=(1,),
                                  padding=[(CONV_WIDTH - 1, 0)],
                                  dimension_numbers=('NWC', 'WIO', 'NWC'),
                                  feature_group_count=CONV_CH)
    yc = layernorm_f32(yc.astype(jnp.float32) + conv_b.astype(jnp.float32), conv_ln_g, conv_ln_b)
    yb = jax.nn.silu(yc).astype(h.dtype)

    log_gamma = jnp.log1p(-jnp.exp2(-5.0 - jnp.arange(RET_HEADS, dtype=jnp.float32)))
    rqr = apply_rope(rq.reshape(B, T, RET_HEADS, RET_HEAD_DIM), ret_cos, ret_sin)
    rkr = apply_rope(rk.reshape(B, T, RET_HEADS, RET_HEAD_DIM), ret_cos, ret_sin)
    yr = retention_chunkwise(rqr, rkr, rv.reshape(B, T, RET_HEADS, RET_HEAD_DIM), log_gamma)
    mu = jnp.mean(yr, axis=-1, keepdims=True)
    var = jnp.mean(jnp.square(yr - mu), axis=-1, keepdims=True)
    yr = ((yr - mu) * lax.rsqrt(var + EPS)).reshape(B, T, MIX_W) * ret_gn_g.astype(jnp.float32)
    yr = (jax.nn.silu(rg.astype(jnp.float32)) * yr).astype(h.dtype)

    g = jax.nn.sigmoid(gates.astype(jnp.float32)).reshape(B, T, N_BRANCH, D)
    merged = (g[:, :, 0] * (ya @ w_branch[0]).astype(jnp.float32)
              + g[:, :, 1] * (yb @ w_branch[1]).astype(jnp.float32)
              + g[:, :, 2] * (yr @ w_branch[2]).astype(jnp.float32))
    return merged.astype(h.dtype) @ w_out


def cross_attention(h, m, wq, wkv, wo):
    B, T, D = h.shape
    M = m.shape[1]
    q = (h @ wq).reshape(B, T, XATTN_HEADS, XATTN_HEAD_DIM).astype(jnp.float32)
    k, v = jnp.split(m @ wkv, 2, axis=-1)
    k = k.reshape(B, M, XATTN_HEADS, XATTN_HEAD_DIM).astype(jnp.float32)
    v = v.reshape(B, M, XATTN_HEADS, XATTN_HEAD_DIM).astype(jnp.float32)
    p = jax.nn.softmax(jnp.einsum('bthd,bmhd->bhtm', q, k) * XATTN_HEAD_DIM ** -0.5, axis=-1)
    o = jnp.einsum('bhtm,bmhd->bthd', p, v).reshape(B, T, D).astype(h.dtype)
    return o @ wo


def swiglu(h, w13, w2):
    a, b = jnp.split(h @ w13, 2, axis=-1)
    return (jax.nn.silu(a.astype(jnp.float32)) * b.astype(jnp.float32)).astype(h.dtype) @ w2


def setup_inputs(seed: int = 0) -> dict:
    key = jax.random.key(seed)
    ks = jax.random.split(key, 24)
    f32 = jnp.float32

    def nrm(k, shape, fan_in):
        return jax.random.normal(k, shape, f32) * fan_in ** -0.5

    def gain(k, shape):
        return 1.0 + 0.02 * jax.random.normal(k, shape, f32)

    return {
        "x": jax.random.normal(ks[0], (BATCH, SEQ, D_MODEL), f32),
        "mem": jax.random.normal(ks[1], (BATCH, MEM_TOKENS, D_MODEL), f32),
        "norm_mix": gain(ks[2], (DEPTH, D_MODEL)),
        "w_in": nrm(ks[3], (DEPTH, D_MODEL, IN_COLS), D_MODEL),
        "diff_lambda": 0.1 * jax.random.normal(ks[4], (DEPTH, 4, DIFF_HEAD_DIM), f32),
        "diff_subln": gain(ks[5], (DEPTH, DIFF_V_DIM)),
        "conv_w": nrm(ks[6], (DEPTH, CONV_WIDTH, CONV_CH), CONV_WIDTH),
        "conv_b": 0.02 * jax.random.normal(ks[7], (DEPTH, CONV_CH), f32),
        "conv_ln_g": gain(ks[8], (DEPTH, CONV_CH)),
        "conv_ln_b": 0.02 * jax.random.normal(ks[9], (DEPTH, CONV_CH), f32),
        "ret_gn_g": gain(ks[10], (DEPTH, MIX_W)),
        "w_branch": nrm(ks[11], (DEPTH, N_BRANCH, MIX_W, D_MODEL), MIX_W),
        "w_out": nrm(ks[12], (DEPTH, D_MODEL, D_MODEL), D_MODEL),
        "norm_xattn": gain(ks[13], (DEPTH, D_MODEL)),
        "norm_mem": gain(ks[14], (DEPTH, D_MODEL)),
        "xattn_wq": nrm(ks[15], (DEPTH, D_MODEL, D_MODEL), D_MODEL),
        "xattn_wkv": nrm(ks[16], (DEPTH, D_MODEL, 2 * D_MODEL), D_MODEL),
        "xattn_wo": nrm(ks[17], (DEPTH, D_MODEL, D_MODEL), D_MODEL),
        "norm_ffn": gain(ks[18], (DEPTH, D_MODEL)),
        "ffn_w13": nrm(ks[19], (DEPTH, D_MODEL, 2 * FFN_HIDDEN), D_MODEL),
        "ffn_w2": nrm(ks[20], (DEPTH, FFN_HIDDEN, D_MODEL), FFN_HIDDEN),
        "norm_final": gain(ks[21], (D_MODEL,)),
    }


def reference(x, mem, norm_mix, w_in, diff_lambda, diff_subln, conv_w, conv_b, conv_ln_g, conv_ln_b,
              ret_gn_g, w_branch, w_out, norm_xattn, norm_mem, xattn_wq, xattn_wkv, xattn_wo,
              norm_ffn, ffn_w13, ffn_w2, norm_final):
    T = x.shape[1]
    diff_inv = ROPE_THETA ** (-jnp.arange(0, DIFF_HEAD_DIM, 2, dtype=jnp.float32) / DIFF_HEAD_DIM)
    diff_cos, diff_sin = rope_tables(T, DIFF_HEAD_DIM, diff_inv)
    ret_inv = 1.0 / (ROPE_THETA ** jnp.linspace(0.0, 1.0, RET_HEAD_DIM // 2, dtype=jnp.float32))
    ret_cos, ret_sin = rope_tables(T, RET_HEAD_DIM, ret_inv)

    for i in range(DEPTH):
        h = rmsnorm(x, norm_mix[i])
        x = x + hybrid_mixer(h, i, w_in[i], diff_lambda[i], diff_subln[i], conv_w[i], conv_b[i],
                             conv_ln_g[i], conv_ln_b[i], ret_gn_g[i], w_branch[i], w_out[i],
                             diff_cos, diff_sin, ret_cos, ret_sin)
        x = x + cross_attention(rmsnorm(x, norm_xattn[i]), rmsnorm(mem, norm_mem[i]),
                                xattn_wq[i], xattn_wkv[i], xattn_wo[i])
        x = x + swiglu(rmsnorm(x, norm_ffn[i]), ffn_w13[i], ffn_w2[i])
    return rmsnorm(x, norm_final)
```

```cpp
#include <hip/hip_runtime.h>
#include <hip/hip_bf16.h>
#include <cstdio>
#include <cstdint>
#include <cmath>
namespace pg8 {
#define PG8_LAS __attribute__((address_space(3)))
typedef unsigned short bf16_t;
typedef short bf16x8 __attribute__((ext_vector_type(8)));
typedef float f32x4 __attribute__((ext_vector_type(4)));
typedef float f32x2 __attribute__((ext_vector_type(2)));
typedef unsigned u32x4 __attribute__((ext_vector_type(4)));
typedef unsigned u32x2 __attribute__((ext_vector_type(2)));
constexpr int BM = 256, BK = 64, HALF = 128, HTB = HALF * BK * 2  , STAGE_BYTES = 8 * HTB, NXCD = 8, WGM = 8;

__host__ __device__ __forceinline__ int lds_byte(int r, int c) { const int st = (r >> 4) * 2 + (c >> 5), rr = r & 15, cc = c & 31, ob = rr * 64 + cc * 2; return st * 1024 + (ob ^ (((ob >> 9) & 1) << 5)); }
__host__ __device__ __forceinline__ void stage_rc(int b, int& R, int& C) { const int st = b / 1024, sb = b % 1024, swz = sb ^ (((sb >> 9) & 1) << 5); R = (st >> 1) * 16 + swz / 64; C = (st & 1) * 32 + (swz % 64) / 2; }
__host__ __device__ __forceinline__ int perm32(int rho) { const int n = rho >> 4, i = rho & 15; return 8 * (i >> 2) + 4 * n + (i & 3); }

template <class T> __device__ __forceinline__ T* uni_ptr(T* p) { const unsigned long long v = (unsigned long long)p; unsigned lo = __builtin_amdgcn_readfirstlane((unsigned)v), hi = __builtin_amdgcn_readfirstlane((unsigned)(v >> 32));
    asm volatile("" : "+s"(lo), "+s"(hi)); return (T*)(((unsigned long long)hi << 32) | lo); }
struct Unit { int pm, pn; unsigned offA, offB; };
struct Gemm { const bf16_t* A; const bf16_t* Bt; int lda, ldb, K; };

struct StaticOrder {
    int nM, nN, nwg, G, c; unsigned tA, tB;
    __device__ void init(int M, int N, int G_, int c_, int lda, int ldb) { nM = M / BM; nN = N / BM; nwg = nM * nN; G = G_; c = c_; tA = (unsigned)BM * lda * 2u; tB = (unsigned)BM * ldb * 2u; }
    __device__ bool next(int i, Unit& u) const {
        const long L = (long)i * G + c; if (L >= nwg) return false;
        int wgid = (int)L; { const int q = nwg / NXCD, r = nwg % NXCD, xcd = wgid % NXCD, off = wgid / NXCD; wgid = (xcd < r ? xcd * (q + 1) : r * (q + 1) + (xcd - r) * q) + off; }
        const int nig = WGM * nN, gid = wgid / nig, fm = gid * WGM, gsz = (nM - fm) < WGM ? (nM - fm) : WGM;
        u.pm = fm + ((wgid % nig) % gsz); u.pn = (wgid % nig) / gsz; u.offA = (unsigned)u.pm * tA; u.offB = (unsigned)u.pn * tB; return true;
    }
    __device__ __forceinline__ void a_ready(const Unit&) const {}
    __device__ __forceinline__ void done(const Unit&) const {}
};
struct XsOrder {
    int G, c;
    __device__ bool next(int i, Unit& u) const {
        const int L = i * G + c; if (L >= 256) return false;
        const int b = L >> 5, h = (L >> 3) & 3, rt = L & 7;
        u.pm = b * 8 + rt; u.pn = h; u.offA = ((unsigned)(b * 2048 + rt * 256) * 2048u + h * 512) * 2u; u.offB = ((unsigned)(b * 256) * 2048u + h * 512) * 2u; return true;
    }
    __device__ __forceinline__ void a_ready(const Unit&) const {}
    __device__ __forceinline__ void done(const Unit&) const {}
};
struct XpOrder {
    int G, c;
    __device__ bool next(int i, Unit& u) const {
        const int L = i * G + c; if (L >= 512) return false;
        const int b = L >> 6, h = (L >> 4) & 3, rt = (L >> 1) & 7, ct = L & 1;
        u.pm = b * 8 + rt; u.pn = h * 2 + ct; u.offA = ((unsigned)(b * 2048 + rt * 256) * 1024u + h * 256) * 2u; u.offB = ((unsigned)(h * 512 + ct * 256) * 2048u + b * 256) * 2u; return true;
    }
    __device__ __forceinline__ void a_ready(const Unit&) const {}
    __device__ __forceinline__ void done(const Unit&) const {}
};

__device__ __forceinline__ unsigned cvt_pk_bf16(float lo, float hi) { unsigned r; asm volatile("v_cvt_pk_bf16_f32 %0, %1, %2" : "=v"(r) : "v"(lo), "v"(hi)); return r; }
__device__ __forceinline__ float bf_lo(unsigned w) { return __uint_as_float(w << 16); }
__device__ __forceinline__ float bf_hi(unsigned w) { return __uint_as_float(w & 0xffff0000u); }
__device__ __forceinline__ float sigmoidf_(float x) { return __builtin_amdgcn_rcpf(1.0f + __builtin_amdgcn_exp2f(-1.4426950408889634f * x)); }

struct EpiBf16 {
    static constexpr bool PERM = true, AFTER_DRAIN = false;
    bf16_t* O; int ldc; int split_cols; size_t split_stride; float scale;
    __device__ __forceinline__ void operator()(const f32x4 (&acc)[2][2][4][2], const Unit& u, int wr, int wc, int fr, int fq) const {
        const int row0 = u.pm * BM + wr * 64 + fr; int colt = u.pn * BM; bf16_t* base = O;
        if (split_cols) { const int t = colt / split_cols; base += (size_t)t * split_stride; colt -= t * split_cols; }
        const int col0 = colt + wc * 32 + 8 * fq; const float sc = scale;
#pragma unroll
        for (int ai = 0; ai < 2; ++ai)
#pragma unroll
            for (int m = 0; m < 4; ++m) { bf16_t* rowp = base + (size_t)(row0 + ai * HALF + m * 16) * ldc + col0;
#pragma unroll
                for (int bj = 0; bj < 2; ++bj) { const f32x4 v0 = acc[ai][bj][m][0] * sc, v1 = acc[ai][bj][m][1] * sc;
                    u32x4 w; w.x = cvt_pk_bf16(v0[0], v0[1]); w.y = cvt_pk_bf16(v0[2], v0[3]); w.z = cvt_pk_bf16(v1[0], v1[1]); w.w = cvt_pk_bf16(v1[2], v1[3]);
                    *(u32x4*)(rowp + bj * HALF) = w; } }
    }
};
struct EpiF32 {
    static constexpr bool PERM = false, AFTER_DRAIN = false;
    const float* base; float* out; int ldc;
    __device__ __forceinline__ void operator()(const f32x4 (&acc)[2][2][4][2], const Unit& u, int wr, int wc, int fr, int fq) const {
        const int col0 = u.pn * BM + wc * 32 + 4 * fq;
#pragma unroll
        for (int ai = 0; ai < 2; ++ai)
#pragma unroll
            for (int m = 0; m < 4; ++m) { const size_t off = (size_t)(u.pm * BM + ai * HALF + wr * 64 + m * 16 + fr) * ldc + col0;
#pragma unroll
                for (int bj = 0; bj < 2; ++bj)
#pragma unroll
                    for (int n = 0; n < 2; ++n) { f32x4 v = acc[ai][bj][m][n]; const size_t p = off + bj * HALF + n * 16;
                        if (base) v = v + *(const f32x4*)(base + p);
                        *(f32x4*)(out + p) = v; } }
    }
};
template <int MODE> struct EpiGate {
    static constexpr bool PERM = false, AFTER_DRAIN = false;
    const bf16_t* gate; float* part; bf16_t* merged;
    __device__ __forceinline__ void operator()(const f32x4 (&acc)[2][2][4][2], const Unit& u, int wr, int wc, int fr, int fq) const {
        const int col0 = u.pn * BM + wc * 32 + 4 * fq;
        const bf16_t* gseg = gate + (size_t)(u.pn >> 2) * ((size_t)16384 * 1024); const int gcol0 = (u.pn & 3) * BM + wc * 32 + 4 * fq;
#pragma unroll
        for (int ai = 0; ai < 2; ++ai)
#pragma unroll
            for (int m = 0; m < 4; ++m) { const size_t row = (size_t)(u.pm * BM + ai * HALF + wr * 64 + m * 16 + fr);
#pragma unroll
                for (int bj = 0; bj < 2; ++bj)
#pragma unroll
                    for (int n = 0; n < 2; ++n) { const u32x2 gw = *(const u32x2*)(gseg + row * 1024 + gcol0 + bj * HALF + n * 16);
                        f32x4 g; g[0] = sigmoidf_(bf_lo(gw.x)); g[1] = sigmoidf_(bf_hi(gw.x)); g[2] = sigmoidf_(bf_lo(gw.y)); g[3] = sigmoidf_(bf_hi(gw.y));
                        f32x4 v = acc[ai][bj][m][n] * g; const size_t p = row * 2048 + col0 + bj * HALF + n * 16;
                        if (MODE >= 1) v = v + *(const f32x4*)(part + p);
                        if (MODE <= 1) *(f32x4*)(part + p) = v;
                        else { u32x2 w; w.x = cvt_pk_bf16(v[0], v[1]); w.y = cvt_pk_bf16(v[2], v[3]); *(u32x2*)(merged + p) = w; } } }
    }
};
struct EpiSwiGLU {
    static constexpr bool PERM = true, AFTER_DRAIN = false;
    bf16_t* O; int ldo;
    __device__ __forceinline__ void operator()(const f32x4 (&acc)[2][2][4][2], const Unit& u, int wr, int wc, int fr, int fq) const {
        const int row0 = u.pm * BM + wr * 64 + fr; const int j0 = (u.pn * BM + wc * 32 + 8 * fq) >> 1;
#pragma unroll
        for (int ai = 0; ai < 2; ++ai)
#pragma unroll
            for (int m = 0; m < 4; ++m) { bf16_t* rowp = O + (size_t)(row0 + ai * HALF + m * 16) * ldo + j0;
#pragma unroll
                for (int bj = 0; bj < 2; ++bj) { const f32x4 v0 = acc[ai][bj][m][0], v1 = acc[ai][bj][m][1];
                    const float o0 = v0[0] * sigmoidf_(v0[0]) * v0[1], o1 = v0[2] * sigmoidf_(v0[2]) * v0[3], o2 = v1[0] * sigmoidf_(v1[0]) * v1[1], o3 = v1[2] * sigmoidf_(v1[2]) * v1[3];
                    u32x2 w; w.x = cvt_pk_bf16(o0, o1); w.y = cvt_pk_bf16(o2, o3);
                    *(u32x2*)(rowp + bj * (HALF / 2)) = w; } }
    }
};

template <class Epi, class Sched, bool ALIGN_EPI = false, bool SP2 = false>
__device__ __forceinline__ void gemm_phase(PG8_LAS unsigned char* lds, const Gemm g, const Sched& S, const Epi& E) {
    int tid_ = threadIdx.x; asm volatile("" : "+v"(tid_));
    const char* gA = uni_ptr((const char*)g.A); const char* gB = uni_ptr((const char*)g.Bt);
    const int tid = tid_, wid = __builtin_amdgcn_readfirstlane(tid >> 6), lane = tid & 63, wr = wid >> 2, wc = wid & 3, fr = lane & 15, fq = lane >> 4;
    int K_ = g.K; asm volatile("" : "+s"(K_));
    const int K = K_, nt = K / BK;
    unsigned voffA[2], voffB[2];
#pragma unroll
    for (int i = 0; i < 2; ++i) { int R, C; stage_rc(tid * 16 + i * 8192, R, C); const int Rb = Epi::PERM ? ((R & ~31) + perm32(R & 31)) : R;
        voffA[i] = (unsigned)(R * g.lda + C) * 2u; voffB[i] = (unsigned)(Rb * g.ldb + C) * 2u; }
    const size_t kstep = (size_t)(BK * 2);
    const unsigned hsA = (unsigned)HALF * g.lda * 2u, hsB = (unsigned)HALF * g.ldb * 2u;
    const unsigned ldsw = (unsigned)wid * 1024u;
    const int aoff = lds_byte(wr * 64 + fr, fq * 8), boff = lds_byte(wc * 32 + fr, fq * 8);
#define PG8_SA(b, h) (((b) * 2 + (h)) * HTB)
#define PG8_SB(b, h) ((4 + (b) * 2 + (h)) * HTB)
#define PG8_STAGE(bufoff, gbase, voff) do { _Pragma("unroll") for (int _i = 0; _i < 2; ++_i) \
        __builtin_amdgcn_global_load_lds((const unsigned*)((const char*)(gbase) + (voff)[_i]), (PG8_LAS unsigned*)(lds + (bufoff) + ldsw + _i * 8192), 16, 0, 0); } while (0)
#define PG8_LDA(dst, b, h) do { _Pragma("unroll") for (int m = 0; m < 4; ++m) _Pragma("unroll") for (int k = 0; k < 2; ++k) dst[m][k] = *(const PG8_LAS bf16x8*)(lds + PG8_SA(b, h) + aoff + m * 2048 + k * 1024); } while (0)
#define PG8_LDB(dst, b, h) do { _Pragma("unroll") for (int n = 0; n < 2; ++n) _Pragma("unroll") for (int k = 0; k < 2; ++k) dst[n][k] = *(const PG8_LAS bf16x8*)(lds + PG8_SB(b, h) + boff + n * 2048 + k * 1024); } while (0)
#define PG8_MMA(ai, bj, At, Bt) do { __builtin_amdgcn_s_setprio(1); _Pragma("unroll") for (int m = 0; m < 4; ++m) _Pragma("unroll") for (int n = 0; n < 2; ++n) _Pragma("unroll") for (int k = 0; k < 2; ++k) \
        acc[ai][bj][m][n] = __builtin_amdgcn_mfma_f32_16x16x32_bf16(Bt[n][k], At[m][k], acc[ai][bj][m][n], 0, 0, 0); __builtin_amdgcn_s_setprio(0); } while (0)
#define PG8_WAIT_V(n) asm volatile("s_waitcnt vmcnt(" #n ")" ::: "memory")
#define PG8_WAIT_L(n) asm volatile("s_waitcnt lgkmcnt(" #n ")" ::: "memory")
#define PG8_BAR __builtin_amdgcn_s_barrier()
#define PG8_SCHED __builtin_amdgcn_sched_barrier(0)
    Unit cur, nxt; int ui = 0;
    if (!S.next(0, cur)) return;
    f32x4 acc[2][2][4][2];
#pragma unroll
    for (int a = 0; a < 2; ++a)
#pragma unroll
        for (int b = 0; b < 2; ++b)
#pragma unroll
            for (int m = 0; m < 4; ++m)
#pragma unroll
                for (int n = 0; n < 2; ++n) acc[a][b][m][n] = (f32x4){0.f, 0.f, 0.f, 0.f};
    bf16x8 At[4][2], B0[2][2], B1[2][2];
    const char* cA = gA + cur.offA; const char* cB = gB + cur.offB;
    S.a_ready(cur);
    if constexpr (SP2) {
        PG8_STAGE(PG8_SB(0, 0), cB, voffB); PG8_STAGE(PG8_SB(0, 1), cB + hsB, voffB); PG8_STAGE(PG8_SA(0, 0), cA, voffA); PG8_STAGE(PG8_SA(0, 1), cA + hsA, voffA);
        if (wr == 1) PG8_BAR;
        PG8_WAIT_V(2); PG8_BAR;
        PG8_STAGE(PG8_SB(1, 0), cB + kstep, voffB); PG8_STAGE(PG8_SA(1, 0), cA + kstep, voffA); PG8_STAGE(PG8_SB(1, 1), cB + hsB + kstep, voffB);
        PG8_WAIT_V(6); PG8_BAR;
    } else {
        PG8_STAGE(PG8_SB(0, 0), cB, voffB); PG8_STAGE(PG8_SA(0, 0), cA, voffA); PG8_STAGE(PG8_SB(0, 1), cB + hsB, voffB); PG8_STAGE(PG8_SA(0, 1), cA + hsA, voffA);
        if (wr == 1) PG8_BAR;
        PG8_WAIT_V(4); PG8_BAR;
        PG8_STAGE(PG8_SB(1, 0), cB + kstep, voffB); PG8_STAGE(PG8_SA(1, 0), cA + kstep, voffA); PG8_STAGE(PG8_SB(1, 1), cB + hsB + kstep, voffB);
        PG8_WAIT_V(6); PG8_BAR;
    }
    for (;;) {
        const bool has_next = S.next(ui + 1, nxt);
        const char* nA = has_next ? gA + nxt.offA : cA; const char* nB = has_next ? gB + nxt.offB : cB;
        for (int t = 0; t < nt; t += 2) {
            const bool last = (t == nt - 2);
            const char* a1 = cA + (size_t)(t + 1) * kstep;
            const char* a2 = last ? nA : cA + (size_t)(t + 2) * kstep; const char* b2 = last ? nB : cB + (size_t)(t + 2) * kstep;
            const char* a3 = a2 + kstep; const char* b3 = b2 + kstep;
            if (last && has_next) S.a_ready(nxt);
            if constexpr (SP2) {
            PG8_LDB(B0, 0, 0); PG8_LDB(B1, 0, 1); PG8_SCHED; PG8_LDA(At, 0, 0); PG8_STAGE(PG8_SA(1, 1), a1 + hsA, voffA);
            PG8_WAIT_V(8); PG8_WAIT_L(0); PG8_BAR; PG8_MMA(0, 0, At, B0); PG8_MMA(0, 1, At, B1); PG8_BAR; PG8_SCHED;
            PG8_LDA(At, 0, 1); PG8_STAGE(PG8_SB(0, 0), b2, voffB); PG8_STAGE(PG8_SB(0, 1), b2 + hsB, voffB); PG8_STAGE(PG8_SA(0, 0), a2, voffA);
            PG8_WAIT_V(8); PG8_WAIT_L(0); PG8_BAR; PG8_MMA(1, 0, At, B0); PG8_MMA(1, 1, At, B1); PG8_BAR; PG8_SCHED;
            PG8_LDB(B0, 1, 0); PG8_LDB(B1, 1, 1); PG8_SCHED; PG8_LDA(At, 1, 0); PG8_STAGE(PG8_SA(0, 1), a2 + hsA, voffA);
            PG8_WAIT_V(8); PG8_WAIT_L(0); PG8_BAR; PG8_MMA(0, 0, At, B0); PG8_MMA(0, 1, At, B1); PG8_BAR; PG8_SCHED;
            PG8_LDA(At, 1, 1); PG8_STAGE(PG8_SB(1, 0), b3, voffB); PG8_STAGE(PG8_SB(1, 1), b3 + hsB, voffB); PG8_STAGE(PG8_SA(1, 0), a3, voffA);
            PG8_WAIT_V(8); PG8_WAIT_L(0); PG8_BAR; PG8_MMA(1, 0, At, B0); PG8_MMA(1, 1, At, B1); PG8_BAR; PG8_SCHED;
            } else {
            PG8_LDB(B0, 0, 0); PG8_SCHED; PG8_LDA(At, 0, 0); PG8_STAGE(PG8_SA(1, 1), a1 + hsA, voffA);
            PG8_WAIT_L(8); PG8_BAR; PG8_WAIT_L(0); PG8_MMA(0, 0, At, B0); PG8_BAR; PG8_SCHED;
            PG8_LDB(B1, 0, 1); PG8_STAGE(PG8_SB(0, 0), b2, voffB);
            PG8_BAR; PG8_WAIT_L(0); PG8_MMA(0, 1, At, B1); PG8_BAR;
            PG8_LDA(At, 0, 1); PG8_STAGE(PG8_SA(0, 0), a2, voffA);
            PG8_BAR; PG8_WAIT_L(0); PG8_MMA(1, 0, At, B0); PG8_BAR; PG8_SCHED;
            PG8_STAGE(PG8_SB(0, 1), b2 + hsB, voffB);
            PG8_WAIT_V(6); PG8_BAR; PG8_MMA(1, 1, At, B1); PG8_BAR;
            PG8_LDB(B0, 1, 0); PG8_SCHED; PG8_LDA(At, 1, 0); PG8_STAGE(PG8_SA(0, 1), a2 + hsA, voffA);
            PG8_WAIT_L(8); PG8_BAR; PG8_WAIT_L(0); PG8_MMA(0, 0, At, B0); PG8_BAR; PG8_SCHED;
            PG8_LDB(B1, 1, 1); PG8_STAGE(PG8_SB(1, 0), b3, voffB);
            PG8_BAR; PG8_WAIT_L(0); PG8_MMA(0, 1, At, B1); PG8_BAR;
            PG8_LDA(At, 1, 1); PG8_STAGE(PG8_SA(1, 0), a3, voffA);
            PG8_BAR; PG8_WAIT_L(0); PG8_MMA(1, 0, At, B0); PG8_BAR; PG8_SCHED;
            PG8_STAGE(PG8_SB(1, 1), b3 + hsB, voffB);
            PG8_WAIT_V(6); PG8_BAR; PG8_MMA(1, 1, At, B1); PG8_BAR;
            }
        }
        if constexpr (ALIGN_EPI) { if (wr == 0) PG8_BAR; }
        if constexpr (!Epi::AFTER_DRAIN) { E(acc, cur, wr, wc, fr, fq); S.done(cur); }
        if (!has_next) break;
#pragma unroll
        for (int a = 0; a < 2; ++a)
#pragma unroll
            for (int b = 0; b < 2; ++b)
#pragma unroll
                for (int m = 0; m < 4; ++m)
#pragma unroll
                    for (int n = 0; n < 2; ++n) acc[a][b][m][n] = (f32x4){0.f, 0.f, 0.f, 0.f};
        cur = nxt; cA = nA; cB = nB; ++ui;
        if constexpr (ALIGN_EPI) { if (wr == 1) PG8_BAR; }
    }
    PG8_WAIT_V(0);
    if constexpr (!ALIGN_EPI) { if (wr == 0) PG8_BAR; }
    PG8_BAR;
    if constexpr (Epi::AFTER_DRAIN) { E.fused(acc, cur, wr, wc, fr, fq, lds, wid, lane); S.done(cur); }
#undef PG8_SA
#undef PG8_SB
#undef PG8_STAGE
#undef PG8_LDA
#undef PG8_LDB
#undef PG8_MMA
#undef PG8_WAIT_V
#undef PG8_WAIT_L
#undef PG8_BAR
#undef PG8_SCHED
}
}

#include <hip/hip_bf16.h>
#include <cmath>
namespace attn_body {
using bf16=__hip_bfloat16;
using bf16x8=__attribute__((ext_vector_type(8)))short;
using s16x4=__attribute__((ext_vector_type(4)))short;
using f32x16=__attribute__((ext_vector_type(16)))float;
using u32x4=__attribute__((ext_vector_type(4)))unsigned;
constexpr int BATCH=8,NHEAD=16,SEQ=2048,D=64,DM=NHEAD*D;
constexpr int NW=8,QBLK=32,QB=QBLK*NW,KVBLK=64,NQB=SEQ/QB;
constexpr int ATTN_PITCH=DM, ATTN_UNIT_ROWS=QB;
__device__ __forceinline__ int crow(int r,int hi){return (r&3)+8*(r>>2)+4*hi;}
#define SBAR() __builtin_amdgcn_sched_barrier(0)
__device__ __forceinline__ void cmask(f32x16&p0,f32x16&p1,int jb,int qrel,int hi){
  const float NEG=-INFINITY; int kb=64*jb+4*hi;
  #pragma unroll
  for(int r=0;r<16;++r){int kv=kb+(r&3)+8*(r>>2); if(kv>qrel)p0[r]=NEG; if(kv+32>qrel)p1[r]=NEG;}
}

constexpr int NSLOT=3, SLOTB=8192;
constexpr int LDS_K=0, LDS_V=NSLOT*SLOTB, LDS_WS=2*NSLOT*SLOTB, LDS_OST=LDS_WS+NW*64*4, LDS_BYTES=LDS_OST+NW*4096;
constexpr float C2=0.125f*1.4426950408889634f;
__device__ __forceinline__ void glds16(const void*gsrc,unsigned lds_dst){unsigned keep;
  asm volatile("s_mov_b32 %0, m0\n\ts_mov_b32 m0, %2\n\ts_nop 0\n\tglobal_load_lds_dwordx4 %1, off\n\ts_mov_b32 m0, %0":"=&s"(keep):"v"(gsrc),"s"(lds_dst):"memory");}
__device__ __forceinline__ float max3f(float a,float b,float c){float r;asm("v_max3_f32 %0, %1, %2, %3":"=v"(r):"v"(a),"v"(b),"v"(c));return r;}
__device__ __forceinline__ float max2f(float a,float b){float r;asm("v_max_f32_e32 %0, %1, %2":"=v"(r):"v"(a),"v"(b));return r;}
__device__ __forceinline__ float fadd_s(float a,float b){float r;asm("v_add_f32_e32 %0, %1, %2":"=v"(r):"v"(a),"v"(b));return r;}
__device__ __forceinline__ float fsub_s(float a,float b){float r;asm("v_sub_f32_e32 %0, %1, %2":"=v"(r):"v"(a),"v"(b));return r;}
typedef float f32x2_t __attribute__((ext_vector_type(2))); typedef __bf16 bf16x2_t __attribute__((ext_vector_type(2)));
__device__ __forceinline__ unsigned cvtpk_s(float lo,float hi){f32x2_t v={lo,hi};bf16x2_t b=__builtin_convertvector(v,bf16x2_t);return __builtin_bit_cast(unsigned,b);}
#define WAIT_BAR(N) asm volatile("s_waitcnt vmcnt(" #N ") lgkmcnt(0)\n\ts_barrier":::"memory")

__device__ __forceinline__ void qkt(f32x16&p0,f32x16&p1,const char*Kslot,const bf16x8*qr,const f32x16&negm,int r32,int hi){
  const char*kb=Kslot+hi*1024+r32*16;
  #pragma unroll
  for(int d0=0;d0<4;++d0){
    const bf16x8 b0=*reinterpret_cast<const bf16x8*>(kb+d0*2048);
    const bf16x8 b1=*reinterpret_cast<const bf16x8*>(kb+d0*2048+512);
    if(d0==0){p0=__builtin_amdgcn_mfma_f32_32x32x16_bf16(b0,qr[0],negm,0,0,0);p1=__builtin_amdgcn_mfma_f32_32x32x16_bf16(b1,qr[0],negm,0,0,0);}
    else{p0=__builtin_amdgcn_mfma_f32_32x32x16_bf16(b0,qr[d0],p0,0,0,0);p1=__builtin_amdgcn_mfma_f32_32x32x16_bf16(b1,qr[d0],p1,0,0,0);}}
}
typedef __attribute__((address_space(3))) const char* lds_cptr;
typedef short v4i16_t __attribute__((ext_vector_type(4)));
__device__ __forceinline__ void kload8(bf16x8*kf,lds_cptr kp){
  kf[0]=*(const __attribute__((address_space(3))) bf16x8*)(kp);      kf[1]=*(const __attribute__((address_space(3))) bf16x8*)(kp+512);
  kf[2]=*(const __attribute__((address_space(3))) bf16x8*)(kp+2048); kf[3]=*(const __attribute__((address_space(3))) bf16x8*)(kp+2560);
  kf[4]=*(const __attribute__((address_space(3))) bf16x8*)(kp+4096); kf[5]=*(const __attribute__((address_space(3))) bf16x8*)(kp+4608);
  kf[6]=*(const __attribute__((address_space(3))) bf16x8*)(kp+6144); kf[7]=*(const __attribute__((address_space(3))) bf16x8*)(kp+6656);
}
__device__ __forceinline__ void kload2(bf16x8*kf,lds_cptr kp,int j){ kf[2*j]=*(const __attribute__((address_space(3))) bf16x8*)(kp+j*2048); kf[2*j+1]=*(const __attribute__((address_space(3))) bf16x8*)(kp+j*2048+512); }
__device__ __forceinline__ s16x4 vtr(lds_cptr p){ return __builtin_bit_cast(s16x4,__builtin_amdgcn_ds_read_tr16_b64_v4i16((__attribute__((address_space(3))) v4i16_t*)p)); }
__device__ __forceinline__ float rowmax(const f32x16&p0,const f32x16&p1){
  float a=max3f(p0[0],p0[1],p1[0]),b=max3f(p0[2],p0[3],p1[1]);a=max3f(a,p1[2],p1[3]);
  #pragma unroll
  for(int r=4;r<16;r+=4){a=max3f(a,p0[r],p0[r+1]);b=max3f(b,p0[r+2],p0[r+3]);a=max3f(a,p1[r],p1[r+1]);b=max3f(b,p1[r+2],p1[r+3]);}
  const float m=max2f(a,b);
  auto rr=__builtin_amdgcn_permlane32_swap(__float_as_uint(m),__float_as_uint(m),false,false);
  return max2f(__uint_as_float(rr[0]),__uint_as_float(rr[1]));
}
__device__ __forceinline__ void pv(f32x16*o,int vb,bf16x8 pa0,bf16x8 pa1,bf16x8 pa2,bf16x8 pa3){
  #pragma unroll
  for(int d0=0;d0<2;++d0){s16x4 lo[4],hi[4];
    #pragma unroll
    for(int ks=0;ks<4;++ks){
      asm volatile("ds_read_b64_tr_b16 %0,%1 offset:%c2":"=&v"(lo[ks]):"v"(vb),"i"(d0*4096+ks*1024):"memory");
      asm volatile("ds_read_b64_tr_b16 %0,%1 offset:%c2":"=&v"(hi[ks]):"v"(vb),"i"(d0*4096+ks*1024+512):"memory");}
    asm volatile("s_waitcnt lgkmcnt(0)":::"memory");SBAR();
    #define PK(k) (bf16x8){lo[k][0],lo[k][1],lo[k][2],lo[k][3],hi[k][0],hi[k][1],hi[k][2],hi[k][3]}
    o[d0]=__builtin_amdgcn_mfma_f32_32x32x16_bf16(pa0,PK(0),o[d0],0,0,0);
    o[d0]=__builtin_amdgcn_mfma_f32_32x32x16_bf16(pa1,PK(1),o[d0],0,0,0);
    o[d0]=__builtin_amdgcn_mfma_f32_32x32x16_bf16(pa2,PK(2),o[d0],0,0,0);
    o[d0]=__builtin_amdgcn_mfma_f32_32x32x16_bf16(pa3,PK(3),o[d0],0,0,0);
    #undef PK
  }
}

#ifndef ATTN_STORE16
#define ATTN_STORE16(p,v) (*(u32x4*)(p)=(v))
#endif
template<int THRL> __device__ __forceinline__ void attn_unit(int b,int h,int hv,int qb,const bf16*Q,const bf16*__restrict__ K,const bf16*__restrict__ V,bf16*O,char*shm){
  int tid_=threadIdx.x; asm volatile("":"+v"(tid_)); const int tid=tid_,lane=tid&63,r32=lane&31,hi=lane>>5; const int wid=__builtin_amdgcn_readfirstlane(tid>>6);
  const long rowbase=(long)b*SEQ; const int q0=qb*QB;
  const bf16*Qw=Q+(rowbase+q0+wid*QBLK)*DM+h*D;
  const bf16*Kh=K+rowbase*DM+h*D,*Vh=V+rowbase*DM+hv*D;
  const unsigned lds0=(unsigned)(uintptr_t)shm;
  float*wsf=(float*)(shm+LDS_WS)+wid*64;
  const bf16*ksrc=Kh+(long)lane*DM+wid*8;
  const bf16*vsrc=Vh+(long)(16*(wid&3)+(lane>>2))*DM+(wid>>2)*32+(lane&3)*8;
  const unsigned kdst=lds0+LDS_K+wid*1024, vdst=lds0+LDS_V+wid*1024;
  #define DMA_K(t,slot) glds16(ksrc+(long)(t)*KVBLK*DM,(unsigned)__builtin_amdgcn_readfirstlane(kdst+(slot)))
  #define DMA_V(t,slot) glds16(vsrc+(long)(t)*KVBLK*DM,(unsigned)__builtin_amdgcn_readfirstlane(vdst+(slot)))
  const int vb0=(int)(lds0+LDS_V)+((lane>>4)&1)*32+(lane&3)*8+(4*hi+((lane&15)>>2))*64;
  const char*Kbase=shm+LDS_K; bf16x8 kf[8];
  const lds_cptr shm3=(lds_cptr)shm; const lds_cptr kp0=shm3+LDS_K+hi*1024+r32*16; const lds_cptr vp0=shm3+LDS_V+((lane>>4)&1)*32+(lane&3)*8+(4*hi+((lane&15)>>2))*64;
  const int NT=(q0+QB)/KVBLK;
  DMA_K(0,0);DMA_V(0,0);DMA_K(1,SLOTB);
  bf16x8 qr[4];
  #pragma unroll
  for(int d0=0;d0<4;++d0)qr[d0]=*reinterpret_cast<const bf16x8*>(&Qw[(long)r32*DM+d0*16+hi*8]);
  float mhat=0.f,l_reg=0.f;f32x16 o[2];o[0]=f32x16{};o[1]=f32x16{};f32x16 negm=f32x16{};asm volatile("":"+v"(negm));
  const int qrel=wid*QBLK+r32;
  #define CMASK(P0,P1,t) do{int jb_=(t)-(NT-4); if(jb_>=0)cmask(P0,P1,jb_,qrel,hi);}while(0)
  bool resc=false;
  #define START(P0,P1) do{ const float rm=rowmax(P0,P1); resc=false; \
    { const float dl=rm; mhat=fadd_s(mhat,dl); \
      _Pragma("unroll") for(int r=0;r<16;++r){P0[r]=fsub_s(P0[r],dl);P1[r]=fsub_s(P1[r],dl);} \
      _Pragma("unroll") for(int r=0;r<16;++r)negm[r]=-mhat; asm volatile("":"+v"(negm)); } \
    _Pragma("unroll") for(int r=0;r<16;++r)P0[r]=__builtin_amdgcn_exp2f(P0[r]); }while(0)
  #define RESC() do{ if(resc){ asm volatile("s_waitcnt lgkmcnt(0)":::"memory"); \
      _Pragma("unroll") for(int d_=0;d_<2;++d_) _Pragma("unroll") for(int r=0;r<16;++r)o[d_][r]*=wsf[crow(r,hi)]; } }while(0)
  f32x16 pA0,pA1,pB0,pB1;
  int sl_prev=0,sl_cur=0,sl_next=SLOTB;
  #define ROT() do{sl_prev=sl_cur;sl_cur=sl_next;sl_next=(sl_next==(NSLOT-1)*SLOTB)?0:sl_next+SLOTB;}while(0)
  DMA_K(2,2*SLOTB);
  WAIT_BAR(3);
  qkt(pA0,pA1,Kbase,qr,negm,r32,hi);asm volatile("s_nop 15\n\ts_nop 7":"+v"(pA0),"+v"(pA1));CMASK(pA0,pA1,0);
  START(pA0,pA1);
  _Pragma("unroll") for(int r=0;r<16;++r)pA1[r]=__builtin_amdgcn_exp2f(pA1[r]);
  WAIT_BAR(0);
  DMA_K(3,0);DMA_V(1,SLOTB);
  ROT();
  kload8(kf,kp0+sl_cur);
  WAIT_BAR(2);
  s16x4 vlo[8],vhi[8]; u32x4 pw0,pw1,pw2,pw3;
  #define PKW(P,B) cvtpk_s(P[B],P[B+1])
  #define PAF(k) __builtin_bit_cast(bf16x8,pw##k)
  #define VFR(i) (bf16x8){vlo[i][0],vlo[i][1],vlo[i][2],vlo[i][3],vhi[i][0],vhi[i][1],vhi[i][2],vhi[i][3]}
  #define PIN(x) asm volatile("":"+v"(x))
  #define MX3(a,b,c) __builtin_fmaxf(__builtin_fmaxf((a),(b)),(c))
  #define GAPA(MF,A0,A1,A2,A3,W0,W1,PW) do{ MF; sacc+=A0; sacc+=A1; sacc+=A2; sacc+=A3; PIN(sacc); W0; W1; PIN(PW); SBAR(); }while(0)
  #define EX(v) __builtin_amdgcn_exp2f(v)
  #define GAPB(MF,X,B) do{ MF; X[B]=EX(X[B]); X[B+1]=EX(X[B+1]); X[B+2]=EX(X[B+2]); X[B+3]=EX(X[B+3]); PIN(X); SBAR(); }while(0)
  #define VRD(i) do{ vlo[i]=vtr(vp_+(((i)>>2)*4096+((i)&3)*1024)); vhi[i]=vtr(vp_+(((i)>>2)*4096+((i)&3)*1024+512)); }while(0)
  #define KRD(G,j) do{ if(G){ kload2(kf,kp0+sl_next,j); SBAR(); } }while(0)
  #define STEP(C0,C1,P0,P1,t,GK,GV,GL) do{ SBAR(); \
    const lds_cptr vp_=vp0+sl_prev; \
    VRD(0); SBAR(); float sacc=(P0[0]+P0[1]); \
    GAPA(C0=__builtin_amdgcn_mfma_f32_32x32x16_bf16(kf[0],qr[0],negm,0,0,0), P0[2],P0[3],P0[4],P0[5],     pw0[0]=PKW(P0,0), pw0[1]=PKW(P0,2), pw0); \
    VRD(4); SBAR(); GAPA(C1=__builtin_amdgcn_mfma_f32_32x32x16_bf16(kf[1],qr[0],negm,0,0,0), P0[6],P0[7],P0[8],P0[9],     pw0[2]=PKW(P0,4), pw0[3]=PKW(P0,6), pw0); \
    VRD(1); SBAR(); GAPA(C0=__builtin_amdgcn_mfma_f32_32x32x16_bf16(kf[2],qr[1],C0,0,0,0),   P0[10],P0[11],P0[12],P0[13], pw1[0]=PKW(P0,8), pw1[1]=PKW(P0,10), pw1); \
    VRD(5); SBAR(); GAPA(C1=__builtin_amdgcn_mfma_f32_32x32x16_bf16(kf[3],qr[1],C1,0,0,0),   P0[14],P0[15],P1[0],P1[1],   pw1[2]=PKW(P0,12),pw1[3]=PKW(P0,14), pw1); \
    VRD(2); SBAR(); GAPA(C0=__builtin_amdgcn_mfma_f32_32x32x16_bf16(kf[4],qr[2],C0,0,0,0),   P1[2],P1[3],P1[4],P1[5],     pw2[0]=PKW(P1,0), pw2[1]=PKW(P1,2), pw2); \
    VRD(6); SBAR(); GAPA(C1=__builtin_amdgcn_mfma_f32_32x32x16_bf16(kf[5],qr[2],C1,0,0,0),   P1[6],P1[7],P1[8],P1[9],     pw2[2]=PKW(P1,4), pw2[3]=PKW(P1,6), pw2); \
    VRD(3); SBAR(); GAPA(C0=__builtin_amdgcn_mfma_f32_32x32x16_bf16(kf[6],qr[3],C0,0,0,0),   P1[10],P1[11],P1[12],P1[13], pw3[0]=PKW(P1,8), pw3[1]=PKW(P1,10), pw3); \
    VRD(7); SBAR(); GAPA(C1=__builtin_amdgcn_mfma_f32_32x32x16_bf16(kf[7],qr[3],C1,0,0,0),   P1[14],P1[15],0.f,0.f,       pw3[2]=PKW(P1,12),pw3[3]=PKW(P1,14), pw3); \
    l_reg+=sacc; \
    if(GK){DMA_K((t)+3,sl_cur);} if(GV){DMA_V((t)+1,sl_next);} \
    CMASK(C0,C1,t); \
    { float a=MX3(C0[0],C0[1],C1[0]),b=MX3(C0[2],C0[3],C1[1]); a=MX3(a,C1[2],C1[3]); \
      _Pragma("unroll") for(int r=4;r<16;r+=4){a=MX3(a,C0[r],C0[r+1]);b=MX3(b,C0[r+2],C0[r+3]);a=MX3(a,C1[r],C1[r+1]);b=MX3(b,C1[r+2],C1[r+3]);} \
      float rm=__builtin_fmaxf(a,b); { auto rr=__builtin_amdgcn_permlane32_swap(__float_as_uint(rm),__float_as_uint(rm),false,false); rm=__builtin_fmaxf(__uint_as_float(rr[0]),__uint_as_float(rr[1])); } \
      resc=false; \
      if(__builtin_expect(__any(rm>(float)THRL),0)){ const float dl=__builtin_fmaxf(rm,0.f); mhat+=dl; \
        _Pragma("unroll") for(int r=0;r<16;++r){C0[r]-=dl;C1[r]-=dl;} \
        _Pragma("unroll") for(int r=0;r<16;++r)negm[r]=-mhat; asm volatile("":"+v"(negm)); \
        const float f=__builtin_amdgcn_exp2f(-dl); l_reg*=f; if(hi==0)wsf[r32]=f; resc=true; } } \
    SBAR(); \
    GAPB(o[0]=__builtin_amdgcn_mfma_f32_32x32x16_bf16(PAF(0),VFR(0),o[0],0,0,0), C0,0); \
    GAPB(o[1]=__builtin_amdgcn_mfma_f32_32x32x16_bf16(PAF(0),VFR(4),o[1],0,0,0), C0,4); \
    KRD(GL,0); GAPB(o[0]=__builtin_amdgcn_mfma_f32_32x32x16_bf16(PAF(1),VFR(1),o[0],0,0,0), C0,8); \
    KRD(GL,1); GAPB(o[1]=__builtin_amdgcn_mfma_f32_32x32x16_bf16(PAF(1),VFR(5),o[1],0,0,0), C0,12); \
    KRD(GL,2); GAPB(o[0]=__builtin_amdgcn_mfma_f32_32x32x16_bf16(PAF(2),VFR(2),o[0],0,0,0), C1,0); \
    KRD(GL,3); GAPB(o[1]=__builtin_amdgcn_mfma_f32_32x32x16_bf16(PAF(2),VFR(6),o[1],0,0,0), C1,4); \
    GAPB(o[0]=__builtin_amdgcn_mfma_f32_32x32x16_bf16(PAF(3),VFR(3),o[0],0,0,0), C1,8); \
    GAPB(o[1]=__builtin_amdgcn_mfma_f32_32x32x16_bf16(PAF(3),VFR(7),o[1],0,0,0), C1,12); \
    }while(0)
  int t=1;
  #undef CMASK
  #define CMASK(P0,P1,t) do{}while(0)
  for(;t+5<NT;t+=2){
    STEP(pB0,pB1,pA0,pA1,t,true,true,true);     WAIT_BAR(2); RESC(); ROT();
    STEP(pA0,pA1,pB0,pB1,t+1,true,true,true);   WAIT_BAR(2); RESC(); ROT();
  }
  #undef CMASK
  #define CMASK(P0,P1,t) do{int jb_=(t)-(NT-4); if(jb_>=0)cmask(P0,P1,jb_,qrel,hi);}while(0)
  #define ENDW(tt) do{ if((tt)+3<NT){WAIT_BAR(2);} else if((tt)+2<NT){WAIT_BAR(1);} else {WAIT_BAR(0);} }while(0)
  for(;t+1<NT;t+=2){
    STEP(pB0,pB1,pA0,pA1,t,(t+3<NT),(t+1<NT),(t+1<NT));       ENDW(t);   RESC(); ROT();
    STEP(pA0,pA1,pB0,pB1,t+1,(t+4<NT),(t+2<NT),(t+2<NT));     ENDW(t+1); RESC(); ROT();
  }
  STEP(pB0,pB1,pA0,pA1,NT-1,false,false,false); RESC();
  { float sacc=pB0[0]+pB0[1]; _Pragma("unroll") for(int r=2;r<16;++r)sacc+=pB0[r]; _Pragma("unroll") for(int r=0;r<16;++r)sacc+=pB1[r]; l_reg+=sacc;
    pw0=(u32x4){PKW(pB0,0),PKW(pB0,2),PKW(pB0,4),PKW(pB0,6)};pw1=(u32x4){PKW(pB0,8),PKW(pB0,10),PKW(pB0,12),PKW(pB0,14)};pw2=(u32x4){PKW(pB1,0),PKW(pB1,2),PKW(pB1,4),PKW(pB1,6)};pw3=(u32x4){PKW(pB1,8),PKW(pB1,10),PKW(pB1,12),PKW(pB1,14)};
    SBAR(); pv(o,vb0+sl_cur,PAF(0),PAF(1),PAF(2),PAF(3)); }
  #undef PKW
  #undef PAF
  #undef VFR
  #undef PIN
  #undef MX3
  #undef GAPA
  #undef GAPB
  #undef EX
  #undef VRD
  #undef KRD
  #undef STEP
  #undef ENDW
  {auto rr=__builtin_amdgcn_permlane32_swap(__float_as_uint(l_reg),__float_as_uint(l_reg),false,false);l_reg=__uint_as_float(rr[0])+__uint_as_float(rr[1]);}
  if(hi==0)wsf[32+r32]=l_reg;asm volatile("s_waitcnt lgkmcnt(0)":::"memory");
  float rli[16];
  #pragma unroll
  for(int r=0;r<16;++r)rli[r]=__builtin_amdgcn_rcpf(wsf[32+crow(r,hi)]);
  bf16*Ow=O+(rowbase+q0+wid*QBLK)*DM+hv*D;
  { bf16*stg=(bf16*)(shm+LDS_OST)+wid*2048;
    #pragma unroll
    for(int r=0;r<16;++r){const int orow=crow(r,hi);
      #pragma unroll
      for(int d0=0;d0<2;++d0)stg[orow*64+d0*32+r32]=__float2bfloat16(o[d0][r]*rli[r]);}
    asm volatile("s_waitcnt lgkmcnt(0)":::"memory");
    #pragma unroll
    for(int i=0;i<4;++i){const int row=i*8+(lane>>3),ch=lane&7; const u32x4 v=*(const u32x4*)(stg+row*64+ch*8); ATTN_STORE16(Ow+(long)row*DM+ch*8,v);} }
  asm volatile("s_waitcnt lgkmcnt(0)\n\ts_barrier":::"memory");
  #undef DMA_K
  #undef DMA_V
  #undef CMASK
  #undef START
  #undef RESC
  #undef ROT
}
constexpr int ATTN_LDS_BYTES=LDS_BYTES;
struct AttnTensors { const bf16* Q; const bf16* K; const bf16* V; bf16* O; };
struct AttnUnit { int b, hq, hv, m, qb; };
struct StaticOrder {
  int vcu, G;
  __device__ __forceinline__ explicit StaticOrder(int grid,int block):vcu((grid%8==0)?(block%8)*(grid/8)+block/8:block),G(grid){}
  __device__ __forceinline__ bool next(int i,AttnUnit&u)const{ const int g=vcu+(i>>3)*G; if(g>=256)return false; const int vh=g&1,m=(g>>1)&1,h8=(g>>2)&7; u.b=g>>5; u.hq=2*h8+m; u.hv=2*h8+vh; u.m=m; u.qb=7-(i&7); return true; }
  __device__ __forceinline__ void a_ready(const AttnUnit&)const{}
  __device__ __forceinline__ void done(const AttnUnit&)const{}
};
template<class Sched,int THRL=8> __device__ __forceinline__ void attn_phase(char*lds,const AttnTensors&T,const Sched&S){
  AttnUnit u; const bf16*Qp=pg8::uni_ptr(T.Q),*Kp=pg8::uni_ptr(T.K),*Vp=pg8::uni_ptr(T.V); bf16*Op=pg8::uni_ptr(T.O);
  for(int i=0;S.next(i,u);++i){ S.a_ready(u); attn_unit<THRL>(u.b,u.hq,u.hv,u.qb,Qp,Kp,Vp,Op+(size_t)u.m*((size_t)BATCH*SEQ*DM),lds); S.done(u); }
}
#undef SBAR
#undef WAIT_BAR
}
#define GAS __attribute__((address_space(1)))
#define LAS __attribute__((address_space(3)))
typedef unsigned short bf16;
typedef unsigned v4u __attribute__((ext_vector_type(4)));
typedef float f32x4 __attribute__((ext_vector_type(4)));
typedef short bf16x8 __attribute__((ext_vector_type(8)));
typedef GAS unsigned gu32;
typedef GAS unsigned long long gu64;
#define RLX_AGENT __ATOMIC_RELAXED, __HIP_MEMORY_SCOPE_AGENT
#define LDS_WAIT() asm volatile("s_waitcnt lgkmcnt(0)" ::: "memory")
#define VM_WAIT() asm volatile("s_waitcnt vmcnt(0)" ::: "memory")
__device__ __forceinline__ unsigned long long rt() { return __builtin_amdgcn_s_memrealtime(); }
__device__ __forceinline__ unsigned f2bf(float f) { unsigned u = __builtin_bit_cast(unsigned, f); return (u + 0x7fffu + ((u >> 16) & 1u)) >> 16; }
__device__ __forceinline__ unsigned pk2(float lo, float hi) { return f2bf(lo) | (f2bf(hi) << 16); }

#define XB_TMO      128
#define XB_XCNT(j)  (256  + 64 * (j))
#define XB_XSUB(j)  (1280 + 64 * (j))
#define XB_XGEN(j)  (2304 + 64 * (j))
#define XB_TOP      3328
#define XB_TOPGEN   3392
#define XCD_BAR_WORDS 3456
#define XB_SPIN_CAP (1u << 18)

__device__ __forceinline__ unsigned xb_ld(unsigned* p)              { return __hip_atomic_load(p, __ATOMIC_RELAXED, __HIP_MEMORY_SCOPE_AGENT); }
__device__ __forceinline__ unsigned xb_add(unsigned* p, unsigned v) { return __hip_atomic_fetch_add(p, v, __ATOMIC_RELAXED, __HIP_MEMORY_SCOPE_AGENT); }
__device__ __forceinline__ unsigned xb_xcc_id() { return (unsigned)__builtin_amdgcn_s_getreg((3 << 11) | 20) & 0xFu; }
#define XB_SPIN(cond, bar) do { unsigned _sp = 0; while (cond) { __builtin_amdgcn_s_sleep(1); \
    if ((++_sp & 255u) == 0u) { if (xb_ld(&(bar)[XB_TMO])) break; if (_sp > XB_SPIN_CAP) { atomicAdd(&(bar)[XB_TMO], 1u); break; } } } } while (0)

struct XcdBarrier {
    unsigned* bar; unsigned x;
    volatile LAS unsigned* st;
};

__device__ __forceinline__ XcdBarrier xcd_barrier_post(unsigned* bar, volatile LAS unsigned* st) {
    XcdBarrier b; b.bar = bar; b.x = xb_xcc_id(); b.st = st;
    if (threadIdx.x == 0) (void)xb_add(&bar[XB_XCNT(b.x)], 1u);
    return b;
}
__device__ __forceinline__ void xcd_barrier_complete(unsigned* bar, unsigned x, unsigned& nloc, unsigned& nx) {
    const unsigned G = gridDim.x * gridDim.y * gridDim.z;
    unsigned sum, cnt, mine, sp = 0u;
    for (;;) {
        sum = 0u; cnt = 0u; mine = 0u;
#pragma unroll
        for (unsigned j = 0; j < 16; ++j) { const unsigned c = xb_ld(&bar[XB_XCNT(j)]); sum += c; cnt += (c > 0u) ? 1u : 0u; mine = (j == x) ? c : mine; }
        if (sum == G) break;
        __builtin_amdgcn_s_sleep(1);
        if ((++sp & 255u) == 0u) { if (xb_ld(&bar[XB_TMO])) break; if (sp > XB_SPIN_CAP) { atomicAdd(&bar[XB_TMO], 1u); break; } }
    }
    nloc = mine > 0u ? mine : 1u; nx = cnt > 0u ? cnt : 1u;
}

__device__ __forceinline__ void xcd_barrier(const XcdBarrier& b) {
    asm volatile("s_waitcnt vmcnt(0)" ::: "memory");
    __syncthreads();
    if (threadIdx.x == 0) {
        unsigned* bar = b.bar;
        __builtin_amdgcn_s_waitcnt(0);
        unsigned nloc = b.st[0], nx = b.st[1];
        if (nloc == 0u) { xcd_barrier_complete(bar, b.x, nloc, nx); b.st[0] = nloc; b.st[1] = nx; }
        const unsigned old = xb_add(&bar[XB_XSUB(b.x)], 1u);
        const unsigned gen = old / nloc;
        if (old + 1u == (gen + 1u) * nloc) {
            __builtin_amdgcn_fence(__ATOMIC_RELEASE, "agent");
            asm volatile("s_waitcnt vmcnt(0)" ::: "memory");
            const unsigned og = xb_add(&bar[XB_TOP], 1u);
            const unsigned tg = og / nx;
            if (og + 1u == (tg + 1u) * nx) xb_add(&bar[XB_TOPGEN], 1u);
            else XB_SPIN(xb_ld(&bar[XB_TOPGEN]) == tg, bar);
            __builtin_amdgcn_fence(__ATOMIC_ACQUIRE, "agent");
            xb_add(&bar[XB_XGEN(b.x)], 1u);
            asm volatile("s_waitcnt vmcnt(0)" ::: "memory");
        } else {
            XB_SPIN(xb_ld(&bar[XB_XGEN(b.x)]) == gen, bar);
            __builtin_amdgcn_fence(__ATOMIC_ACQUIRE, "agent");
            asm volatile("s_waitcnt vmcnt(0)" ::: "memory");
        }
    }
    __syncthreads();
}

constexpr int NWAVES = 8;
constexpr int NB = 8, NT_ = 2048, DM_ = 2048, M = NB * NT_;
constexpr int MIXW = 1024, INC = 15360, FFH = 5632, MEMROWS = 2048;
constexpr int DEPTH = 2, NPH = 16;
constexpr float EPSN = 1e-6f;
constexpr float LOG2E = 1.4426950408889634f;

constexpr size_t MiB = 1u << 20;
constexpr size_t WS_CTL = 0, CTL_ZERO_BYTES = 1 * MiB;
constexpr size_t WS_DCS = 1 * MiB, WS_RCS = 2 * MiB;
constexpr size_t WS_W = 4 * MiB;
constexpr size_t W_IN = WS_W, W_BR = W_IN + 60 * MiB, W_OUT = W_BR + 12 * MiB, W_Q = W_OUT + 8 * MiB, W_KV = W_Q + 8 * MiB, W_O = W_KV + 16 * MiB, W_13 = W_O + 8 * MiB, W_2 = W_13 + 44 * MiB, W_END = W_2 + 22 * MiB;
constexpr size_t WS_XN = W_END;
constexpr size_t WS_MN = WS_XN + 64 * MiB, WS_KM = WS_MN + 8 * MiB, WS_VT = WS_KM + 8 * MiB;
constexpr size_t WS_Y = WS_VT + 8 * MiB;
constexpr size_t WS_YRAW = WS_Y + 96 * MiB;
constexpr size_t WS_BIG = WS_YRAW + 64 * MiB;
constexpr size_t SEG = 32 * MiB, SEG_E = (size_t)16384 * 1024;
constexpr size_t WS_END = WS_BIG + 15 * SEG;
static_assert(W_END == 182 * MiB && WS_END == 910 * MiB, "d_ws map");
constexpr int CW_TMO = 0, CW_BAR = 4096;

constexpr int RING_OFF = 0, RING_BYTES = 131072;
constexpr int LDSCTL_OFF = RING_BYTES, MISC_OFF = LDSCTL_OFF + 320;
constexpr int LDS_BYTES = 147456;
static_assert(MISC_OFF + 128 <= LDS_BYTES, "LDS map");

struct Args { const float* in[22]; float* out; unsigned char* ws; int l_lo, l_hi; };
struct Frame {
    LAS unsigned char* lds;
    volatile LAS unsigned* MISC;
    int vcu, G;
};
#define PH_ENTER() int tid = threadIdx.x; asm volatile("" : "+v"(tid)); const int lane = tid & 63, wave = __builtin_amdgcn_readfirstlane(tid >> 6); \
    unsigned char* ws = pg8::uni_ptr(args.ws); (void)lane; (void)wave; (void)tid
__device__ __forceinline__ float wave_sum(float v) {
#pragma unroll
    for (int o = 1; o < 64; o <<= 1) v += __shfl_xor(v, o);
    return v;
}
__device__ __forceinline__ float bflo(unsigned w) { return __uint_as_float(w << 16); }
__device__ __forceinline__ float bfhi(unsigned w) { return __uint_as_float(w & 0xffff0000u); }
__device__ __forceinline__ float sigm(float x) { return __builtin_amdgcn_rcpf(1.0f + __builtin_amdgcn_exp2f(-LOG2E * x)); }

template <int CMAP> __device__ __forceinline__ void transpose_item(const float* W, int K, int N, bf16* WT, LAS float* scr, int item, int lane) {
    const int nblk = N / 32, kb = item / nblk, nb = item % nblk, k0 = 64 * kb, n0 = 32 * nb;
    const int nn = n0 + (lane & 31); const int sc = CMAP == 1 ? ((nn & 1) * FFH + (nn >> 1)) : nn;
#pragma unroll 8
    for (int i = 0; i < 32; ++i) { const int kk = 2 * i + (lane >> 5); scr[kk * 33 + (lane & 31)] = W[(size_t)(k0 + kk) * N + sc]; }
    LDS_WAIT(); asm volatile("" ::: "memory");
    const int c = lane & 7;
#pragma unroll
    for (int j = 0; j < 4; ++j) { const int n = (lane >> 3) + 8 * j; const LAS float* s = scr + (8 * c) * 33 + n;
        v4u o; o.x = pk2(s[0 * 33], s[1 * 33]); o.y = pk2(s[2 * 33], s[3 * 33]); o.z = pk2(s[4 * 33], s[5 * 33]); o.w = pk2(s[6 * 33], s[7 * 33]);
        *(GAS v4u*)(WT + (size_t)(n0 + n) * K + k0 + 8 * c) = o; }
    LDS_WAIT(); asm volatile("" ::: "memory");
}
template <bool TOF32> __device__ __forceinline__ void rms_row(int lane, const float* xrow, const float* gain, void* orow) {
    const GAS f32x4* xr = (const GAS f32x4*)xrow + lane; const GAS f32x4* gr = (const GAS f32x4*)gain + lane;
    f32x4 v[8]; float s = 0.f;
#pragma unroll
    for (int j = 0; j < 8; ++j) { v[j] = xr[64 * j]; s += (v[j].x * v[j].x + v[j].y * v[j].y) + (v[j].z * v[j].z + v[j].w * v[j].w); }
    const float r = 1.0f / sqrtf(wave_sum(s) * (1.f / 2048.f) + EPSN);
#pragma unroll
    for (int j = 0; j < 8; ++j) { const f32x4 g = gr[64 * j]; const f32x4 y = v[j] * r * g;
        if (TOF32) ((GAS f32x4*)orow + lane)[64 * j] = y;
        else ((GAS unsigned long long*)orow + lane)[64 * j] = (unsigned long long)pk2(y.x, y.y) | ((unsigned long long)pk2(y.z, y.w) << 32); }
}

__device__ __forceinline__ void ph_prep(Frame& F, const Args& args, int l, const float* xcur) {
    PH_ENTER();
    LAS float* scr = (LAS float*)(F.lds + RING_OFF + wave * 16384);
    const int gw = F.vcu * NWAVES + wave, NGW = F.G * NWAVES;
    constexpr int I_IN = 32 * (INC / 32), I_BR = 16 * 64, I_SQ = 32 * 64, I_KV = 32 * 128, I_13 = 32 * (2 * FFH / 32), I_2 = (FFH / 64) * 64;
    constexpr int NITEMS = I_IN + 3 * I_BR + I_SQ + I_SQ + I_KV + I_SQ + I_13 + I_2;
    for (int it = gw; it < NITEMS; it += NGW) {
        int r = it;
        if (r < I_IN) { transpose_item<0>(args.in[3] + (size_t)l * DM_ * INC, DM_, INC, (bf16*)(ws + W_IN), scr, r, lane); continue; } r -= I_IN;
        if (r < 3 * I_BR) { const int br = r / I_BR; transpose_item<0>(args.in[11] + ((size_t)l * 3 + br) * MIXW * DM_, MIXW, DM_, (bf16*)(ws + W_BR) + (size_t)br * DM_ * MIXW, scr, r % I_BR, lane); continue; } r -= 3 * I_BR;
        if (r < I_SQ) { transpose_item<0>(args.in[12] + (size_t)l * DM_ * DM_, DM_, DM_, (bf16*)(ws + W_OUT), scr, r, lane); continue; } r -= I_SQ;
        if (r < I_SQ) { transpose_item<0>(args.in[15] + (size_t)l * DM_ * DM_, DM_, DM_, (bf16*)(ws + W_Q), scr, r, lane); continue; } r -= I_SQ;
        if (r < I_KV) { transpose_item<0>(args.in[16] + (size_t)l * DM_ * 2 * DM_, DM_, 2 * DM_, (bf16*)(ws + W_KV), scr, r, lane); continue; } r -= I_KV;
        if (r < I_SQ) { transpose_item<0>(args.in[17] + (size_t)l * DM_ * DM_, DM_, DM_, (bf16*)(ws + W_O), scr, r, lane); continue; } r -= I_SQ;
        if (r < I_13) { transpose_item<1>(args.in[19] + (size_t)l * DM_ * 2 * FFH, DM_, 2 * FFH, (bf16*)(ws + W_13), scr, r, lane); continue; } r -= I_13;
        transpose_item<0>(args.in[20] + (size_t)l * FFH * DM_, FFH, DM_, (bf16*)(ws + W_2), scr, r, lane);
    }
    for (int m = gw; m < M; m += NGW) rms_row<false>(lane, xcur + (size_t)m * DM_, args.in[2] + (size_t)l * DM_, (bf16*)(ws + WS_XN) + (size_t)m * DM_);
    for (int m = gw; m < MEMROWS; m += NGW) rms_row<false>(lane, args.in[1] + (size_t)m * DM_, args.in[14] + (size_t)l * DM_, (bf16*)(ws + WS_MN) + (size_t)m * DM_);
    if (l == 0) {
        const int gt = F.vcu * (NWAVES * 64) + tid, NGT = F.G * NWAVES * 64;
        for (int e = gt; e < 2048 * 96; e += NGT) {
            const int t = e / 96, i = e % 96; float inv; float* dst;
            if (i < 32) { inv = (float)exp2(-(double)(2 * i) / 64.0 * 13.287712379549449); dst = (float*)(ws + WS_DCS) + ((size_t)t * 32 + i) * 2; }
            else { const int k = i - 32; inv = (float)exp2(-(double)k / 63.0 * 13.287712379549449); dst = (float*)(ws + WS_RCS) + ((size_t)t * 64 + k) * 2; }
            const float ang = (float)t * inv; const double rev = (double)ang * 0.15915494309189535; const float fr = (float)(rev - floor(rev));
            dst[0] = __builtin_amdgcn_cosf(fr); dst[1] = __builtin_amdgcn_sinf(fr);
        }
    }
}

__device__ __forceinline__ void ph_rope(Frame& F, const Args& args) {
    PH_ENTER();
    const int gw = F.vcu * NWAVES + wave, NGW = F.G * NWAVES;
    for (int it = gw; it < 4 * M; it += NGW) {
        const int sel = it / M, row = it % M, t = row % NT_;
        const int seg = sel == 0 ? 0 : sel == 1 ? 1 : sel == 2 ? 5 : 6;
        bf16* base = (bf16*)(ws + WS_BIG + (size_t)seg * SEG) + (size_t)row * 1024;
        int c1, c2; const float* tab; float sc;
        if (sel < 2) { const int blk = lane >> 2, d0 = (lane & 3) * 8; c1 = blk * 64 + d0; c2 = c1 + 32; tab = (const float*)(ws + WS_DCS) + ((size_t)t * 32 + d0) * 2; sc = sel == 0 ? 0.125f * LOG2E : 1.0f; }
        else { const int blk = lane >> 3, d0 = (lane & 7) * 8; c1 = blk * 128 + d0; c2 = c1 + 64; tab = (const float*)(ws + WS_RCS) + ((size_t)t * 64 + d0) * 2; sc = sel == 2 ? 0.08838834764831845f : 1.0f; }
        const v4u a = *(const GAS v4u*)(base + c1), b = *(const GAS v4u*)(base + c2);
        const GAS f32x4* tb = (const GAS f32x4*)tab; const f32x4 t0 = tb[0], t1 = tb[1], t2 = tb[2], t3 = tb[3];
        const float cs[8] = {t0.x, t0.z, t1.x, t1.z, t2.x, t2.z, t3.x, t3.z}, sn[8] = {t0.y, t0.w, t1.y, t1.w, t2.y, t2.w, t3.y, t3.w};
        const unsigned aw[4] = {a.x, a.y, a.z, a.w}, bw[4] = {b.x, b.y, b.z, b.w}; unsigned oa[4], ob[4];
#pragma unroll
        for (int j = 0; j < 4; ++j) {
            const float x1l = bflo(aw[j]), x1h = bfhi(aw[j]), x2l = bflo(bw[j]), x2h = bfhi(bw[j]);
            const float y1l = (x1l * cs[2 * j] - x2l * sn[2 * j]) * sc, y2l = (x2l * cs[2 * j] + x1l * sn[2 * j]) * sc;
            const float y1h = (x1h * cs[2 * j + 1] - x2h * sn[2 * j + 1]) * sc, y2h = (x2h * cs[2 * j + 1] + x1h * sn[2 * j + 1]) * sc;
            oa[j] = pk2(y1l, y1h); ob[j] = pk2(y2l, y2h);
        }
        v4u wa; wa.x = oa[0]; wa.y = oa[1]; wa.z = oa[2]; wa.w = oa[3]; v4u wb; wb.x = ob[0]; wb.y = ob[1]; wb.z = ob[2]; wb.w = ob[3];
        *(GAS v4u*)(base + c1) = wa; *(GAS v4u*)(base + c2) = wb;
    }
}

__device__ __forceinline__ void ph_conv(Frame& F, const Args& args, int l) {
    PH_ENTER();
    const bf16* CA = (const bf16*)(ws + WS_BIG + 3 * SEG); const bf16* CB = (const bf16*)(ws + WS_BIG + 4 * SEG);
    bf16* YB = (bf16*)(ws + WS_Y);
    const int c0 = 2 * tid;
    const float* cw = args.in[6] + (size_t)l * 31 * 1024;
    float w0[31], w1[31];
#pragma unroll
    for (int j = 0; j < 31; ++j) { const float2 w = *(const float2*)(cw + j * 1024 + c0); w0[j] = w.x; w1[j] = w.y; }
    const float2 bias = *(const float2*)(args.in[7] + (size_t)l * 1024 + c0), lg = *(const float2*)(args.in[8] + (size_t)l * 1024 + c0), lb = *(const float2*)(args.in[9] + (size_t)l * 1024 + c0);
    LAS float* red1 = (LAS float*)(F.lds + RING_OFF); LAS float* red2 = red1 + 16 * 8;
    for (int unit = F.vcu; unit < 1024; unit += F.G) {
        const int b = unit >> 7, t0 = (unit & 127) * 16;
        float a0[16], a1[16];
#pragma unroll
        for (int t = 0; t < 16; ++t) { a0[t] = 0.f; a1[t] = 0.f; }
#pragma unroll
        for (int r = 0; r < 46; ++r) {
            const int tg = t0 - 30 + r; const bool valid = tg >= 0; const size_t row = (size_t)b * NT_ + (valid ? tg : 0);
            const unsigned ua = *(const GAS unsigned*)(CA + row * 1024 + c0), ub = *(const GAS unsigned*)(CB + row * 1024 + c0);
            float u0 = bflo(ua) * sigm(bflo(ub)), u1 = bfhi(ua) * sigm(bfhi(ub));
            if (!valid) { u0 = 0.f; u1 = 0.f; }
#pragma unroll
            for (int t = 0; t < 16; ++t) { const int j = r - t; if (j >= 0 && j <= 30) { a0[t] += u0 * w0[j]; a1[t] += u1 * w1[j]; } }
        }
        float mu[16];
#pragma unroll
        for (int t = 0; t < 16; ++t) { a0[t] += bias.x; a1[t] += bias.y; const float s = wave_sum(a0[t] + a1[t]); if (lane == 0) red1[t * 8 + wave] = s; }
        __syncthreads();
#pragma unroll
        for (int t = 0; t < 16; ++t) { float s = 0.f;
#pragma unroll
            for (int w = 0; w < 8; ++w) s += red1[t * 8 + w];
            mu[t] = s * (1.f / 1024.f); a0[t] -= mu[t]; a1[t] -= mu[t];
            const float q = wave_sum(a0[t] * a0[t] + a1[t] * a1[t]); if (lane == 0) red2[t * 8 + wave] = q; }
        __syncthreads();
#pragma unroll
        for (int t = 0; t < 16; ++t) { float q = 0.f;
#pragma unroll
            for (int w = 0; w < 8; ++w) q += red2[t * 8 + w];
            const float rs = 1.0f / sqrtf(q * (1.f / 1024.f) + EPSN);
            const float y0 = a0[t] * rs * lg.x + lb.x, y1 = a1[t] * rs * lg.y + lb.y;
            *(GAS unsigned*)(YB + ((size_t)b * NT_ + t0 + t) * 1024 + c0) = pk2(y0 * sigm(y0), y1 * sigm(y1)); }
    }
    __syncthreads();
}

__device__ __forceinline__ void ph_ret(Frame& F, const Args& args) {
    PH_ENTER();
    typedef short bf16x8v __attribute__((ext_vector_type(8)));
    constexpr int PT = 136;
    LAS bf16* Qs = (LAS bf16*)(F.lds + RING_OFF); LAS bf16* Ks = Qs + 128 * PT; LAS bf16* KTs = Ks + 128 * PT; LAS bf16* VTs = KTs + 128 * PT; LAS bf16* STs = VTs + 32 * PT;
    const bf16* RQ = (const bf16*)(ws + WS_BIG + 5 * SEG); const bf16* RK = (const bf16*)(ws + WS_BIG + 6 * SEG); const bf16* RV = (const bf16*)(ws + WS_BIG + 7 * SEG);
    float* YR = (float*)(ws + WS_YRAW);
    const int wid = wave, fr = lane & 15, fq = lane >> 4;
    for (int unit = F.vcu; unit < 256; unit += F.G) {
        const int b = unit >> 5, h = (unit >> 2) & 7, dvq = unit & 3;
        const float lg2 = log2f(1.0f - exp2f(-5.0f - (float)h));
        const float cdec = exp2f(128.0f * lg2);
        f32x4 st[2]; st[0] = (f32x4){0.f, 0.f, 0.f, 0.f}; st[1] = st[0];
        const int sw = wid & 1, c2b = (wid >> 1) * 2;
        for (int e = tid; e < 32 * PT; e += NWAVES * 64) STs[e] = 0;
        for (int n = 0; n < 16; ++n) {
            const size_t row0 = (size_t)b * NT_ + (size_t)n * 128;
#pragma unroll
            for (int i = 0; i < 4; ++i) { const int ch = tid + 512 * i, r = ch >> 4, cc = ch & 15;
                const v4u q = *(const GAS v4u*)(RQ + (row0 + r) * 1024 + h * 128 + cc * 8), k = *(const GAS v4u*)(RK + (row0 + r) * 1024 + h * 128 + cc * 8);
                *(LAS v4u*)(Qs + r * PT + cc * 8) = q; *(LAS v4u*)(Ks + r * PT + cc * 8) = k;
                const float kd = exp2f((float)(127 - r) * lg2); const unsigned kw[4] = {k.x, k.y, k.z, k.w};
#pragma unroll
                for (int j = 0; j < 4; ++j) { KTs[(cc * 8 + 2 * j) * PT + r] = (bf16)f2bf(bflo(kw[j]) * kd); KTs[(cc * 8 + 2 * j + 1) * PT + r] = (bf16)f2bf(bfhi(kw[j]) * kd); } }
            { const int r = tid >> 2, cc = tid & 3; const v4u v = *(const GAS v4u*)(RV + (row0 + r) * 1024 + h * 128 + dvq * 32 + cc * 8); const unsigned vw[4] = {v.x, v.y, v.z, v.w};
#pragma unroll
                for (int j = 0; j < 4; ++j) { VTs[(cc * 8 + 2 * j) * PT + r] = (bf16)(vw[j] & 0xffffu); VTs[(cc * 8 + 2 * j + 1) * PT + r] = (bf16)(vw[j] >> 16); } }
            __syncthreads();
            bf16x8v qa[4];
#pragma unroll
            for (int ks = 0; ks < 4; ++ks) qa[ks] = *(const LAS bf16x8v*)(Qs + (16 * wid + fr) * PT + ks * 32 + fq * 8);
            f32x4 S[8];
#pragma unroll
            for (int c = 0; c < 8; ++c) { S[c] = (f32x4){0.f, 0.f, 0.f, 0.f};
#pragma unroll
                for (int ks = 0; ks < 4; ++ks) { const bf16x8v kb = *(const LAS bf16x8v*)(Ks + (16 * c + fr) * PT + ks * 32 + fq * 8);
                    S[c] = __builtin_amdgcn_mfma_f32_16x16x32_bf16(qa[ks], kb, S[c], 0, 0, 0); } }
            __syncthreads();
#pragma unroll
            for (int c = 0; c < 8; ++c)
#pragma unroll
                for (int rg = 0; rg < 4; ++rg) { const int tl = 16 * wid + 4 * fq + rg, sl = 16 * c + fr;
                    const float p = sl <= tl ? S[c][rg] * exp2f((float)(tl - sl) * lg2) : 0.f;
                    Ks[tl * PT + sl] = (bf16)f2bf(p); }
            LDS_WAIT(); asm volatile("" ::: "memory");
            f32x4 o[2];
#pragma unroll
            for (int ct = 0; ct < 2; ++ct) { o[ct] = (f32x4){0.f, 0.f, 0.f, 0.f};
#pragma unroll
                for (int ks = 0; ks < 4; ++ks) { const bf16x8v sb = *(const LAS bf16x8v*)(STs + (16 * ct + fr) * PT + ks * 32 + fq * 8);
                    o[ct] = __builtin_amdgcn_mfma_f32_16x16x32_bf16(qa[ks], sb, o[ct], 0, 0, 0); }
#pragma unroll
                for (int rg = 0; rg < 4; ++rg) o[ct][rg] *= exp2f((float)(16 * wid + 4 * fq + rg + 1) * lg2);
#pragma unroll
                for (int ks = 0; ks < 4; ++ks) { const bf16x8v pa = *(const LAS bf16x8v*)(Ks + (16 * wid + fr) * PT + ks * 32 + fq * 8);
                    const bf16x8v vb = *(const LAS bf16x8v*)(VTs + (16 * ct + fr) * PT + ks * 32 + fq * 8);
                    o[ct] = __builtin_amdgcn_mfma_f32_16x16x32_bf16(pa, vb, o[ct], 0, 0, 0); }
#pragma unroll
                for (int rg = 0; rg < 4; ++rg) YR[(row0 + 16 * wid + 4 * fq + rg) * 1024 + h * 128 + dvq * 32 + 16 * ct + fr] = o[ct][rg];
            }
#pragma unroll
            for (int x = 0; x < 2; ++x) { st[x] = st[x] * cdec;
#pragma unroll
                for (int ks = 0; ks < 4; ++ks) { const bf16x8v va = *(const LAS bf16x8v*)(VTs + (16 * sw + fr) * PT + ks * 32 + fq * 8);
                    const bf16x8v kb = *(const LAS bf16x8v*)(KTs + (16 * (c2b + x) + fr) * PT + ks * 32 + fq * 8);
                    st[x] = __builtin_amdgcn_mfma_f32_16x16x32_bf16(va, kb, st[x], 0, 0, 0); } }
            __syncthreads();
#pragma unroll
            for (int x = 0; x < 2; ++x)
#pragma unroll
                for (int rg = 0; rg < 4; ++rg) STs[(16 * sw + 4 * fq + rg) * PT + 16 * (c2b + x) + fr] = (bf16)f2bf(st[x][rg]);
        }
        __syncthreads();
    }
}

__device__ __forceinline__ void ph_combine(Frame& F, const Args& args, int l) {
    PH_ENTER();
    const int gw = F.vcu * NWAVES + wave, NGW = F.G * NWAVES;
    const float* dl = args.in[4] + (size_t)l * 256;
    const float s01 = wave_sum(dl[lane] * dl[64 + lane]), s23 = wave_sum(dl[128 + lane] * dl[192 + lane]);
    const float linit = 0.8f - 0.6f * expf(-0.3f * (float)l);
    const float lam = expf(s01) - expf(s23) + linit;
    const float* subln = args.in[5] + (size_t)l * 128 + (lane & 7) * 16;
    const float* gng = args.in[10] + (size_t)l * 1024 + lane * 16;
    float sl[16], gg[16];
#pragma unroll
    for (int i = 0; i < 16; ++i) { sl[i] = subln[i] * (1.0f - linit); gg[i] = gng[i]; }
    const bf16* O0 = (const bf16*)(ws + WS_XN); const bf16* O1 = O0 + SEG_E;
    bf16* YA = (bf16*)(ws + WS_Y) + SEG_E; bf16* YRo = (bf16*)(ws + WS_Y) + 2 * SEG_E;
    const float* YRAW = (const float*)(ws + WS_YRAW); const bf16* RG = (const bf16*)(ws + WS_BIG + 8 * SEG);
    for (int m = gw; m < M; m += NGW) {
        const size_t off = (size_t)m * 1024 + lane * 16;
        {   const v4u a0 = *(const GAS v4u*)(O0 + off), a1 = *(const GAS v4u*)(O0 + off + 8), b0 = *(const GAS v4u*)(O1 + off), b1 = *(const GAS v4u*)(O1 + off + 8);
            const unsigned aw[8] = {a0.x, a0.y, a0.z, a0.w, a1.x, a1.y, a1.z, a1.w}, bw[8] = {b0.x, b0.y, b0.z, b0.w, b1.x, b1.y, b1.z, b1.w};
            float d[16]; float ss = 0.f;
#pragma unroll
            for (int j = 0; j < 8; ++j) { d[2 * j] = bflo(aw[j]) - lam * bflo(bw[j]); d[2 * j + 1] = bfhi(aw[j]) - lam * bfhi(bw[j]); ss += d[2 * j] * d[2 * j] + d[2 * j + 1] * d[2 * j + 1]; }
            ss += __shfl_xor(ss, 1); ss += __shfl_xor(ss, 2); ss += __shfl_xor(ss, 4);
            const float r = 1.0f / sqrtf(ss * (1.f / 128.f) + EPSN);
            unsigned ow[8];
#pragma unroll
            for (int j = 0; j < 8; ++j) ow[j] = pk2(d[2 * j] * r * sl[2 * j], d[2 * j + 1] * r * sl[2 * j + 1]);
            v4u w0; w0.x = ow[0]; w0.y = ow[1]; w0.z = ow[2]; w0.w = ow[3]; v4u w1; w1.x = ow[4]; w1.y = ow[5]; w1.z = ow[6]; w1.w = ow[7];
            *(GAS v4u*)(YA + off) = w0; *(GAS v4u*)(YA + off + 8) = w1; }
        {   const GAS f32x4* yp = (const GAS f32x4*)(YRAW + off); const f32x4 y0 = yp[0], y1 = yp[1], y2 = yp[2], y3 = yp[3];
            const v4u g0 = *(const GAS v4u*)(RG + off), g1 = *(const GAS v4u*)(RG + off + 8);
            float v[16] = {y0.x, y0.y, y0.z, y0.w, y1.x, y1.y, y1.z, y1.w, y2.x, y2.y, y2.z, y2.w, y3.x, y3.y, y3.z, y3.w};
            const unsigned gw_[8] = {g0.x, g0.y, g0.z, g0.w, g1.x, g1.y, g1.z, g1.w};
            float s = 0.f;
#pragma unroll
            for (int i = 0; i < 16; ++i) s += v[i];
            s += __shfl_xor(s, 1); s += __shfl_xor(s, 2); s += __shfl_xor(s, 4);
            const float mu = s * (1.f / 128.f); float q = 0.f;
#pragma unroll
            for (int i = 0; i < 16; ++i) { v[i] -= mu; q += v[i] * v[i]; }
            q += __shfl_xor(q, 1); q += __shfl_xor(q, 2); q += __shfl_xor(q, 4);
            const float r = 1.0f / sqrtf(q * (1.f / 128.f) + EPSN);
            unsigned ow[8];
#pragma unroll
            for (int j = 0; j < 8; ++j) { const float ga = bflo(gw_[j]), gb = bfhi(gw_[j]);
                ow[j] = pk2(ga * sigm(ga) * v[2 * j] * r * gg[2 * j], gb * sigm(gb) * v[2 * j + 1] * r * gg[2 * j + 1]); }
            v4u w0; w0.x = ow[0]; w0.y = ow[1]; w0.z = ow[2]; w0.w = ow[3]; v4u w1; w1.x = ow[4]; w1.y = ow[5]; w1.z = ow[6]; w1.w = ow[7];
            *(GAS v4u*)(YRo + off) = w0; *(GAS v4u*)(YRo + off + 8) = w1; }
    }
}

__device__ __forceinline__ void ph_softmax(Frame& F, const Args& args) {
    PH_ENTER();
    const int gw = F.vcu * NWAVES + wave, NGW = F.G * NWAVES;
    const float* SX = (const float*)(ws + WS_BIG + 2 * SEG); bf16* PX = (bf16*)(ws + WS_BIG + 4 * SEG);
    for (int m = gw; m < M; m += NGW) {
        const size_t off = (size_t)m * 1024 + lane * 16;
        const GAS f32x4* sp = (const GAS f32x4*)(SX + off); const f32x4 y0 = sp[0], y1 = sp[1], y2 = sp[2], y3 = sp[3];
        float v[16] = {y0.x, y0.y, y0.z, y0.w, y1.x, y1.y, y1.z, y1.w, y2.x, y2.y, y2.z, y2.w, y3.x, y3.y, y3.z, y3.w};
        float mx = v[0];
#pragma unroll
        for (int i = 1; i < 16; ++i) mx = fmaxf(mx, v[i]);
        mx = fmaxf(mx, __shfl_xor(mx, 1)); mx = fmaxf(mx, __shfl_xor(mx, 2)); mx = fmaxf(mx, __shfl_xor(mx, 4)); mx = fmaxf(mx, __shfl_xor(mx, 8));
        float s = 0.f;
#pragma unroll
        for (int i = 0; i < 16; ++i) { v[i] = __builtin_amdgcn_exp2f(v[i] - mx); s += v[i]; }
        s += __shfl_xor(s, 1); s += __shfl_xor(s, 2); s += __shfl_xor(s, 4); s += __shfl_xor(s, 8);
        const float r = 1.0f / s;
        v4u w0; w0.x = pk2(v[0] * r, v[1] * r); w0.y = pk2(v[2] * r, v[3] * r); w0.z = pk2(v[4] * r, v[5] * r); w0.w = pk2(v[6] * r, v[7] * r);
        v4u w1; w1.x = pk2(v[8] * r, v[9] * r); w1.y = pk2(v[10] * r, v[11] * r); w1.z = pk2(v[12] * r, v[13] * r); w1.w = pk2(v[14] * r, v[15] * r);
        *(GAS v4u*)(PX + off) = w0; *(GAS v4u*)(PX + off + 8) = w1;
    }
}

#ifndef MK_MULTI
#define MK_MULTI 1
#endif
template <int KLO, int KHI> __global__ void __launch_bounds__(NWAVES * 64, 2) mk_fwd(Args args) {
    extern __shared__ __attribute__((aligned(16))) unsigned char lds[];
    Frame F;
    F.lds = (LAS unsigned char*)lds;
    F.MISC = (volatile LAS unsigned*)(F.lds + MISC_OFF);
    F.G = gridDim.x; { const int bx = blockIdx.x; F.vcu = (F.G % 8 == 0) ? (bx % 8) * (F.G / 8) + bx / 8 : bx; }
    for (int u = threadIdx.x; u < (LDS_BYTES - LDSCTL_OFF) / 4; u += NWAVES * 64) ((LAS unsigned*)(F.lds + LDSCTL_OFF))[u] = 0u;
    __syncthreads();
    XcdBarrier bar; bar.bar = (unsigned*)(args.ws + WS_CTL) + CW_BAR; bar.x = 0; bar.st = nullptr;
    if (!MK_MULTI) bar = xcd_barrier_post((unsigned*)(args.ws + WS_CTL) + CW_BAR, F.MISC + 8);
#define IN(k) (KLO <= (k) && (k) < KHI)
#define SEAM(k) do { if (!MK_MULTI && IN(k) && IN((k) + 1)) xcd_barrier(bar); } while (0)
#define PHP() unsigned char* ws = pg8::uni_ptr(args.ws); bf16* const XN = (bf16*)(ws + WS_XN); bf16* const BIGp = (bf16*)(ws + WS_BIG); const int bx = (int)blockIdx.x; (void)XN; (void)BIGp; (void)bx

    for (int l = args.l_lo; l < args.l_hi; ++l) {
        constexpr int pb = 0;
        const float* xcur = l == 0 ? args.in[0] : (const float*)args.out;
        if (IN(pb + 0)) ph_prep(F, args, l, xcur);
        SEAM(pb + 0);
        if (IN(pb + 1)) { PHP();
            { pg8::Gemm g{XN, (const bf16*)(ws + W_IN), DM_, DM_, DM_}; pg8::StaticOrder S; S.init(M, INC, F.G, bx, DM_, DM_);
              pg8::EpiBf16 E{BIGp, 1024, 1024, SEG_E, 1.0f};
              pg8::gemm_phase<pg8::EpiBf16, pg8::StaticOrder, true, true>(F.lds + RING_OFF, g, S, E); }
            { pg8::Gemm g{(const bf16*)(ws + WS_MN), (const bf16*)(ws + W_KV), DM_, DM_, DM_}; pg8::StaticOrder S; S.init(MEMROWS, DM_, F.G, bx, DM_, DM_);
              pg8::EpiBf16 E{(bf16*)(ws + WS_KM), DM_, 0, 0, 1.0f};
              pg8::gemm_phase<pg8::EpiBf16, pg8::StaticOrder, true, true>(F.lds + RING_OFF, g, S, E); }
            { pg8::Gemm g{(const bf16*)(ws + W_KV) + (size_t)DM_ * DM_, (const bf16*)(ws + WS_MN), DM_, DM_, DM_}; pg8::StaticOrder S; S.init(DM_, MEMROWS, F.G, (bx + F.G - 64) % F.G, DM_, DM_);
              pg8::EpiBf16 E{(bf16*)(ws + WS_VT), MEMROWS, 0, 0, 1.0f};
              pg8::gemm_phase<pg8::EpiBf16, pg8::StaticOrder, true, true>(F.lds + RING_OFF, g, S, E); }
        }
        SEAM(pb + 1);
        if (IN(pb + 2)) ph_rope(F, args);
        SEAM(pb + 2);
        if (IN(pb + 3)) { PHP();
            const attn_body::AttnTensors AT{(const attn_body::bf16*)BIGp, (const attn_body::bf16*)(BIGp + SEG_E), (const attn_body::bf16*)(BIGp + 2 * SEG_E), (attn_body::bf16*)XN};
            const attn_body::StaticOrder S((int)F.G, bx);
            attn_body::attn_phase<attn_body::StaticOrder>((char*)lds + RING_OFF, AT, S);
            __syncthreads();
            ph_conv(F, args, l);
            ph_ret(F, args);
        }
        SEAM(pb + 3);
        if (IN(pb + 4)) ph_combine(F, args, l);
        SEAM(pb + 4);
        if (IN(pb + 5)) { PHP();
            bf16* Y = (bf16*)(ws + WS_Y); float* part = (float*)(ws + WS_BIG);
            { pg8::Gemm g{Y + SEG_E, (const bf16*)(ws + W_BR), MIXW, MIXW, MIXW}; pg8::StaticOrder S; S.init(M, DM_, F.G, bx, MIXW, MIXW);
              pg8::EpiGate<0> E{BIGp + 9 * SEG_E, part, XN};
              pg8::gemm_phase<pg8::EpiGate<0>, pg8::StaticOrder, true, true>(F.lds + RING_OFF, g, S, E); }
            { pg8::Gemm g{Y, (const bf16*)(ws + W_BR) + (size_t)DM_ * MIXW, MIXW, MIXW, MIXW}; pg8::StaticOrder S; S.init(M, DM_, F.G, bx, MIXW, MIXW);
              pg8::EpiGate<1> E{BIGp + 11 * SEG_E, part, XN};
              pg8::gemm_phase<pg8::EpiGate<1>, pg8::StaticOrder, true, true>(F.lds + RING_OFF, g, S, E); }
            { pg8::Gemm g{Y + 2 * SEG_E, (const bf16*)(ws + W_BR) + 2 * (size_t)DM_ * MIXW, MIXW, MIXW, MIXW}; pg8::StaticOrder S; S.init(M, DM_, F.G, bx, MIXW, MIXW);
              pg8::EpiGate<2> E{BIGp + 13 * SEG_E, part, XN};
              pg8::gemm_phase<pg8::EpiGate<2>, pg8::StaticOrder, true, true>(F.lds + RING_OFF, g, S, E); }
        }
        SEAM(pb + 5);
        if (IN(pb + 6)) { PHP();
            pg8::Gemm g{XN, (const bf16*)(ws + W_OUT), DM_, DM_, DM_}; pg8::StaticOrder S; S.init(M, DM_, F.G, bx, DM_, DM_);
            pg8::EpiF32 E{xcur, args.out, DM_};
            pg8::gemm_phase<pg8::EpiF32, pg8::StaticOrder, true, true>(F.lds + RING_OFF, g, S, E);
        }
        SEAM(pb + 6);
        if (IN(pb + 7)) { PH_ENTER(); bf16* const XN = (bf16*)(ws + WS_XN); const int gw = F.vcu * NWAVES + wave, NGW = F.G * NWAVES;
            for (int m = gw; m < M; m += NGW) rms_row<false>(lane, args.out + (size_t)m * DM_, args.in[13] + (size_t)l * DM_, XN + (size_t)m * DM_); }
        SEAM(pb + 7);
        if (IN(pb + 8)) { PHP();
            pg8::Gemm g{XN, (const bf16*)(ws + W_Q), DM_, DM_, DM_}; pg8::StaticOrder S; S.init(M, DM_, F.G, bx, DM_, DM_);
            pg8::EpiBf16 E{BIGp, DM_, 0, 0, 0.044194173824159216f * LOG2E};
            pg8::gemm_phase<pg8::EpiBf16, pg8::StaticOrder, true, true>(F.lds + RING_OFF, g, S, E);
        }
        SEAM(pb + 8);
        if (IN(pb + 9)) { PHP();
            pg8::Gemm g{BIGp, (const bf16*)(ws + WS_KM), DM_, DM_, 512}; pg8::XsOrder S{F.G, bx};
            pg8::EpiF32 E{nullptr, (float*)(ws + WS_BIG + 2 * SEG), 1024};
            pg8::gemm_phase<pg8::EpiF32, pg8::XsOrder, true, true>(F.lds + RING_OFF, g, S, E);
        }
        SEAM(pb + 9);
        if (IN(pb + 10)) ph_softmax(F, args);
        SEAM(pb + 10);
        if (IN(pb + 11)) { PHP();
            pg8::Gemm g{BIGp + 4 * SEG_E, (const bf16*)(ws + WS_VT), 1024, MEMROWS, 256}; pg8::XpOrder S{F.G, bx};
            pg8::EpiBf16 E{BIGp + 5 * SEG_E, DM_, 0, 0, 1.0f};
            pg8::gemm_phase<pg8::EpiBf16, pg8::XpOrder, true, true>(F.lds + RING_OFF, g, S, E);
        }
        SEAM(pb + 11);
        if (IN(pb + 12)) { PHP();
            pg8::Gemm g{BIGp + 5 * SEG_E, (const bf16*)(ws + W_O), DM_, DM_, DM_}; pg8::StaticOrder S; S.init(M, DM_, F.G, bx, DM_, DM_);
            pg8::EpiF32 E{args.out, args.out, DM_};
            pg8::gemm_phase<pg8::EpiF32, pg8::StaticOrder, true, true>(F.lds + RING_OFF, g, S, E);
        }
        SEAM(pb + 12);
        if (IN(pb + 13)) { PH_ENTER(); bf16* const XN = (bf16*)(ws + WS_XN); const int gw = F.vcu * NWAVES + wave, NGW = F.G * NWAVES;
            for (int m = gw; m < M; m += NGW) rms_row<false>(lane, args.out + (size_t)m * DM_, args.in[18] + (size_t)l * DM_, XN + (size_t)m * DM_); }
        SEAM(pb + 13);
        if (IN(pb + 14)) { PHP();
            pg8::Gemm g{XN, (const bf16*)(ws + W_13), DM_, DM_, DM_}; pg8::StaticOrder S; S.init(M, 2 * FFH, F.G, bx, DM_, DM_);
            pg8::EpiSwiGLU E{BIGp, FFH};
            pg8::gemm_phase<pg8::EpiSwiGLU, pg8::StaticOrder, true, true>(F.lds + RING_OFF, g, S, E);
        }
        SEAM(pb + 14);
        if (IN(pb + 15)) { PHP();
            pg8::Gemm g{BIGp, (const bf16*)(ws + W_2), FFH, FFH, FFH}; pg8::StaticOrder S; S.init(M, DM_, F.G, bx, FFH, FFH);
            pg8::EpiF32 E{args.out, args.out, DM_};
            pg8::gemm_phase<pg8::EpiF32, pg8::StaticOrder, true, true>(F.lds + RING_OFF, g, S, E);
        }
        SEAM(pb + 15);
    }
    if (IN(NPH)) { PH_ENTER(); bf16* const XN = (bf16*)(ws + WS_XN); const int gw = F.vcu * NWAVES + wave, NGW = F.G * NWAVES;
        for (int m = gw; m < M; m += NGW) rms_row<true>(lane, args.out + (size_t)m * DM_, args.in[21], args.out + (size_t)m * DM_); }
#undef IN
#undef SEAM
}

extern "C" void kernel_launch(void* const* d_in, const int* in_sizes, int n_in, void* d_out, int out_size, void* d_ws, size_t ws_size, hipStream_t stream) {
    static int grid = 0; static bool first = true;
    if (grid == 0) {
        if (n_in != 22 || in_sizes[0] != M * DM_ || out_size != M * DM_ || ws_size < WS_END) { fprintf(stderr, "kernel_launch: unexpected shapes / workspace (n_in %d, in0 %d, out %d, ws %zu, need %zu); nothing launched\n", n_in, n_in > 0 ? in_sizes[0] : -1, out_size, ws_size, (size_t)WS_END); grid = -1; return; }
        int dev = 0, cus = 0, per_cu = 0;
        if (hipGetDevice(&dev) != hipSuccess || hipDeviceGetAttribute(&cus, hipDeviceAttributeMultiprocessorCount, dev) != hipSuccess) { grid = -1; return; }
        if (hipFuncSetAttribute((const void*)mk_fwd<MK_MULTI ? NPH : 0, NPH + 1>, hipFuncAttributeMaxDynamicSharedMemorySize, LDS_BYTES) != hipSuccess) { fprintf(stderr, "kernel_launch: hipFuncSetAttribute failed\n"); grid = -1; return; }
        if (hipOccupancyMaxActiveBlocksPerMultiprocessor(&per_cu, (const void*)mk_fwd<MK_MULTI ? NPH : 0, NPH + 1>, NWAVES * 64, LDS_BYTES) != hipSuccess || per_cu < 1) fprintf(stderr, "kernel_launch: occupancy query reports %d\n", per_cu);
        (void)hipGetLastError();
        grid = cus;
    }
    if (grid < 0) return;
    if (hipMemsetAsync((char*)d_ws + WS_CTL, 0, CTL_ZERO_BYTES, stream) != hipSuccess) return;
    Args a{};
    for (int i = 0; i < 22; ++i) a.in[i] = (const float*)d_in[i];
    a.out = (float*)d_out; a.ws = (unsigned char*)d_ws;
#if MK_MULTI
#define LAUNCH_K(K) do { if (first) (void)hipFuncSetAttribute((const void*)mk_fwd<K, K + 1>, hipFuncAttributeMaxDynamicSharedMemorySize, LDS_BYTES); hipLaunchKernelGGL((mk_fwd<K, K + 1>), dim3(grid), dim3(NWAVES * 64), LDS_BYTES, stream, a); } while (0)
    for (int l = 0; l < DEPTH; ++l) { a.l_lo = l; a.l_hi = l + 1;
        LAUNCH_K(0); LAUNCH_K(1); LAUNCH_K(2); LAUNCH_K(3); LAUNCH_K(4); LAUNCH_K(5); LAUNCH_K(6); LAUNCH_K(7); LAUNCH_K(8); LAUNCH_K(9); LAUNCH_K(10); LAUNCH_K(11); LAUNCH_K(12); LAUNCH_K(13); LAUNCH_K(14); LAUNCH_K(15); }
    a.l_lo = DEPTH; a.l_hi = DEPTH; LAUNCH_K(16);
    first = false;
#else
    a.l_lo = 0; a.l_hi = DEPTH;
    hipLaunchKernelGGL((mk_fwd<MK_MULTI ? NPH : 0, NPH + 1>), dim3(grid), dim3(NWAVES * 64), LDS_BYTES, stream, a);
#endif
}
```

```cpp
#include <hip/hip_runtime.h>
#include <hip/hip_bf16.h>
#include <cstdio>
#include <cstdint>
#include <cmath>
namespace pg8 {
#define PG8_LAS __attribute__((address_space(3)))
typedef unsigned short bf16_t;
typedef short bf16x8 __attribute__((ext_vector_type(8)));
typedef float f32x4 __attribute__((ext_vector_type(4)));
typedef float f32x2 __attribute__((ext_vector_type(2)));
typedef unsigned u32x4 __attribute__((ext_vector_type(4)));
typedef unsigned u32x2 __attribute__((ext_vector_type(2)));
constexpr int BM = 256, BK = 64, HALF = 128, HTB = HALF * BK * 2  , STAGE_BYTES = 8 * HTB, NXCD = 8, WGM = 8;

__host__ __device__ __forceinline__ int lds_byte(int r, int c) { const int st = (r >> 4) * 2 + (c >> 5), rr = r & 15, cc = c & 31, ob = rr * 64 + cc * 2; return st * 1024 + (ob ^ (((ob >> 9) & 1) << 5)); }
__host__ __device__ __forceinline__ void stage_rc(int b, int& R, int& C) { const int st = b / 1024, sb = b % 1024, swz = sb ^ (((sb >> 9) & 1) << 5); R = (st >> 1) * 16 + swz / 64; C = (st & 1) * 32 + (swz % 64) / 2; }
__host__ __device__ __forceinline__ int perm32(int rho) { const int n = rho >> 4, i = rho & 15; return 8 * (i >> 2) + 4 * n + (i & 3); }

template <class T> __device__ __forceinline__ T* uni_ptr(T* p) { const unsigned long long v = (unsigned long long)p; unsigned lo = (unsigned)v, hi = (unsigned)(v >> 32);
    asm volatile("" : "+s"(lo), "+s"(hi)); return (T*)(((unsigned long long)hi << 32) | lo); }
__device__ __forceinline__ int lane_id() { int l; asm volatile("v_mbcnt_lo_u32_b32 %0, -1, 0\n\tv_mbcnt_hi_u32_b32 %0, -1, %0" : "=v"(l)); return l; }
__device__ __forceinline__ int opq(int x) { asm volatile("" : "+s"(x)); return x; }
template <int M> __device__ __forceinline__ float xadd(float v) {
    if constexpr (M == 32) { const auto rr = __builtin_amdgcn_permlane32_swap(__float_as_uint(v), __float_as_uint(v), false, false); return __uint_as_float(rr[0]) + __uint_as_float(rr[1]); }
    else return v + __int_as_float(__builtin_amdgcn_ds_swizzle(__float_as_int(v), (M << 10) | 0x1f));
}
__device__ __forceinline__ float row_sum16(float v) {
#define PG8_DPPADD(ctrl) v += __int_as_float(__builtin_amdgcn_update_dpp(0, __float_as_int(v), ctrl, 0xf, 0xf, true))
    PG8_DPPADD(0xB1); PG8_DPPADD(0x4E); PG8_DPPADD(0x141); PG8_DPPADD(0x140); return v;
#undef PG8_DPPADD
}
struct Unit { int pm, pn; unsigned offA, offB; int sub = 0; };
struct Gemm { const bf16_t* A; const bf16_t* Bt; int lda, ldb, K; };

struct StaticOrder {
    int nM, nN, nwg, G, c; unsigned tA, tB;
    __device__ void init(int M, int N, int G_, int c_, int lda, int ldb) { nM = M / BM; nN = N / BM; nwg = nM * nN; G = G_; c = c_; tA = (unsigned)BM * lda * 2u; tB = (unsigned)BM * ldb * 2u; }
    __device__ __forceinline__ bool next(int i, Unit& u) const {
        const long L = (long)i * G + c; if (L >= nwg) return false;
        int wgid = (int)L; { const int q = nwg / NXCD, r = nwg % NXCD, xcd = wgid % NXCD, off = wgid / NXCD; wgid = (xcd < r ? xcd * (q + 1) : r * (q + 1) + (xcd - r) * q) + off; }
        const int nig = WGM * nN, gid = wgid / nig, fm = gid * WGM, gsz = (nM - fm) < WGM ? (nM - fm) : WGM;
        u.pm = fm + ((wgid % nig) % gsz); u.pn = (wgid % nig) / gsz; u.offA = (unsigned)u.pm * tA; u.offB = (unsigned)u.pn * tB; return true;
    }
    __device__ __forceinline__ void a_ready(const Unit&) const {}
    __device__ __forceinline__ void done(const Unit&) const {}
};
struct XprodOrder {
    int G, c; unsigned ld, oK, oV, oWq, oWo;
    __device__ __forceinline__ bool next(int i, Unit& u) const {
        const int L = i * G + c; if (L >= 512) return false;
        const int q = L & 255, b = q >> 5, h = (q >> 3) & 3, t = q & 7;
        if (L < 256) { u.sub = 0; u.pm = b * 4 + h; u.pn = t; u.offA = oK + ((unsigned)(b * 256) * ld + h * 512) * 2u; u.offB = oWq + ((unsigned)(t * 256) * ld + h * 512) * 2u; }
        else         { u.sub = 1; u.pm = b * 8 + t; u.pn = h; u.offA = oWo + ((unsigned)(t * 256) * ld + h * 512) * 2u; u.offB = oV + ((unsigned)(b * 256) * ld + h * 512) * 2u; }
        return true;
    }
    __device__ __forceinline__ void a_ready(const Unit&) const {}
    __device__ __forceinline__ void done(const Unit&) const {}
};
struct XsOrder {
    int G, c, lda;
    __device__ __forceinline__ bool next(int i, Unit& u) const {
        const int L = i * G + c; if (L >= 256) return false;
        const int b = L >> 5, rt = (L >> 2) & 7, h = L & 3;
        u.pm = b * 8 + rt; u.pn = h; u.offA = ((unsigned)(b * 2048 + rt * 256) * (unsigned)lda) * 2u; u.offB = ((unsigned)(b * 1024 + h * 256) * 2048u) * 2u; return true;
    }
    __device__ __forceinline__ void a_ready(const Unit&) const {}
    __device__ __forceinline__ void done(const Unit&) const {}
};
struct XoOrder {
    int G, c;
    __device__ __forceinline__ bool next(int i, Unit& u) const {
        const int L = i * G + c; if (L >= 512) return false;
        const int b = L >> 6, rt = (L >> 3) & 7, ct = L & 7;
        u.pm = b * 8 + rt; u.pn = ct; u.offA = ((unsigned)(b * 2048 + rt * 256) * 1024u) * 2u; u.offB = ((unsigned)(b * 2048 + ct * 256) * 1024u) * 2u; return true;
    }
    __device__ __forceinline__ void a_ready(const Unit&) const {}
    __device__ __forceinline__ void done(const Unit&) const {}
};

__device__ __forceinline__ unsigned cvt_pk_bf16(float lo, float hi) { unsigned r; asm volatile("v_cvt_pk_bf16_f32 %0, %1, %2" : "=v"(r) : "v"(lo), "v"(hi)); return r; }
__device__ __forceinline__ float bf_lo(unsigned w) { return __uint_as_float(w << 16); }
__device__ __forceinline__ float bf_hi(unsigned w) { return __uint_as_float(w & 0xffff0000u); }
__device__ __forceinline__ float sigmoidf_(float x) { return __builtin_amdgcn_rcpf(1.0f + __builtin_amdgcn_exp2f(-1.4426950408889634f * x)); }

__device__ __forceinline__ void row_rs8(float (&rs)[2][4], const float* rssp, int row0, int fq) {
    f32x4 a[2][4], b[2][4];
#pragma unroll
    for (int ai = 0; ai < 2; ++ai)
#pragma unroll
        for (int m = 0; m < 4; ++m) { const float* p = rssp + (size_t)(row0 + ai * HALF + m * 16) * 32 + fq * 8; a[ai][m] = *(const f32x4*)p; b[ai][m] = *(const f32x4*)(p + 4); }
#pragma unroll
    for (int ai = 0; ai < 2; ++ai)
#pragma unroll
        for (int m = 0; m < 4; ++m) { float s = ((a[ai][m][0] + a[ai][m][1]) + (a[ai][m][2] + a[ai][m][3])) + ((b[ai][m][0] + b[ai][m][1]) + (b[ai][m][2] + b[ai][m][3]));
            s = pg8::xadd<16>(s); s = pg8::xadd<32>(s); rs[ai][m] = __builtin_amdgcn_rsqf(s * (1.0f / 2048.0f) + 1e-6f); }
}
struct EpiBf16 {
    static constexpr bool PERM = true, AFTER_DRAIN = false, MULTI = false;
    bf16_t* O; int ldc; int split_cols; size_t split_stride; float scale; const float* rss;
    __device__ __forceinline__ void operator()(const f32x4 (&acc)[2][2][4][2], const Unit& u, int wr, int wc, int fr, int fq) const {
        const int row0 = u.pm * BM + wr * 64 + fr; int colt = u.pn * BM; bf16_t* base = O;
        if (split_cols) { const int t = colt / split_cols; base += (size_t)t * split_stride; colt -= t * split_cols; }
        const int col0 = colt + wc * 32 + 8 * fq; const float sc = scale;
        float rs[2][4];
        if (rss) row_rs8(rs, rss, row0, fq);
#pragma unroll
        for (int ai = 0; ai < 2; ++ai)
#pragma unroll
            for (int m = 0; m < 4; ++m) { bf16_t* rowp = base + (size_t)(row0 + ai * HALF + m * 16) * ldc + col0;
                const float sr = rss ? sc * rs[ai][m] : sc;
#pragma unroll
                for (int bj = 0; bj < 2; ++bj) { const f32x4 v0 = acc[ai][bj][m][0] * sr, v1 = acc[ai][bj][m][1] * sr;
                    u32x4 w; w.x = cvt_pk_bf16(v0[0], v0[1]); w.y = cvt_pk_bf16(v0[2], v0[3]); w.z = cvt_pk_bf16(v1[0], v1[1]); w.w = cvt_pk_bf16(v1[2], v1[3]);
                    *(u32x4*)(rowp + bj * HALF) = w; } }
    }
};
struct EpiBf16Two {
    static constexpr bool PERM = true, AFTER_DRAIN = false, MULTI = false;
    bf16_t* O0; int ld0; bf16_t* O1; int ld1;
    __device__ __forceinline__ void operator()(const f32x4 (&acc)[2][2][4][2], const Unit& u, int wr, int wc, int fr, int fq) const {
        bf16_t* base = u.sub ? O1 : O0; const int ldc = u.sub ? ld1 : ld0;
        const int row0 = u.pm * BM + wr * 64 + fr, col0 = u.pn * BM + wc * 32 + 8 * fq;
#pragma unroll
        for (int ai = 0; ai < 2; ++ai)
#pragma unroll
            for (int m = 0; m < 4; ++m) { bf16_t* rowp = base + (size_t)(row0 + ai * HALF + m * 16) * ldc + col0;
#pragma unroll
                for (int bj = 0; bj < 2; ++bj) { const f32x4 v0 = acc[ai][bj][m][0], v1 = acc[ai][bj][m][1];
                    u32x4 w; w.x = cvt_pk_bf16(v0[0], v0[1]); w.y = cvt_pk_bf16(v0[2], v0[3]); w.z = cvt_pk_bf16(v1[0], v1[1]); w.w = cvt_pk_bf16(v1[2], v1[3]);
                    *(u32x4*)(rowp + bj * HALF) = w; } }
    }
};
struct EpiInProj {
    static constexpr bool PERM = true, AFTER_DRAIN = false, MULTI = false;
    bf16_t* BIG; const float* dcs; const float* rcs; const float* rss;
    __device__ __forceinline__ void operator()(const f32x4 (&acc)[2][2][4][2], const Unit& u, int wr, int wc, int fr, int fq) const {
        const int pn = u.pn; const int row0 = u.pm * BM + wr * 64 + fr; const size_t SEGE = (size_t)16384 * 1024;
        const int cw = wc * 32 + 8 * fq;
        float rs[2][4]; row_rs8(rs, rss, row0, fq);
        if (pn < 8 || (pn >= 20 && pn < 28)) {
            const bool isd = pn < 8; const int seg = isd ? (pn >> 2) : 5 + ((pn - 20) >> 2);
            const float sc = pn < 4 ? 0.125f * 1.4426950408889634f : (pn >= 20 && pn < 24) ? 0.08838834764831845f : 1.0f;
            const int i0 = isd ? ((cw & 63) >> 1) : ((cw & 127) >> 1);
            bf16_t* base = BIG + (size_t)seg * SEGE + (pn & 3) * BM + cw;
#pragma unroll
            for (int ai = 0; ai < 2; ++ai)
#pragma unroll
              for (int mp = 0; mp < 2; ++mp) {
                f32x4 ta[2], tb4[2];
#pragma unroll
                for (int mm = 0; mm < 2; ++mm) { const int t = (row0 + ai * HALF + (2 * mp + mm) * 16) & 2047;
                    const float* tb = isd ? dcs + ((size_t)t * 32 + i0) * 2 : rcs + ((size_t)t * 64 + i0) * 2; ta[mm] = *(const f32x4*)tb; tb4[mm] = *(const f32x4*)(tb + 4); }
#pragma unroll
                for (int mm = 0; mm < 2; ++mm) { const int m = 2 * mp + mm; const int row = row0 + ai * HALF + m * 16; const float sr = sc * rs[ai][m]; const f32x4 t0 = ta[mm], t1 = tb4[mm];
#pragma unroll
                    for (int bj = 0; bj < 2; ++bj) { const f32x4 v0 = acc[ai][bj][m][0], v1 = acc[ai][bj][m][1];
                        const float y0 = (v0[0] * t0[0] - v0[1] * t0[1]) * sr, y1 = (v0[1] * t0[0] + v0[0] * t0[1]) * sr, y2 = (v0[2] * t0[2] - v0[3] * t0[3]) * sr, y3 = (v0[3] * t0[2] + v0[2] * t0[3]) * sr;
                        const float y4 = (v1[0] * t1[0] - v1[1] * t1[1]) * sr, y5 = (v1[1] * t1[0] + v1[0] * t1[1]) * sr, y6 = (v1[2] * t1[2] - v1[3] * t1[3]) * sr, y7 = (v1[3] * t1[2] + v1[2] * t1[3]) * sr;
                        u32x4 w; w.x = cvt_pk_bf16(y0, y1); w.y = cvt_pk_bf16(y2, y3); w.z = cvt_pk_bf16(y4, y5); w.w = cvt_pk_bf16(y6, y7);
                        *(u32x4*)(base + (size_t)row * 1024 + bj * HALF) = w; } }
                asm volatile("" ::: "memory"); }
        } else if (pn >= 12 && pn < 20) {
            bf16_t* base = BIG + 3 * SEGE + (pn - 12) * (BM / 2) + (cw >> 1);
#pragma unroll
            for (int ai = 0; ai < 2; ++ai)
#pragma unroll
                for (int m = 0; m < 4; ++m) { bf16_t* rowp = base + (size_t)(row0 + ai * HALF + m * 16) * 1024; const float sr = rs[ai][m];
#pragma unroll
                    for (int bj = 0; bj < 2; ++bj) { const f32x4 v0 = acc[ai][bj][m][0] * sr, v1 = acc[ai][bj][m][1] * sr;
                        u32x2 w; w.x = cvt_pk_bf16(v0[0] * sigmoidf_(v0[1]), v0[2] * sigmoidf_(v0[3])); w.y = cvt_pk_bf16(v1[0] * sigmoidf_(v1[1]), v1[2] * sigmoidf_(v1[3]));
                        *(u32x2*)(rowp + bj * (HALF / 2)) = w; } }
        } else {
            bf16_t* base = BIG + (size_t)(pn >> 2) * SEGE + (pn & 3) * BM + cw; const bool sg = pn >= 36;
#pragma unroll
            for (int ai = 0; ai < 2; ++ai)
#pragma unroll
                for (int m = 0; m < 4; ++m) { bf16_t* rowp = base + (size_t)(row0 + ai * HALF + m * 16) * 1024; const float sr = rs[ai][m];
#pragma unroll
                    for (int bj = 0; bj < 2; ++bj) { f32x4 v0 = acc[ai][bj][m][0] * sr, v1 = acc[ai][bj][m][1] * sr;
                        if (sg) { v0[0] = sigmoidf_(v0[0]); v0[1] = sigmoidf_(v0[1]); v0[2] = sigmoidf_(v0[2]); v0[3] = sigmoidf_(v0[3]); v1[0] = sigmoidf_(v1[0]); v1[1] = sigmoidf_(v1[1]); v1[2] = sigmoidf_(v1[2]); v1[3] = sigmoidf_(v1[3]); }
                        u32x4 w; w.x = cvt_pk_bf16(v0[0], v0[1]); w.y = cvt_pk_bf16(v0[2], v0[3]); w.z = cvt_pk_bf16(v1[0], v1[1]); w.w = cvt_pk_bf16(v1[2], v1[3]);
                        *(u32x4*)(rowp + bj * HALF) = w; } }
        }
    }
};
struct EpiSoftmax {
    static constexpr bool PERM = true, AFTER_DRAIN = true, MULTI = false;
    bf16_t* P; int ldp; float sc; const float* rss;
    __device__ __forceinline__ void fused(f32x4 (&acc)[2][2][4][2], const Unit& u, int wr, int wc, int fr, int fq, PG8_LAS unsigned char* lds, int wid, int lane) const {
        PG8_LAS float* Ps = (PG8_LAS float*)lds;
        const int row0 = u.pm * BM + wr * 64 + fr;
        float rs[2][4]; row_rs8(rs, rss, row0, fq);
#pragma unroll
        for (int ai = 0; ai < 2; ++ai)
#pragma unroll
            for (int m = 0; m < 4; ++m) { const float k = sc * rs[ai][m]; float t = 0.f;
#pragma unroll
                for (int bj = 0; bj < 2; ++bj)
#pragma unroll
                    for (int n = 0; n < 2; ++n) { f32x4 e = acc[ai][bj][m][n] * k; e[0] = __builtin_amdgcn_exp2f(e[0]); e[1] = __builtin_amdgcn_exp2f(e[1]); e[2] = __builtin_amdgcn_exp2f(e[2]); e[3] = __builtin_amdgcn_exp2f(e[3]);
                        acc[ai][bj][m][n] = e; t += (e[0] + e[1]) + (e[2] + e[3]); }
                t = pg8::xadd<16>(t); t = pg8::xadd<32>(t);
                if (fq == 0) Ps[(ai * HALF + wr * 64 + m * 16 + fr) * 4 + wc] = t; }
        asm volatile("s_waitcnt lgkmcnt(0)" ::: "memory"); __builtin_amdgcn_s_barrier(); asm volatile("" ::: "memory");
#pragma unroll
        for (int ai = 0; ai < 2; ++ai)
#pragma unroll
            for (int m = 0; m < 4; ++m) { const f32x4 q = *(const PG8_LAS f32x4*)(Ps + (ai * HALF + wr * 64 + m * 16 + fr) * 4); const float inv = 1.0f / ((q[0] + q[1]) + (q[2] + q[3]));
                bf16_t* rowp = P + (size_t)(row0 + ai * HALF + m * 16) * ldp + u.pn * BM + wc * 32 + 8 * fq;
#pragma unroll
                for (int bj = 0; bj < 2; ++bj) { const f32x4 v0 = acc[ai][bj][m][0] * inv, v1 = acc[ai][bj][m][1] * inv;
                    u32x4 w; w.x = cvt_pk_bf16(v0[0], v0[1]); w.y = cvt_pk_bf16(v0[2], v0[3]); w.z = cvt_pk_bf16(v1[0], v1[1]); w.w = cvt_pk_bf16(v1[2], v1[3]);
                    *(u32x4*)(rowp + bj * HALF) = w; } }
        asm volatile("s_waitcnt lgkmcnt(0)" ::: "memory"); __builtin_amdgcn_s_barrier(); asm volatile("" ::: "memory");
    }
};
struct EpiRes {
    static constexpr bool PERM = true, AFTER_DRAIN = false, MULTI = false;
    const bf16_t* xo; bf16_t* xb; int ldx; float* rssp;
    __device__ __forceinline__ void operator()(const f32x4 (&acc)[2][2][4][2], const Unit& u, int wr, int wc, int fr, int fq) const {
        const int col0 = u.pn * BM + wc * 32 + 8 * fq;
#pragma unroll
        for (int ai = 0; ai < 2; ++ai) {
            u32x4 ro[4][2];
#pragma unroll
            for (int m = 0; m < 4; ++m)
#pragma unroll
                for (int bj = 0; bj < 2; ++bj) ro[m][bj] = *(const u32x4*)(xo + (size_t)(u.pm * BM + ai * HALF + wr * 64 + m * 16 + fr) * ldx + col0 + bj * HALF);
#pragma unroll
            for (int m = 0; m < 4; ++m) { const int row = u.pm * BM + ai * HALF + wr * 64 + m * 16 + fr; float ss = 0.f;
#pragma unroll
                for (int bj = 0; bj < 2; ++bj) { const u32x4 o = ro[m][bj];
                    f32x4 v0 = acc[ai][bj][m][0], v1 = acc[ai][bj][m][1];
                    v0[0] += bf_lo(o.x); v0[1] += bf_hi(o.x); v0[2] += bf_lo(o.y); v0[3] += bf_hi(o.y); v1[0] += bf_lo(o.z); v1[1] += bf_hi(o.z); v1[2] += bf_lo(o.w); v1[3] += bf_hi(o.w);
                    ss += ((v0[0] * v0[0] + v0[1] * v0[1]) + (v0[2] * v0[2] + v0[3] * v0[3])) + ((v1[0] * v1[0] + v1[1] * v1[1]) + (v1[2] * v1[2] + v1[3] * v1[3]));
                    u32x4 w; w.x = cvt_pk_bf16(v0[0], v0[1]); w.y = cvt_pk_bf16(v0[2], v0[3]); w.z = cvt_pk_bf16(v1[0], v1[1]); w.w = cvt_pk_bf16(v1[2], v1[3]);
                    *(u32x4*)(xb + (size_t)row * ldx + col0 + bj * HALF) = w; }
                ss = pg8::xadd<16>(ss); ss = pg8::xadd<32>(ss);
                if (fq == 0) rssp[(size_t)row * 32 + u.pn * 4 + wc] = ss; }
            asm volatile("" ::: "memory"); }
    }
};
struct EpiMerge {
    static constexpr bool PERM = true, AFTER_DRAIN = false, MULTI = true;
    const bf16_t* gates; bf16_t* merged;
    __device__ __forceinline__ void step(f32x4 (&acc)[2][2][4][2], const Unit& u, int wr, int wc, int fr, int fq) const {
        const size_t SEGE = (size_t)16384 * 1024; const int sub = u.sub; const bool last = sub == 2;
        const int row0 = u.pm * BM + wr * 64 + fr; const int gcol = (u.pn & 3) * BM + wc * 32 + 8 * fq;
        const bf16_t* ga = gates + (size_t)(2 * sub + (u.pn >> 2)) * SEGE + gcol;
        const bf16_t* gb = last ? ga : ga + 2 * SEGE;
#pragma unroll
        for (int ai = 0; ai < 2; ++ai)
#pragma unroll
            for (int m = 0; m < 4; ++m) {
                u32x4 za[2], zb[2];
#pragma unroll
                for (int bj = 0; bj < 2; ++bj) { const size_t p = (size_t)(row0 + ai * HALF + m * 16) * 1024 + bj * HALF; za[bj] = *(const u32x4*)(ga + p); zb[bj] = *(const u32x4*)(gb + p); }
#pragma unroll
                for (int bj = 0; bj < 2; ++bj) { const unsigned aw[4] = {za[bj].x, za[bj].y, za[bj].z, za[bj].w}; unsigned bw[4] = {zb[bj].x, zb[bj].y, zb[bj].z, zb[bj].w};
                    float f[8];
#pragma unroll
                    for (int j = 0; j < 4; ++j) { if (last) bw[j] = 0x3f803f80u; f[2 * j] = bf_lo(aw[j]) * __builtin_amdgcn_rcpf(bf_lo(bw[j])); f[2 * j + 1] = bf_hi(aw[j]) * __builtin_amdgcn_rcpf(bf_hi(bw[j])); }
                    f32x4 v0 = acc[ai][bj][m][0], v1 = acc[ai][bj][m][1];
                    v0[0] *= f[0]; v0[1] *= f[1]; v0[2] *= f[2]; v0[3] *= f[3]; v1[0] *= f[4]; v1[1] *= f[5]; v1[2] *= f[6]; v1[3] *= f[7];
                    acc[ai][bj][m][0] = v0; acc[ai][bj][m][1] = v1;
                    if (last) { u32x4 w; w.x = cvt_pk_bf16(v0[0], v0[1]); w.y = cvt_pk_bf16(v0[2], v0[3]); w.z = cvt_pk_bf16(v1[0], v1[1]); w.w = cvt_pk_bf16(v1[2], v1[3]);
                        *(u32x4*)(merged + (size_t)(row0 + ai * HALF + m * 16) * 2048 + u.pn * BM + wc * 32 + 8 * fq + bj * HALF) = w; } }
                if (m & 1) asm volatile("" ::: "memory"); }
    }
};
struct MergeOrder {
    StaticOrder T; unsigned ystride, wstride;
    __device__ __forceinline__ bool next(int i, Unit& u) const {
        const int ti = i / 3, sub = i - 3 * ti;
        if (!T.next(ti, u)) return false;
        u.sub = sub; u.offA += (unsigned)sub * ystride; u.offB += (unsigned)sub * wstride; return true;
    }
    __device__ __forceinline__ void a_ready(const Unit&) const {}
    __device__ __forceinline__ void done(const Unit&) const {}
};
struct EpiSwiGLU {
    static constexpr bool PERM = true, AFTER_DRAIN = false, MULTI = false;
    bf16_t* O; int ldo; const float* rss;
    __device__ __forceinline__ void operator()(const f32x4 (&acc)[2][2][4][2], const Unit& u, int wr, int wc, int fr, int fq) const {
        const int row0 = u.pm * BM + wr * 64 + fr; const int j0 = (u.pn * BM + wc * 32 + 8 * fq) >> 1;
        float rs[2][4]; row_rs8(rs, rss, row0, fq);
#pragma unroll
        for (int ai = 0; ai < 2; ++ai)
#pragma unroll
            for (int m = 0; m < 4; ++m) { bf16_t* rowp = O + (size_t)(row0 + ai * HALF + m * 16) * ldo + j0; const float sr = rs[ai][m];
#pragma unroll
                for (int bj = 0; bj < 2; ++bj) { const f32x4 v0 = acc[ai][bj][m][0] * sr, v1 = acc[ai][bj][m][1] * sr;
                    const float o0 = v0[0] * sigmoidf_(v0[0]) * v0[1], o1 = v0[2] * sigmoidf_(v0[2]) * v0[3], o2 = v1[0] * sigmoidf_(v1[0]) * v1[1], o3 = v1[2] * sigmoidf_(v1[2]) * v1[3];
                    u32x2 w; w.x = cvt_pk_bf16(o0, o1); w.y = cvt_pk_bf16(o2, o3);
                    *(u32x2*)(rowp + bj * (HALF / 2)) = w; } }
    }
};

template <class Epi, class Sched, bool ALIGN_EPI = false, bool SP2 = false>
__device__ __forceinline__ void gemm_phase(PG8_LAS unsigned char* lds, const Gemm g, const Sched& S, const Epi& E, const int wave_sg) {
    int tid_ = opq(wave_sg) * 64 + lane_id(); asm volatile("" : "+v"(tid_));
    const char* gA = uni_ptr((const char*)g.A); const char* gB = uni_ptr((const char*)g.Bt);
    const int tid = tid_, wid = __builtin_amdgcn_readfirstlane(tid >> 6), lane = tid & 63, wr = wid >> 2, wc = wid & 3, fr = lane & 15, fq = lane >> 4;
    int K_ = g.K; asm volatile("" : "+s"(K_));
    const int K = K_, nt = K / BK;
    unsigned voffA[2], voffB[2];
#pragma unroll
    for (int i = 0; i < 2; ++i) { int R, C; stage_rc(tid * 16 + i * 8192, R, C); const int Rb = Epi::PERM ? ((R & ~31) + perm32(R & 31)) : R;
        voffA[i] = (unsigned)(R * g.lda + C) * 2u; voffB[i] = (unsigned)(Rb * g.ldb + C) * 2u; }
    const size_t kstep = (size_t)(BK * 2);
    const unsigned hsA = (unsigned)HALF * g.lda * 2u, hsB = (unsigned)HALF * g.ldb * 2u;
    const unsigned ldsw = (unsigned)wid * 1024u;
    const int aoff = lds_byte(wr * 64 + fr, fq * 8), boff = lds_byte(wc * 32 + fr, fq * 8);
#define PG8_SA(b, h) (((b) * 2 + (h)) * HTB)
#define PG8_SB(b, h) ((4 + (b) * 2 + (h)) * HTB)
#define PG8_STAGE(bufoff, gbase, voff) do { _Pragma("unroll") for (int _i = 0; _i < 2; ++_i) \
        __builtin_amdgcn_global_load_lds((const unsigned*)((const char*)(gbase) + (voff)[_i]), (PG8_LAS unsigned*)(lds + (bufoff) + ldsw + _i * 8192), 16, 0, 0); } while (0)
#define PG8_LDA(dst, b, h) do { _Pragma("unroll") for (int m = 0; m < 4; ++m) _Pragma("unroll") for (int k = 0; k < 2; ++k) dst[m][k] = *(const PG8_LAS bf16x8*)(lds + PG8_SA(b, h) + aoff + m * 2048 + k * 1024); } while (0)
#define PG8_LDB(dst, b, h) do { _Pragma("unroll") for (int n = 0; n < 2; ++n) _Pragma("unroll") for (int k = 0; k < 2; ++k) dst[n][k] = *(const PG8_LAS bf16x8*)(lds + PG8_SB(b, h) + boff + n * 2048 + k * 1024); } while (0)
#define PG8_MMA(ai, bj, At, Bt) do { __builtin_amdgcn_s_setprio(1); _Pragma("unroll") for (int m = 0; m < 4; ++m) _Pragma("unroll") for (int n = 0; n < 2; ++n) _Pragma("unroll") for (int k = 0; k < 2; ++k) \
        asm volatile("v_mfma_f32_16x16x32_bf16 %0, %1, %2, %0" : "+v"(acc[ai][bj][m][n]) : "v"(Bt[n][k]), "v"(At[m][k])); __builtin_amdgcn_s_setprio(0); } while (0)
#define PG8_WAIT_V(n) asm volatile("s_waitcnt vmcnt(" #n ")" ::: "memory")
#define PG8_WAIT_L(n) asm volatile("s_waitcnt lgkmcnt(" #n ")" ::: "memory")
#define PG8_BAR __builtin_amdgcn_s_barrier()
#define PG8_SCHED __builtin_amdgcn_sched_barrier(0)
    Unit cur, nxt; int ui = 0;
    if (!S.next(0, cur)) return;
    f32x4 acc[2][2][4][2];
#pragma unroll
    for (int a = 0; a < 2; ++a)
#pragma unroll
        for (int b = 0; b < 2; ++b)
#pragma unroll
            for (int m = 0; m < 4; ++m)
#pragma unroll
                for (int n = 0; n < 2; ++n) acc[a][b][m][n] = (f32x4){0.f, 0.f, 0.f, 0.f};
    bf16x8 At[4][2], B0[2][2], B1[2][2];
    const char* cA = gA + cur.offA; const char* cB = gB + cur.offB;
    S.a_ready(cur);
    if constexpr (SP2) {
        PG8_STAGE(PG8_SB(0, 0), cB, voffB); PG8_STAGE(PG8_SB(0, 1), cB + hsB, voffB); PG8_STAGE(PG8_SA(0, 0), cA, voffA); PG8_STAGE(PG8_SA(0, 1), cA + hsA, voffA);
        if (wr == 1) PG8_BAR;
        PG8_WAIT_V(2); PG8_BAR;
        PG8_STAGE(PG8_SB(1, 0), cB + kstep, voffB); PG8_STAGE(PG8_SA(1, 0), cA + kstep, voffA); PG8_STAGE(PG8_SB(1, 1), cB + hsB + kstep, voffB);
        PG8_WAIT_V(6); PG8_BAR;
    } else {
        PG8_STAGE(PG8_SB(0, 0), cB, voffB); PG8_STAGE(PG8_SA(0, 0), cA, voffA); PG8_STAGE(PG8_SB(0, 1), cB + hsB, voffB); PG8_STAGE(PG8_SA(0, 1), cA + hsA, voffA);
        if (wr == 1) PG8_BAR;
        PG8_WAIT_V(4); PG8_BAR;
        PG8_STAGE(PG8_SB(1, 0), cB + kstep, voffB); PG8_STAGE(PG8_SA(1, 0), cA + kstep, voffA); PG8_STAGE(PG8_SB(1, 1), cB + hsB + kstep, voffB);
        PG8_WAIT_V(6); PG8_BAR;
    }
    for (;;) {
        const bool has_next = S.next(ui + 1, nxt);
        const char* nA = has_next ? gA + nxt.offA : cA; const char* nB = has_next ? gB + nxt.offB : cB;
        for (int t = 0; t < nt; t += 2) {
            const bool last = (t == nt - 2);
            const char* a1 = cA + (size_t)(t + 1) * kstep;
            const char* a2 = last ? nA : cA + (size_t)(t + 2) * kstep; const char* b2 = last ? nB : cB + (size_t)(t + 2) * kstep;
            const char* a3 = a2 + kstep; const char* b3 = b2 + kstep;
            if (last && has_next) S.a_ready(nxt);
            if constexpr (SP2) {
            PG8_LDB(B0, 0, 0); PG8_LDB(B1, 0, 1); PG8_SCHED; PG8_LDA(At, 0, 0); PG8_STAGE(PG8_SA(1, 1), a1 + hsA, voffA);
            PG8_WAIT_V(8); PG8_WAIT_L(0); PG8_BAR; PG8_MMA(0, 0, At, B0); PG8_MMA(0, 1, At, B1); PG8_BAR; PG8_SCHED;
            PG8_LDA(At, 0, 1); PG8_STAGE(PG8_SB(0, 0), b2, voffB); PG8_STAGE(PG8_SB(0, 1), b2 + hsB, voffB); PG8_STAGE(PG8_SA(0, 0), a2, voffA);
            PG8_WAIT_V(8); PG8_WAIT_L(0); PG8_BAR; PG8_MMA(1, 0, At, B0); PG8_MMA(1, 1, At, B1); PG8_BAR; PG8_SCHED;
            PG8_LDB(B0, 1, 0); PG8_LDB(B1, 1, 1); PG8_SCHED; PG8_LDA(At, 1, 0); PG8_STAGE(PG8_SA(0, 1), a2 + hsA, voffA);
            PG8_WAIT_V(8); PG8_WAIT_L(0); PG8_BAR; PG8_MMA(0, 0, At, B0); PG8_MMA(0, 1, At, B1); PG8_BAR; PG8_SCHED;
            PG8_LDA(At, 1, 1); PG8_STAGE(PG8_SB(1, 0), b3, voffB); PG8_STAGE(PG8_SB(1, 1), b3 + hsB, voffB); PG8_STAGE(PG8_SA(1, 0), a3, voffA);
            PG8_WAIT_V(8); PG8_WAIT_L(0); PG8_BAR; PG8_MMA(1, 0, At, B0); PG8_MMA(1, 1, At, B1); PG8_BAR; PG8_SCHED;
            } else {
            PG8_LDB(B0, 0, 0); PG8_SCHED; PG8_LDA(At, 0, 0); PG8_STAGE(PG8_SA(1, 1), a1 + hsA, voffA);
            PG8_WAIT_L(8); PG8_BAR; PG8_WAIT_L(0); PG8_MMA(0, 0, At, B0); PG8_BAR; PG8_SCHED;
            PG8_LDB(B1, 0, 1); PG8_STAGE(PG8_SB(0, 0), b2, voffB);
            PG8_BAR; PG8_WAIT_L(0); PG8_MMA(0, 1, At, B1); PG8_BAR;
            PG8_LDA(At, 0, 1); PG8_STAGE(PG8_SA(0, 0), a2, voffA);
            PG8_BAR; PG8_WAIT_L(0); PG8_MMA(1, 0, At, B0); PG8_BAR; PG8_SCHED;
            PG8_STAGE(PG8_SB(0, 1), b2 + hsB, voffB);
            PG8_WAIT_V(6); PG8_BAR; PG8_MMA(1, 1, At, B1); PG8_BAR;
            PG8_LDB(B0, 1, 0); PG8_SCHED; PG8_LDA(At, 1, 0); PG8_STAGE(PG8_SA(0, 1), a2 + hsA, voffA);
            PG8_WAIT_L(8); PG8_BAR; PG8_WAIT_L(0); PG8_MMA(0, 0, At, B0); PG8_BAR; PG8_SCHED;
            PG8_LDB(B1, 1, 1); PG8_STAGE(PG8_SB(1, 0), b3, voffB);
            PG8_BAR; PG8_WAIT_L(0); PG8_MMA(0, 1, At, B1); PG8_BAR;
            PG8_LDA(At, 1, 1); PG8_STAGE(PG8_SA(1, 0), a3, voffA);
            PG8_BAR; PG8_WAIT_L(0); PG8_MMA(1, 0, At, B0); PG8_BAR; PG8_SCHED;
            PG8_STAGE(PG8_SB(1, 1), b3 + hsB, voffB);
            PG8_WAIT_V(6); PG8_BAR; PG8_MMA(1, 1, At, B1); PG8_BAR;
            }
        }
        if constexpr (ALIGN_EPI) { if (wr == 0) PG8_BAR; }
        asm volatile("s_nop 15\n\ts_nop 15" ::: "memory");
        if constexpr (Epi::MULTI) { E.step(acc, cur, wr, wc, fr, fq); S.done(cur); }
        else if constexpr (!Epi::AFTER_DRAIN) { E(acc, cur, wr, wc, fr, fq);
#if defined(EPI_TWICE)
            if constexpr (Epi::PERM) { asm volatile("" ::: "memory"); E(acc, cur, wr, wc, fr, fq); }
#endif
            S.done(cur); }
        if (!has_next) break;
        if (!Epi::MULTI || cur.sub == 2) {
#pragma unroll
        for (int a = 0; a < 2; ++a)
#pragma unroll
            for (int b = 0; b < 2; ++b)
#pragma unroll
                for (int m = 0; m < 4; ++m)
#pragma unroll
                    for (int n = 0; n < 2; ++n) acc[a][b][m][n] = (f32x4){0.f, 0.f, 0.f, 0.f}; }
        cur = nxt; cA = nA; cB = nB; ++ui;
        if constexpr (ALIGN_EPI) { if (wr == 1) PG8_BAR; }
    }
    PG8_WAIT_V(0);
    if constexpr (!ALIGN_EPI) { if (wr == 0) PG8_BAR; }
    PG8_BAR;
    if constexpr (Epi::AFTER_DRAIN) { E.fused(acc, cur, wr, wc, fr, fq, lds, wid, lane); S.done(cur); }
#undef PG8_SA
#undef PG8_SB
#undef PG8_STAGE
#undef PG8_LDA
#undef PG8_LDB
#undef PG8_MMA
#undef PG8_WAIT_V
#undef PG8_WAIT_L
#undef PG8_BAR
#undef PG8_SCHED
}
}

#include <hip/hip_bf16.h>
#include <cmath>
namespace attn_body {
using bf16=__hip_bfloat16;
using bf16x8=__attribute__((ext_vector_type(8)))short;
using s16x4=__attribute__((ext_vector_type(4)))short;
using f32x16=__attribute__((ext_vector_type(16)))float;
using u32x4=__attribute__((ext_vector_type(4)))unsigned;
constexpr int BATCH=8,NHEAD=16,SEQ=2048,D=64,DM=NHEAD*D;
constexpr int NW=8,QBLK=32,QB=QBLK*NW,KVBLK=64,NQB=SEQ/QB;
constexpr int ATTN_PITCH=DM, ATTN_UNIT_ROWS=QB;
__device__ __forceinline__ int crow(int r,int hi){return (r&3)+8*(r>>2)+4*hi;}
#define SBAR() __builtin_amdgcn_sched_barrier(0)
__device__ __forceinline__ void cmask(f32x16&p0,f32x16&p1,int jb,int qrel,int hi){
  const float NEG=-INFINITY; int kb=64*jb+4*hi;
  #pragma unroll
  for(int r=0;r<16;++r){int kv=kb+(r&3)+8*(r>>2); if(kv>qrel)p0[r]=NEG; if(kv+32>qrel)p1[r]=NEG;}
}

constexpr int NSLOT=3, SLOTB=8192;
constexpr int LDS_K=0, LDS_V=NSLOT*SLOTB, LDS_WS=2*NSLOT*SLOTB, LDS_OST=LDS_WS+NW*64*4, LDS_BYTES=LDS_OST+NW*4096;
constexpr float C2=0.125f*1.4426950408889634f;
__device__ __forceinline__ void glds16(const void*gsrc,unsigned lds_dst){unsigned keep;
  asm volatile("s_mov_b32 %0, m0\n\ts_mov_b32 m0, %2\n\ts_nop 0\n\tglobal_load_lds_dwordx4 %1, off\n\ts_mov_b32 m0, %0":"=&s"(keep):"v"(gsrc),"s"(lds_dst):"memory");}
__device__ __forceinline__ float max3f(float a,float b,float c){float r;asm("v_max3_f32 %0, %1, %2, %3":"=v"(r):"v"(a),"v"(b),"v"(c));return r;}
__device__ __forceinline__ float max2f(float a,float b){float r;asm("v_max_f32_e32 %0, %1, %2":"=v"(r):"v"(a),"v"(b));return r;}
__device__ __forceinline__ float fadd_s(float a,float b){float r;asm("v_add_f32_e32 %0, %1, %2":"=v"(r):"v"(a),"v"(b));return r;}
__device__ __forceinline__ float fsub_s(float a,float b){float r;asm("v_sub_f32_e32 %0, %1, %2":"=v"(r):"v"(a),"v"(b));return r;}
typedef float f32x2_t __attribute__((ext_vector_type(2))); typedef __bf16 bf16x2_t __attribute__((ext_vector_type(2)));
__device__ __forceinline__ unsigned cvtpk_s(float lo,float hi){f32x2_t v={lo,hi};bf16x2_t b=__builtin_convertvector(v,bf16x2_t);return __builtin_bit_cast(unsigned,b);}
#define WAIT_BAR(N) asm volatile("s_waitcnt vmcnt(" #N ") lgkmcnt(0)\n\ts_barrier":::"memory")

__device__ __forceinline__ void qkt(f32x16&p0,f32x16&p1,const char*Kslot,const bf16x8*qr,const f32x16&negm,int r32,int hi){
  const char*kb=Kslot+hi*1024+r32*16;
  #pragma unroll
  for(int d0=0;d0<4;++d0){
    const bf16x8 b0=*reinterpret_cast<const bf16x8*>(kb+d0*2048);
    const bf16x8 b1=*reinterpret_cast<const bf16x8*>(kb+d0*2048+512);
    if(d0==0){p0=__builtin_amdgcn_mfma_f32_32x32x16_bf16(b0,qr[0],negm,0,0,0);p1=__builtin_amdgcn_mfma_f32_32x32x16_bf16(b1,qr[0],negm,0,0,0);}
    else{p0=__builtin_amdgcn_mfma_f32_32x32x16_bf16(b0,qr[d0],p0,0,0,0);p1=__builtin_amdgcn_mfma_f32_32x32x16_bf16(b1,qr[d0],p1,0,0,0);}}
}
typedef __attribute__((address_space(3))) const char* lds_cptr;
typedef short v4i16_t __attribute__((ext_vector_type(4)));
__device__ __forceinline__ void kload8(bf16x8*kf,lds_cptr kp){
  kf[0]=*(const __attribute__((address_space(3))) bf16x8*)(kp);      kf[1]=*(const __attribute__((address_space(3))) bf16x8*)(kp+512);
  kf[2]=*(const __attribute__((address_space(3))) bf16x8*)(kp+2048); kf[3]=*(const __attribute__((address_space(3))) bf16x8*)(kp+2560);
  kf[4]=*(const __attribute__((address_space(3))) bf16x8*)(kp+4096); kf[5]=*(const __attribute__((address_space(3))) bf16x8*)(kp+4608);
  kf[6]=*(const __attribute__((address_space(3))) bf16x8*)(kp+6144); kf[7]=*(const __attribute__((address_space(3))) bf16x8*)(kp+6656);
}
__device__ __forceinline__ void kload2(bf16x8*kf,lds_cptr kp,int j){ kf[2*j]=*(const __attribute__((address_space(3))) bf16x8*)(kp+j*2048); kf[2*j+1]=*(const __attribute__((address_space(3))) bf16x8*)(kp+j*2048+512); }
__device__ __forceinline__ s16x4 vtr(lds_cptr p){ return __builtin_bit_cast(s16x4,__builtin_amdgcn_ds_read_tr16_b64_v4i16((__attribute__((address_space(3))) v4i16_t*)p)); }
__device__ __forceinline__ float rowmax(const f32x16&p0,const f32x16&p1){
  float a=max3f(p0[0],p0[1],p1[0]),b=max3f(p0[2],p0[3],p1[1]);a=max3f(a,p1[2],p1[3]);
  #pragma unroll
  for(int r=4;r<16;r+=4){a=max3f(a,p0[r],p0[r+1]);b=max3f(b,p0[r+2],p0[r+3]);a=max3f(a,p1[r],p1[r+1]);b=max3f(b,p1[r+2],p1[r+3]);}
  const float m=max2f(a,b);
  auto rr=__builtin_amdgcn_permlane32_swap(__float_as_uint(m),__float_as_uint(m),false,false);
  return max2f(__uint_as_float(rr[0]),__uint_as_float(rr[1]));
}
__device__ __forceinline__ void pv(f32x16*o,int vb,bf16x8 pa0,bf16x8 pa1,bf16x8 pa2,bf16x8 pa3){
  #pragma unroll
  for(int d0=0;d0<2;++d0){s16x4 lo[4],hi[4];
    #pragma unroll
    for(int ks=0;ks<4;++ks){
      asm volatile("ds_read_b64_tr_b16 %0,%1 offset:%c2":"=&v"(lo[ks]):"v"(vb),"i"(d0*4096+ks*1024):"memory");
      asm volatile("ds_read_b64_tr_b16 %0,%1 offset:%c2":"=&v"(hi[ks]):"v"(vb),"i"(d0*4096+ks*1024+512):"memory");}
    asm volatile("s_waitcnt lgkmcnt(0)":::"memory");SBAR();
    #define PK(k) (bf16x8){lo[k][0],lo[k][1],lo[k][2],lo[k][3],hi[k][0],hi[k][1],hi[k][2],hi[k][3]}
    o[d0]=__builtin_amdgcn_mfma_f32_32x32x16_bf16(pa0,PK(0),o[d0],0,0,0);
    o[d0]=__builtin_amdgcn_mfma_f32_32x32x16_bf16(pa1,PK(1),o[d0],0,0,0);
    o[d0]=__builtin_amdgcn_mfma_f32_32x32x16_bf16(pa2,PK(2),o[d0],0,0,0);
    o[d0]=__builtin_amdgcn_mfma_f32_32x32x16_bf16(pa3,PK(3),o[d0],0,0,0);
    #undef PK
  }
}

#ifndef ATTN_STORE16
#define ATTN_STORE16(p,v) (*(u32x4*)(p)=(v))
#endif
template<int THRL> __device__ __forceinline__ void attn_unit(int wave_sg,int b,int h,int hv,int qb,const bf16*Q,const bf16*__restrict__ K,const bf16*__restrict__ V,bf16*O,char*shm){
  int tid_=pg8::opq(wave_sg)*64+pg8::lane_id(); asm volatile("":"+v"(tid_)); const int tid=tid_,lane=tid&63,r32=lane&31,hi=lane>>5; const int wid=__builtin_amdgcn_readfirstlane(tid>>6);
  const long rowbase=(long)b*SEQ; const int q0=qb*QB;
  const bf16*Qw=Q+(rowbase+q0+wid*QBLK)*DM+h*D;
  const bf16*Kh=K+rowbase*DM+h*D,*Vh=V+rowbase*DM+hv*D;
  const unsigned lds0=(unsigned)(uintptr_t)shm;
  float*wsf=(float*)(shm+LDS_WS)+wid*64;
  const bf16*ksrc=Kh+(long)lane*DM+wid*8;
  const bf16*vsrc=Vh+(long)(16*(wid&3)+(lane>>2))*DM+(wid>>2)*32+(lane&3)*8;
  const unsigned kdst=lds0+LDS_K+wid*1024, vdst=lds0+LDS_V+wid*1024;
  #define DMA_K(t,slot) glds16(ksrc+(long)(t)*KVBLK*DM,(unsigned)__builtin_amdgcn_readfirstlane(kdst+(slot)))
  #define DMA_V(t,slot) glds16(vsrc+(long)(t)*KVBLK*DM,(unsigned)__builtin_amdgcn_readfirstlane(vdst+(slot)))
  const int vb0=(int)(lds0+LDS_V)+((lane>>4)&1)*32+(lane&3)*8+(4*hi+((lane&15)>>2))*64;
  const char*Kbase=shm+LDS_K; bf16x8 kf[8];
  const lds_cptr shm3=(lds_cptr)shm; const lds_cptr kp0=shm3+LDS_K+hi*1024+r32*16; const lds_cptr vp0=shm3+LDS_V+((lane>>4)&1)*32+(lane&3)*8+(4*hi+((lane&15)>>2))*64;
  const int NT=(q0+QB)/KVBLK;
  DMA_K(0,0);DMA_V(0,0);DMA_K(1,SLOTB);
  bf16x8 qr[4];
  #pragma unroll
  for(int d0=0;d0<4;++d0)qr[d0]=*reinterpret_cast<const bf16x8*>(&Qw[(long)r32*DM+d0*16+hi*8]);
  float mhat=0.f,l_reg=0.f;f32x16 o[2];o[0]=f32x16{};o[1]=f32x16{};f32x16 negm=f32x16{};asm volatile("":"+v"(negm));
  const int qrel=wid*QBLK+r32;
  #define CMASK(P0,P1,t) do{int jb_=(t)-(NT-4); if(jb_>=0)cmask(P0,P1,jb_,qrel,hi);}while(0)
  bool resc=false;
  #define START(P0,P1) do{ const float rm=rowmax(P0,P1); resc=false; \
    { const float dl=rm; mhat=fadd_s(mhat,dl); \
      _Pragma("unroll") for(int r=0;r<16;++r){P0[r]=fsub_s(P0[r],dl);P1[r]=fsub_s(P1[r],dl);} \
      _Pragma("unroll") for(int r=0;r<16;++r)negm[r]=-mhat; asm volatile("":"+v"(negm)); } \
    _Pragma("unroll") for(int r=0;r<16;++r)P0[r]=__builtin_amdgcn_exp2f(P0[r]); }while(0)
  #define RESC() do{ if(resc){ asm volatile("s_waitcnt lgkmcnt(0)":::"memory"); \
      _Pragma("unroll") for(int d_=0;d_<2;++d_) _Pragma("unroll") for(int r=0;r<16;++r)o[d_][r]*=wsf[crow(r,hi)]; } }while(0)
  f32x16 pA0,pA1,pB0,pB1;
  int sl_prev=0,sl_cur=0,sl_next=SLOTB;
  #define ROT() do{sl_prev=sl_cur;sl_cur=sl_next;sl_next=(sl_next==(NSLOT-1)*SLOTB)?0:sl_next+SLOTB;}while(0)
  DMA_K(2,2*SLOTB);
  WAIT_BAR(3);
  qkt(pA0,pA1,Kbase,qr,negm,r32,hi);asm volatile("s_nop 15\n\ts_nop 7":"+v"(pA0),"+v"(pA1));CMASK(pA0,pA1,0);
  START(pA0,pA1);
  _Pragma("unroll") for(int r=0;r<16;++r)pA1[r]=__builtin_amdgcn_exp2f(pA1[r]);
  WAIT_BAR(0);
  DMA_K(3,0);DMA_V(1,SLOTB);
  ROT();
  kload8(kf,kp0+sl_cur);
  WAIT_BAR(2);
  s16x4 vlo[8],vhi[8]; u32x4 pw0,pw1,pw2,pw3;
  #define PKW(P,B) cvtpk_s(P[B],P[B+1])
  #define PAF(k) __builtin_bit_cast(bf16x8,pw##k)
  #define VFR(i) (bf16x8){vlo[i][0],vlo[i][1],vlo[i][2],vlo[i][3],vhi[i][0],vhi[i][1],vhi[i][2],vhi[i][3]}
  #define PIN(x) asm volatile("":"+v"(x))
  #define MX3(a,b,c) __builtin_fmaxf(__builtin_fmaxf((a),(b)),(c))
  #define GAPA(MF,A0,A1,A2,A3,W0,W1,PW) do{ MF; sacc+=A0; sacc+=A1; sacc+=A2; sacc+=A3; PIN(sacc); W0; W1; PIN(PW); SBAR(); }while(0)
  #define EX(v) __builtin_amdgcn_exp2f(v)
  #define GAPB(MF,X,B) do{ MF; X[B]=EX(X[B]); X[B+1]=EX(X[B+1]); X[B+2]=EX(X[B+2]); X[B+3]=EX(X[B+3]); PIN(X); SBAR(); }while(0)
  #define VRD(i) do{ vlo[i]=vtr(vp_+(((i)>>2)*4096+((i)&3)*1024)); vhi[i]=vtr(vp_+(((i)>>2)*4096+((i)&3)*1024+512)); }while(0)
  #define KRD(G,j) do{ if(G){ kload2(kf,kp0+sl_next,j); SBAR(); } }while(0)
  #define STEP(C0,C1,P0,P1,t,GK,GV,GL) do{ SBAR(); \
    const lds_cptr vp_=vp0+sl_prev; \
    VRD(0); SBAR(); float sacc=(P0[0]+P0[1]); \
    GAPA(C0=__builtin_amdgcn_mfma_f32_32x32x16_bf16(kf[0],qr[0],negm,0,0,0), P0[2],P0[3],P0[4],P0[5],     pw0[0]=PKW(P0,0), pw0[1]=PKW(P0,2), pw0); \
    VRD(4); SBAR(); GAPA(C1=__builtin_amdgcn_mfma_f32_32x32x16_bf16(kf[1],qr[0],negm,0,0,0), P0[6],P0[7],P0[8],P0[9],     pw0[2]=PKW(P0,4), pw0[3]=PKW(P0,6), pw0); \
    VRD(1); SBAR(); GAPA(C0=__builtin_amdgcn_mfma_f32_32x32x16_bf16(kf[2],qr[1],C0,0,0,0),   P0[10],P0[11],P0[12],P0[13], pw1[0]=PKW(P0,8), pw1[1]=PKW(P0,10), pw1); \
    VRD(5); SBAR(); GAPA(C1=__builtin_amdgcn_mfma_f32_32x32x16_bf16(kf[3],qr[1],C1,0,0,0),   P0[14],P0[15],P1[0],P1[1],   pw1[2]=PKW(P0,12),pw1[3]=PKW(P0,14), pw1); \
    VRD(2); SBAR(); GAPA(C0=__builtin_amdgcn_mfma_f32_32x32x16_bf16(kf[4],qr[2],C0,0,0,0),   P1[2],P1[3],P1[4],P1[5],     pw2[0]=PKW(P1,0), pw2[1]=PKW(P1,2), pw2); \
    VRD(6); SBAR(); GAPA(C1=__builtin_amdgcn_mfma_f32_32x32x16_bf16(kf[5],qr[2],C1,0,0,0),   P1[6],P1[7],P1[8],P1[9],     pw2[2]=PKW(P1,4), pw2[3]=PKW(P1,6), pw2); \
    VRD(3); SBAR(); GAPA(C0=__builtin_amdgcn_mfma_f32_32x32x16_bf16(kf[6],qr[3],C0,0,0,0),   P1[10],P1[11],P1[12],P1[13], pw3[0]=PKW(P1,8), pw3[1]=PKW(P1,10), pw3); \
    VRD(7); SBAR(); GAPA(C1=__builtin_amdgcn_mfma_f32_32x32x16_bf16(kf[7],qr[3],C1,0,0,0),   P1[14],P1[15],0.f,0.f,       pw3[2]=PKW(P1,12),pw3[3]=PKW(P1,14), pw3); \
    l_reg+=sacc; \
    if(GK){DMA_K((t)+3,sl_cur);} if(GV){DMA_V((t)+1,sl_next);} \
    CMASK(C0,C1,t); \
    { float a=MX3(C0[0],C0[1],C1[0]),b=MX3(C0[2],C0[3],C1[1]); a=MX3(a,C1[2],C1[3]); \
      _Pragma("unroll") for(int r=4;r<16;r+=4){a=MX3(a,C0[r],C0[r+1]);b=MX3(b,C0[r+2],C0[r+3]);a=MX3(a,C1[r],C1[r+1]);b=MX3(b,C1[r+2],C1[r+3]);} \
      float rm=__builtin_fmaxf(a,b); { auto rr=__builtin_amdgcn_permlane32_swap(__float_as_uint(rm),__float_as_uint(rm),false,false); rm=__builtin_fmaxf(__uint_as_float(rr[0]),__uint_as_float(rr[1])); } \
      resc=false; \
      if(__builtin_expect(__any(rm>(float)THRL),0)){ const float dl=__builtin_fmaxf(rm,0.f); mhat+=dl; \
        _Pragma("unroll") for(int r=0;r<16;++r){C0[r]-=dl;C1[r]-=dl;} \
        _Pragma("unroll") for(int r=0;r<16;++r)negm[r]=-mhat; asm volatile("":"+v"(negm)); \
        const float f=__builtin_amdgcn_exp2f(-dl); l_reg*=f; if(hi==0)wsf[r32]=f; resc=true; } } \
    SBAR(); \
    GAPB(o[0]=__builtin_amdgcn_mfma_f32_32x32x16_bf16(PAF(0),VFR(0),o[0],0,0,0), C0,0); \
    GAPB(o[1]=__builtin_amdgcn_mfma_f32_32x32x16_bf16(PAF(0),VFR(4),o[1],0,0,0), C0,4); \
    KRD(GL,0); GAPB(o[0]=__builtin_amdgcn_mfma_f32_32x32x16_bf16(PAF(1),VFR(1),o[0],0,0,0), C0,8); \
    KRD(GL,1); GAPB(o[1]=__builtin_amdgcn_mfma_f32_32x32x16_bf16(PAF(1),VFR(5),o[1],0,0,0), C0,12); \
    KRD(GL,2); GAPB(o[0]=__builtin_amdgcn_mfma_f32_32x32x16_bf16(PAF(2),VFR(2),o[0],0,0,0), C1,0); \
    KRD(GL,3); GAPB(o[1]=__builtin_amdgcn_mfma_f32_32x32x16_bf16(PAF(2),VFR(6),o[1],0,0,0), C1,4); \
    GAPB(o[0]=__builtin_amdgcn_mfma_f32_32x32x16_bf16(PAF(3),VFR(3),o[0],0,0,0), C1,8); \
    GAPB(o[1]=__builtin_amdgcn_mfma_f32_32x32x16_bf16(PAF(3),VFR(7),o[1],0,0,0), C1,12); \
    }while(0)
  int t=1;
  #undef CMASK
  #define CMASK(P0,P1,t) do{}while(0)
  for(;t+5<NT;t+=2){
    STEP(pB0,pB1,pA0,pA1,t,true,true,true);     WAIT_BAR(2); RESC(); ROT();
    STEP(pA0,pA1,pB0,pB1,t+1,true,true,true);   WAIT_BAR(2); RESC(); ROT();
  }
  #undef CMASK
  #define CMASK(P0,P1,t) do{int jb_=(t)-(NT-4); if(jb_>=0)cmask(P0,P1,jb_,qrel,hi);}while(0)
  #define ENDW(tt) do{ if((tt)+3<NT){WAIT_BAR(2);} else if((tt)+2<NT){WAIT_BAR(1);} else {WAIT_BAR(0);} }while(0)
  for(;t+1<NT;t+=2){
    STEP(pB0,pB1,pA0,pA1,t,(t+3<NT),(t+1<NT),(t+1<NT));       ENDW(t);   RESC(); ROT();
    STEP(pA0,pA1,pB0,pB1,t+1,(t+4<NT),(t+2<NT),(t+2<NT));     ENDW(t+1); RESC(); ROT();
  }
  STEP(pB0,pB1,pA0,pA1,NT-1,false,false,false); RESC();
  { float sacc=pB0[0]+pB0[1]; _Pragma("unroll") for(int r=2;r<16;++r)sacc+=pB0[r]; _Pragma("unroll") for(int r=0;r<16;++r)sacc+=pB1[r]; l_reg+=sacc;
    pw0=(u32x4){PKW(pB0,0),PKW(pB0,2),PKW(pB0,4),PKW(pB0,6)};pw1=(u32x4){PKW(pB0,8),PKW(pB0,10),PKW(pB0,12),PKW(pB0,14)};pw2=(u32x4){PKW(pB1,0),PKW(pB1,2),PKW(pB1,4),PKW(pB1,6)};pw3=(u32x4){PKW(pB1,8),PKW(pB1,10),PKW(pB1,12),PKW(pB1,14)};
    SBAR(); pv(o,vb0+sl_cur,PAF(0),PAF(1),PAF(2),PAF(3)); }
  #undef PKW
  #undef PAF
  #undef VFR
  #undef PIN
  #undef MX3
  #undef GAPA
  #undef GAPB
  #undef EX
  #undef VRD
  #undef KRD
  #undef STEP
  #undef ENDW
  {auto rr=__builtin_amdgcn_permlane32_swap(__float_as_uint(l_reg),__float_as_uint(l_reg),false,false);l_reg=__uint_as_float(rr[0])+__uint_as_float(rr[1]);}
  if(hi==0)wsf[32+r32]=l_reg;asm volatile("s_waitcnt lgkmcnt(0)":::"memory");
  float rli[16];
  #pragma unroll
  for(int r=0;r<16;++r)rli[r]=__builtin_amdgcn_rcpf(wsf[32+crow(r,hi)]);
  bf16*Ow=O+(rowbase+q0+wid*QBLK)*DM+hv*D;
  { bf16*stg=(bf16*)(shm+LDS_OST)+wid*2048;
    #pragma unroll
    for(int r=0;r<16;++r){const int orow=crow(r,hi);
      #pragma unroll
      for(int d0=0;d0<2;++d0)stg[orow*64+d0*32+r32]=__float2bfloat16(o[d0][r]*rli[r]);}
    asm volatile("s_waitcnt lgkmcnt(0)":::"memory");
    #pragma unroll
    for(int i=0;i<4;++i){const int row=i*8+(lane>>3),ch=lane&7; const u32x4 v=*(const u32x4*)(stg+row*64+ch*8); ATTN_STORE16(Ow+(long)row*DM+ch*8,v);} }
  asm volatile("s_waitcnt lgkmcnt(0)\n\ts_barrier":::"memory");
  #undef DMA_K
  #undef DMA_V
  #undef CMASK
  #undef START
  #undef RESC
  #undef ROT
}
constexpr int VSLOTB=16384, LW_K=0, LW_V=NSLOT*SLOTB, LW_WS=LW_V+NSLOT*VSLOTB, LW_BYTES=LW_WS+NW*64*4;
static_assert(NW*8192<=LW_WS,"O stage overlays the K/V rings");
__device__ __forceinline__ void pv4(f32x16*o,int vb,bf16x8 pa0,bf16x8 pa1,bf16x8 pa2,bf16x8 pa3){
  #pragma unroll
  for(int d0=0;d0<4;++d0){s16x4 lo[4],hi[4];
    #pragma unroll
    for(int ks=0;ks<4;++ks){
      asm volatile("ds_read_b64_tr_b16 %0,%1 offset:%c2":"=&v"(lo[ks]):"v"(vb),"i"(d0*4096+ks*1024):"memory");
      asm volatile("ds_read_b64_tr_b16 %0,%1 offset:%c2":"=&v"(hi[ks]):"v"(vb),"i"(d0*4096+ks*1024+512):"memory");}
    asm volatile("s_waitcnt lgkmcnt(0)":::"memory");SBAR();
    #define PK(k) (bf16x8){lo[k][0],lo[k][1],lo[k][2],lo[k][3],hi[k][0],hi[k][1],hi[k][2],hi[k][3]}
    o[d0]=__builtin_amdgcn_mfma_f32_32x32x16_bf16(pa0,PK(0),o[d0],0,0,0);
    o[d0]=__builtin_amdgcn_mfma_f32_32x32x16_bf16(pa1,PK(1),o[d0],0,0,0);
    o[d0]=__builtin_amdgcn_mfma_f32_32x32x16_bf16(pa2,PK(2),o[d0],0,0,0);
    o[d0]=__builtin_amdgcn_mfma_f32_32x32x16_bf16(pa3,PK(3),o[d0],0,0,0);
    #undef PK
  }
}
__device__ __forceinline__ void attn_unit_w(int wave_sg,int b,int h8,int m,int qb,const bf16*Q,const bf16*__restrict__ K,const bf16*__restrict__ V,bf16*O,char*shm,bf16*YAo,const float*fz){
  int tid_=pg8::opq(wave_sg)*64+pg8::lane_id(); asm volatile("":"+v"(tid_)); const int tid=tid_,lane=tid&63,r32=lane&31,hi=lane>>5; const int wid=__builtin_amdgcn_readfirstlane(tid>>6);
  const long rowbase=(long)b*SEQ; const int q0=qb*QB; const int hq=2*h8+m;
  const bf16*Qw=Q+(rowbase+q0+wid*QBLK)*DM+hq*D;
  const bf16*Kh=K+rowbase*DM+hq*D,*Vh=V+rowbase*DM+h8*128;
  const unsigned lds0=(unsigned)(uintptr_t)shm;
  float*wsf=(float*)(shm+LW_WS)+wid*64;
  const bf16*ksrc=Kh+(long)lane*DM+wid*8;
  const bf16*vsrcA=Vh+(long)(16*(wid&3)+(lane>>2))*DM+(wid>>2)*32+(lane&3)*8;
  const bf16*vsrcB=vsrcA+64;
  const unsigned kdst=lds0+LW_K+wid*1024, vdstA=lds0+LW_V+wid*1024, vdstB=vdstA+8192;
  #define DMA_K(t,slot) glds16(ksrc+(long)(t)*KVBLK*DM,(unsigned)__builtin_amdgcn_readfirstlane(kdst+(slot)))
  #define DMA_V(t,slot) do{ glds16(vsrcA+(long)(t)*KVBLK*DM,(unsigned)__builtin_amdgcn_readfirstlane(vdstA+2*(slot))); glds16(vsrcB+(long)(t)*KVBLK*DM,(unsigned)__builtin_amdgcn_readfirstlane(vdstB+2*(slot))); }while(0)
  const int vb0=(int)(lds0+LW_V)+((lane>>4)&1)*32+(lane&3)*8+(4*hi+((lane&15)>>2))*64;
  const char*Kbase=shm+LW_K; bf16x8 kf[8];
  const lds_cptr shm3=(lds_cptr)shm; const lds_cptr kp0=shm3+LW_K+hi*1024+r32*16; const lds_cptr vp0=shm3+LW_V+((lane>>4)&1)*32+(lane&3)*8+(4*hi+((lane&15)>>2))*64;
  const int NT=(q0+QB)/KVBLK;
  DMA_K(0,0);DMA_V(0,0);DMA_K(1,SLOTB);
  bf16x8 qr[4];
  #pragma unroll
  for(int d0=0;d0<4;++d0)qr[d0]=*reinterpret_cast<const bf16x8*>(&Qw[(long)r32*DM+d0*16+hi*8]);
  float l_reg=0.f;f32x16 o[4];o[0]=f32x16{};o[1]=f32x16{};o[2]=f32x16{};o[3]=f32x16{};
  const int qrel=wid*QBLK+r32;
  #define CMASK(P0,P1,t) do{int jb_=(t)-(NT-4); if(jb_>=0)cmask(P0,P1,jb_,qrel,hi);}while(0)
  f32x16 pA0,pA1,pB0,pB1;
  int sl_prev=0,sl_cur=0,sl_next=SLOTB;
  #define ROT() do{sl_prev=sl_cur;sl_cur=sl_next;sl_next=(sl_next==(NSLOT-1)*SLOTB)?0:sl_next+SLOTB;}while(0)
  DMA_K(2,2*SLOTB);
  WAIT_BAR(4);
  { const char*kb=Kbase+hi*1024+r32*16;
    #pragma unroll
    for(int d0=0;d0<4;++d0){
      const bf16x8 b0=*reinterpret_cast<const bf16x8*>(kb+d0*2048);
      const bf16x8 b1=*reinterpret_cast<const bf16x8*>(kb+d0*2048+512);
      if(d0==0){pA0=__builtin_amdgcn_mfma_f32_32x32x16_bf16(b0,qr[0],f32x16{},0,0,0);pA1=__builtin_amdgcn_mfma_f32_32x32x16_bf16(b1,qr[0],f32x16{},0,0,0);}
      else{pA0=__builtin_amdgcn_mfma_f32_32x32x16_bf16(b0,qr[d0],pA0,0,0,0);pA1=__builtin_amdgcn_mfma_f32_32x32x16_bf16(b1,qr[d0],pA1,0,0,0);}} }
  asm volatile("s_nop 15\n\ts_nop 7":"+v"(pA0),"+v"(pA1));CMASK(pA0,pA1,0);
  _Pragma("unroll") for(int r=0;r<16;++r){pA0[r]=__builtin_amdgcn_exp2f(pA0[r]);pA1[r]=__builtin_amdgcn_exp2f(pA1[r]);}
  WAIT_BAR(0);
  DMA_K(3,0);DMA_V(1,SLOTB);
  ROT();
  kload8(kf,kp0+sl_cur);
  WAIT_BAR(3);
  s16x4 vlo[8],vhi[8]; u32x4 pw0,pw1,pw2,pw3;
  #define PKW(P,B) cvtpk_s(P[B],P[B+1])
  #define PAF(k) __builtin_bit_cast(bf16x8,pw##k)
  #define VFR(i) (bf16x8){vlo[i][0],vlo[i][1],vlo[i][2],vlo[i][3],vhi[i][0],vhi[i][1],vhi[i][2],vhi[i][3]}
  #define PIN(x) asm volatile("":"+v"(x))
  #define GAPA(MF,A0,A1,A2,A3,W0,W1,PW) do{ MF; sacc+=A0; sacc+=A1; sacc+=A2; sacc+=A3; PIN(sacc); W0; W1; PIN(PW); SBAR(); }while(0)
  #define EX(v) __builtin_amdgcn_exp2f(v)
  #define GAPB(MF,X,B) do{ MF; X[B]=EX(X[B]); X[B+1]=EX(X[B+1]); PIN(X); SBAR(); }while(0)
  #define VRD(j,i) do{ vlo[j]=vtr(vp_+(((i)>>2)*4096+((i)&3)*1024)); vhi[j]=vtr(vp_+(((i)>>2)*4096+((i)&3)*1024+512)); }while(0)
  #define KRD(G,j) do{ if(G){ kload2(kf,kp0+sl_next,j); SBAR(); } }while(0)
  #define STEP(C0,C1,P0,P1,t,GK,GV,GL) do{ SBAR(); \
    const lds_cptr vp_=vp0+2*sl_prev; \
    VRD(0,0); SBAR(); float sacc=(P0[0]+P0[1]); \
    GAPA(C0=__builtin_amdgcn_mfma_f32_32x32x16_bf16(kf[0],qr[0],f32x16{},0,0,0), P0[2],P0[3],P0[4],P0[5],     pw0[0]=PKW(P0,0), pw0[1]=PKW(P0,2), pw0); \
    VRD(4,4); SBAR(); GAPA(C1=__builtin_amdgcn_mfma_f32_32x32x16_bf16(kf[1],qr[0],f32x16{},0,0,0), P0[6],P0[7],P0[8],P0[9],     pw0[2]=PKW(P0,4), pw0[3]=PKW(P0,6), pw0); \
    VRD(1,1); SBAR(); GAPA(C0=__builtin_amdgcn_mfma_f32_32x32x16_bf16(kf[2],qr[1],C0,0,0,0),   P0[10],P0[11],P0[12],P0[13], pw1[0]=PKW(P0,8), pw1[1]=PKW(P0,10), pw1); \
    VRD(5,5); SBAR(); GAPA(C1=__builtin_amdgcn_mfma_f32_32x32x16_bf16(kf[3],qr[1],C1,0,0,0),   P0[14],P0[15],P1[0],P1[1],   pw1[2]=PKW(P0,12),pw1[3]=PKW(P0,14), pw1); \
    VRD(2,2); SBAR(); GAPA(C0=__builtin_amdgcn_mfma_f32_32x32x16_bf16(kf[4],qr[2],C0,0,0,0),   P1[2],P1[3],P1[4],P1[5],     pw2[0]=PKW(P1,0), pw2[1]=PKW(P1,2), pw2); \
    VRD(6,6); SBAR(); GAPA(C1=__builtin_amdgcn_mfma_f32_32x32x16_bf16(kf[5],qr[2],C1,0,0,0),   P1[6],P1[7],P1[8],P1[9],     pw2[2]=PKW(P1,4), pw2[3]=PKW(P1,6), pw2); \
    VRD(3,3); SBAR(); GAPA(C0=__builtin_amdgcn_mfma_f32_32x32x16_bf16(kf[6],qr[3],C0,0,0,0),   P1[10],P1[11],P1[12],P1[13], pw3[0]=PKW(P1,8), pw3[1]=PKW(P1,10), pw3); \
    VRD(7,7); SBAR(); GAPA(C1=__builtin_amdgcn_mfma_f32_32x32x16_bf16(kf[7],qr[3],C1,0,0,0),   P1[14],P1[15],0.f,0.f,       pw3[2]=PKW(P1,12),pw3[3]=PKW(P1,14), pw3); \
    l_reg+=sacc; \
    if(GK){DMA_K((t)+3,sl_cur);} if(GV){DMA_V((t)+1,sl_next);} \
    CMASK(C0,C1,t); \
    SBAR(); \
    GAPB(o[0]=__builtin_amdgcn_mfma_f32_32x32x16_bf16(PAF(0),VFR(0),o[0],0,0,0), C0,0);  VRD(0,8);  SBAR(); \
    GAPB(o[1]=__builtin_amdgcn_mfma_f32_32x32x16_bf16(PAF(0),VFR(4),o[1],0,0,0), C0,2);  VRD(4,12); SBAR(); \
    KRD(GL,0); GAPB(o[0]=__builtin_amdgcn_mfma_f32_32x32x16_bf16(PAF(1),VFR(1),o[0],0,0,0), C0,4);  VRD(1,9);  SBAR(); \
    KRD(GL,1); GAPB(o[1]=__builtin_amdgcn_mfma_f32_32x32x16_bf16(PAF(1),VFR(5),o[1],0,0,0), C0,6);  VRD(5,13); SBAR(); \
    KRD(GL,2); GAPB(o[0]=__builtin_amdgcn_mfma_f32_32x32x16_bf16(PAF(2),VFR(2),o[0],0,0,0), C0,8);  VRD(2,10); SBAR(); \
    KRD(GL,3); GAPB(o[1]=__builtin_amdgcn_mfma_f32_32x32x16_bf16(PAF(2),VFR(6),o[1],0,0,0), C0,10); VRD(6,14); SBAR(); \
    GAPB(o[0]=__builtin_amdgcn_mfma_f32_32x32x16_bf16(PAF(3),VFR(3),o[0],0,0,0), C0,12); VRD(3,11); SBAR(); \
    GAPB(o[1]=__builtin_amdgcn_mfma_f32_32x32x16_bf16(PAF(3),VFR(7),o[1],0,0,0), C0,14); VRD(7,15); SBAR(); \
    GAPB(o[2]=__builtin_amdgcn_mfma_f32_32x32x16_bf16(PAF(0),VFR(0),o[2],0,0,0), C1,0); \
    GAPB(o[3]=__builtin_amdgcn_mfma_f32_32x32x16_bf16(PAF(0),VFR(4),o[3],0,0,0), C1,2); \
    GAPB(o[2]=__builtin_amdgcn_mfma_f32_32x32x16_bf16(PAF(1),VFR(1),o[2],0,0,0), C1,4); \
    GAPB(o[3]=__builtin_amdgcn_mfma_f32_32x32x16_bf16(PAF(1),VFR(5),o[3],0,0,0), C1,6); \
    GAPB(o[2]=__builtin_amdgcn_mfma_f32_32x32x16_bf16(PAF(2),VFR(2),o[2],0,0,0), C1,8); \
    GAPB(o[3]=__builtin_amdgcn_mfma_f32_32x32x16_bf16(PAF(2),VFR(6),o[3],0,0,0), C1,10); \
    GAPB(o[2]=__builtin_amdgcn_mfma_f32_32x32x16_bf16(PAF(3),VFR(3),o[2],0,0,0), C1,12); \
    GAPB(o[3]=__builtin_amdgcn_mfma_f32_32x32x16_bf16(PAF(3),VFR(7),o[3],0,0,0), C1,14); \
    }while(0)
  int t=1;
  #undef CMASK
  #define CMASK(P0,P1,t) do{}while(0)
  for(;t+5<NT;t+=2){
    STEP(pB0,pB1,pA0,pA1,t,true,true,true);     WAIT_BAR(3); ROT();
    STEP(pA0,pA1,pB0,pB1,t+1,true,true,true);   WAIT_BAR(3); ROT();
  }
  #undef CMASK
  #define CMASK(P0,P1,t) do{int jb_=(t)-(NT-4); if(jb_>=0)cmask(P0,P1,jb_,qrel,hi);}while(0)
  #define ENDW(tt) do{ if((tt)+3<NT){WAIT_BAR(3);} else if((tt)+2<NT){WAIT_BAR(2);} else {WAIT_BAR(0);} }while(0)
  for(;t+1<NT;t+=2){
    STEP(pB0,pB1,pA0,pA1,t,(t+3<NT),(t+1<NT),(t+1<NT));       ENDW(t);   ROT();
    STEP(pA0,pA1,pB0,pB1,t+1,(t+4<NT),(t+2<NT),(t+2<NT));     ENDW(t+1); ROT();
  }
  STEP(pB0,pB1,pA0,pA1,NT-1,false,false,false);
  { float sacc=pB0[0]+pB0[1]; _Pragma("unroll") for(int r=2;r<16;++r)sacc+=pB0[r]; _Pragma("unroll") for(int r=0;r<16;++r)sacc+=pB1[r]; l_reg+=sacc;
    pw0=(u32x4){PKW(pB0,0),PKW(pB0,2),PKW(pB0,4),PKW(pB0,6)};pw1=(u32x4){PKW(pB0,8),PKW(pB0,10),PKW(pB0,12),PKW(pB0,14)};pw2=(u32x4){PKW(pB1,0),PKW(pB1,2),PKW(pB1,4),PKW(pB1,6)};pw3=(u32x4){PKW(pB1,8),PKW(pB1,10),PKW(pB1,12),PKW(pB1,14)};
    SBAR(); pv4(o,vb0+2*sl_cur,PAF(0),PAF(1),PAF(2),PAF(3)); }
  #undef PKW
  #undef PAF
  #undef VFR
  #undef PIN
  #undef GAPA
  #undef GAPB
  #undef EX
  #undef VRD
  #undef KRD
  #undef STEP
  #undef ENDW
  {auto rr=__builtin_amdgcn_permlane32_swap(__float_as_uint(l_reg),__float_as_uint(l_reg),false,false);l_reg=__uint_as_float(rr[0])+__uint_as_float(rr[1]);}
  if(hi==0)wsf[32+r32]=l_reg;
  asm volatile("s_waitcnt lgkmcnt(0)\n\ts_barrier":::"memory");
  float rli[16];
  #pragma unroll
  for(int r=0;r<16;++r)rli[r]=__builtin_amdgcn_rcpf(wsf[32+crow(r,hi)]);
  bf16*Ow=O+(rowbase+q0+wid*QBLK)*DM+h8*128;
  { bf16*stg=(bf16*)shm+wid*4096;
    #pragma unroll
    for(int r=0;r<16;++r){const int orow=crow(r,hi);
      #pragma unroll
      for(int d0=0;d0<4;++d0)stg[orow*128+d0*32+r32]=__float2bfloat16(o[d0][r]*rli[r]);}
    asm volatile("s_waitcnt lgkmcnt(0)":::"memory");
    if(fz==nullptr){
    #pragma unroll
    for(int i=0;i<8;++i){const int row=i*4+(lane>>4),ch=lane&15; const u32x4 v=*(const u32x4*)(stg+row*128+ch*8); ATTN_STORE16(Ow+(long)row*DM+ch*8,v);} }
    else{ const bf16*O0w=Ow; bf16*Yw=YAo+(rowbase+q0+wid*QBLK)*DM+h8*128; const int ch=lane&15; const float lam=fz[0];
      asm volatile("s_waitcnt vmcnt(0)":::"memory");
      u32x4 a0[8];
      #pragma unroll
      for(int i=0;i<8;++i)a0[i]=*(const u32x4*)(O0w+(long)(i*4+(lane>>4))*DM+ch*8);
      float sl8[8];
      #pragma unroll
      for(int e=0;e<8;++e)sl8[e]=fz[2+ch*8+e];
      #pragma unroll
      for(int i=0;i<8;++i){const int row=i*4+(lane>>4); const u32x4 v1=*(const u32x4*)(stg+row*128+ch*8);
        const unsigned aw[4]={a0[i].x,a0[i].y,a0[i].z,a0[i].w},bw[4]={v1.x,v1.y,v1.z,v1.w}; float d[8]; float ss=0.f;
        #pragma unroll
        for(int j=0;j<4;++j){d[2*j]=__uint_as_float(aw[j]<<16)-lam*__uint_as_float(bw[j]<<16); d[2*j+1]=__uint_as_float(aw[j]&0xffff0000u)-lam*__uint_as_float(bw[j]&0xffff0000u); ss+=d[2*j]*d[2*j]+d[2*j+1]*d[2*j+1];}
        ss=pg8::row_sum16(ss);
        const float rr=1.0f/sqrtf(ss*(1.f/128.f)+1e-6f);
        u32x4 w; w.x=cvtpk_s(d[0]*rr*sl8[0],d[1]*rr*sl8[1]); w.y=cvtpk_s(d[2]*rr*sl8[2],d[3]*rr*sl8[3]); w.z=cvtpk_s(d[4]*rr*sl8[4],d[5]*rr*sl8[5]); w.w=cvtpk_s(d[6]*rr*sl8[6],d[7]*rr*sl8[7]);
        ATTN_STORE16(Yw+(long)row*DM+ch*8,w);} } }
  asm volatile("s_waitcnt lgkmcnt(0)\n\ts_barrier":::"memory");
  #undef DMA_K
  #undef DMA_V
  #undef CMASK
  #undef ROT
}
constexpr int ATTN_LDS_BYTES=LDS_BYTES;
struct AttnTensors { const bf16* Q; const bf16* K; const bf16* V; bf16* O; };
struct AttnUnit { int b, hq, hv, m, qb; };
struct StaticOrder {
  int vcu, G;
  __device__ __forceinline__ explicit StaticOrder(int grid,int block):vcu((grid%8==0)?(block%8)*(grid/8)+block/8:block),G(grid){}
  __device__ __forceinline__ bool next(int i,AttnUnit&u)const{ const int g=vcu+(i>>3)*G; if(g>=256)return false; const int vh=g&1,m=(g>>1)&1,h8=(g>>2)&7; u.b=g>>5; u.hq=2*h8+m; u.hv=2*h8+vh; u.m=m; u.qb=7-(i&7); return true; }
  __device__ __forceinline__ void a_ready(const AttnUnit&)const{}
  __device__ __forceinline__ void done(const AttnUnit&)const{}
};
template<class Sched,int THRL=8> __device__ __forceinline__ void attn_phase(char*lds,const AttnTensors&T,const Sched&S,const int wave_sg){
  AttnUnit u; const bf16*Qp=pg8::uni_ptr(T.Q),*Kp=pg8::uni_ptr(T.K),*Vp=pg8::uni_ptr(T.V); bf16*Op=pg8::uni_ptr(T.O);
  for(int i=0;S.next(i,u);++i){ S.a_ready(u); attn_unit<THRL>(wave_sg,u.b,u.hq,u.hv,u.qb,Qp,Kp,Vp,Op+(size_t)u.m*((size_t)BATCH*SEQ*DM),lds); S.done(u); }
}
#undef SBAR
#undef WAIT_BAR
}
#define GAS __attribute__((address_space(1)))
#define LAS __attribute__((address_space(3)))
typedef unsigned short bf16;
typedef unsigned v4u __attribute__((ext_vector_type(4)));
typedef float f32x4 __attribute__((ext_vector_type(4)));
typedef short bf16x8 __attribute__((ext_vector_type(8)));
typedef GAS unsigned gu32;
typedef GAS unsigned long long gu64;
#define RLX_AGENT __ATOMIC_RELAXED, __HIP_MEMORY_SCOPE_AGENT
#define LDS_WAIT() asm volatile("s_waitcnt lgkmcnt(0)" ::: "memory")
#define VM_WAIT() asm volatile("s_waitcnt vmcnt(0)" ::: "memory")
__device__ __forceinline__ unsigned long long rt() { return __builtin_amdgcn_s_memrealtime(); }
__device__ __forceinline__ unsigned f2bf(float f) { unsigned u = __builtin_bit_cast(unsigned, f); return (u + 0x7fffu + ((u >> 16) & 1u)) >> 16; }
__device__ __forceinline__ unsigned pk2(float lo, float hi) { return f2bf(lo) | (f2bf(hi) << 16); }

#define XB_TMO      128
#define XB_XCNT(j)  (256  + 64 * (j))
#define XB_XSUB(j)  (1280 + 64 * (j))
#define XB_XGEN(j)  (2304 + 64 * (j))
#define XB_TOP      3328
#define XB_TOPGEN   3392
#define XCD_BAR_WORDS 3456
#define XB_SPIN_CAP (1u << 18)

__device__ __forceinline__ unsigned xb_ld(unsigned* p)              { return __hip_atomic_load(p, __ATOMIC_RELAXED, __HIP_MEMORY_SCOPE_AGENT); }
__device__ __forceinline__ unsigned xb_add(unsigned* p, unsigned v) { return __hip_atomic_fetch_add(p, v, __ATOMIC_RELAXED, __HIP_MEMORY_SCOPE_AGENT); }
__device__ __forceinline__ unsigned xb_xcc_id() { return (unsigned)__builtin_amdgcn_s_getreg((3 << 11) | 20) & 0xFu; }
#define XB_SPIN(cond, bar) do { unsigned _sp = 0; while (cond) { __builtin_amdgcn_s_sleep(1); \
    if ((++_sp & 255u) == 0u) { if (xb_ld(&(bar)[XB_TMO])) break; if (_sp > XB_SPIN_CAP) { atomicAdd(&(bar)[XB_TMO], 1u); break; } } } } while (0)

struct XcdBarrier {
    unsigned* bar; unsigned x;
    volatile LAS unsigned* st;
};

__device__ __forceinline__ XcdBarrier xcd_barrier_post(unsigned* bar, volatile LAS unsigned* st, const bool t0) {
    XcdBarrier b; b.bar = bar; b.x = xb_xcc_id(); b.st = st;
    if (t0) (void)xb_add(&bar[XB_XCNT(b.x)], 1u);
    return b;
}
__device__ __forceinline__ void xcd_barrier_complete(unsigned* bar, unsigned x, unsigned& nloc, unsigned& nx) {
    const unsigned G = gridDim.x * gridDim.y * gridDim.z;
    unsigned sum, cnt, mine, sp = 0u;
    for (;;) {
        sum = 0u; cnt = 0u; mine = 0u;
#pragma unroll
        for (unsigned j = 0; j < 16; ++j) { const unsigned c = xb_ld(&bar[XB_XCNT(j)]); sum += c; cnt += (c > 0u) ? 1u : 0u; mine = (j == x) ? c : mine; }
        if (sum == G) break;
        __builtin_amdgcn_s_sleep(1);
        if ((++sp & 255u) == 0u) { if (xb_ld(&bar[XB_TMO])) break; if (sp > XB_SPIN_CAP) { atomicAdd(&bar[XB_TMO], 1u); break; } }
    }
    nloc = mine > 0u ? mine : 1u; nx = cnt > 0u ? cnt : 1u;
}

__device__ __forceinline__ void xcd_barrier(const XcdBarrier& b, const bool t0) {
    asm volatile("s_waitcnt vmcnt(0)" ::: "memory");
    __syncthreads();
    if (t0) {
        unsigned* bar = pg8::uni_ptr(b.bar);
        __builtin_amdgcn_s_waitcnt(0);
        unsigned nloc = b.st[0], nx = b.st[1];
        if (nloc == 0u) { xcd_barrier_complete(bar, b.x, nloc, nx); b.st[0] = nloc; b.st[1] = nx; }
        const unsigned old = xb_add(&bar[XB_XSUB(b.x)], 1u);
        const unsigned gen = old / nloc;
        if (old + 1u == (gen + 1u) * nloc) {
            __builtin_amdgcn_fence(__ATOMIC_RELEASE, "agent");
            asm volatile("s_waitcnt vmcnt(0)" ::: "memory");
            const unsigned og = xb_add(&bar[XB_TOP], 1u);
            const unsigned tg = og / nx;
            if (og + 1u == (tg + 1u) * nx) xb_add(&bar[XB_TOPGEN], 1u);
            else XB_SPIN(xb_ld(&bar[XB_TOPGEN]) == tg, bar);
            __builtin_amdgcn_fence(__ATOMIC_ACQUIRE, "agent");
            xb_add(&bar[XB_XGEN(b.x)], 1u);
            asm volatile("s_waitcnt vmcnt(0)" ::: "memory");
        } else {
            XB_SPIN(xb_ld(&bar[XB_XGEN(b.x)]) == gen, bar);
            __builtin_amdgcn_fence(__ATOMIC_ACQUIRE, "agent");
            asm volatile("s_waitcnt vmcnt(0)" ::: "memory");
        }
    }
    __syncthreads();
}

constexpr int NWAVES = 8;
constexpr int NB = 8, NT_ = 2048, DM_ = 2048, M = NB * NT_;
constexpr int MIXW = 1024, INC = 15360, FFH = 5632, MEMROWS = 2048;
constexpr int DEPTH = 2, NPH = 16;
constexpr float EPSN = 1e-6f;
constexpr float LOG2E = 1.4426950408889634f;

constexpr size_t MiB = 1u << 20;
constexpr size_t WS_CTL = 0, CTL_ZERO_BYTES = 1 * MiB;
constexpr size_t WS_LAM = 1 * MiB + 512 * 1024;
constexpr size_t WS_DCS = 1 * MiB, WS_RCS = 2 * MiB;
constexpr size_t WS_W = 4 * MiB;
constexpr int KPAD = 64;
constexpr int LD2K = DM_ + KPAD, LD1K = MIXW + KPAD, LDFF = FFH + KPAD;
constexpr size_t W_IN = WS_W, W_BR = W_IN + 62 * MiB, W_OUT = W_BR + 13 * MiB, W_Q = W_OUT + 9 * MiB, W_KV = W_Q + 9 * MiB, W_O = W_KV + 17 * MiB, W_13 = W_O + 9 * MiB, W_2 = W_13 + 46 * MiB, W_END = W_2 + 23 * MiB;
constexpr size_t WS_XN = W_END;
constexpr size_t WS_MN = WS_XN + 66 * MiB, WS_KM = WS_MN + 8 * MiB, WS_VT = WS_KM + 9 * MiB;
constexpr size_t WS_Y = WS_VT + 8 * MiB;
constexpr size_t WS_YRAW = WS_Y + 96 * MiB;
constexpr size_t WS_BIG = WS_YRAW + 64 * MiB;
constexpr size_t SEG = 32 * MiB, SEG_E = (size_t)16384 * 1024;
constexpr size_t WS_END_BIG = WS_BIG + 15 * SEG;
constexpr size_t RSS_STRIDE = (size_t)16384 * 32;
constexpr size_t WS_END = WS_END_BIG + 7 * RSS_STRIDE * 4;
static_assert(W_END == 192 * MiB && WS_END == 937 * MiB, "d_ws map");
constexpr size_t DO_WKV1 = 64 * MiB, DO_MN1 = 81 * MiB, DO_KV1 = 90 * MiB;
constexpr int CW_TMO = 0, CW_BAR = 4096, CW_Q = 8192;
constexpr size_t WS_RSS = WS_END_BIG;

constexpr int RING_OFF = 0, RING_BYTES = 131072;
constexpr int LDSCTL_OFF = RING_BYTES, MISC_OFF = LDSCTL_OFF + 320;
constexpr int LDS_BYTES = 147456;
static_assert(MISC_OFF + 128 <= LDS_BYTES, "LDS map");

struct Args { const float* in[22]; float* out; unsigned char* ws; int l_lo, l_hi; };
__device__ const float ROPE_INV[96] = {1.0f, 0.749894202f, 0.562341332f, 0.421696514f, 0.316227764f, 0.237137377f, 0.177827939f, 0.133352146f, 0.100000001f, 0.0749894232f, 0.0562341325f, 0.0421696492f, 0.0316227749f, 0.0237137377f, 0.0177827943f, 0.013335214f, 0.00999999978f, 0.00749894232f, 0.00562341325f, 0.00421696482f, 0.00316227763f, 0.00237137382f, 0.00177827943f, 0.00133352145f, 0.00100000005f, 0.000749894185f, 0.000562341302f, 0.000421696517f, 0.000316227757f, 0.00023713737f, 0.00017782794f, 0.00013335215f, 1.0f, 0.863988459f, 0.746476054f, 0.644946694f, 0.557226479f, 0.481437236f, 0.415956229f, 0.359381378f, 0.310501337f, 0.268269569f, 0.231781825f, 0.20025681f, 0.173019573f, 0.149486914f, 0.129154965f, 0.111588396f, 0.0964110866f, 0.0832980648f, 0.0719685704f, 0.0621800125f, 0.05372281f, 0.0464158878f, 0.040102791f, 0.0346483476f, 0.0299357735f, 0.0258641616f, 0.0223463364f, 0.0193069782f, 0.0166810062f, 0.0144121964f, 0.0124519709f, 0.010758359f, 0.00929509755f, 0.00803085696f, 0.00693856785f, 0.00599484239f, 0.0051794746f, 0.00447500637f, 0.00386635377f, 0.00334048504f, 0.00288614049f, 0.00249359198f, 0.0021544348f, 0.00186140672f, 0.0016082339f, 0.00138949545f, 0.00120050809f, 0.00103722513f, 0.000896150479f, 0.000774263695f, 0.000668954861f, 0.000577969302f, 0.000499358808f, 0.000431440218f, 0.000372759358f, 0.000322059786f, 0.000278255931f, 0.000240409921f, 0.00020771139f, 0.000179460243f, 0.000155051574f, 0.000133962778f, 0.000115742288f, 9.99999975e-05f};
struct Frame {
    LAS unsigned char* lds;
    volatile LAS unsigned* MISC;
    int vcu, G, wave;
};
#define PH_ENTER() const int wave = pg8::opq(F.wave), vcu_ = pg8::opq(F.vcu), G_ = pg8::opq(F.G); int tid = wave * 64 + pg8::lane_id(); asm volatile("" : "+v"(tid)); const int lane = tid & 63; (void)vcu_; (void)G_; \
    unsigned char* ws = pg8::uni_ptr(args.ws); (void)lane; (void)wave; (void)tid
__device__ __forceinline__ float wave_sum(float v) {
    v = pg8::xadd<1>(v); v = pg8::xadd<2>(v); v = pg8::xadd<4>(v); v = pg8::xadd<8>(v); v = pg8::xadd<16>(v); v = pg8::xadd<32>(v);
    return v;
}
__device__ __forceinline__ float wave_total(float v) {
#define DPPADD(ctrl, rmask) v += __int_as_float(__builtin_amdgcn_update_dpp(0, __float_as_int(v), ctrl, rmask, 0xf, true))
    DPPADD(0xB1, 0xf); DPPADD(0x4E, 0xf); DPPADD(0x141, 0xf); DPPADD(0x140, 0xf); DPPADD(0x142, 0xa); DPPADD(0x143, 0xc);
#undef DPPADD
    return __int_as_float(__builtin_amdgcn_readlane(__float_as_int(v), 63));
}
__device__ __forceinline__ float bflo(unsigned w) { return __uint_as_float(w << 16); }
__device__ __forceinline__ float bfhi(unsigned w) { return __uint_as_float(w & 0xffff0000u); }
__device__ __forceinline__ float sigm(float x) { return __builtin_amdgcn_rcpf(1.0f + __builtin_amdgcn_exp2f(-LOG2E * x)); }

template <int CMAP> __device__ __forceinline__ void transpose_item(const float* W, int K, int N, bf16* WT, int ldw, LAS float* scr, int item, int lane, const float* gain = nullptr) {
    const int nblk = N / 32, kb = item / nblk, nb = item % nblk, k0 = 64 * kb, n0 = 32 * nb;
    const int nn = n0 + (lane & 31); int sc = nn;
    if (CMAP == 1) sc = (nn & 1) * FFH + (nn >> 1);
    if (CMAP == 2) {
        if (nn < 2048) { const int w = nn & 63; sc = (nn & ~63) + (w & 1) * 32 + (w >> 1); }
        else if (nn >= 3072 && nn < 5120) { const int j = nn - 3072; sc = 3072 + (j & 1) * 1024 + (j >> 1); }
        else if (nn >= 5120 && nn < 7168) { const int w = (nn - 5120) & 127; sc = 5120 + ((nn - 5120) & ~127) + (w & 1) * 64 + (w >> 1); } }
    float wv[32]; const float gv = gain ? gain[k0 + lane] : 1.0f;
#pragma unroll
    for (int i = 0; i < 32; ++i) wv[i] = W[(size_t)(k0 + 2 * i + (lane >> 5)) * N + sc];
#pragma unroll
    for (int i = 0; i < 32; ++i) { const float g0 = __builtin_bit_cast(float, __builtin_amdgcn_readlane(__builtin_bit_cast(int, gv), 2 * i)), g1 = __builtin_bit_cast(float, __builtin_amdgcn_readlane(__builtin_bit_cast(int, gv), 2 * i + 1));
        scr[(2 * i + (lane >> 5)) * 33 + (lane & 31)] = wv[i] * ((lane >> 5) ? g1 : g0); }
    LDS_WAIT(); asm volatile("" ::: "memory");
    const int c = lane & 7;
#pragma unroll
    for (int j = 0; j < 4; ++j) { const int n = (lane >> 3) + 8 * j; const LAS float* s = scr + (8 * c) * 33 + n;
        v4u o; o.x = pk2(s[0 * 33], s[1 * 33]); o.y = pk2(s[2 * 33], s[3 * 33]); o.z = pk2(s[4 * 33], s[5 * 33]); o.w = pk2(s[6 * 33], s[7 * 33]);
        *(GAS v4u*)(WT + (size_t)(n0 + n) * ldw + k0 + 8 * c) = o; }
    LDS_WAIT(); asm volatile("" ::: "memory");
}
template <int CMAP> __device__ __forceinline__ int wt_row(int s) {
    if (CMAP == 1) return s < FFH ? 2 * s : 2 * (s - FFH) + 1;
    if (CMAP == 2) {
        if (s < 2048) { const int ws = s & 63; return (s & ~63) + (ws < 32 ? 2 * ws : 2 * (ws - 32) + 1); }
        if (s >= 3072 && s < 5120) { const int j = s - 3072; return 3072 + (j < 1024 ? 2 * j : 2 * (j - 1024) + 1); }
        if (s >= 5120 && s < 7168) { const int ws = (s - 5120) & 127; return 5120 + ((s - 5120) & ~127) + (ws < 64 ? 2 * ws : 2 * (ws - 64) + 1); } }
    return s;
}
template <int CMAP, int K> __device__ __forceinline__ void transpose_item_w(const float* W, int N, bf16* WT, int ldw, LAS unsigned char* scr, int item, int lane, const float* gain = nullptr) {
    constexpr int nkb = K / 64; const int nb = item / nkb, kb = item % nkb,
        k0 = 64 * kb, h = lane >> 5, cl = lane & 31, s0 = 128 * nb + 4 * cl;
    const float* src = W + (size_t)(k0 + h) * N + s0;
    f32x4 r[32]; const float gv = gain ? gain[k0 + lane] : 1.0f;
#pragma unroll
    for (int i = 0; i < 32; ++i) r[i] = *(const GAS f32x4*)(src + (size_t)(2 * i) * N);
    if (gain) {
#pragma unroll
        for (int i = 0; i < 32; ++i) { const float g0 = __builtin_bit_cast(float, __builtin_amdgcn_readlane(__builtin_bit_cast(int, gv), 2 * i)), g1 = __builtin_bit_cast(float, __builtin_amdgcn_readlane(__builtin_bit_cast(int, gv), 2 * i + 1));
            r[i] *= (h ? g1 : g0); } }
#pragma unroll
    for (int c0 = 0; c0 < 4; c0 += 2) {
#pragma unroll
        for (int d = 0; d < 2; ++d) {
            unsigned p[16];
#pragma unroll
            for (int i = 0; i < 16; ++i) { const auto rr = __builtin_amdgcn_permlane32_swap(__float_as_uint(r[i][c0 + d]), __float_as_uint(r[i + 16][c0 + d]), false, false);
                p[i] = pg8::cvt_pk_bf16(__uint_as_float(rr[0]), __uint_as_float(rr[1])); }
            const int rl = 2 * cl + d;
#pragma unroll
            for (int q = 0; q < 4; ++q) { v4u o; o.x = p[4 * q]; o.y = p[4 * q + 1]; o.z = p[4 * q + 2]; o.w = p[4 * q + 3];
                *(LAS v4u*)(scr + rl * 128 + (((4 * h + q) ^ (rl & 7)) << 4)) = o; }
        }
        LDS_WAIT(); asm volatile("" ::: "memory");
        v4u o[8];
#pragma unroll
        for (int j = 0; j < 8; ++j) { const int rl = (lane >> 3) + 8 * j; o[j] = *(const LAS v4u*)(scr + rl * 128 + (((lane & 7) ^ (rl & 7)) << 4)); }
        LDS_WAIT(); asm volatile("" ::: "memory");
#pragma unroll
        for (int j = 0; j < 8; ++j) { const int rl = (lane >> 3) + 8 * j; const int sc = 128 * nb + 4 * (rl >> 1) + c0 + (rl & 1);
            *(GAS v4u*)(WT + (size_t)wt_row<CMAP>(sc) * ldw + k0 + 8 * (lane & 7)) = o[j]; }
    }
}
__device__ __forceinline__ void convert_item(const float* W, bf16* WO, int ldw, int item, int lane, const float* gain) {
    const int kb = item / 64, nb = item % 64, k0 = 64 * kb, n0 = 32 * nb; const int kk = lane >> 3, c4 = (lane & 7) * 4;
    f32x4 v[8]; float g[8];
#pragma unroll
    for (int i = 0; i < 8; ++i) { const int k = k0 + 8 * i + kk; v[i] = *(const GAS f32x4*)(W + (size_t)k * DM_ + n0 + c4); g[i] = gain[k]; }
#pragma unroll
    for (int i = 0; i < 8; ++i) { const int k = k0 + 8 * i + kk;
        *(GAS unsigned long long*)(WO + (size_t)k * ldw + n0 + c4) = (unsigned long long)pk2(v[i].x * g[i], v[i].y * g[i]) | ((unsigned long long)pk2(v[i].z * g[i], v[i].w * g[i]) << 32); }
}
__device__ __forceinline__ void convert_item_w(const float* W, bf16* WO, int ldw, int item, int lane, const float* gain) {
    const int kb = item / 16, nb = item % 16, k0 = 64 * kb, h = lane >> 5, n0 = 128 * nb + 4 * (lane & 31);
    const float* src = W + (size_t)(k0 + h) * DM_ + n0; bf16* dst = WO + (size_t)(k0 + h) * ldw + n0;
    f32x4 r[32]; const float gv = gain[k0 + lane];
#pragma unroll
    for (int i = 0; i < 32; ++i) r[i] = *(const GAS f32x4*)(src + (size_t)(2 * i) * DM_);
#pragma unroll
    for (int i = 0; i < 32; ++i) { const float g0 = __builtin_bit_cast(float, __builtin_amdgcn_readlane(__builtin_bit_cast(int, gv), 2 * i)), g1 = __builtin_bit_cast(float, __builtin_amdgcn_readlane(__builtin_bit_cast(int, gv), 2 * i + 1));
        const f32x4 v = r[i] * (h ? g1 : g0);
        *(GAS unsigned long long*)(dst + (size_t)(2 * i) * ldw) = (unsigned long long)pg8::cvt_pk_bf16(v.x, v.y) | ((unsigned long long)pg8::cvt_pk_bf16(v.z, v.w) << 32); }
}
constexpr int LATE_ITEMS = 6528, LATE_ITEMS_IN = 3840, CHUNK_ITEMS = 32;
constexpr int KV_CHUNKS = (2 * MEMROWS * LD2K / 8) / 8192;
static_assert((2 * MEMROWS * LD2K / 8) % 8192 == 0, "KV move chunks");
typedef const __attribute__((address_space(4))) unsigned char* kargp_t;
__device__ __forceinline__ const float* karg_in(kargp_t kp, int k) { return *(const float* const __attribute__((address_space(4)))*)(kp + 8 * k); }
__device__ __forceinline__ void late_item(kargp_t kp, unsigned char* ws, int l, int r, LAS unsigned char* scr, int lane) {
    if (r < 768) { const int br = r >> 8; transpose_item_w<0, MIXW>(karg_in(kp, 11) + ((size_t)l * 3 + br) * MIXW * DM_, DM_, (bf16*)(ws + W_BR) + (size_t)br * DM_ * LD1K, LD1K, scr, r & 255, lane); return; } r -= 768;
    if (r < 512) { transpose_item_w<0, DM_>(karg_in(kp, 12) + (size_t)l * DM_ * DM_, DM_, (bf16*)(ws + W_OUT), LD2K, scr, r, lane); return; } r -= 512;
    if (r < 512) { convert_item_w(karg_in(kp, 15) + (size_t)l * DM_ * DM_, (bf16*)(ws + W_Q), LD2K, r, lane, karg_in(kp, 13) + (size_t)l * DM_); return; } r -= 512;
    if (r < 512) { transpose_item_w<0, DM_>(karg_in(kp, 17) + (size_t)l * DM_ * DM_, DM_, (bf16*)(ws + W_O), LD2K, scr, r, lane); return; } r -= 512;
    if (r < 2816) { transpose_item_w<1, DM_>(karg_in(kp, 19) + (size_t)l * DM_ * 2 * FFH, 2 * FFH, (bf16*)(ws + W_13), LD2K, scr, r, lane, karg_in(kp, 18) + (size_t)l * DM_); return; } r -= 2816;
    if (r < 1408) { transpose_item_w<0, FFH>(karg_in(kp, 20) + (size_t)l * FFH * DM_, DM_, (bf16*)(ws + W_2), LDFF, scr, r, lane); return; } r -= 1408;
    transpose_item_w<2, DM_>(karg_in(kp, 3) + (size_t)(l + 1) * DM_ * INC, INC, (bf16*)(ws + W_IN), LD2K, scr, r, lane, karg_in(kp, 2) + (size_t)(l + 1) * DM_);
}
template <bool TOF32> __device__ __forceinline__ void rms_row(int lane, const float* xrow, const float* gain, void* orow) {
    const GAS f32x4* xr = (const GAS f32x4*)xrow + lane; const GAS f32x4* gr = (const GAS f32x4*)gain + lane;
    f32x4 v[8]; float s = 0.f;
#pragma unroll
    for (int j = 0; j < 8; ++j) { v[j] = xr[64 * j]; s += (v[j].x * v[j].x + v[j].y * v[j].y) + (v[j].z * v[j].z + v[j].w * v[j].w); }
    const float r = 1.0f / sqrtf(wave_sum(s) * (1.f / 2048.f) + EPSN);
#pragma unroll
    for (int j = 0; j < 8; ++j) { const f32x4 g = gr[64 * j]; const f32x4 y = v[j] * r * g;
        if (TOF32) ((GAS f32x4*)orow + lane)[64 * j] = y;
        else ((GAS unsigned long long*)orow + lane)[64 * j] = (unsigned long long)pk2(y.x, y.y) | ((unsigned long long)pk2(y.z, y.w) << 32); }
}

__device__ __forceinline__ void ph_prep(Frame& F, const Args& args, int l, const float* xcur) {
    PH_ENTER();
    LAS float* scr = (LAS float*)(F.lds + RING_OFF + wave * 16384);
    const int gw = vcu_ * NWAVES + wave, NGW = G_ * NWAVES;
    constexpr int I_IN = 32 * (INC / 128), I_KV = 32 * 32;
    if (l == 0) for (int it = gw; it < I_IN + I_KV; it += NGW) {
        int r = it;
        if (r < I_IN) { transpose_item_w<2, DM_>(args.in[3], INC, (bf16*)(ws + W_IN), LD2K, (LAS unsigned char*)scr, r, lane, args.in[2]); continue; } r -= I_IN;
        transpose_item_w<0, DM_>(args.in[16], 2 * DM_, (bf16*)(ws + W_KV), LD2K, (LAS unsigned char*)scr, r, lane);
        transpose_item_w<0, DM_>(args.in[16] + (size_t)DM_ * 2 * DM_, 2 * DM_, (bf16*)((unsigned char*)args.out + DO_WKV1), LD2K, (LAS unsigned char*)scr, r, lane);
    }
    if (l == 0) for (int m = gw; m < M; m += NGW) {
        const GAS f32x4* xr = (const GAS f32x4*)(xcur + (size_t)m * DM_) + lane; GAS unsigned long long* orow = (GAS unsigned long long*)((bf16*)(ws + WS_XN) + (size_t)m * LD2K) + lane; float sq = 0.f;
#pragma unroll
        for (int j = 0; j < 8; ++j) { const f32x4 v = xr[64 * j]; sq += (v.x * v.x + v.y * v.y) + (v.z * v.z + v.w * v.w); orow[64 * j] = (unsigned long long)pk2(v.x, v.y) | ((unsigned long long)pk2(v.z, v.w) << 32); }
        sq = wave_sum(sq); if (lane < 32) ((float*)(ws + WS_RSS))[(size_t)m * 32 + lane] = lane == 0 ? sq : 0.f; }
    if (l == 0) for (int m = gw; m < MEMROWS; m += NGW) { rms_row<false>(lane, args.in[1] + (size_t)m * DM_, args.in[14], (bf16*)(ws + WS_MN) + (size_t)m * DM_);
                                                         rms_row<false>(lane, args.in[1] + (size_t)m * DM_, args.in[14] + DM_, (bf16*)((unsigned char*)args.out + DO_MN1) + (size_t)m * DM_); }
    if (l == 0 && vcu_ == 0 && wave == 0) {
#pragma unroll
        for (int ll = 0; ll < DEPTH; ++ll) { const float* dl = args.in[4] + (size_t)ll * 256;
            const float s01 = wave_sum(dl[lane] * dl[64 + lane]), s23 = wave_sum(dl[128 + lane] * dl[192 + lane]);
            const float linit = 0.8f - 0.6f * expf(-0.3f * (float)ll);
            float* fz = (float*)(ws + WS_LAM) + 192 * ll;
            if (lane == 0) { fz[0] = expf(s01) - expf(s23) + linit; fz[1] = 1.0f - linit; }
            fz[2 + lane] = args.in[5][(size_t)ll * 128 + lane] * (1.0f - linit); fz[66 + lane] = args.in[5][(size_t)ll * 128 + 64 + lane] * (1.0f - linit); } }
    if (l == 0) {
        const int gt = vcu_ * (NWAVES * 64) + tid, NGT = G_ * NWAVES * 64;
        for (int e = gt; e < 2048 * 96; e += NGT) {
            const int t = e / 96, i = e % 96; float inv; float* dst;
            if (i < 32) { dst = (float*)(ws + WS_DCS) + ((size_t)t * 32 + i) * 2; }
            else { dst = (float*)(ws + WS_RCS) + ((size_t)t * 64 + (i - 32)) * 2; }
            inv = ROPE_INV[i];
            const float ang = (float)t * inv;
            const float CH = 0.15915494f, CL = 6.4206382e-09f;
            const float p = ang * CH, pe = fmaf(ang, CH, -p) + ang * CL; const float fr = (p - floorf(p)) + pe;
            dst[0] = __builtin_amdgcn_cosf(fr); dst[1] = __builtin_amdgcn_sinf(fr);
        }
    }
}

__device__ __forceinline__ void ph_rope(Frame& F, const Args& args) {
    PH_ENTER();
    const int gw = vcu_ * NWAVES + wave, NGW = G_ * NWAVES;
    for (int it = gw; it < 4 * M; it += NGW) {
        const int sel = it / M, row = it % M, t = row % NT_;
        const int seg = sel == 0 ? 0 : sel == 1 ? 1 : sel == 2 ? 5 : 6;
        bf16* base = (bf16*)(ws + WS_BIG + (size_t)seg * SEG) + (size_t)row * 1024;
        int c1, c2; const float* tab; float sc;
        if (sel < 2) { const int blk = lane >> 2, d0 = (lane & 3) * 8; c1 = blk * 64 + d0; c2 = c1 + 32; tab = (const float*)(ws + WS_DCS) + ((size_t)t * 32 + d0) * 2; sc = sel == 0 ? 0.125f * LOG2E : 1.0f; }
        else { const int blk = lane >> 3, d0 = (lane & 7) * 8; c1 = blk * 128 + d0; c2 = c1 + 64; tab = (const float*)(ws + WS_RCS) + ((size_t)t * 64 + d0) * 2; sc = sel == 2 ? 0.08838834764831845f : 1.0f; }
        const v4u a = *(const GAS v4u*)(base + c1), b = *(const GAS v4u*)(base + c2);
        const GAS f32x4* tb = (const GAS f32x4*)tab; const f32x4 t0 = tb[0], t1 = tb[1], t2 = tb[2], t3 = tb[3];
        const float cs[8] = {t0.x, t0.z, t1.x, t1.z, t2.x, t2.z, t3.x, t3.z}, sn[8] = {t0.y, t0.w, t1.y, t1.w, t2.y, t2.w, t3.y, t3.w};
        const unsigned aw[4] = {a.x, a.y, a.z, a.w}, bw[4] = {b.x, b.y, b.z, b.w}; unsigned oa[4], ob[4];
#pragma unroll
        for (int j = 0; j < 4; ++j) {
            const float x1l = bflo(aw[j]), x1h = bfhi(aw[j]), x2l = bflo(bw[j]), x2h = bfhi(bw[j]);
            const float y1l = (x1l * cs[2 * j] - x2l * sn[2 * j]) * sc, y2l = (x2l * cs[2 * j] + x1l * sn[2 * j]) * sc;
            const float y1h = (x1h * cs[2 * j + 1] - x2h * sn[2 * j + 1]) * sc, y2h = (x2h * cs[2 * j + 1] + x1h * sn[2 * j + 1]) * sc;
            oa[j] = pk2(y1l, y1h); ob[j] = pk2(y2l, y2h);
        }
        v4u wa; wa.x = oa[0]; wa.y = oa[1]; wa.z = oa[2]; wa.w = oa[3]; v4u wb; wb.x = ob[0]; wb.y = ob[1]; wb.z = ob[2]; wb.w = ob[3];
        *(GAS v4u*)(base + c1) = wa; *(GAS v4u*)(base + c2) = wb;
    }
}

__device__ __forceinline__ void ph_conv(Frame& F, const Args& args, int l, int ustart, int uend) {
    PH_ENTER();
    const bf16* U = (const bf16*)(ws + WS_BIG + 3 * SEG);
    bf16* YB = (bf16*)(ws + WS_Y) + SEG_E;
    const int c0 = 2 * tid;
    const float* cw = args.in[6] + (size_t)l * 31 * 1024;
    typedef float f32x2c __attribute__((ext_vector_type(2)));
    f32x2c w2[31];
#pragma unroll
    for (int j = 0; j < 31; ++j) { const float2 w = *(const float2*)(cw + j * 1024 + c0); w2[j] = (f32x2c){w.x, w.y}; }
    const float2 bias = *(const float2*)(args.in[7] + (size_t)l * 1024 + c0), lg = *(const float2*)(args.in[8] + (size_t)l * 1024 + c0), lb = *(const float2*)(args.in[9] + (size_t)l * 1024 + c0);
    LAS unsigned char* Us = F.lds + RING_OFF;
    LAS float* red1 = (LAS float*)(F.lds + RING_OFF + 46 * 2048); LAS float* red2 = red1 + 16 * 8;
    for (int unit = ustart; unit < uend; ++unit) {
        const int b = unit >> 7, t0 = (unit & 127) * 16;
#pragma unroll
        for (int i = 0; i < 12; ++i) { const int idx = tid + 512 * i; const int r = idx >> 7, ch = idx & 127;
            if (idx < 46 * 128) { const int tg = t0 - 30 + r; v4u v; v.x = 0u; v.y = 0u; v.z = 0u; v.w = 0u;
                if (tg >= 0) v = *(const GAS v4u*)(U + ((size_t)b * NT_ + tg) * 1024 + ch * 8);
                *(LAS v4u*)(Us + r * 2048 + ch * 16) = v; } }
        __syncthreads();
        f32x2c acc2[16];
#pragma unroll
        for (int t = 0; t < 16; ++t) acc2[t] = (f32x2c){0.f, 0.f};
#pragma unroll
        for (int r = 0; r < 46; ++r) {
            const unsigned uw = *(const LAS unsigned*)(Us + r * 2048 + tid * 4);
            const f32x2c u2 = {bflo(uw), bfhi(uw)};
#pragma unroll
            for (int t = 0; t < 16; ++t) { const int j = r - t; if (j >= 0 && j <= 30) acc2[t] = __builtin_elementwise_fma(u2, w2[j], acc2[t]); }
        }
        float a0[16], a1[16];
#pragma unroll
        for (int t = 0; t < 16; ++t) { a0[t] = acc2[t].x; a1[t] = acc2[t].y; }
        float mu[16];
#pragma unroll
        for (int t = 0; t < 16; ++t) { a0[t] += bias.x; a1[t] += bias.y; const float s = wave_total(a0[t] + a1[t]); if (lane == 0) red1[t * 8 + wave] = s; }
        __syncthreads();
#pragma unroll
        for (int t = 0; t < 16; ++t) { float s = 0.f;
#pragma unroll
            for (int w = 0; w < 8; ++w) s += red1[t * 8 + w];
            mu[t] = s * (1.f / 1024.f); a0[t] -= mu[t]; a1[t] -= mu[t];
            const float q = wave_total(a0[t] * a0[t] + a1[t] * a1[t]); if (lane == 0) red2[t * 8 + wave] = q; }
        __syncthreads();
#pragma unroll
        for (int t = 0; t < 16; ++t) { float q = 0.f;
#pragma unroll
            for (int w = 0; w < 8; ++w) q += red2[t * 8 + w];
            const float rs = 1.0f / sqrtf(q * (1.f / 1024.f) + EPSN);
            const float y0 = a0[t] * rs * lg.x + lb.x, y1 = a1[t] * rs * lg.y + lb.y;
            *(GAS unsigned*)(YB + ((size_t)b * NT_ + t0 + t) * 1024 + c0) = pk2(y0 * sigm(y0), y1 * sigm(y1)); }
    }
    __syncthreads();
}
__device__ __forceinline__ int sw_off(int row, int col) { return row * 256 + ((((col >> 3) ^ (row & 15)) << 4) | ((col & 7) << 1)); }
__device__ __forceinline__ void ph_ret_seq(Frame& F, const Args& args, int l, int bh) {
    PH_ENTER();
    typedef short bf16x8v __attribute__((ext_vector_type(8)));
    LAS unsigned char* Ks = F.lds + RING_OFF; LAS unsigned char* KTs = Ks + 32768; LAS unsigned char* VTs = KTs + 32768; LAS unsigned char* STs = VTs + 32768;
    const bf16* RQ = (const bf16*)(ws + WS_BIG + 5 * SEG); const bf16* RK = (const bf16*)(ws + WS_BIG + 6 * SEG); const bf16* RV = (const bf16*)(ws + WS_BIG + 7 * SEG); const bf16* RG = (const bf16*)(ws + WS_BIG + 8 * SEG);
    bf16* YRo = (bf16*)(ws + WS_Y) + 2 * SEG_E;
    const float* gng = args.in[10] + (size_t)l * 1024;
    const int wid = wave;
    const int b = bh >> 3, h = bh & 7;
    const float lg2 = log2f(1.0f - exp2f(-5.0f - (float)h));
    const float cdec = exp2f(128.0f * lg2);
    f32x4 st[8];
#pragma unroll
    for (int c = 0; c < 8; ++c) st[c] = (f32x4){0.f, 0.f, 0.f, 0.f};
    for (int e = tid; e < 8192; e += NWAVES * 64) ((LAS unsigned*)STs)[e] = 0u;
    bf16x8v qa[4]; v4u kq[4], vq[4];
    { const size_t r0 = (size_t)b * NT_; const int fr0 = lane & 15, fq0 = lane >> 4;
#pragma unroll
      for (int ks = 0; ks < 4; ++ks) qa[ks] = *(const GAS bf16x8v*)(RQ + (r0 + 16 * wid + fr0) * 1024 + h * 128 + ks * 32 + fq0 * 8);
#pragma unroll
      for (int i = 0; i < 4; ++i) { const int r = lane + 64 * (i & 1), cc = 2 * wid + (i >> 1); const size_t go = (r0 + r) * 1024 + h * 128 + cc * 8;
          kq[i] = *(const GAS v4u*)(RK + go); vq[i] = *(const GAS v4u*)(RV + go); } }
    for (int n = 0; n < 16; ++n) {
        const size_t row0 = (size_t)b * NT_ + (size_t)n * 128;
        int lane_n = lane; asm volatile("" : "+v"(lane_n)); const int fr = lane_n & 15, fq = lane_n >> 4;
        float lgn = lg2; asm volatile("" : "+v"(lgn));
#pragma unroll
        for (int i = 0; i < 4; ++i) { const int r = lane_n + 64 * (i & 1), cc = 2 * wid + (i >> 1);
            const v4u k = kq[i], v = vq[i];
            *(LAS v4u*)(Ks + sw_off(r, cc * 8)) = k;
            const float kd = __builtin_amdgcn_exp2f((float)(127 - r) * lgn); const unsigned kw[4] = {k.x, k.y, k.z, k.w}, vw[4] = {v.x, v.y, v.z, v.w};
#pragma unroll
            for (int j = 0; j < 4; ++j) {
                *(LAS bf16*)(KTs + sw_off(cc * 8 + 2 * j, r)) = (bf16)f2bf(bflo(kw[j]) * kd); *(LAS bf16*)(KTs + sw_off(cc * 8 + 2 * j + 1, r)) = (bf16)f2bf(bfhi(kw[j]) * kd);
                *(LAS bf16*)(VTs + sw_off(cc * 8 + 2 * j, r)) = (bf16)(vw[j] & 0xffffu); *(LAS bf16*)(VTs + sw_off(cc * 8 + 2 * j + 1, r)) = (bf16)(vw[j] >> 16); }
            if (i & 1) asm volatile("" ::: "memory"); }
        __syncthreads();
        unsigned Pk[8][2]; f32x4 o[8];
#pragma unroll
        for (int c = 0; c < 8; ++c) { f32x4 Sc = (f32x4){0.f, 0.f, 0.f, 0.f};
#pragma unroll
            for (int ks = 0; ks < 4; ++ks) { const bf16x8v kb = *(const LAS bf16x8v*)(Ks + sw_off(16 * c + fr, ks * 32 + fq * 8));
                Sc = __builtin_amdgcn_mfma_f32_16x16x32_bf16(qa[ks], kb, Sc, 0, 0, 0); }
            float p4[4];
#pragma unroll
            for (int rg = 0; rg < 4; ++rg) { const int tl = 16 * wid + 4 * fq + rg, sl = 16 * c + fr; p4[rg] = sl <= tl ? Sc[rg] * __builtin_amdgcn_exp2f((float)(tl - sl) * lgn) : 0.f; }
            Pk[c][0] = pk2(p4[0], p4[1]); Pk[c][1] = pk2(p4[2], p4[3]);
            asm volatile("" ::: "memory"); }
#pragma unroll
        for (int c = 0; c < 8; ++c) { o[c] = (f32x4){0.f, 0.f, 0.f, 0.f};
#pragma unroll
            for (int ks = 0; ks < 4; ++ks) { const bf16x8v sb = *(const LAS bf16x8v*)(STs + sw_off(16 * c + fr, ks * 32 + fq * 8));
                o[c] = __builtin_amdgcn_mfma_f32_16x16x32_bf16(qa[ks], sb, o[c], 0, 0, 0); }
#pragma unroll
            for (int rg = 0; rg < 4; ++rg) o[c][rg] *= __builtin_amdgcn_exp2f((float)(16 * wid + 4 * fq + rg + 1) * lgn);
            asm volatile("" ::: "memory"); }
        {
            bf16x8v va[4];
#pragma unroll
            for (int ks = 0; ks < 4; ++ks) va[ks] = *(const LAS bf16x8v*)(VTs + sw_off(16 * wid + fr, ks * 32 + fq * 8));
#pragma unroll
            for (int c = 0; c < 8; ++c) { st[c] = st[c] * cdec;
#pragma unroll
                for (int ks = 0; ks < 4; ++ks) { const bf16x8v kb = *(const LAS bf16x8v*)(KTs + sw_off(16 * c + fr, ks * 32 + fq * 8));
                    st[c] = __builtin_amdgcn_mfma_f32_16x16x32_bf16(va[ks], kb, st[c], 0, 0, 0); }
                asm volatile("" ::: "memory"); }
        }
        __syncthreads();
        v4u gq[4];
#pragma unroll
        for (int i = 0; i < 4; ++i) gq[i] = *(const GAS v4u*)(RG + (row0 + 16 * wid + (lane_n >> 4) + 4 * i) * 1024 + h * 128 + (lane_n & 15) * 8);
        bf16x8v qn[4];
        if (n + 1 < 16) { const size_t r1 = row0 + 128;
#pragma unroll
            for (int ks = 0; ks < 4; ++ks) qn[ks] = *(const GAS bf16x8v*)(RQ + (r1 + 16 * wid + fr) * 1024 + h * 128 + ks * 32 + fq * 8);
#pragma unroll
            for (int i = 0; i < 4; ++i) { const int r = lane_n + 64 * (i & 1), cc = 2 * wid + (i >> 1); const size_t go = (r1 + r) * 1024 + h * 128 + cc * 8;
                kq[i] = *(const GAS v4u*)(RK + go); vq[i] = *(const GAS v4u*)(RV + go); } }
        else {
#pragma unroll
            for (int ks = 0; ks < 4; ++ks) qn[ks] = qa[ks]; }
#pragma unroll
        for (int c = 0; c < 8; ++c)
#pragma unroll
            for (int rg = 0; rg < 4; ++rg) { const int tl = 16 * wid + 4 * fq + rg, sl = 16 * c + fr;
                *(LAS bf16*)(Ks + sw_off(tl, sl)) = (bf16)((rg & 1) ? (Pk[c][rg >> 1] >> 16) : (Pk[c][rg >> 1] & 0xffffu));
                *(LAS bf16*)(STs + sw_off(tl, sl)) = (bf16)f2bf(st[c][rg]); }
        LDS_WAIT(); asm volatile("" ::: "memory");
        bf16x8v pa[4];
#pragma unroll
        for (int ks = 0; ks < 4; ++ks) pa[ks] = *(const LAS bf16x8v*)(Ks + sw_off(16 * wid + fr, ks * 32 + fq * 8));
#pragma unroll
        for (int c = 0; c < 8; ++c) {
#pragma unroll
            for (int ks = 0; ks < 4; ++ks) { const bf16x8v vb = *(const LAS bf16x8v*)(VTs + sw_off(16 * c + fr, ks * 32 + fq * 8));
                o[c] = __builtin_amdgcn_mfma_f32_16x16x32_bf16(pa[ks], vb, o[c], 0, 0, 0); }
            asm volatile("" ::: "memory"); }
        float mu[4], rs[4];
#pragma unroll
        for (int rg = 0; rg < 4; ++rg) { float s = 0.f;
#pragma unroll
            for (int c = 0; c < 8; ++c) s += o[c][rg];
            s = pg8::xadd<1>(s); s = pg8::xadd<2>(s); s = pg8::xadd<4>(s); s = pg8::xadd<8>(s); mu[rg] = s * (1.f / 128.f);
            float q = 0.f;
#pragma unroll
            for (int c = 0; c < 8; ++c) { const float d = o[c][rg] - mu[rg]; q += d * d; }
            q = pg8::xadd<1>(q); q = pg8::xadd<2>(q); q = pg8::xadd<4>(q); q = pg8::xadd<8>(q); rs[rg] = 1.0f / sqrtf(q * (1.f / 128.f) + EPSN); }
#pragma unroll
        for (int c = 0; c < 8; ++c)
#pragma unroll
            for (int rg = 0; rg < 4; ++rg) *(LAS bf16*)(Ks + sw_off(16 * wid + 4 * fq + rg, 16 * c + fr)) = (bf16)f2bf((o[c][rg] - mu[rg]) * rs[rg] * gng[h * 128 + 16 * c + fr]);
        LDS_WAIT(); asm volatile("" ::: "memory");
#pragma unroll
        for (int i = 0; i < 4; ++i) { const int r = 16 * wid + (lane_n >> 4) + 4 * i, cc = lane_n & 15;
            const v4u y = *(const LAS v4u*)(Ks + sw_off(r, cc * 8)); const size_t go = (row0 + r) * 1024 + h * 128 + cc * 8;
            const unsigned yw[4] = {y.x, y.y, y.z, y.w}, gw4[4] = {gq[i].x, gq[i].y, gq[i].z, gq[i].w}; unsigned ow[4];
#pragma unroll
            for (int j = 0; j < 4; ++j) { const float ga = bflo(gw4[j]), gb = bfhi(gw4[j]); ow[j] = pk2(ga * sigm(ga) * bflo(yw[j]), gb * sigm(gb) * bfhi(yw[j])); }
            v4u w; w.x = ow[0]; w.y = ow[1]; w.z = ow[2]; w.w = ow[3]; *(GAS v4u*)(YRo + go) = w; }
        __syncthreads();
#pragma unroll
        for (int ks = 0; ks < 4; ++ks) qa[ks] = qn[ks];
    }
}

__device__ __forceinline__ void ph_combine(Frame& F, const Args& args, int l) {
    PH_ENTER();
    const int gw = vcu_ * NWAVES + wave, NGW = G_ * NWAVES;
    const float* dl = args.in[4] + (size_t)l * 256;
    const float s01 = wave_sum(dl[lane] * dl[64 + lane]), s23 = wave_sum(dl[128 + lane] * dl[192 + lane]);
    const float linit = 0.8f - 0.6f * expf(-0.3f * (float)l);
    const float lam = expf(s01) - expf(s23) + linit;
    const float* subln = args.in[5] + (size_t)l * 128 + (lane & 7) * 16;
    float sl[16];
#pragma unroll
    for (int i = 0; i < 16; ++i) sl[i] = subln[i] * (1.0f - linit);
    const bf16* O0 = (const bf16*)args.out; const bf16* O1 = O0 + SEG_E;
    bf16* YA = (bf16*)(ws + WS_Y);
    for (int m = gw; m < M; m += NGW) {
        const size_t off = (size_t)m * 1024 + lane * 16;
        {   const v4u a0 = *(const GAS v4u*)(O0 + off), a1 = *(const GAS v4u*)(O0 + off + 8), b0 = *(const GAS v4u*)(O1 + off), b1 = *(const GAS v4u*)(O1 + off + 8);
            const unsigned aw[8] = {a0.x, a0.y, a0.z, a0.w, a1.x, a1.y, a1.z, a1.w}, bw[8] = {b0.x, b0.y, b0.z, b0.w, b1.x, b1.y, b1.z, b1.w};
            float d[16]; float ss = 0.f;
#pragma unroll
            for (int j = 0; j < 8; ++j) { d[2 * j] = bflo(aw[j]) - lam * bflo(bw[j]); d[2 * j + 1] = bfhi(aw[j]) - lam * bfhi(bw[j]); ss += d[2 * j] * d[2 * j] + d[2 * j + 1] * d[2 * j + 1]; }
            ss = pg8::xadd<1>(ss); ss = pg8::xadd<2>(ss); ss = pg8::xadd<4>(ss);
            const float r = 1.0f / sqrtf(ss * (1.f / 128.f) + EPSN);
            unsigned ow[8];
#pragma unroll
            for (int j = 0; j < 8; ++j) ow[j] = pk2(d[2 * j] * r * sl[2 * j], d[2 * j + 1] * r * sl[2 * j + 1]);
            v4u w0; w0.x = ow[0]; w0.y = ow[1]; w0.z = ow[2]; w0.w = ow[3]; v4u w1; w1.x = ow[4]; w1.y = ow[5]; w1.z = ow[6]; w1.w = ow[7];
            *(GAS v4u*)(YA + off) = w0; *(GAS v4u*)(YA + off + 8) = w1; }
    }
}

#ifndef MK_MULTI
#define MK_MULTI 0
#endif
template <int KLO, int KHI> __global__ void __launch_bounds__(NWAVES * 64, 2) mk_fwd(Args args) {
    extern __shared__ __attribute__((aligned(16))) unsigned char lds[];
    Frame F;
    F.lds = (LAS unsigned char*)lds;
    F.MISC = (volatile LAS unsigned*)(F.lds + MISC_OFF);
    F.wave = __builtin_amdgcn_readfirstlane((int)threadIdx.x >> 6); F.G = gridDim.x; { const int bx = blockIdx.x; F.vcu = (F.G % 8 == 0) ? (bx % 8) * (F.G / 8) + bx / 8 : bx; }
    for (int u = threadIdx.x; u < (LDS_BYTES - LDSCTL_OFF) / 4; u += NWAVES * 64) ((LAS unsigned*)(F.lds + LDSCTL_OFF))[u] = 0u;
    __syncthreads();
    XcdBarrier bar; bar.bar = (unsigned*)(args.ws + WS_CTL) + CW_BAR; bar.x = 0; bar.st = nullptr;
    if (!MK_MULTI) bar = xcd_barrier_post((unsigned*)(args.ws + WS_CTL) + CW_BAR, F.MISC + 8, threadIdx.x == 0);
#ifndef REP_MASK
#define REP_MASK 0u
#endif
#define NREP(k) ((((REP_MASK) >> (k)) & 1u) ? 2 : 1)
#define IN(k) (KLO <= (k) && (k) < KHI)
#define SEAM(k) do { if (!MK_MULTI && IN(k) && IN((k) + 1)) xcd_barrier(bar, F.wave == 0 && pg8::lane_id() == 0); } while (0)
#define PHP() unsigned char* ws = pg8::uni_ptr(args.ws); bf16* const XN = (bf16*)(ws + WS_XN); bf16* const BIGp = (bf16*)(ws + WS_BIG); const int bx = pg8::opq((int)blockIdx.x), G_ = pg8::opq(F.G); (void)XN; (void)BIGp; (void)bx; (void)G_

    for (int l = args.l_lo; l < args.l_hi; ++l) {
        constexpr int pb = 0;
        const float* xcur = args.in[0];
        if (l == 0) {
        if (IN(pb + 0)) for (int rep_ = 0; rep_ < NREP(0); ++rep_) ph_prep(F, args, l, xcur);
        SEAM(pb + 0); }
        if (IN(pb + 1)) for (int rep_ = 0; rep_ < NREP(1); ++rep_) { PHP();
            { pg8::Gemm g{XN, (const bf16*)(ws + W_IN), LD2K, LD2K, DM_}; pg8::StaticOrder S; S.init(M, INC, G_, bx, LD2K, LD2K);
              pg8::EpiInProj E{BIGp, (const float*)(ws + WS_DCS), (const float*)(ws + WS_RCS), (const float*)(ws + WS_RSS) + (l == 0 ? 0 : 3 * RSS_STRIDE)};
              pg8::gemm_phase<pg8::EpiInProj, pg8::StaticOrder, true, true>(F.lds + RING_OFF, g, S, E, F.wave); }
            if (l == 0) {
            { pg8::Gemm g{(const bf16*)(ws + WS_MN), (const bf16*)(ws + W_KV), DM_, LD2K, DM_}; pg8::StaticOrder S; S.init(MEMROWS, 2 * DM_, G_, (bx + 128) % G_, DM_, LD2K);
              pg8::EpiBf16 E{(bf16*)(ws + WS_KM), LD2K, DM_, (size_t)MEMROWS * LD2K, 1.0f, nullptr};
              pg8::gemm_phase<pg8::EpiBf16, pg8::StaticOrder, true, true>(F.lds + RING_OFF, g, S, E, F.wave); }
            { pg8::Gemm g{(const bf16*)((unsigned char*)args.out + DO_MN1), (const bf16*)((unsigned char*)args.out + DO_WKV1), DM_, LD2K, DM_}; pg8::StaticOrder S; S.init(MEMROWS, 2 * DM_, G_, bx, DM_, LD2K);
              pg8::EpiBf16 E{(bf16*)((unsigned char*)args.out + DO_KV1), LD2K, DM_, (size_t)MEMROWS * LD2K, 1.0f, nullptr};
              pg8::gemm_phase<pg8::EpiBf16, pg8::StaticOrder, true, true>(F.lds + RING_OFF, g, S, E, F.wave); }
            }
        }
        SEAM(pb + 1);
        if (IN(pb + 3)) for (int rep_ = 0; rep_ < NREP(3); ++rep_) { PHP();
            const attn_body::bf16* Qp = (const attn_body::bf16*)BIGp; const attn_body::bf16* Kp = (const attn_body::bf16*)(BIGp + SEG_E); const attn_body::bf16* Vp = (const attn_body::bf16*)(BIGp + 2 * SEG_E);
            attn_body::bf16* Op = (attn_body::bf16*)args.out;
            unsigned* qctr = (unsigned*)(ws + WS_CTL) + CW_Q + 64 * (2 * l + rep_);
            const float* fzl = (const float*)(ws + WS_LAM) + 192 * l;
            const int nwc = (LATE_ITEMS + (l + 1 < DEPTH ? LATE_ITEMS_IN : 0)) / CHUNK_ITEMS, nch = nwc + (l == 0 ? 0 : KV_CHUNKS);
            for (;;) {
                if (F.wave == 0 && pg8::lane_id() == 0) { const unsigned idq = __hip_atomic_fetch_add(qctr, 1u, __ATOMIC_RELAXED, __HIP_MEMORY_SCOPE_AGENT); F.MISC[12] = idq; }
                __syncthreads();
                const int idq = pg8::opq((int)__builtin_amdgcn_readfirstlane((int)F.MISC[12]));
                if (idq >= 1088 + nch) break;
                int id = idq;
                if (idq >= 64) { const int j = idq - 64;
                    if (j < 3 * nch) { const int q = j / 3, rr = j - 3 * q;
                        if (rr == 2) {
                            if (q >= nwc) {
                                int tq = pg8::opq(F.wave) * 64 + pg8::lane_id(); asm volatile("" : "+v"(tq));
                                const GAS v4u* src = (const GAS v4u*)(pg8::uni_ptr((const unsigned char*)args.out) + DO_KV1) + (size_t)(q - nwc) * 8192 + tq; GAS v4u* dst = (GAS v4u*)(ws + WS_KM) + (size_t)(q - nwc) * 8192 + tq;
                                v4u t[16];
#pragma unroll
                                for (int i = 0; i < 16; ++i) t[i] = src[512 * i];
#pragma unroll
                                for (int i = 0; i < 16; ++i) dst[512 * i] = t[i];
                                __syncthreads(); continue; }
                            LAS unsigned char* scr = (LAS unsigned char*)(F.lds + RING_OFF + F.wave * 16384);
                            kargp_t kp = (kargp_t)__builtin_amdgcn_kernarg_segment_ptr(); asm volatile("" : "+s"(kp)); int lane_q = pg8::lane_id(); asm volatile("" : "+v"(lane_q));
                            for (int i = 0; i < CHUNK_ITEMS / NWAVES; ++i) late_item(kp, ws, pg8::opq(l), CHUNK_ITEMS * q + pg8::opq(F.wave) + NWAVES * i, scr, lane_q);
                            __syncthreads(); continue; }
                        id = 64 + 2 * q + rr; }
                    else id = 64 + j - nch; }
                if (id < 64) ph_ret_seq(F, args, l, id);
                else if (id >= 320 && id < 832) { const int k2 = id - 320; ph_conv(F, args, l, 2 * k2, 2 * k2 + 2); }
                else { const int j = id < 320 ? id - 64 : id - 832 + 256;
                    const int qb = 7 - (j >> 6), g = j & 63, h8 = g & 7, b = g >> 3;
                    attn_body::attn_unit_w(F.wave, b, h8, 0, qb, Qp, Kp, Vp, Op, (char*)lds + RING_OFF, nullptr, nullptr);
                    attn_body::attn_unit_w(F.wave, b, h8, 1, qb, Qp, Kp, Vp, Op, (char*)lds + RING_OFF, (attn_body::bf16*)(ws + WS_Y), fzl); }
            }
            __syncthreads();
        }
        SEAM(pb + 3);
        if (IN(pb + 5)) for (int rep_ = 0; rep_ < NREP(5); ++rep_) { PHP();
            bf16* Y = (bf16*)(ws + WS_Y);
            pg8::Gemm g{Y, (const bf16*)(ws + W_BR), MIXW, LD1K, MIXW}; pg8::MergeOrder S; S.T.init(M, DM_, G_, bx, MIXW, LD1K);
            S.ystride = (unsigned)(SEG_E * 2); S.wstride = (unsigned)((size_t)DM_ * LD1K * 2);
            pg8::EpiMerge E{BIGp + 9 * SEG_E, BIGp};
            pg8::gemm_phase<pg8::EpiMerge, pg8::MergeOrder, true, true>(F.lds + RING_OFF, g, S, E, F.wave);
        }
        SEAM(pb + 5);
        if (IN(pb + 6))
#pragma unroll
        for (int rep_ = 0; rep_ < NREP(6); ++rep_) { PHP();
            { pg8::Gemm g{BIGp, (const bf16*)(ws + W_OUT), DM_, LD2K, DM_}; pg8::StaticOrder S; S.init(M, DM_, G_, bx, DM_, LD2K);
              pg8::EpiRes E{XN, rep_ ? BIGp + 11 * SEG_E : BIGp + 8 * SEG_E, LD2K, (float*)(ws + WS_RSS) + (size_t)(rep_ ? 6 : 1 + 3 * l) * RSS_STRIDE};
              pg8::gemm_phase<pg8::EpiRes, pg8::StaticOrder, true, true>(F.lds + RING_OFF, g, S, E, F.wave); }
            { pg8::Gemm g{(const bf16*)ws, (const bf16*)ws, LD2K, LD2K, 512};
              pg8::XprodOrder S{G_, bx, (unsigned)LD2K, (unsigned)WS_KM, (unsigned)(WS_KM + (size_t)MEMROWS * LD2K * 2), (unsigned)W_Q, (unsigned)W_O};
              pg8::EpiBf16Two E{(bf16*)(ws + WS_YRAW), DM_, (bf16*)(ws + WS_YRAW) + SEG_E, 1024};
              pg8::gemm_phase<pg8::EpiBf16Two, pg8::XprodOrder, true, true>(F.lds + RING_OFF, g, S, E, F.wave); }
        }
        SEAM(pb + 6);
        if (IN(pb + 8)) for (int rep_ = 0; rep_ < NREP(8); ++rep_) { PHP();
            pg8::Gemm g{BIGp + 8 * SEG_E, (const bf16*)(ws + WS_YRAW), LD2K, DM_, DM_}; pg8::XsOrder S{G_, bx, LD2K};
            pg8::EpiSoftmax E{BIGp + 2 * SEG_E, 1024, 0.044194173824159216f * LOG2E, (const float*)(ws + WS_RSS) + (size_t)(1 + 3 * l) * RSS_STRIDE};
            pg8::gemm_phase<pg8::EpiSoftmax, pg8::XsOrder, false, true>(F.lds + RING_OFF, g, S, E, F.wave);
        }
        SEAM(pb + 8);
        if (IN(pb + 12))
#pragma unroll
        for (int rep_ = 0; rep_ < NREP(12); ++rep_) { PHP();
            pg8::Gemm g{BIGp + 2 * SEG_E, (const bf16*)(ws + WS_YRAW) + SEG_E, 1024, 1024, 1024}; pg8::XoOrder S{G_, bx};
            pg8::EpiRes E{BIGp + 8 * SEG_E, rep_ ? BIGp + 11 * SEG_E : XN, LD2K, (float*)(ws + WS_RSS) + (size_t)(rep_ ? 6 : 2 + 3 * l) * RSS_STRIDE};
            pg8::gemm_phase<pg8::EpiRes, pg8::XoOrder, true, true>(F.lds + RING_OFF, g, S, E, F.wave);
        }
        SEAM(pb + 12);
        if (IN(pb + 14)) for (int rep_ = 0; rep_ < NREP(14); ++rep_) { PHP();
            pg8::Gemm g{XN, (const bf16*)(ws + W_13), LD2K, LD2K, DM_}; pg8::StaticOrder S; S.init(M, 2 * FFH, G_, bx, LD2K, LD2K);
            pg8::EpiSwiGLU E{BIGp, FFH, (const float*)(ws + WS_RSS) + (size_t)(2 + 3 * l) * RSS_STRIDE};
            pg8::gemm_phase<pg8::EpiSwiGLU, pg8::StaticOrder, true, true>(F.lds + RING_OFF, g, S, E, F.wave);
        }
        SEAM(pb + 14);
        if (IN(pb + 15))
#pragma unroll
        for (int rep_ = 0; rep_ < NREP(15); ++rep_) { PHP();
            pg8::Gemm g{BIGp, (const bf16*)(ws + W_2), FFH, LDFF, FFH}; pg8::StaticOrder S; S.init(M, DM_, G_, bx, FFH, LDFF);
            pg8::EpiRes E{XN, rep_ ? BIGp + 11 * SEG_E : XN, LD2K, (float*)(ws + WS_RSS) + (size_t)(rep_ ? 6 : 3 + 3 * l) * RSS_STRIDE};
            pg8::gemm_phase<pg8::EpiRes, pg8::StaticOrder, true, true>(F.lds + RING_OFF, g, S, E, F.wave);
        }
        SEAM(pb + 15);
    }
    if (IN(NPH)) { PH_ENTER(); const bf16* XB = (const bf16*)(ws + WS_XN); const float* rp = (const float*)(ws + WS_RSS) + (size_t)(3 * DEPTH) * RSS_STRIDE; const int gw = vcu_ * NWAVES + wave, NGW = G_ * NWAVES;
        for (int m = gw; m < M; m += NGW) {
            float sv = lane < 32 ? rp[(size_t)m * 32 + lane] : 0.f; sv = wave_sum(sv); const float r = 1.0f / sqrtf(sv * (1.f / 2048.f) + EPSN);
            const GAS v4u* xr = (const GAS v4u*)(XB + (size_t)m * LD2K) + lane; const GAS f32x4* gr = (const GAS f32x4*)args.in[21] + 2 * lane; GAS f32x4* orow = (GAS f32x4*)(args.out + (size_t)m * DM_) + 2 * lane;
#pragma unroll
            for (int j = 0; j < 4; ++j) { const v4u x = xr[64 * j]; const f32x4 g0 = gr[128 * j], g1 = gr[128 * j + 1];
                orow[128 * j] = (f32x4){bflo(x.x) * r * g0.x, bfhi(x.x) * r * g0.y, bflo(x.y) * r * g0.z, bfhi(x.y) * r * g0.w};
                orow[128 * j + 1] = (f32x4){bflo(x.z) * r * g1.x, bfhi(x.z) * r * g1.y, bflo(x.w) * r * g1.z, bfhi(x.w) * r * g1.w}; } } }
#undef IN
#undef SEAM
}

extern "C" void kernel_launch(void* const* d_in, const int* in_sizes, int n_in, void* d_out, int out_size, void* d_ws, size_t ws_size, hipStream_t stream) {
    static int grid = 0; static bool first = true;
    if (grid == 0) {
        if (n_in != 22 || in_sizes[0] != M * DM_ || out_size != M * DM_ || ws_size < WS_END) { fprintf(stderr, "kernel_launch: unexpected shapes / workspace (n_in %d, in0 %d, out %d, ws %zu, need %zu); nothing launched\n", n_in, n_in > 0 ? in_sizes[0] : -1, out_size, ws_size, (size_t)WS_END); grid = -1; return; }
        int dev = 0, cus = 0, per_cu = 0;
        if (hipGetDevice(&dev) != hipSuccess || hipDeviceGetAttribute(&cus, hipDeviceAttributeMultiprocessorCount, dev) != hipSuccess) { grid = -1; return; }
        if (hipFuncSetAttribute((const void*)mk_fwd<MK_MULTI ? NPH : 0, NPH + 1>, hipFuncAttributeMaxDynamicSharedMemorySize, LDS_BYTES) != hipSuccess) { fprintf(stderr, "kernel_launch: hipFuncSetAttribute failed\n"); grid = -1; return; }
        if (hipOccupancyMaxActiveBlocksPerMultiprocessor(&per_cu, (const void*)mk_fwd<MK_MULTI ? NPH : 0, NPH + 1>, NWAVES * 64, LDS_BYTES) != hipSuccess || per_cu < 1) fprintf(stderr, "kernel_launch: occupancy query reports %d\n", per_cu);
        (void)hipGetLastError();
        grid = cus;
    }
    if (grid < 0) return;
    if (hipMemsetAsync((char*)d_ws + WS_CTL, 0, CTL_ZERO_BYTES, stream) != hipSuccess) return;
    Args a{};
    for (int i = 0; i < 22; ++i) a.in[i] = (const float*)d_in[i];
    a.out = (float*)d_out; a.ws = (unsigned char*)d_ws;
#if MK_MULTI
#define LAUNCH_K(K) do { if (first) (void)hipFuncSetAttribute((const void*)mk_fwd<K, K + 1>, hipFuncAttributeMaxDynamicSharedMemorySize, LDS_BYTES); hipLaunchKernelGGL((mk_fwd<K, K + 1>), dim3(grid), dim3(NWAVES * 64), LDS_BYTES, stream, a); } while (0)
    for (int l = 0; l < DEPTH; ++l) { a.l_lo = l; a.l_hi = l + 1;
        LAUNCH_K(0); LAUNCH_K(1); LAUNCH_K(2); LAUNCH_K(3); LAUNCH_K(4); LAUNCH_K(5); LAUNCH_K(6); LAUNCH_K(7); LAUNCH_K(8); LAUNCH_K(9); LAUNCH_K(10); LAUNCH_K(11); LAUNCH_K(12); LAUNCH_K(13); LAUNCH_K(14); LAUNCH_K(15); }
    a.l_lo = DEPTH; a.l_hi = DEPTH; LAUNCH_K(16);
    first = false;
#else
    a.l_lo = 0; a.l_hi = DEPTH;
    hipLaunchKernelGGL((mk_fwd<MK_MULTI ? NPH : 0, NPH + 1>), dim3(grid), dim3(NWAVES * 64), LDS_BYTES, stream, a);
#endif
}
```

```cpp
#include <hip/hip_runtime.h>
#include <hip/hip_bf16.h>
#include <cstdio>
#include <cstdint>
#include <cmath>
namespace pg8 {
#define PG8_LAS __attribute__((address_space(3)))
typedef unsigned short bf16_t;
typedef short bf16x8 __attribute__((ext_vector_type(8)));
typedef float f32x4 __attribute__((ext_vector_type(4)));
typedef float f32x2 __attribute__((ext_vector_type(2)));
typedef unsigned u32x4 __attribute__((ext_vector_type(4)));
typedef unsigned u32x2 __attribute__((ext_vector_type(2)));
constexpr int BM = 256, BK = 64, HALF = 128, HTB = HALF * BK * 2  , STAGE_BYTES = 8 * HTB, NXCD = 8, WGM = 8;

__host__ __device__ __forceinline__ int lds_byte(int r, int c) { const int st = (r >> 4) * 2 + (c >> 5), rr = r & 15, cc = c & 31, ob = rr * 64 + cc * 2; return st * 1024 + (ob ^ (((ob >> 9) & 1) << 5)); }
__host__ __device__ __forceinline__ void stage_rc(int b, int& R, int& C) { const int st = b / 1024, sb = b % 1024, swz = sb ^ (((sb >> 9) & 1) << 5); R = (st >> 1) * 16 + swz / 64; C = (st & 1) * 32 + (swz % 64) / 2; }
__host__ __device__ __forceinline__ int perm32(int rho) { const int n = rho >> 4, i = rho & 15; return 8 * (i >> 2) + 4 * n + (i & 3); }

template <class T> __device__ __forceinline__ T* uni_ptr(T* p) { const unsigned long long v = (unsigned long long)p; unsigned lo = (unsigned)v, hi = (unsigned)(v >> 32);
    asm volatile("" : "+s"(lo), "+s"(hi)); return (T*)(((unsigned long long)hi << 32) | lo); }
__device__ __forceinline__ int lane_id() { int l; asm volatile("v_mbcnt_lo_u32_b32 %0, -1, 0\n\tv_mbcnt_hi_u32_b32 %0, -1, %0" : "=v"(l)); return l; }
__device__ __forceinline__ int opq(int x) { asm volatile("" : "+s"(x)); return x; }
template <int M> __device__ __forceinline__ float xadd(float v) {
    if constexpr (M == 32) { const auto rr = __builtin_amdgcn_permlane32_swap(__float_as_uint(v), __float_as_uint(v), false, false); return __uint_as_float(rr[0]) + __uint_as_float(rr[1]); }
    else return v + __int_as_float(__builtin_amdgcn_ds_swizzle(__float_as_int(v), (M << 10) | 0x1f));
}
__device__ __forceinline__ float row_sum16(float v) {
#define PG8_DPPADD(ctrl) v += __int_as_float(__builtin_amdgcn_update_dpp(0, __float_as_int(v), ctrl, 0xf, 0xf, true))
    PG8_DPPADD(0xB1); PG8_DPPADD(0x4E); PG8_DPPADD(0x141); PG8_DPPADD(0x140); return v;
#undef PG8_DPPADD
}
struct Unit { int pm, pn; unsigned offA, offB; int sub = 0; };
struct Gemm { const bf16_t* A; const bf16_t* Bt; int lda, ldb, K; };

struct StaticOrder {
    int nM, nN, nwg, G, c; unsigned tA, tB;
    __device__ void init(int M, int N, int G_, int c_, int lda, int ldb) { nM = M / BM; nN = N / BM; nwg = nM * nN; G = G_; c = c_; tA = (unsigned)BM * lda * 2u; tB = (unsigned)BM * ldb * 2u; }
    __device__ __forceinline__ bool next(int i, Unit& u) const {
        const long L = (long)i * G + c; if (L >= nwg) return false;
        int wgid = (int)L; { const int q = nwg / NXCD, r = nwg % NXCD, xcd = wgid % NXCD, off = wgid / NXCD; wgid = (xcd < r ? xcd * (q + 1) : r * (q + 1) + (xcd - r) * q) + off; }
        const int nig = WGM * nN, gid = wgid / nig, fm = gid * WGM, gsz = (nM - fm) < WGM ? (nM - fm) : WGM;
        u.pm = fm + ((wgid % nig) % gsz); u.pn = (wgid % nig) / gsz; u.offA = (unsigned)u.pm * tA; u.offB = (unsigned)u.pn * tB; return true;
    }
    __device__ __forceinline__ void a_ready(const Unit&) const {}
    __device__ __forceinline__ void done(const Unit&) const {}
};
struct XprodOrder {
    int G, c; unsigned ld, oK, oV, oWq, oWo;
    __device__ __forceinline__ bool next(int i, Unit& u) const {
        const int L = i * G + c; if (L >= 512) return false;
        const int q = L & 255, b = q >> 5, h = (q >> 3) & 3, t = q & 7;
        if (L < 256) { u.sub = 0; u.pm = b * 4 + h; u.pn = t; u.offA = oK + ((unsigned)(b * 256) * ld + h * 512) * 2u; u.offB = oWq + ((unsigned)(t * 256) * ld + h * 512) * 2u; }
        else         { u.sub = 1; u.pm = b * 8 + t; u.pn = h; u.offA = oWo + ((unsigned)(t * 256) * ld + h * 512) * 2u; u.offB = oV + ((unsigned)(b * 256) * ld + h * 512) * 2u; }
        return true;
    }
    __device__ __forceinline__ void a_ready(const Unit&) const {}
    __device__ __forceinline__ void done(const Unit&) const {}
};
struct XsOrder {
    int G, c, lda;
    __device__ __forceinline__ bool next(int i, Unit& u) const {
        const int L = i * G + c; if (L >= 256) return false;
        const int b = L >> 5, rt = (L >> 2) & 7, h = L & 3;
        u.pm = b * 8 + rt; u.pn = h; u.offA = ((unsigned)(b * 2048 + rt * 256) * (unsigned)lda) * 2u; u.offB = ((unsigned)(b * 1024 + h * 256) * 2048u) * 2u; return true;
    }
    __device__ __forceinline__ void a_ready(const Unit&) const {}
    __device__ __forceinline__ void done(const Unit&) const {}
};
struct XoOrder {
    int G, c;
    __device__ __forceinline__ bool next(int i, Unit& u) const {
        const int L = i * G + c; if (L >= 512) return false;
        const int b = L >> 6, rt = (L >> 3) & 7, ct = L & 7;
        u.pm = b * 8 + rt; u.pn = ct; u.offA = ((unsigned)(b * 2048 + rt * 256) * 1024u) * 2u; u.offB = ((unsigned)(b * 2048 + ct * 256) * 1024u) * 2u; return true;
    }
    __device__ __forceinline__ void a_ready(const Unit&) const {}
    __device__ __forceinline__ void done(const Unit&) const {}
};

__device__ __forceinline__ unsigned cvt_pk_bf16(float lo, float hi) { unsigned r; asm volatile("v_cvt_pk_bf16_f32 %0, %1, %2" : "=v"(r) : "v"(lo), "v"(hi)); return r; }
__device__ __forceinline__ float bf_lo(unsigned w) { return __uint_as_float(w << 16); }
__device__ __forceinline__ float bf_hi(unsigned w) { return __uint_as_float(w & 0xffff0000u); }
__device__ __forceinline__ float sigmoidf_(float x) { return __builtin_amdgcn_rcpf(1.0f + __builtin_amdgcn_exp2f(-1.4426950408889634f * x)); }

__device__ __forceinline__ void row_rs8(float (&rs)[2][4], const float* rssp, int row0, int fq) {
    f32x4 a[2][4], b[2][4];
#pragma unroll
    for (int ai = 0; ai < 2; ++ai)
#pragma unroll
        for (int m = 0; m < 4; ++m) { const float* p = rssp + (size_t)(row0 + ai * HALF + m * 16) * 32 + fq * 8; a[ai][m] = *(const f32x4*)p; b[ai][m] = *(const f32x4*)(p + 4); }
#pragma unroll
    for (int ai = 0; ai < 2; ++ai)
#pragma unroll
        for (int m = 0; m < 4; ++m) { float s = ((a[ai][m][0] + a[ai][m][1]) + (a[ai][m][2] + a[ai][m][3])) + ((b[ai][m][0] + b[ai][m][1]) + (b[ai][m][2] + b[ai][m][3]));
            s = pg8::xadd<16>(s); s = pg8::xadd<32>(s); rs[ai][m] = __builtin_amdgcn_rsqf(s * (1.0f / 2048.0f) + 1e-6f); }
}
struct EpiBf16 {
    static constexpr bool PERM = true, AFTER_DRAIN = false, MULTI = false;
    bf16_t* O; int ldc; int split_cols; size_t split_stride; float scale; const float* rss;
    __device__ __forceinline__ void operator()(const f32x4 (&acc)[2][2][4][2], const Unit& u, int wr, int wc, int fr, int fq) const {
        const int row0 = u.pm * BM + wr * 64 + fr; int colt = u.pn * BM; bf16_t* base = O;
        if (split_cols) { const int t = colt / split_cols; base += (size_t)t * split_stride; colt -= t * split_cols; }
        const int col0 = colt + wc * 32 + 8 * fq; const float sc = scale;
        float rs[2][4];
        if (rss) row_rs8(rs, rss, row0, fq);
#pragma unroll
        for (int ai = 0; ai < 2; ++ai)
#pragma unroll
            for (int m = 0; m < 4; ++m) { bf16_t* rowp = base + (size_t)(row0 + ai * HALF + m * 16) * ldc + col0;
                const float sr = rss ? sc * rs[ai][m] : sc;
#pragma unroll
                for (int bj = 0; bj < 2; ++bj) { const f32x4 v0 = acc[ai][bj][m][0] * sr, v1 = acc[ai][bj][m][1] * sr;
                    u32x4 w; w.x = cvt_pk_bf16(v0[0], v0[1]); w.y = cvt_pk_bf16(v0[2], v0[3]); w.z = cvt_pk_bf16(v1[0], v1[1]); w.w = cvt_pk_bf16(v1[2], v1[3]);
                    *(u32x4*)(rowp + bj * HALF) = w; } }
    }
};
struct EpiBf16Two {
    static constexpr bool PERM = true, AFTER_DRAIN = false, MULTI = false;
    bf16_t* O0; int ld0; bf16_t* O1; int ld1;
    __device__ __forceinline__ void operator()(const f32x4 (&acc)[2][2][4][2], const Unit& u, int wr, int wc, int fr, int fq) const {
        bf16_t* base = u.sub ? O1 : O0; const int ldc = u.sub ? ld1 : ld0;
        const int row0 = u.pm * BM + wr * 64 + fr, col0 = u.pn * BM + wc * 32 + 8 * fq;
#pragma unroll
        for (int ai = 0; ai < 2; ++ai)
#pragma unroll
            for (int m = 0; m < 4; ++m) { bf16_t* rowp = base + (size_t)(row0 + ai * HALF + m * 16) * ldc + col0;
#pragma unroll
                for (int bj = 0; bj < 2; ++bj) { const f32x4 v0 = acc[ai][bj][m][0], v1 = acc[ai][bj][m][1];
                    u32x4 w; w.x = cvt_pk_bf16(v0[0], v0[1]); w.y = cvt_pk_bf16(v0[2], v0[3]); w.z = cvt_pk_bf16(v1[0], v1[1]); w.w = cvt_pk_bf16(v1[2], v1[3]);
                    *(u32x4*)(rowp + bj * HALF) = w; } }
    }
};
struct EpiInProj {
    static constexpr bool PERM = true, AFTER_DRAIN = false, MULTI = false;
    bf16_t* BIG; const float* dcs; const float* rcs; const float* rss;
    __device__ __forceinline__ void operator()(const f32x4 (&acc)[2][2][4][2], const Unit& u, int wr, int wc, int fr, int fq) const {
        const int pn = u.pn; const int row0 = u.pm * BM + wr * 64 + fr; const size_t SEGE = (size_t)16384 * 1024;
        const int cw = wc * 32 + 8 * fq;
        float rs[2][4]; row_rs8(rs, rss, row0, fq);
        if (pn < 8 || (pn >= 20 && pn < 28)) {
            const bool isd = pn < 8; const int seg = isd ? (pn >> 2) : 5 + ((pn - 20) >> 2);
            const float sc = pn < 4 ? 0.125f * 1.4426950408889634f : (pn >= 20 && pn < 24) ? 0.08838834764831845f : 1.0f;
            const int i0 = isd ? ((cw & 63) >> 1) : ((cw & 127) >> 1);
            bf16_t* base = BIG + (size_t)seg * SEGE + (pn & 3) * BM + cw;
#pragma unroll
            for (int ai = 0; ai < 2; ++ai)
#pragma unroll
              for (int mp = 0; mp < 2; ++mp) {
                f32x4 ta[2], tb4[2];
#pragma unroll
                for (int mm = 0; mm < 2; ++mm) { const int t = (row0 + ai * HALF + (2 * mp + mm) * 16) & 2047;
                    const float* tb = isd ? dcs + ((size_t)t * 32 + i0) * 2 : rcs + ((size_t)t * 64 + i0) * 2; ta[mm] = *(const f32x4*)tb; tb4[mm] = *(const f32x4*)(tb + 4); }
#pragma unroll
                for (int mm = 0; mm < 2; ++mm) { const int m = 2 * mp + mm; const int row = row0 + ai * HALF + m * 16; const float sr = sc * rs[ai][m]; const f32x4 t0 = ta[mm], t1 = tb4[mm];
#pragma unroll
                    for (int bj = 0; bj < 2; ++bj) { const f32x4 v0 = acc[ai][bj][m][0], v1 = acc[ai][bj][m][1];
                        const float y0 = (v0[0] * t0[0] - v0[1] * t0[1]) * sr, y1 = (v0[1] * t0[0] + v0[0] * t0[1]) * sr, y2 = (v0[2] * t0[2] - v0[3] * t0[3]) * sr, y3 = (v0[3] * t0[2] + v0[2] * t0[3]) * sr;
                        const float y4 = (v1[0] * t1[0] - v1[1] * t1[1]) * sr, y5 = (v1[1] * t1[0] + v1[0] * t1[1]) * sr, y6 = (v1[2] * t1[2] - v1[3] * t1[3]) * sr, y7 = (v1[3] * t1[2] + v1[2] * t1[3]) * sr;
                        u32x4 w; w.x = cvt_pk_bf16(y0, y1); w.y = cvt_pk_bf16(y2, y3); w.z = cvt_pk_bf16(y4, y5); w.w = cvt_pk_bf16(y6, y7);
                        *(u32x4*)(base + (size_t)row * 1024 + bj * HALF) = w; } }
                asm volatile("" ::: "memory"); }
        } else if (pn >= 12 && pn < 20) {
            bf16_t* base = BIG + 3 * SEGE + (pn - 12) * (BM / 2) + (cw >> 1);
#pragma unroll
            for (int ai = 0; ai < 2; ++ai)
#pragma unroll
                for (int m = 0; m < 4; ++m) { bf16_t* rowp = base + (size_t)(row0 + ai * HALF + m * 16) * 1024; const float sr = rs[ai][m];
#pragma unroll
                    for (int bj = 0; bj < 2; ++bj) { const f32x4 v0 = acc[ai][bj][m][0] * sr, v1 = acc[ai][bj][m][1] * sr;
                        u32x2 w; w.x = cvt_pk_bf16(v0[0] * sigmoidf_(v0[1]), v0[2] * sigmoidf_(v0[3])); w.y = cvt_pk_bf16(v1[0] * sigmoidf_(v1[1]), v1[2] * sigmoidf_(v1[3]));
                        *(u32x2*)(rowp + bj * (HALF / 2)) = w; } }
        } else {
            bf16_t* base = BIG + (size_t)(pn >> 2) * SEGE + (pn & 3) * BM + cw; const bool sg = pn >= 36;
#pragma unroll
            for (int ai = 0; ai < 2; ++ai)
#pragma unroll
                for (int m = 0; m < 4; ++m) { bf16_t* rowp = base + (size_t)(row0 + ai * HALF + m * 16) * 1024; const float sr = rs[ai][m];
#pragma unroll
                    for (int bj = 0; bj < 2; ++bj) { f32x4 v0 = acc[ai][bj][m][0] * sr, v1 = acc[ai][bj][m][1] * sr;
                        if (sg) { v0[0] = sigmoidf_(v0[0]); v0[1] = sigmoidf_(v0[1]); v0[2] = sigmoidf_(v0[2]); v0[3] = sigmoidf_(v0[3]); v1[0] = sigmoidf_(v1[0]); v1[1] = sigmoidf_(v1[1]); v1[2] = sigmoidf_(v1[2]); v1[3] = sigmoidf_(v1[3]); }
                        u32x4 w; w.x = cvt_pk_bf16(v0[0], v0[1]); w.y = cvt_pk_bf16(v0[2], v0[3]); w.z = cvt_pk_bf16(v1[0], v1[1]); w.w = cvt_pk_bf16(v1[2], v1[3]);
                        *(u32x4*)(rowp + bj * HALF) = w; } }
        }
    }
};
struct EpiSoftmax {
    static constexpr bool PERM = true, AFTER_DRAIN = true, MULTI = false;
    bf16_t* P; int ldp; float sc; const float* rss;
    __device__ __forceinline__ void fused(f32x4 (&acc)[2][2][4][2], const Unit& u, int wr, int wc, int fr, int fq, PG8_LAS unsigned char* lds, int wid, int lane) const {
        PG8_LAS float* Ps = (PG8_LAS float*)lds;
        const int row0 = u.pm * BM + wr * 64 + fr;
        float rs[2][4]; row_rs8(rs, rss, row0, fq);
#pragma unroll
        for (int ai = 0; ai < 2; ++ai)
#pragma unroll
            for (int m = 0; m < 4; ++m) { const float k = sc * rs[ai][m]; float t = 0.f;
#pragma unroll
                for (int bj = 0; bj < 2; ++bj)
#pragma unroll
                    for (int n = 0; n < 2; ++n) { f32x4 e = acc[ai][bj][m][n] * k; e[0] = __builtin_amdgcn_exp2f(e[0]); e[1] = __builtin_amdgcn_exp2f(e[1]); e[2] = __builtin_amdgcn_exp2f(e[2]); e[3] = __builtin_amdgcn_exp2f(e[3]);
                        acc[ai][bj][m][n] = e; t += (e[0] + e[1]) + (e[2] + e[3]); }
                t = pg8::xadd<16>(t); t = pg8::xadd<32>(t);
                if (fq == 0) Ps[(ai * HALF + wr * 64 + m * 16 + fr) * 4 + wc] = t; }
        asm volatile("s_waitcnt lgkmcnt(0)" ::: "memory"); __builtin_amdgcn_s_barrier(); asm volatile("" ::: "memory");
#pragma unroll
        for (int ai = 0; ai < 2; ++ai)
#pragma unroll
            for (int m = 0; m < 4; ++m) { const f32x4 q = *(const PG8_LAS f32x4*)(Ps + (ai * HALF + wr * 64 + m * 16 + fr) * 4); const float inv = 1.0f / ((q[0] + q[1]) + (q[2] + q[3]));
                bf16_t* rowp = P + (size_t)(row0 + ai * HALF + m * 16) * ldp + u.pn * BM + wc * 32 + 8 * fq;
#pragma unroll
                for (int bj = 0; bj < 2; ++bj) { const f32x4 v0 = acc[ai][bj][m][0] * inv, v1 = acc[ai][bj][m][1] * inv;
                    u32x4 w; w.x = cvt_pk_bf16(v0[0], v0[1]); w.y = cvt_pk_bf16(v0[2], v0[3]); w.z = cvt_pk_bf16(v1[0], v1[1]); w.w = cvt_pk_bf16(v1[2], v1[3]);
                    *(u32x4*)(rowp + bj * HALF) = w; } }
        asm volatile("s_waitcnt lgkmcnt(0)" ::: "memory"); __builtin_amdgcn_s_barrier(); asm volatile("" ::: "memory");
    }
};
struct EpiRes {
    static constexpr bool PERM = true, AFTER_DRAIN = false, MULTI = false;
    const bf16_t* xo; bf16_t* xb; int ldx; float* rssp;
    __device__ __forceinline__ void operator()(const f32x4 (&acc)[2][2][4][2], const Unit& u, int wr, int wc, int fr, int fq) const {
        const int col0 = u.pn * BM + wc * 32 + 8 * fq;
#pragma unroll
        for (int ai = 0; ai < 2; ++ai) {
            u32x4 ro[4][2];
#pragma unroll
            for (int m = 0; m < 4; ++m)
#pragma unroll
                for (int bj = 0; bj < 2; ++bj) ro[m][bj] = *(const u32x4*)(xo + (size_t)(u.pm * BM + ai * HALF + wr * 64 + m * 16 + fr) * ldx + col0 + bj * HALF);
#pragma unroll
            for (int m = 0; m < 4; ++m) { const int row = u.pm * BM + ai * HALF + wr * 64 + m * 16 + fr; float ss = 0.f;
#pragma unroll
                for (int bj = 0; bj < 2; ++bj) { const u32x4 o = ro[m][bj];
                    f32x4 v0 = acc[ai][bj][m][0], v1 = acc[ai][bj][m][1];
                    v0[0] += bf_lo(o.x); v0[1] += bf_hi(o.x); v0[2] += bf_lo(o.y); v0[3] += bf_hi(o.y); v1[0] += bf_lo(o.z); v1[1] += bf_hi(o.z); v1[2] += bf_lo(o.w); v1[3] += bf_hi(o.w);
                    ss += ((v0[0] * v0[0] + v0[1] * v0[1]) + (v0[2] * v0[2] + v0[3] * v0[3])) + ((v1[0] * v1[0] + v1[1] * v1[1]) + (v1[2] * v1[2] + v1[3] * v1[3]));
                    u32x4 w; w.x = cvt_pk_bf16(v0[0], v0[1]); w.y = cvt_pk_bf16(v0[2], v0[3]); w.z = cvt_pk_bf16(v1[0], v1[1]); w.w = cvt_pk_bf16(v1[2], v1[3]);
                    *(u32x4*)(xb + (size_t)row * ldx + col0 + bj * HALF) = w; }
                ss = pg8::xadd<16>(ss); ss = pg8::xadd<32>(ss);
                if (fq == 0) rssp[(size_t)row * 32 + u.pn * 4 + wc] = ss; }
            asm volatile("" ::: "memory"); }
    }
};
struct EpiMerge {
    static constexpr bool PERM = true, AFTER_DRAIN = false, MULTI = true;
    const bf16_t* gates; bf16_t* merged;
    __device__ __forceinline__ void step(f32x4 (&acc)[2][2][4][2], const Unit& u, int wr, int wc, int fr, int fq) const {
        const size_t SEGE = (size_t)16384 * 1024; const int sub = u.sub; const bool last = sub == 2;
        const int row0 = u.pm * BM + wr * 64 + fr; const int gcol = (u.pn & 3) * BM + wc * 32 + 8 * fq;
        const bf16_t* ga = gates + (size_t)(2 * sub + (u.pn >> 2)) * SEGE + gcol;
        const bf16_t* gb = last ? ga : ga + 2 * SEGE;
#pragma unroll
        for (int ai = 0; ai < 2; ++ai)
#pragma unroll
            for (int m = 0; m < 4; ++m) {
                u32x4 za[2], zb[2];
#pragma unroll
                for (int bj = 0; bj < 2; ++bj) { const size_t p = (size_t)(row0 + ai * HALF + m * 16) * 1024 + bj * HALF; za[bj] = *(const u32x4*)(ga + p); zb[bj] = *(const u32x4*)(gb + p); }
#pragma unroll
                for (int bj = 0; bj < 2; ++bj) { const unsigned aw[4] = {za[bj].x, za[bj].y, za[bj].z, za[bj].w}; unsigned bw[4] = {zb[bj].x, zb[bj].y, zb[bj].z, zb[bj].w};
                    float f[8];
#pragma unroll
                    for (int j = 0; j < 4; ++j) { if (last) bw[j] = 0x3f803f80u; f[2 * j] = bf_lo(aw[j]) * __builtin_amdgcn_rcpf(bf_lo(bw[j])); f[2 * j + 1] = bf_hi(aw[j]) * __builtin_amdgcn_rcpf(bf_hi(bw[j])); }
                    f32x4 v0 = acc[ai][bj][m][0], v1 = acc[ai][bj][m][1];
                    v0[0] *= f[0]; v0[1] *= f[1]; v0[2] *= f[2]; v0[3] *= f[3]; v1[0] *= f[4]; v1[1] *= f[5]; v1[2] *= f[6]; v1[3] *= f[7];
                    acc[ai][bj][m][0] = v0; acc[ai][bj][m][1] = v1;
                    if (last) { u32x4 w; w.x = cvt_pk_bf16(v0[0], v0[1]); w.y = cvt_pk_bf16(v0[2], v0[3]); w.z = cvt_pk_bf16(v1[0], v1[1]); w.w = cvt_pk_bf16(v1[2], v1[3]);
                        *(u32x4*)(merged + (size_t)(row0 + ai * HALF + m * 16) * 2048 + u.pn * BM + wc * 32 + 8 * fq + bj * HALF) = w; } }
                if (m & 1) asm volatile("" ::: "memory"); }
    }
};
struct MergeOrder {
    StaticOrder T; unsigned ystride, wstride;
    __device__ __forceinline__ bool next(int i, Unit& u) const {
        const int ti = i / 3, sub = i - 3 * ti;
        if (!T.next(ti, u)) return false;
        u.sub = sub; u.offA += (unsigned)sub * ystride; u.offB += (unsigned)sub * wstride; return true;
    }
    __device__ __forceinline__ void a_ready(const Unit&) const {}
    __device__ __forceinline__ void done(const Unit&) const {}
};
struct EpiSwiGLU {
    static constexpr bool PERM = true, AFTER_DRAIN = false, MULTI = false;
    bf16_t* O; int ldo; const float* rss;
    __device__ __forceinline__ void operator()(const f32x4 (&acc)[2][2][4][2], const Unit& u, int wr, int wc, int fr, int fq) const {
        const int row0 = u.pm * BM + wr * 64 + fr; const int j0 = (u.pn * BM + wc * 32 + 8 * fq) >> 1;
        float rs[2][4]; row_rs8(rs, rss, row0, fq);
#pragma unroll
        for (int ai = 0; ai < 2; ++ai)
#pragma unroll
            for (int m = 0; m < 4; ++m) { bf16_t* rowp = O + (size_t)(row0 + ai * HALF + m * 16) * ldo + j0; const float sr = rs[ai][m];
#pragma unroll
                for (int bj = 0; bj < 2; ++bj) { const f32x4 v0 = acc[ai][bj][m][0] * sr, v1 = acc[ai][bj][m][1] * sr;
                    const float o0 = v0[0] * sigmoidf_(v0[0]) * v0[1], o1 = v0[2] * sigmoidf_(v0[2]) * v0[3], o2 = v1[0] * sigmoidf_(v1[0]) * v1[1], o3 = v1[2] * sigmoidf_(v1[2]) * v1[3];
                    u32x2 w; w.x = cvt_pk_bf16(o0, o1); w.y = cvt_pk_bf16(o2, o3);
                    *(u32x2*)(rowp + bj * (HALF / 2)) = w; } }
    }
};

template <class Epi, class Sched, bool ALIGN_EPI = false, bool SP2 = false>
__device__ __forceinline__ void gemm_phase(PG8_LAS unsigned char* lds, const Gemm g, const Sched& S, const Epi& E, const int wave_sg) {
    int tid_ = opq(wave_sg) * 64 + lane_id(); asm volatile("" : "+v"(tid_));
    const char* gA = uni_ptr((const char*)g.A); const char* gB = uni_ptr((const char*)g.Bt);
    const int tid = tid_, wid = __builtin_amdgcn_readfirstlane(tid >> 6), lane = tid & 63, wr = wid >> 2, wc = wid & 3, fr = lane & 15, fq = lane >> 4;
    int K_ = g.K; asm volatile("" : "+s"(K_));
    const int K = K_, nt = K / BK;
    unsigned voffA[2], voffB[2];
#pragma unroll
    for (int i = 0; i < 2; ++i) { int R, C; stage_rc(tid * 16 + i * 8192, R, C); const int Rb = Epi::PERM ? ((R & ~31) + perm32(R & 31)) : R;
        voffA[i] = (unsigned)(R * g.lda + C) * 2u; voffB[i] = (unsigned)(Rb * g.ldb + C) * 2u; }
    const size_t kstep = (size_t)(BK * 2);
    const unsigned hsA = (unsigned)HALF * g.lda * 2u, hsB = (unsigned)HALF * g.ldb * 2u;
    const unsigned ldsw = (unsigned)wid * 1024u;
    const int aoff = lds_byte(wr * 64 + fr, fq * 8), boff = lds_byte(wc * 32 + fr, fq * 8);
#define PG8_SA(b, h) (((b) * 2 + (h)) * HTB)
#define PG8_SB(b, h) ((4 + (b) * 2 + (h)) * HTB)
#define PG8_STAGE(bufoff, gbase, voff) do { _Pragma("unroll") for (int _i = 0; _i < 2; ++_i) \
        __builtin_amdgcn_global_load_lds((const unsigned*)((const char*)(gbase) + (voff)[_i]), (PG8_LAS unsigned*)(lds + (bufoff) + ldsw + _i * 8192), 16, 0, 0); } while (0)
#define PG8_LDA(dst, b, h) do { _Pragma("unroll") for (int m = 0; m < 4; ++m) _Pragma("unroll") for (int k = 0; k < 2; ++k) dst[m][k] = *(const PG8_LAS bf16x8*)(lds + PG8_SA(b, h) + aoff + m * 2048 + k * 1024); } while (0)
#define PG8_LDB(dst, b, h) do { _Pragma("unroll") for (int n = 0; n < 2; ++n) _Pragma("unroll") for (int k = 0; k < 2; ++k) dst[n][k] = *(const PG8_LAS bf16x8*)(lds + PG8_SB(b, h) + boff + n * 2048 + k * 1024); } while (0)
#define PG8_MMA(ai, bj, At, Bt) do { __builtin_amdgcn_s_setprio(1); _Pragma("unroll") for (int m = 0; m < 4; ++m) _Pragma("unroll") for (int n = 0; n < 2; ++n) _Pragma("unroll") for (int k = 0; k < 2; ++k) \
        asm volatile("v_mfma_f32_16x16x32_bf16 %0, %1, %2, %0" : "+v"(acc[ai][bj][m][n]) : "v"(Bt[n][k]), "v"(At[m][k])); __builtin_amdgcn_s_setprio(0); } while (0)
#define PG8_WAIT_V(n) asm volatile("s_waitcnt vmcnt(" #n ")" ::: "memory")
#define PG8_WAIT_L(n) asm volatile("s_waitcnt lgkmcnt(" #n ")" ::: "memory")
#define PG8_BAR __builtin_amdgcn_s_barrier()
#define PG8_SCHED __builtin_amdgcn_sched_barrier(0)
    Unit cur, nxt; int ui = 0;
    if (!S.next(0, cur)) return;
    f32x4 acc[2][2][4][2];
#pragma unroll
    for (int a = 0; a < 2; ++a)
#pragma unroll
        for (int b = 0; b < 2; ++b)
#pragma unroll
            for (int m = 0; m < 4; ++m)
#pragma unroll
                for (int n = 0; n < 2; ++n) acc[a][b][m][n] = (f32x4){0.f, 0.f, 0.f, 0.f};
    bf16x8 At[4][2], B0[2][2], B1[2][2];
    const char* cA = gA + cur.offA; const char* cB = gB + cur.offB;
    S.a_ready(cur);
    if constexpr (SP2) {
        PG8_STAGE(PG8_SB(0, 0), cB, voffB); PG8_STAGE(PG8_SB(0, 1), cB + hsB, voffB); PG8_STAGE(PG8_SA(0, 0), cA, voffA); PG8_STAGE(PG8_SA(0, 1), cA + hsA, voffA);
        if (wr == 1) PG8_BAR;
        PG8_WAIT_V(2); PG8_BAR;
        PG8_STAGE(PG8_SB(1, 0), cB + kstep, voffB); PG8_STAGE(PG8_SA(1, 0), cA + kstep, voffA); PG8_STAGE(PG8_SB(1, 1), cB + hsB + kstep, voffB);
        PG8_WAIT_V(6); PG8_BAR;
    } else {
        PG8_STAGE(PG8_SB(0, 0), cB, voffB); PG8_STAGE(PG8_SA(0, 0), cA, voffA); PG8_STAGE(PG8_SB(0, 1), cB + hsB, voffB); PG8_STAGE(PG8_SA(0, 1), cA + hsA, voffA);
        if (wr == 1) PG8_BAR;
        PG8_WAIT_V(4); PG8_BAR;
        PG8_STAGE(PG8_SB(1, 0), cB + kstep, voffB); PG8_STAGE(PG8_SA(1, 0), cA + kstep, voffA); PG8_STAGE(PG8_SB(1, 1), cB + hsB + kstep, voffB);
        PG8_WAIT_V(6); PG8_BAR;
    }
    for (;;) {
        const bool has_next = S.next(ui + 1, nxt);
        const char* nA = has_next ? gA + nxt.offA : cA; const char* nB = has_next ? gB + nxt.offB : cB;
        for (int t = 0; t < nt; t += 2) {
            const bool last = (t == nt - 2);
            const char* a1 = cA + (size_t)(t + 1) * kstep;
            const char* a2 = last ? nA : cA + (size_t)(t + 2) * kstep; const char* b2 = last ? nB : cB + (size_t)(t + 2) * kstep;
            const char* a3 = a2 + kstep; const char* b3 = b2 + kstep;
            if (last && has_next) S.a_ready(nxt);
            if constexpr (SP2) {
            PG8_LDB(B0, 0, 0); PG8_LDB(B1, 0, 1); PG8_SCHED; PG8_LDA(At, 0, 0); PG8_STAGE(PG8_SA(1, 1), a1 + hsA, voffA);
            PG8_WAIT_V(8); PG8_WAIT_L(0); PG8_BAR; PG8_MMA(0, 0, At, B0); PG8_MMA(0, 1, At, B1); PG8_BAR; PG8_SCHED;
            PG8_LDA(At, 0, 1); PG8_STAGE(PG8_SB(0, 0), b2, voffB); PG8_STAGE(PG8_SB(0, 1), b2 + hsB, voffB); PG8_STAGE(PG8_SA(0, 0), a2, voffA);
            PG8_WAIT_V(8); PG8_WAIT_L(0); PG8_BAR; PG8_MMA(1, 0, At, B0); PG8_MMA(1, 1, At, B1); PG8_BAR; PG8_SCHED;
            PG8_LDB(B0, 1, 0); PG8_LDB(B1, 1, 1); PG8_SCHED; PG8_LDA(At, 1, 0); PG8_STAGE(PG8_SA(0, 1), a2 + hsA, voffA);
            PG8_WAIT_V(8); PG8_WAIT_L(0); PG8_BAR; PG8_MMA(0, 0, At, B0); PG8_MMA(0, 1, At, B1); PG8_BAR; PG8_SCHED;
            PG8_LDA(At, 1, 1); PG8_STAGE(PG8_SB(1, 0), b3, voffB); PG8_STAGE(PG8_SB(1, 1), b3 + hsB, voffB); PG8_STAGE(PG8_SA(1, 0), a3, voffA);
            PG8_WAIT_V(8); PG8_WAIT_L(0); PG8_BAR; PG8_MMA(1, 0, At, B0); PG8_MMA(1, 1, At, B1); PG8_BAR; PG8_SCHED;
            } else {
            PG8_LDB(B0, 0, 0); PG8_SCHED; PG8_LDA(At, 0, 0); PG8_STAGE(PG8_SA(1, 1), a1 + hsA, voffA);
            PG8_WAIT_L(8); PG8_BAR; PG8_WAIT_L(0); PG8_MMA(0, 0, At, B0); PG8_BAR; PG8_SCHED;
            PG8_LDB(B1, 0, 1); PG8_STAGE(PG8_SB(0, 0), b2, voffB);
            PG8_BAR; PG8_WAIT_L(0); PG8_MMA(0, 1, At, B1); PG8_BAR;
            PG8_LDA(At, 0, 1); PG8_STAGE(PG8_SA(0, 0), a2, voffA);
            PG8_BAR; PG8_WAIT_L(0); PG8_MMA(1, 0, At, B0); PG8_BAR; PG8_SCHED;
            PG8_STAGE(PG8_SB(0, 1), b2 + hsB, voffB);
            PG8_WAIT_V(6); PG8_BAR; PG8_MMA(1, 1, At, B1); PG8_BAR;
            PG8_LDB(B0, 1, 0); PG8_SCHED; PG8_LDA(At, 1, 0); PG8_STAGE(PG8_SA(0, 1), a2 + hsA, voffA);
            PG8_WAIT_L(8); PG8_BAR; PG8_WAIT_L(0); PG8_MMA(0, 0, At, B0); PG8_BAR; PG8_SCHED;
            PG8_LDB(B1, 1, 1); PG8_STAGE(PG8_SB(1, 0), b3, voffB);
            PG8_BAR; PG8_WAIT_L(0); PG8_MMA(0, 1, At, B1); PG8_BAR;
            PG8_LDA(At, 1, 1); PG8_STAGE(PG8_SA(1, 0), a3, voffA);
            PG8_BAR; PG8_WAIT_L(0); PG8_MMA(1, 0, At, B0); PG8_BAR; PG8_SCHED;
            PG8_STAGE(PG8_SB(1, 1), b3 + hsB, voffB);
            PG8_WAIT_V(6); PG8_BAR; PG8_MMA(1, 1, At, B1); PG8_BAR;
            }
        }
        if constexpr (ALIGN_EPI) { if (wr == 0) PG8_BAR; }
        asm volatile("s_nop 15\n\ts_nop 15" ::: "memory");
        if constexpr (Epi::MULTI) { E.step(acc, cur, wr, wc, fr, fq); S.done(cur); }
        else if constexpr (!Epi::AFTER_DRAIN) { E(acc, cur, wr, wc, fr, fq);
#if defined(EPI_TWICE)
            if constexpr (Epi::PERM) { asm volatile("" ::: "memory"); E(acc, cur, wr, wc, fr, fq); }
#endif
            S.done(cur); }
        if (!has_next) break;
        if (!Epi::MULTI || cur.sub == 2) {
#pragma unroll
        for (int a = 0; a < 2; ++a)
#pragma unroll
            for (int b = 0; b < 2; ++b)
#pragma unroll
                for (int m = 0; m < 4; ++m)
#pragma unroll
                    for (int n = 0; n < 2; ++n) acc[a][b][m][n] = (f32x4){0.f, 0.f, 0.f, 0.f}; }
        cur = nxt; cA = nA; cB = nB; ++ui;
        if constexpr (ALIGN_EPI) { if (wr == 1) PG8_BAR; }
    }
    PG8_WAIT_V(0);
    if constexpr (!ALIGN_EPI) { if (wr == 0) PG8_BAR; }
    PG8_BAR;
    if constexpr (Epi::AFTER_DRAIN) { E.fused(acc, cur, wr, wc, fr, fq, lds, wid, lane); S.done(cur); }
#undef PG8_SA
#undef PG8_SB
#undef PG8_STAGE
#undef PG8_LDA
#undef PG8_LDB
#undef PG8_MMA
#undef PG8_WAIT_V
#undef PG8_WAIT_L
#undef PG8_BAR
#undef PG8_SCHED
}
}

#include <hip/hip_bf16.h>
#include <cmath>
namespace attn_body {
using bf16=__hip_bfloat16;
using bf16x8=__attribute__((ext_vector_type(8)))short;
using s16x4=__attribute__((ext_vector_type(4)))short;
using f32x16=__attribute__((ext_vector_type(16)))float;
using u32x4=__attribute__((ext_vector_type(4)))unsigned;
constexpr int BATCH=8,NHEAD=16,SEQ=2048,D=64,DM=NHEAD*D;
constexpr int NW=8,QBLK=32,QB=QBLK*NW,KVBLK=64,NQB=SEQ/QB;
constexpr int ATTN_PITCH=DM, ATTN_UNIT_ROWS=QB;
__device__ __forceinline__ int crow(int r,int hi){return (r&3)+8*(r>>2)+4*hi;}
#define SBAR() __builtin_amdgcn_sched_barrier(0)
__device__ __forceinline__ void cmask(f32x16&p0,f32x16&p1,int jb,int qrel,int hi){
  const float NEG=-INFINITY; int kb=64*jb+4*hi;
  #pragma unroll
  for(int r=0;r<16;++r){int kv=kb+(r&3)+8*(r>>2); if(kv>qrel)p0[r]=NEG; if(kv+32>qrel)p1[r]=NEG;}
}

constexpr int NSLOT=3, SLOTB=8192;
constexpr int LDS_K=0, LDS_V=NSLOT*SLOTB, LDS_WS=2*NSLOT*SLOTB, LDS_OST=LDS_WS+NW*64*4, LDS_BYTES=LDS_OST+NW*4096;
constexpr float C2=0.125f*1.4426950408889634f;
__device__ __forceinline__ void glds16(const void*gsrc,unsigned lds_dst){unsigned keep;
  asm volatile("s_mov_b32 %0, m0\n\ts_mov_b32 m0, %2\n\ts_nop 0\n\tglobal_load_lds_dwordx4 %1, off\n\ts_mov_b32 m0, %0":"=&s"(keep):"v"(gsrc),"s"(lds_dst):"memory");}
__device__ __forceinline__ float max3f(float a,float b,float c){float r;asm("v_max3_f32 %0, %1, %2, %3":"=v"(r):"v"(a),"v"(b),"v"(c));return r;}
__device__ __forceinline__ float max2f(float a,float b){float r;asm("v_max_f32_e32 %0, %1, %2":"=v"(r):"v"(a),"v"(b));return r;}
__device__ __forceinline__ float fadd_s(float a,float b){float r;asm("v_add_f32_e32 %0, %1, %2":"=v"(r):"v"(a),"v"(b));return r;}
__device__ __forceinline__ float fsub_s(float a,float b){float r;asm("v_sub_f32_e32 %0, %1, %2":"=v"(r):"v"(a),"v"(b));return r;}
typedef float f32x2_t __attribute__((ext_vector_type(2))); typedef __bf16 bf16x2_t __attribute__((ext_vector_type(2)));
__device__ __forceinline__ unsigned cvtpk_s(float lo,float hi){f32x2_t v={lo,hi};bf16x2_t b=__builtin_convertvector(v,bf16x2_t);return __builtin_bit_cast(unsigned,b);}
#define WAIT_BAR(N) asm volatile("s_waitcnt vmcnt(" #N ") lgkmcnt(0)\n\ts_barrier":::"memory")

__device__ __forceinline__ void qkt(f32x16&p0,f32x16&p1,const char*Kslot,const bf16x8*qr,const f32x16&negm,int r32,int hi){
  const char*kb=Kslot+hi*1024+r32*16;
  #pragma unroll
  for(int d0=0;d0<4;++d0){
    const bf16x8 b0=*reinterpret_cast<const bf16x8*>(kb+d0*2048);
    const bf16x8 b1=*reinterpret_cast<const bf16x8*>(kb+d0*2048+512);
    if(d0==0){p0=__builtin_amdgcn_mfma_f32_32x32x16_bf16(b0,qr[0],negm,0,0,0);p1=__builtin_amdgcn_mfma_f32_32x32x16_bf16(b1,qr[0],negm,0,0,0);}
    else{p0=__builtin_amdgcn_mfma_f32_32x32x16_bf16(b0,qr[d0],p0,0,0,0);p1=__builtin_amdgcn_mfma_f32_32x32x16_bf16(b1,qr[d0],p1,0,0,0);}}
}
typedef __attribute__((address_space(3))) const char* lds_cptr;
typedef short v4i16_t __attribute__((ext_vector_type(4)));
__device__ __forceinline__ void kload8(bf16x8*kf,lds_cptr kp){
  kf[0]=*(const __attribute__((address_space(3))) bf16x8*)(kp);      kf[1]=*(const __attribute__((address_space(3))) bf16x8*)(kp+512);
  kf[2]=*(const __attribute__((address_space(3))) bf16x8*)(kp+2048); kf[3]=*(const __attribute__((address_space(3))) bf16x8*)(kp+2560);
  kf[4]=*(const __attribute__((address_space(3))) bf16x8*)(kp+4096); kf[5]=*(const __attribute__((address_space(3))) bf16x8*)(kp+4608);
  kf[6]=*(const __attribute__((address_space(3))) bf16x8*)(kp+6144); kf[7]=*(const __attribute__((address_space(3))) bf16x8*)(kp+6656);
}
__device__ __forceinline__ void kload2(bf16x8*kf,lds_cptr kp,int j){ kf[2*j]=*(const __attribute__((address_space(3))) bf16x8*)(kp+j*2048); kf[2*j+1]=*(const __attribute__((address_space(3))) bf16x8*)(kp+j*2048+512); }
__device__ __forceinline__ s16x4 vtr(lds_cptr p){ return __builtin_bit_cast(s16x4,__builtin_amdgcn_ds_read_tr16_b64_v4i16((__attribute__((address_space(3))) v4i16_t*)p)); }
__device__ __forceinline__ float rowmax(const f32x16&p0,const f32x16&p1){
  float a=max3f(p0[0],p0[1],p1[0]),b=max3f(p0[2],p0[3],p1[1]);a=max3f(a,p1[2],p1[3]);
  #pragma unroll
  for(int r=4;r<16;r+=4){a=max3f(a,p0[r],p0[r+1]);b=max3f(b,p0[r+2],p0[r+3]);a=max3f(a,p1[r],p1[r+1]);b=max3f(b,p1[r+2],p1[r+3]);}
  const float m=max2f(a,b);
  auto rr=__builtin_amdgcn_permlane32_swap(__float_as_uint(m),__float_as_uint(m),false,false);
  return max2f(__uint_as_float(rr[0]),__uint_as_float(rr[1]));
}
__device__ __forceinline__ void pv(f32x16*o,int vb,bf16x8 pa0,bf16x8 pa1,bf16x8 pa2,bf16x8 pa3){
  #pragma unroll
  for(int d0=0;d0<2;++d0){s16x4 lo[4],hi[4];
    #pragma unroll
    for(int ks=0;ks<4;++ks){
      asm volatile("ds_read_b64_tr_b16 %0,%1 offset:%c2":"=&v"(lo[ks]):"v"(vb),"i"(d0*4096+ks*1024):"memory");
      asm volatile("ds_read_b64_tr_b16 %0,%1 offset:%c2":"=&v"(hi[ks]):"v"(vb),"i"(d0*4096+ks*1024+512):"memory");}
    asm volatile("s_waitcnt lgkmcnt(0)":::"memory");SBAR();
    #define PK(k) (bf16x8){lo[k][0],lo[k][1],lo[k][2],lo[k][3],hi[k][0],hi[k][1],hi[k][2],hi[k][3]}
    o[d0]=__builtin_amdgcn_mfma_f32_32x32x16_bf16(pa0,PK(0),o[d0],0,0,0);
    o[d0]=__builtin_amdgcn_mfma_f32_32x32x16_bf16(pa1,PK(1),o[d0],0,0,0);
    o[d0]=__builtin_amdgcn_mfma_f32_32x32x16_bf16(pa2,PK(2),o[d0],0,0,0);
    o[d0]=__builtin_amdgcn_mfma_f32_32x32x16_bf16(pa3,PK(3),o[d0],0,0,0);
    #undef PK
  }
}

#ifndef ATTN_STORE16
#define ATTN_STORE16(p,v) (*(u32x4*)(p)=(v))
#endif
template<int THRL> __device__ __forceinline__ void attn_unit(int wave_sg,int b,int h,int hv,int qb,const bf16*Q,const bf16*__restrict__ K,const bf16*__restrict__ V,bf16*O,char*shm){
  int tid_=pg8::opq(wave_sg)*64+pg8::lane_id(); asm volatile("":"+v"(tid_)); const int tid=tid_,lane=tid&63,r32=lane&31,hi=lane>>5; const int wid=__builtin_amdgcn_readfirstlane(tid>>6);
  const long rowbase=(long)b*SEQ; const int q0=qb*QB;
  const bf16*Qw=Q+(rowbase+q0+wid*QBLK)*DM+h*D;
  const bf16*Kh=K+rowbase*DM+h*D,*Vh=V+rowbase*DM+hv*D;
  const unsigned lds0=(unsigned)(uintptr_t)shm;
  float*wsf=(float*)(shm+LDS_WS)+wid*64;
  const bf16*ksrc=Kh+(long)lane*DM+wid*8;
  const bf16*vsrc=Vh+(long)(16*(wid&3)+(lane>>2))*DM+(wid>>2)*32+(lane&3)*8;
  const unsigned kdst=lds0+LDS_K+wid*1024, vdst=lds0+LDS_V+wid*1024;
  #define DMA_K(t,slot) glds16(ksrc+(long)(t)*KVBLK*DM,(unsigned)__builtin_amdgcn_readfirstlane(kdst+(slot)))
  #define DMA_V(t,slot) glds16(vsrc+(long)(t)*KVBLK*DM,(unsigned)__builtin_amdgcn_readfirstlane(vdst+(slot)))
  const int vb0=(int)(lds0+LDS_V)+((lane>>4)&1)*32+(lane&3)*8+(4*hi+((lane&15)>>2))*64;
  const char*Kbase=shm+LDS_K; bf16x8 kf[8];
  const lds_cptr shm3=(lds_cptr)shm; const lds_cptr kp0=shm3+LDS_K+hi*1024+r32*16; const lds_cptr vp0=shm3+LDS_V+((lane>>4)&1)*32+(lane&3)*8+(4*hi+((lane&15)>>2))*64;
  const int NT=(q0+QB)/KVBLK;
  DMA_K(0,0);DMA_V(0,0);DMA_K(1,SLOTB);
  bf16x8 qr[4];
  #pragma unroll
  for(int d0=0;d0<4;++d0)qr[d0]=*reinterpret_cast<const bf16x8*>(&Qw[(long)r32*DM+d0*16+hi*8]);
  float mhat=0.f,l_reg=0.f;f32x16 o[2];o[0]=f32x16{};o[1]=f32x16{};f32x16 negm=f32x16{};asm volatile("":"+v"(negm));
  const int qrel=wid*QBLK+r32;
  #define CMASK(P0,P1,t) do{int jb_=(t)-(NT-4); if(jb_>=0)cmask(P0,P1,jb_,qrel,hi);}while(0)
  bool resc=false;
  #define START(P0,P1) do{ const float rm=rowmax(P0,P1); resc=false; \
    { const float dl=rm; mhat=fadd_s(mhat,dl); \
      _Pragma("unroll") for(int r=0;r<16;++r){P0[r]=fsub_s(P0[r],dl);P1[r]=fsub_s(P1[r],dl);} \
      _Pragma("unroll") for(int r=0;r<16;++r)negm[r]=-mhat; asm volatile("":"+v"(negm)); } \
    _Pragma("unroll") for(int r=0;r<16;++r)P0[r]=__builtin_amdgcn_exp2f(P0[r]); }while(0)
  #define RESC() do{ if(resc){ asm volatile("s_waitcnt lgkmcnt(0)":::"memory"); \
      _Pragma("unroll") for(int d_=0;d_<2;++d_) _Pragma("unroll") for(int r=0;r<16;++r)o[d_][r]*=wsf[crow(r,hi)]; } }while(0)
  f32x16 pA0,pA1,pB0,pB1;
  int sl_prev=0,sl_cur=0,sl_next=SLOTB;
  #define ROT() do{sl_prev=sl_cur;sl_cur=sl_next;sl_next=(sl_next==(NSLOT-1)*SLOTB)?0:sl_next+SLOTB;}while(0)
  DMA_K(2,2*SLOTB);
  WAIT_BAR(3);
  qkt(pA0,pA1,Kbase,qr,negm,r32,hi);asm volatile("s_nop 15\n\ts_nop 7":"+v"(pA0),"+v"(pA1));CMASK(pA0,pA1,0);
  START(pA0,pA1);
  _Pragma("unroll") for(int r=0;r<16;++r)pA1[r]=__builtin_amdgcn_exp2f(pA1[r]);
  WAIT_BAR(0);
  DMA_K(3,0);DMA_V(1,SLOTB);
  ROT();
  kload8(kf,kp0+sl_cur);
  WAIT_BAR(2);
  s16x4 vlo[8],vhi[8]; u32x4 pw0,pw1,pw2,pw3;
  #define PKW(P,B) cvtpk_s(P[B],P[B+1])
  #define PAF(k) __builtin_bit_cast(bf16x8,pw##k)
  #define VFR(i) (bf16x8){vlo[i][0],vlo[i][1],vlo[i][2],vlo[i][3],vhi[i][0],vhi[i][1],vhi[i][2],vhi[i][3]}
  #define PIN(x) asm volatile("":"+v"(x))
  #define MX3(a,b,c) __builtin_fmaxf(__builtin_fmaxf((a),(b)),(c))
  #define GAPA(MF,A0,A1,A2,A3,W0,W1,PW) do{ MF; sacc+=A0; sacc+=A1; sacc+=A2; sacc+=A3; PIN(sacc); W0; W1; PIN(PW); SBAR(); }while(0)
  #define EX(v) __builtin_amdgcn_exp2f(v)
  #define GAPB(MF,X,B) do{ MF; X[B]=EX(X[B]); X[B+1]=EX(X[B+1]); X[B+2]=EX(X[B+2]); X[B+3]=EX(X[B+3]); PIN(X); SBAR(); }while(0)
  #define VRD(i) do{ vlo[i]=vtr(vp_+(((i)>>2)*4096+((i)&3)*1024)); vhi[i]=vtr(vp_+(((i)>>2)*4096+((i)&3)*1024+512)); }while(0)
  #define KRD(G,j) do{ if(G){ kload2(kf,kp0+sl_next,j); SBAR(); } }while(0)
  #define STEP(C0,C1,P0,P1,t,GK,GV,GL) do{ SBAR(); \
    const lds_cptr vp_=vp0+sl_prev; \
    VRD(0); SBAR(); float sacc=(P0[0]+P0[1]); \
    GAPA(C0=__builtin_amdgcn_mfma_f32_32x32x16_bf16(kf[0],qr[0],negm,0,0,0), P0[2],P0[3],P0[4],P0[5],     pw0[0]=PKW(P0,0), pw0[1]=PKW(P0,2), pw0); \
    VRD(4); SBAR(); GAPA(C1=__builtin_amdgcn_mfma_f32_32x32x16_bf16(kf[1],qr[0],negm,0,0,0), P0[6],P0[7],P0[8],P0[9],     pw0[2]=PKW(P0,4), pw0[3]=PKW(P0,6), pw0); \
    VRD(1); SBAR(); GAPA(C0=__builtin_amdgcn_mfma_f32_32x32x16_bf16(kf[2],qr[1],C0,0,0,0),   P0[10],P0[11],P0[12],P0[13], pw1[0]=PKW(P0,8), pw1[1]=PKW(P0,10), pw1); \
    VRD(5); SBAR(); GAPA(C1=__builtin_amdgcn_mfma_f32_32x32x16_bf16(kf[3],qr[1],C1,0,0,0),   P0[14],P0[15],P1[0],P1[1],   pw1[2]=PKW(P0,12),pw1[3]=PKW(P0,14), pw1); \
    VRD(2); SBAR(); GAPA(C0=__builtin_amdgcn_mfma_f32_32x32x16_bf16(kf[4],qr[2],C0,0,0,0),   P1[2],P1[3],P1[4],P1[5],     pw2[0]=PKW(P1,0), pw2[1]=PKW(P1,2), pw2); \
    VRD(6); SBAR(); GAPA(C1=__builtin_amdgcn_mfma_f32_32x32x16_bf16(kf[5],qr[2],C1,0,0,0),   P1[6],P1[7],P1[8],P1[9],     pw2[2]=PKW(P1,4), pw2[3]=PKW(P1,6), pw2); \
    VRD(3); SBAR(); GAPA(C0=__builtin_amdgcn_mfma_f32_32x32x16_bf16(kf[6],qr[3],C0,0,0,0),   P1[10],P1[11],P1[12],P1[13], pw3[0]=PKW(P1,8), pw3[1]=PKW(P1,10), pw3); \
    VRD(7); SBAR(); GAPA(C1=__builtin_amdgcn_mfma_f32_32x32x16_bf16(kf[7],qr[3],C1,0,0,0),   P1[14],P1[15],0.f,0.f,       pw3[2]=PKW(P1,12),pw3[3]=PKW(P1,14), pw3); \
    l_reg+=sacc; \
    if(GK){DMA_K((t)+3,sl_cur);} if(GV){DMA_V((t)+1,sl_next);} \
    CMASK(C0,C1,t); \
    { float a=MX3(C0[0],C0[1],C1[0]),b=MX3(C0[2],C0[3],C1[1]); a=MX3(a,C1[2],C1[3]); \
      _Pragma("unroll") for(int r=4;r<16;r+=4){a=MX3(a,C0[r],C0[r+1]);b=MX3(b,C0[r+2],C0[r+3]);a=MX3(a,C1[r],C1[r+1]);b=MX3(b,C1[r+2],C1[r+3]);} \
      float rm=__builtin_fmaxf(a,b); { auto rr=__builtin_amdgcn_permlane32_swap(__float_as_uint(rm),__float_as_uint(rm),false,false); rm=__builtin_fmaxf(__uint_as_float(rr[0]),__uint_as_float(rr[1])); } \
      resc=false; \
      if(__builtin_expect(__any(rm>(float)THRL),0)){ const float dl=__builtin_fmaxf(rm,0.f); mhat+=dl; \
        _Pragma("unroll") for(int r=0;r<16;++r){C0[r]-=dl;C1[r]-=dl;} \
        _Pragma("unroll") for(int r=0;r<16;++r)negm[r]=-mhat; asm volatile("":"+v"(negm)); \
        const float f=__builtin_amdgcn_exp2f(-dl); l_reg*=f; if(hi==0)wsf[r32]=f; resc=true; } } \
    SBAR(); \
    GAPB(o[0]=__builtin_amdgcn_mfma_f32_32x32x16_bf16(PAF(0),VFR(0),o[0],0,0,0), C0,0); \
    GAPB(o[1]=__builtin_amdgcn_mfma_f32_32x32x16_bf16(PAF(0),VFR(4),o[1],0,0,0), C0,4); \
    KRD(GL,0); GAPB(o[0]=__builtin_amdgcn_mfma_f32_32x32x16_bf16(PAF(1),VFR(1),o[0],0,0,0), C0,8); \
    KRD(GL,1); GAPB(o[1]=__builtin_amdgcn_mfma_f32_32x32x16_bf16(PAF(1),VFR(5),o[1],0,0,0), C0,12); \
    KRD(GL,2); GAPB(o[0]=__builtin_amdgcn_mfma_f32_32x32x16_bf16(PAF(2),VFR(2),o[0],0,0,0), C1,0); \
    KRD(GL,3); GAPB(o[1]=__builtin_amdgcn_mfma_f32_32x32x16_bf16(PAF(2),VFR(6),o[1],0,0,0), C1,4); \
    GAPB(o[0]=__builtin_amdgcn_mfma_f32_32x32x16_bf16(PAF(3),VFR(3),o[0],0,0,0), C1,8); \
    GAPB(o[1]=__builtin_amdgcn_mfma_f32_32x32x16_bf16(PAF(3),VFR(7),o[1],0,0,0), C1,12); \
    }while(0)
  int t=1;
  #undef CMASK
  #define CMASK(P0,P1,t) do{}while(0)
  for(;t+5<NT;t+=2){
    STEP(pB0,pB1,pA0,pA1,t,true,true,true);     WAIT_BAR(2); RESC(); ROT();
    STEP(pA0,pA1,pB0,pB1,t+1,true,true,true);   WAIT_BAR(2); RESC(); ROT();
  }
  #undef CMASK
  #define CMASK(P0,P1,t) do{int jb_=(t)-(NT-4); if(jb_>=0)cmask(P0,P1,jb_,qrel,hi);}while(0)
  #define ENDW(tt) do{ if((tt)+3<NT){WAIT_BAR(2);} else if((tt)+2<NT){WAIT_BAR(1);} else {WAIT_BAR(0);} }while(0)
  for(;t+1<NT;t+=2){
    STEP(pB0,pB1,pA0,pA1,t,(t+3<NT),(t+1<NT),(t+1<NT));       ENDW(t);   RESC(); ROT();
    STEP(pA0,pA1,pB0,pB1,t+1,(t+4<NT),(t+2<NT),(t+2<NT));     ENDW(t+1); RESC(); ROT();
  }
  STEP(pB0,pB1,pA0,pA1,NT-1,false,false,false); RESC();
  { float sacc=pB0[0]+pB0[1]; _Pragma("unroll") for(int r=2;r<16;++r)sacc+=pB0[r]; _Pragma("unroll") for(int r=0;r<16;++r)sacc+=pB1[r]; l_reg+=sacc;
    pw0=(u32x4){PKW(pB0,0),PKW(pB0,2),PKW(pB0,4),PKW(pB0,6)};pw1=(u32x4){PKW(pB0,8),PKW(pB0,10),PKW(pB0,12),PKW(pB0,14)};pw2=(u32x4){PKW(pB1,0),PKW(pB1,2),PKW(pB1,4),PKW(pB1,6)};pw3=(u32x4){PKW(pB1,8),PKW(pB1,10),PKW(pB1,12),PKW(pB1,14)};
    SBAR(); pv(o,vb0+sl_cur,PAF(0),PAF(1),PAF(2),PAF(3)); }
  #undef PKW
  #undef PAF
  #undef VFR
  #undef PIN
  #undef MX3
  #undef GAPA
  #undef GAPB
  #undef EX
  #undef VRD
  #undef KRD
  #undef STEP
  #undef ENDW
  {auto rr=__builtin_amdgcn_permlane32_swap(__float_as_uint(l_reg),__float_as_uint(l_reg),false,false);l_reg=__uint_as_float(rr[0])+__uint_as_float(rr[1]);}
  if(hi==0)wsf[32+r32]=l_reg;asm volatile("s_waitcnt lgkmcnt(0)":::"memory");
  float rli[16];
  #pragma unroll
  for(int r=0;r<16;++r)rli[r]=__builtin_amdgcn_rcpf(wsf[32+crow(r,hi)]);
  bf16*Ow=O+(rowbase+q0+wid*QBLK)*DM+hv*D;
  { bf16*stg=(bf16*)(shm+LDS_OST)+wid*2048;
    #pragma unroll
    for(int r=0;r<16;++r){const int orow=crow(r,hi);
      #pragma unroll
      for(int d0=0;d0<2;++d0)stg[orow*64+d0*32+r32]=__float2bfloat16(o[d0][r]*rli[r]);}
    asm volatile("s_waitcnt lgkmcnt(0)":::"memory");
    #pragma unroll
    for(int i=0;i<4;++i){const int row=i*8+(lane>>3),ch=lane&7; const u32x4 v=*(const u32x4*)(stg+row*64+ch*8); ATTN_STORE16(Ow+(long)row*DM+ch*8,v);} }
  asm volatile("s_waitcnt lgkmcnt(0)\n\ts_barrier":::"memory");
  #undef DMA_K
  #undef DMA_V
  #undef CMASK
  #undef START
  #undef RESC
  #undef ROT
}
constexpr int VSLOTB=16384, LW_K=0, LW_V=NSLOT*SLOTB, LW_WS=LW_V+NSLOT*VSLOTB, LW_BYTES=LW_WS+NW*64*4;
static_assert(NW*8192<=LW_WS,"O stage overlays the K/V rings");
__device__ __forceinline__ void pv4(f32x16*o,int vb,bf16x8 pa0,bf16x8 pa1,bf16x8 pa2,bf16x8 pa3){
  #pragma unroll
  for(int d0=0;d0<4;++d0){s16x4 lo[4],hi[4];
    #pragma unroll
    for(int ks=0;ks<4;++ks){
      asm volatile("ds_read_b64_tr_b16 %0,%1 offset:%c2":"=&v"(lo[ks]):"v"(vb),"i"(d0*4096+ks*1024):"memory");
      asm volatile("ds_read_b64_tr_b16 %0,%1 offset:%c2":"=&v"(hi[ks]):"v"(vb),"i"(d0*4096+ks*1024+512):"memory");}
    asm volatile("s_waitcnt lgkmcnt(0)":::"memory");SBAR();
    #define PK(k) (bf16x8){lo[k][0],lo[k][1],lo[k][2],lo[k][3],hi[k][0],hi[k][1],hi[k][2],hi[k][3]}
    o[d0]=__builtin_amdgcn_mfma_f32_32x32x16_bf16(pa0,PK(0),o[d0],0,0,0);
    o[d0]=__builtin_amdgcn_mfma_f32_32x32x16_bf16(pa1,PK(1),o[d0],0,0,0);
    o[d0]=__builtin_amdgcn_mfma_f32_32x32x16_bf16(pa2,PK(2),o[d0],0,0,0);
    o[d0]=__builtin_amdgcn_mfma_f32_32x32x16_bf16(pa3,PK(3),o[d0],0,0,0);
    #undef PK
  }
}
__device__ __forceinline__ void attn_unit_w(int wave_sg,int b,int h8,int m,int qb,const bf16*Q,const bf16*__restrict__ K,const bf16*__restrict__ V,bf16*O,char*shm,bf16*YAo,const float*fz){
  int tid_=pg8::opq(wave_sg)*64+pg8::lane_id(); asm volatile("":"+v"(tid_)); const int tid=tid_,lane=tid&63,r32=lane&31,hi=lane>>5; const int wid=__builtin_amdgcn_readfirstlane(tid>>6);
  const long rowbase=(long)b*SEQ; const int q0=qb*QB; const int hq=2*h8+m;
  const bf16*Qw=Q+(rowbase+q0+wid*QBLK)*DM+hq*D;
  const bf16*Kh=K+rowbase*DM+hq*D,*Vh=V+rowbase*DM+h8*128;
  const unsigned lds0=(unsigned)(uintptr_t)shm;
  float*wsf=(float*)(shm+LW_WS)+wid*64;
  const bf16*ksrc=Kh+(long)lane*DM+wid*8;
  const bf16*vsrcA=Vh+(long)(16*(wid&3)+(lane>>2))*DM+(wid>>2)*32+(lane&3)*8;
  const bf16*vsrcB=vsrcA+64;
  const unsigned kdst=lds0+LW_K+wid*1024, vdstA=lds0+LW_V+wid*1024, vdstB=vdstA+8192;
  #define DMA_K(t,slot) glds16(ksrc+(long)(t)*KVBLK*DM,(unsigned)__builtin_amdgcn_readfirstlane(kdst+(slot)))
  #define DMA_V(t,slot) do{ glds16(vsrcA+(long)(t)*KVBLK*DM,(unsigned)__builtin_amdgcn_readfirstlane(vdstA+2*(slot))); glds16(vsrcB+(long)(t)*KVBLK*DM,(unsigned)__builtin_amdgcn_readfirstlane(vdstB+2*(slot))); }while(0)
  const int vb0=(int)(lds0+LW_V)+((lane>>4)&1)*32+(lane&3)*8+(4*hi+((lane&15)>>2))*64;
  const char*Kbase=shm+LW_K; bf16x8 kf[8];
  const lds_cptr shm3=(lds_cptr)shm; const lds_cptr kp0=shm3+LW_K+hi*1024+r32*16; const lds_cptr vp0=shm3+LW_V+((lane>>4)&1)*32+(lane&3)*8+(4*hi+((lane&15)>>2))*64;
  const int NT=(q0+QB)/KVBLK;
  DMA_K(0,0);DMA_V(0,0);DMA_K(1,SLOTB);
  bf16x8 qr[4];
  #pragma unroll
  for(int d0=0;d0<4;++d0)qr[d0]=*reinterpret_cast<const bf16x8*>(&Qw[(long)r32*DM+d0*16+hi*8]);
  float l_reg=0.f;f32x16 o[4];o[0]=f32x16{};o[1]=f32x16{};o[2]=f32x16{};o[3]=f32x16{};
  const int qrel=wid*QBLK+r32;
  #define CMASK(P0,P1,t) do{int jb_=(t)-(NT-4); if(jb_>=0)cmask(P0,P1,jb_,qrel,hi);}while(0)
  f32x16 pA0,pA1,pB0,pB1;
  int sl_prev=0,sl_cur=0,sl_next=SLOTB;
  #define ROT() do{sl_prev=sl_cur;sl_cur=sl_next;sl_next=(sl_next==(NSLOT-1)*SLOTB)?0:sl_next+SLOTB;}while(0)
  DMA_K(2,2*SLOTB);
  WAIT_BAR(4);
  { const char*kb=Kbase+hi*1024+r32*16;
    #pragma unroll
    for(int d0=0;d0<4;++d0){
      const bf16x8 b0=*reinterpret_cast<const bf16x8*>(kb+d0*2048);
      const bf16x8 b1=*reinterpret_cast<const bf16x8*>(kb+d0*2048+512);
      if(d0==0){pA0=__builtin_amdgcn_mfma_f32_32x32x16_bf16(b0,qr[0],f32x16{},0,0,0);pA1=__builtin_amdgcn_mfma_f32_32x32x16_bf16(b1,qr[0],f32x16{},0,0,0);}
      else{pA0=__builtin_amdgcn_mfma_f32_32x32x16_bf16(b0,qr[d0],pA0,0,0,0);pA1=__builtin_amdgcn_mfma_f32_32x32x16_bf16(b1,qr[d0],pA1,0,0,0);}} }
  asm volatile("s_nop 15\n\ts_nop 7":"+v"(pA0),"+v"(pA1));CMASK(pA0,pA1,0);
  _Pragma("unroll") for(int r=0;r<16;++r){pA0[r]=__builtin_amdgcn_exp2f(pA0[r]);pA1[r]=__builtin_amdgcn_exp2f(pA1[r]);}
  WAIT_BAR(0);
  DMA_K(3,0);DMA_V(1,SLOTB);
  ROT();
  kload8(kf,kp0+sl_cur);
  WAIT_BAR(3);
  s16x4 vlo[8],vhi[8]; u32x4 pw0,pw1,pw2,pw3;
  #define PKW(P,B) cvtpk_s(P[B],P[B+1])
  #define PAF(k) __builtin_bit_cast(bf16x8,pw##k)
  #define VFR(i) (bf16x8){vlo[i][0],vlo[i][1],vlo[i][2],vlo[i][3],vhi[i][0],vhi[i][1],vhi[i][2],vhi[i][3]}
  #define PIN(x) asm volatile("":"+v"(x))
  #define GAPA(MF,A0,A1,A2,A3,W0,W1,PW) do{ MF; sacc+=A0; sacc+=A1; sacc+=A2; sacc+=A3; PIN(sacc); W0; W1; PIN(PW); SBAR(); }while(0)
  #define EX(v) __builtin_amdgcn_exp2f(v)
  #define GAPB(MF,X,B) do{ MF; X[B]=EX(X[B]); X[B+1]=EX(X[B+1]); PIN(X); SBAR(); }while(0)
  #define VRD(j,i) do{ vlo[j]=vtr(vp_+(((i)>>2)*4096+((i)&3)*1024)); vhi[j]=vtr(vp_+(((i)>>2)*4096+((i)&3)*1024+512)); }while(0)
  #define KRD(G,j) do{ if(G){ kload2(kf,kp0+sl_next,j); SBAR(); } }while(0)
  #define STEP(C0,C1,P0,P1,t,GK,GV,GL) do{ SBAR(); \
    const lds_cptr vp_=vp0+2*sl_prev; \
    VRD(0,0); SBAR(); float sacc=(P0[0]+P0[1]); \
    GAPA(C0=__builtin_amdgcn_mfma_f32_32x32x16_bf16(kf[0],qr[0],f32x16{},0,0,0), P0[2],P0[3],P0[4],P0[5],     pw0[0]=PKW(P0,0), pw0[1]=PKW(P0,2), pw0); \
    VRD(4,4); SBAR(); GAPA(C1=__builtin_amdgcn_mfma_f32_32x32x16_bf16(kf[1],qr[0],f32x16{},0,0,0), P0[6],P0[7],P0[8],P0[9],     pw0[2]=PKW(P0,4), pw0[3]=PKW(P0,6), pw0); \
    VRD(1,1); SBAR(); GAPA(C0=__builtin_amdgcn_mfma_f32_32x32x16_bf16(kf[2],qr[1],C0,0,0,0),   P0[10],P0[11],P0[12],P0[13], pw1[0]=PKW(P0,8), pw1[1]=PKW(P0,10), pw1); \
    VRD(5,5); SBAR(); GAPA(C1=__builtin_amdgcn_mfma_f32_32x32x16_bf16(kf[3],qr[1],C1,0,0,0),   P0[14],P0[15],P1[0],P1[1],   pw1[2]=PKW(P0,12),pw1[3]=PKW(P0,14), pw1); \
    VRD(2,2); SBAR(); GAPA(C0=__builtin_amdgcn_mfma_f32_32x32x16_bf16(kf[4],qr[2],C0,0,0,0),   P1[2],P1[3],P1[4],P1[5],     pw2[0]=PKW(P1,0), pw2[1]=PKW(P1,2), pw2); \
    VRD(6,6); SBAR(); GAPA(C1=__builtin_amdgcn_mfma_f32_32x32x16_bf16(kf[5],qr[2],C1,0,0,0),   P1[6],P1[7],P1[8],P1[9],     pw2[2]=PKW(P1,4), pw2[3]=PKW(P1,6), pw2); \
    VRD(3,3); SBAR(); GAPA(C0=__builtin_amdgcn_mfma_f32_32x32x16_bf16(kf[6],qr[3],C0,0,0,0),   P1[10],P1[11],P1[12],P1[13], pw3[0]=PKW(P1,8), pw3[1]=PKW(P1,10), pw3); \
    VRD(7,7); SBAR(); GAPA(C1=__builtin_amdgcn_mfma_f32_32x32x16_bf16(kf[7],qr[3],C1,0,0,0),   P1[14],P1[15],0.f,0.f,       pw3[2]=PKW(P1,12),pw3[3]=PKW(P1,14), pw3); \
    l_reg+=sacc; \
    if(GK){DMA_K((t)+3,sl_cur);} if(GV){DMA_V((t)+1,sl_next);} \
    CMASK(C0,C1,t); \
    SBAR(); \
    GAPB(o[0]=__builtin_amdgcn_mfma_f32_32x32x16_bf16(PAF(0),VFR(0),o[0],0,0,0), C0,0);  VRD(0,8);  SBAR(); \
    GAPB(o[1]=__builtin_amdgcn_mfma_f32_32x32x16_bf16(PAF(0),VFR(4),o[1],0,0,0), C0,2);  VRD(4,12); SBAR(); \
    KRD(GL,0); GAPB(o[0]=__builtin_amdgcn_mfma_f32_32x32x16_bf16(PAF(1),VFR(1),o[0],0,0,0), C0,4);  VRD(1,9);  SBAR(); \
    KRD(GL,1); GAPB(o[1]=__builtin_amdgcn_mfma_f32_32x32x16_bf16(PAF(1),VFR(5),o[1],0,0,0), C0,6);  VRD(5,13); SBAR(); \
    KRD(GL,2); GAPB(o[0]=__builtin_amdgcn_mfma_f32_32x32x16_bf16(PAF(2),VFR(2),o[0],0,0,0), C0,8);  VRD(2,10); SBAR(); \
    KRD(GL,3); GAPB(o[1]=__builtin_amdgcn_mfma_f32_32x32x16_bf16(PAF(2),VFR(6),o[1],0,0,0), C0,10); VRD(6,14); SBAR(); \
    GAPB(o[0]=__builtin_amdgcn_mfma_f32_32x32x16_bf16(PAF(3),VFR(3),o[0],0,0,0), C0,12); VRD(3,11); SBAR(); \
    GAPB(o[1]=__builtin_amdgcn_mfma_f32_32x32x16_bf16(PAF(3),VFR(7),o[1],0,0,0), C0,14); VRD(7,15); SBAR(); \
    GAPB(o[2]=__builtin_amdgcn_mfma_f32_32x32x16_bf16(PAF(0),VFR(0),o[2],0,0,0), C1,0); \
    GAPB(o[3]=__builtin_amdgcn_mfma_f32_32x32x16_bf16(PAF(0),VFR(4),o[3],0,0,0), C1,2); \
    GAPB(o[2]=__builtin_amdgcn_mfma_f32_32x32x16_bf16(PAF(1),VFR(1),o[2],0,0,0), C1,4); \
    GAPB(o[3]=__builtin_amdgcn_mfma_f32_32x32x16_bf16(PAF(1),VFR(5),o[3],0,0,0), C1,6); \
    GAPB(o[2]=__builtin_amdgcn_mfma_f32_32x32x16_bf16(PAF(2),VFR(2),o[2],0,0,0), C1,8); \
    GAPB(o[3]=__builtin_amdgcn_mfma_f32_32x32x16_bf16(PAF(2),VFR(6),o[3],0,0,0), C1,10); \
    GAPB(o[2]=__builtin_amdgcn_mfma_f32_32x32x16_bf16(PAF(3),VFR(3),o[2],0,0,0), C1,12); \
    GAPB(o[3]=__builtin_amdgcn_mfma_f32_32x32x16_bf16(PAF(3),VFR(7),o[3],0,0,0), C1,14); \
    }while(0)
  int t=1;
  #undef CMASK
  #define CMASK(P0,P1,t) do{}while(0)
  for(;t+5<NT;t+=2){
    STEP(pB0,pB1,pA0,pA1,t,true,true,true);     WAIT_BAR(3); ROT();
    STEP(pA0,pA1,pB0,pB1,t+1,true,true,true);   WAIT_BAR(3); ROT();
  }
  #undef CMASK
  #define CMASK(P0,P1,t) do{int jb_=(t)-(NT-4); if(jb_>=0)cmask(P0,P1,jb_,qrel,hi);}while(0)
  #define ENDW(tt) do{ if((tt)+3<NT){WAIT_BAR(3);} else if((tt)+2<NT){WAIT_BAR(2);} else {WAIT_BAR(0);} }while(0)
  for(;t+1<NT;t+=2){
    STEP(pB0,pB1,pA0,pA1,t,(t+3<NT),(t+1<NT),(t+1<NT));       ENDW(t);   ROT();
    STEP(pA0,pA1,pB0,pB1,t+1,(t+4<NT),(t+2<NT),(t+2<NT));     ENDW(t+1); ROT();
  }
  STEP(pB0,pB1,pA0,pA1,NT-1,false,false,false);
  { float sacc=pB0[0]+pB0[1]; _Pragma("unroll") for(int r=2;r<16;++r)sacc+=pB0[r]; _Pragma("unroll") for(int r=0;r<16;++r)sacc+=pB1[r]; l_reg+=sacc;
    pw0=(u32x4){PKW(pB0,0),PKW(pB0,2),PKW(pB0,4),PKW(pB0,6)};pw1=(u32x4){PKW(pB0,8),PKW(pB0,10),PKW(pB0,12),PKW(pB0,14)};pw2=(u32x4){PKW(pB1,0),PKW(pB1,2),PKW(pB1,4),PKW(pB1,6)};pw3=(u32x4){PKW(pB1,8),PKW(pB1,10),PKW(pB1,12),PKW(pB1,14)};
    SBAR(); pv4(o,vb0+2*sl_cur,PAF(0),PAF(1),PAF(2),PAF(3)); }
  #undef PKW
  #undef PAF
  #undef VFR
  #undef PIN
  #undef GAPA
  #undef GAPB
  #undef EX
  #undef VRD
  #undef KRD
  #undef STEP
  #undef ENDW
  {auto rr=__builtin_amdgcn_permlane32_swap(__float_as_uint(l_reg),__float_as_uint(l_reg),false,false);l_reg=__uint_as_float(rr[0])+__uint_as_float(rr[1]);}
  if(hi==0)wsf[32+r32]=l_reg;
  asm volatile("s_waitcnt lgkmcnt(0)\n\ts_barrier":::"memory");
  float rli[16];
  #pragma unroll
  for(int r=0;r<16;++r)rli[r]=__builtin_amdgcn_rcpf(wsf[32+crow(r,hi)]);
  bf16*Ow=O+(rowbase+q0+wid*QBLK)*DM+h8*128;
  { bf16*stg=(bf16*)shm+wid*4096;
    #pragma unroll
    for(int r=0;r<16;++r){const int orow=crow(r,hi);
      #pragma unroll
      for(int d0=0;d0<4;++d0)stg[orow*128+d0*32+r32]=__float2bfloat16(o[d0][r]*rli[r]);}
    asm volatile("s_waitcnt lgkmcnt(0)":::"memory");
    if(fz==nullptr){
    #pragma unroll
    for(int i=0;i<8;++i){const int row=i*4+(lane>>4),ch=lane&15; const u32x4 v=*(const u32x4*)(stg+row*128+ch*8); ATTN_STORE16(Ow+(long)row*DM+ch*8,v);} }
    else{ const bf16*O0w=Ow; bf16*Yw=YAo+(rowbase+q0+wid*QBLK)*DM+h8*128; const int ch=lane&15; const float lam=fz[0];
      asm volatile("s_waitcnt vmcnt(0)":::"memory");
      u32x4 a0[8];
      #pragma unroll
      for(int i=0;i<8;++i)a0[i]=*(const u32x4*)(O0w+(long)(i*4+(lane>>4))*DM+ch*8);
      float sl8[8];
      #pragma unroll
      for(int e=0;e<8;++e)sl8[e]=fz[2+ch*8+e];
      #pragma unroll
      for(int i=0;i<8;++i){const int row=i*4+(lane>>4); const u32x4 v1=*(const u32x4*)(stg+row*128+ch*8);
        const unsigned aw[4]={a0[i].x,a0[i].y,a0[i].z,a0[i].w},bw[4]={v1.x,v1.y,v1.z,v1.w}; float d[8]; float ss=0.f;
        #pragma unroll
        for(int j=0;j<4;++j){d[2*j]=__uint_as_float(aw[j]<<16)-lam*__uint_as_float(bw[j]<<16); d[2*j+1]=__uint_as_float(aw[j]&0xffff0000u)-lam*__uint_as_float(bw[j]&0xffff0000u); ss+=d[2*j]*d[2*j]+d[2*j+1]*d[2*j+1];}
        ss=pg8::row_sum16(ss);
        const float rr=1.0f/sqrtf(ss*(1.f/128.f)+1e-6f);
        u32x4 w; w.x=cvtpk_s(d[0]*rr*sl8[0],d[1]*rr*sl8[1]); w.y=cvtpk_s(d[2]*rr*sl8[2],d[3]*rr*sl8[3]); w.z=cvtpk_s(d[4]*rr*sl8[4],d[5]*rr*sl8[5]); w.w=cvtpk_s(d[6]*rr*sl8[6],d[7]*rr*sl8[7]);
        ATTN_STORE16(Yw+(long)row*DM+ch*8,w);} } }
  asm volatile("s_waitcnt lgkmcnt(0)\n\ts_barrier":::"memory");
  #undef DMA_K
  #undef DMA_V
  #undef CMASK
  #undef ROT
}
constexpr int ATTN_LDS_BYTES=LDS_BYTES;
struct AttnTensors { const bf16* Q; const bf16* K; const bf16* V; bf16* O; };
struct AttnUnit { int b, hq, hv, m, qb; };
struct StaticOrder {
  int vcu, G;
  __device__ __forceinline__ explicit StaticOrder(int grid,int block):vcu((grid%8==0)?(block%8)*(grid/8)+block/8:block),G(grid){}
  __device__ __forceinline__ bool next(int i,AttnUnit&u)const{ const int g=vcu+(i>>3)*G; if(g>=256)return false; const int vh=g&1,m=(g>>1)&1,h8=(g>>2)&7; u.b=g>>5; u.hq=2*h8+m; u.hv=2*h8+vh; u.m=m; u.qb=7-(i&7); return true; }
  __device__ __forceinline__ void a_ready(const AttnUnit&)const{}
  __device__ __forceinline__ void done(const AttnUnit&)const{}
};
template<class Sched,int THRL=8> __device__ __forceinline__ void attn_phase(char*lds,const AttnTensors&T,const Sched&S,const int wave_sg){
  AttnUnit u; const bf16*Qp=pg8::uni_ptr(T.Q),*Kp=pg8::uni_ptr(T.K),*Vp=pg8::uni_ptr(T.V); bf16*Op=pg8::uni_ptr(T.O);
  for(int i=0;S.next(i,u);++i){ S.a_ready(u); attn_unit<THRL>(wave_sg,u.b,u.hq,u.hv,u.qb,Qp,Kp,Vp,Op+(size_t)u.m*((size_t)BATCH*SEQ*DM),lds); S.done(u); }
}
#undef SBAR
#undef WAIT_BAR
}
#define GAS __attribute__((address_space(1)))
#define LAS __attribute__((address_space(3)))
typedef unsigned short bf16;
typedef unsigned v4u __attribute__((ext_vector_type(4)));
typedef float f32x4 __attribute__((ext_vector_type(4)));
typedef short bf16x8 __attribute__((ext_vector_type(8)));
typedef GAS unsigned gu32;
typedef GAS unsigned long long gu64;
#define RLX_AGENT __ATOMIC_RELAXED, __HIP_MEMORY_SCOPE_AGENT
#define LDS_WAIT() asm volatile("s_waitcnt lgkmcnt(0)" ::: "memory")
#define VM_WAIT() asm volatile("s_waitcnt vmcnt(0)" ::: "memory")
__device__ __forceinline__ unsigned long long rt() { return __builtin_amdgcn_s_memrealtime(); }
__device__ __forceinline__ unsigned f2bf(float f) { unsigned u = __builtin_bit_cast(unsigned, f); return (u + 0x7fffu + ((u >> 16) & 1u)) >> 16; }
__device__ __forceinline__ unsigned pk2(float lo, float hi) { return f2bf(lo) | (f2bf(hi) << 16); }

#define XB_TMO      128
#define XB_XCNT(j)  (256  + 64 * (j))
#define XB_XSUB(j)  (1280 + 64 * (j))
#define XB_XGEN(j)  (2304 + 64 * (j))
#define XB_TOP      3328
#define XB_TOPGEN   3392
#define XCD_BAR_WORDS 3456
#define XB_SPIN_CAP (1u << 18)

__device__ __forceinline__ unsigned xb_ld(unsigned* p)              { return __hip_atomic_load(p, __ATOMIC_RELAXED, __HIP_MEMORY_SCOPE_AGENT); }
__device__ __forceinline__ unsigned xb_add(unsigned* p, unsigned v) { return __hip_atomic_fetch_add(p, v, __ATOMIC_RELAXED, __HIP_MEMORY_SCOPE_AGENT); }
__device__ __forceinline__ unsigned xb_xcc_id() { return (unsigned)__builtin_amdgcn_s_getreg((3 << 11) | 20) & 0xFu; }
#define XB_SPIN(cond, bar) do { unsigned _sp = 0; while (cond) { __builtin_amdgcn_s_sleep(1); \
    if ((++_sp & 255u) == 0u) { if (xb_ld(&(bar)[XB_TMO])) break; if (_sp > XB_SPIN_CAP) { atomicAdd(&(bar)[XB_TMO], 1u); break; } } } } while (0)

struct XcdBarrier {
    unsigned* bar; unsigned x;
    volatile LAS unsigned* st;
};

__device__ __forceinline__ XcdBarrier xcd_barrier_post(unsigned* bar, volatile LAS unsigned* st, const bool t0) {
    XcdBarrier b; b.bar = bar; b.x = xb_xcc_id(); b.st = st;
    if (t0) (void)xb_add(&bar[XB_XCNT(b.x)], 1u);
    return b;
}
__device__ __forceinline__ void xcd_barrier_complete(unsigned* bar, unsigned x, unsigned& nloc, unsigned& nx) {
    const unsigned G = gridDim.x * gridDim.y * gridDim.z;
    unsigned sum, cnt, mine, sp = 0u;
    for (;;) {
        sum = 0u; cnt = 0u; mine = 0u;
#pragma unroll
        for (unsigned j = 0; j < 16; ++j) { const unsigned c = xb_ld(&bar[XB_XCNT(j)]); sum += c; cnt += (c > 0u) ? 1u : 0u; mine = (j == x) ? c : mine; }
        if (sum == G) break;
        __builtin_amdgcn_s_sleep(1);
        if ((++sp & 255u) == 0u) { if (xb_ld(&bar[XB_TMO])) break; if (sp > XB_SPIN_CAP) { atomicAdd(&bar[XB_TMO], 1u); break; } }
    }
    nloc = mine > 0u ? mine : 1u; nx = cnt > 0u ? cnt : 1u;
}

__device__ __forceinline__ void xcd_barrier(const XcdBarrier& b, const bool t0) {
    asm volatile("s_waitcnt vmcnt(0)" ::: "memory");
    __syncthreads();
    if (t0) {
        unsigned* bar = pg8::uni_ptr(b.bar);
        __builtin_amdgcn_s_waitcnt(0);
        unsigned nloc = b.st[0], nx = b.st[1];
        if (nloc == 0u) { xcd_barrier_complete(bar, b.x, nloc, nx); b.st[0] = nloc; b.st[1] = nx; }
        const unsigned old = xb_add(&bar[XB_XSUB(b.x)], 1u);
        const unsigned gen = old / nloc;
        if (old + 1u == (gen + 1u) * nloc) {
            __builtin_amdgcn_fence(__ATOMIC_RELEASE, "agent");
            asm volatile("s_waitcnt vmcnt(0)" ::: "memory");
            const unsigned og = xb_add(&bar[XB_TOP], 1u);
            const unsigned tg = og / nx;
            if (og + 1u == (tg + 1u) * nx) xb_add(&bar[XB_TOPGEN], 1u);
            else XB_SPIN(xb_ld(&bar[XB_TOPGEN]) == tg, bar);
            __builtin_amdgcn_fence(__ATOMIC_ACQUIRE, "agent");
            xb_add(&bar[XB_XGEN(b.x)], 1u);
            asm volatile("s_waitcnt vmcnt(0)" ::: "memory");
        } else {
            XB_SPIN(xb_ld(&bar[XB_XGEN(b.x)]) == gen, bar);
            __builtin_amdgcn_fence(__ATOMIC_ACQUIRE, "agent");
            asm volatile("s_waitcnt vmcnt(0)" ::: "memory");
        }
    }
    __syncthreads();
}

constexpr int NWAVES = 8;
constexpr int NB = 8, NT_ = 2048, DM_ = 2048, M = NB * NT_;
constexpr int MIXW = 1024, INC = 15360, FFH = 5632, MEMROWS = 2048;
constexpr int DEPTH = 2, NPH = 16;
constexpr float EPSN = 1e-6f;
constexpr float LOG2E = 1.4426950408889634f;

constexpr size_t MiB = 1u << 20;
constexpr size_t WS_CTL = 0, CTL_ZERO_BYTES = 1 * MiB;
constexpr size_t WS_LAM = 1 * MiB + 512 * 1024;
constexpr size_t WS_DCS = 1 * MiB, WS_RCS = 2 * MiB;
constexpr size_t WS_W = 4 * MiB;
constexpr int KPAD = 64;
constexpr int LD2K = DM_ + KPAD, LD1K = MIXW + KPAD, LDFF = FFH + KPAD;
constexpr size_t W_IN = WS_W, W_BR = W_IN + 62 * MiB, W_OUT = W_BR + 13 * MiB, W_Q = W_OUT + 9 * MiB, W_KV = W_Q + 9 * MiB, W_O = W_KV + 17 * MiB, W_13 = W_O + 9 * MiB, W_2 = W_13 + 46 * MiB, W_END = W_2 + 23 * MiB;
constexpr size_t WS_XN = W_END;
constexpr size_t WS_MN = WS_XN + 66 * MiB, WS_KM = WS_MN + 8 * MiB, WS_VT = WS_KM + 9 * MiB;
constexpr size_t WS_Y = WS_VT + 8 * MiB;
constexpr size_t WS_YRAW = WS_Y + 96 * MiB;
constexpr size_t WS_BIG = WS_YRAW + 64 * MiB;
constexpr size_t SEG = 32 * MiB, SEG_E = (size_t)16384 * 1024;
constexpr size_t WS_END_BIG = WS_BIG + 15 * SEG;
constexpr size_t RSS_STRIDE = (size_t)16384 * 32;
constexpr size_t WS_END = WS_END_BIG + 7 * RSS_STRIDE * 4;
static_assert(W_END == 192 * MiB && WS_END == 937 * MiB, "d_ws map");
constexpr size_t DO_WKV1 = 64 * MiB, DO_MN1 = 81 * MiB, DO_KV1 = 90 * MiB;
constexpr int CW_TMO = 0, CW_BAR = 4096, CW_Q = 8192;
constexpr size_t WS_RSS = WS_END_BIG;

constexpr int RING_OFF = 0, RING_BYTES = 131072;
constexpr int LDSCTL_OFF = RING_BYTES, MISC_OFF = LDSCTL_OFF + 320;
constexpr int LDS_BYTES = 147456;
static_assert(MISC_OFF + 128 <= LDS_BYTES, "LDS map");

struct Args { const float* in[22]; float* out; unsigned char* ws; int l_lo, l_hi; };
__device__ const float ROPE_INV[96] = {1.0f, 0.749894202f, 0.562341332f, 0.421696514f, 0.316227764f, 0.237137377f, 0.177827939f, 0.133352146f, 0.100000001f, 0.0749894232f, 0.0562341325f, 0.0421696492f, 0.0316227749f, 0.0237137377f, 0.0177827943f, 0.013335214f, 0.00999999978f, 0.00749894232f, 0.00562341325f, 0.00421696482f, 0.00316227763f, 0.00237137382f, 0.00177827943f, 0.00133352145f, 0.00100000005f, 0.000749894185f, 0.000562341302f, 0.000421696517f, 0.000316227757f, 0.00023713737f, 0.00017782794f, 0.00013335215f, 1.0f, 0.863988459f, 0.746476054f, 0.644946694f, 0.557226479f, 0.481437236f, 0.415956229f, 0.359381378f, 0.310501337f, 0.268269569f, 0.231781825f, 0.20025681f, 0.173019573f, 0.149486914f, 0.129154965f, 0.111588396f, 0.0964110866f, 0.0832980648f, 0.0719685704f, 0.0621800125f, 0.05372281f, 0.0464158878f, 0.040102791f, 0.0346483476f, 0.0299357735f, 0.0258641616f, 0.0223463364f, 0.0193069782f, 0.0166810062f, 0.0144121964f, 0.0124519709f, 0.010758359f, 0.00929509755f, 0.00803085696f, 0.00693856785f, 0.00599484239f, 0.0051794746f, 0.00447500637f, 0.00386635377f, 0.00334048504f, 0.00288614049f, 0.00249359198f, 0.0021544348f, 0.00186140672f, 0.0016082339f, 0.00138949545f, 0.00120050809f, 0.00103722513f, 0.000896150479f, 0.000774263695f, 0.000668954861f, 0.000577969302f, 0.000499358808f, 0.000431440218f, 0.000372759358f, 0.000322059786f, 0.000278255931f, 0.000240409921f, 0.00020771139f, 0.000179460243f, 0.000155051574f, 0.000133962778f, 0.000115742288f, 9.99999975e-05f};
struct Frame {
    LAS unsigned char* lds;
    volatile LAS unsigned* MISC;
    int vcu, G, wave;
};
#define PH_ENTER() const int wave = pg8::opq(F.wave), vcu_ = pg8::opq(F.vcu), G_ = pg8::opq(F.G); int tid = wave * 64 + pg8::lane_id(); asm volatile("" : "+v"(tid)); const int lane = tid & 63; (void)vcu_; (void)G_; \
    unsigned char* ws = pg8::uni_ptr(args.ws); (void)lane; (void)wave; (void)tid
__device__ __forceinline__ float wave_sum(float v) {
    v = pg8::xadd<1>(v); v = pg8::xadd<2>(v); v = pg8::xadd<4>(v); v = pg8::xadd<8>(v); v = pg8::xadd<16>(v); v = pg8::xadd<32>(v);
    return v;
}
__device__ __forceinline__ float wave_total(float v) {
#define DPPADD(ctrl, rmask) v += __int_as_float(__builtin_amdgcn_update_dpp(0, __float_as_int(v), ctrl, rmask, 0xf, true))
    DPPADD(0xB1, 0xf); DPPADD(0x4E, 0xf); DPPADD(0x141, 0xf); DPPADD(0x140, 0xf); DPPADD(0x142, 0xa); DPPADD(0x143, 0xc);
#undef DPPADD
    return __int_as_float(__builtin_amdgcn_readlane(__float_as_int(v), 63));
}
__device__ __forceinline__ float bflo(unsigned w) { return __uint_as_float(w << 16); }
__device__ __forceinline__ float bfhi(unsigned w) { return __uint_as_float(w & 0xffff0000u); }
__device__ __forceinline__ float sigm(float x) { return __builtin_amdgcn_rcpf(1.0f + __builtin_amdgcn_exp2f(-LOG2E * x)); }

template <int CMAP> __device__ __forceinline__ void transpose_item(const float* W, int K, int N, bf16* WT, int ldw, LAS float* scr, int item, int lane, const float* gain = nullptr) {
    const int nblk = N / 32, kb = item / nblk, nb = item % nblk, k0 = 64 * kb, n0 = 32 * nb;
    const int nn = n0 + (lane & 31); int sc = nn;
    if (CMAP == 1) sc = (nn & 1) * FFH + (nn >> 1);
    if (CMAP == 2) {
        if (nn < 2048) { const int w = nn & 63; sc = (nn & ~63) + (w & 1) * 32 + (w >> 1); }
        else if (nn >= 3072 && nn < 5120) { const int j = nn - 3072; sc = 3072 + (j & 1) * 1024 + (j >> 1); }
        else if (nn >= 5120 && nn < 7168) { const int w = (nn - 5120) & 127; sc = 5120 + ((nn - 5120) & ~127) + (w & 1) * 64 + (w >> 1); } }
    float wv[32]; const float gv = gain ? gain[k0 + lane] : 1.0f;
#pragma unroll
    for (int i = 0; i < 32; ++i) wv[i] = W[(size_t)(k0 + 2 * i + (lane >> 5)) * N + sc];
#pragma unroll
    for (int i = 0; i < 32; ++i) { const float g0 = __builtin_bit_cast(float, __builtin_amdgcn_readlane(__builtin_bit_cast(int, gv), 2 * i)), g1 = __builtin_bit_cast(float, __builtin_amdgcn_readlane(__builtin_bit_cast(int, gv), 2 * i + 1));
        scr[(2 * i + (lane >> 5)) * 33 + (lane & 31)] = wv[i] * ((lane >> 5) ? g1 : g0); }
    LDS_WAIT(); asm volatile("" ::: "memory");
    const int c = lane & 7;
#pragma unroll
    for (int j = 0; j < 4; ++j) { const int n = (lane >> 3) + 8 * j; const LAS float* s = scr + (8 * c) * 33 + n;
        v4u o; o.x = pk2(s[0 * 33], s[1 * 33]); o.y = pk2(s[2 * 33], s[3 * 33]); o.z = pk2(s[4 * 33], s[5 * 33]); o.w = pk2(s[6 * 33], s[7 * 33]);
        *(GAS v4u*)(WT + (size_t)(n0 + n) * ldw + k0 + 8 * c) = o; }
    LDS_WAIT(); asm volatile("" ::: "memory");
}
template <int CMAP> __device__ __forceinline__ int wt_row(int s) {
    if (CMAP == 1) return s < FFH ? 2 * s : 2 * (s - FFH) + 1;
    if (CMAP == 2) {
        if (s < 2048) { const int ws = s & 63; return (s & ~63) + (ws < 32 ? 2 * ws : 2 * (ws - 32) + 1); }
        if (s >= 3072 && s < 5120) { const int j = s - 3072; return 3072 + (j < 1024 ? 2 * j : 2 * (j - 1024) + 1); }
        if (s >= 5120 && s < 7168) { const int ws = (s - 5120) & 127; return 5120 + ((s - 5120) & ~127) + (ws < 64 ? 2 * ws : 2 * (ws - 64) + 1); } }
    return s;
}
template <int CMAP, int K> __device__ __forceinline__ void transpose_item_w(const float* W, int N, bf16* WT, int ldw, LAS unsigned char* scr, int item, int lane, const float* gain = nullptr) {
    constexpr int nkb = K / 64; const int nb = item / nkb, kb = item % nkb,
        k0 = 64 * kb, h = lane >> 5, cl = lane & 31, s0 = 128 * nb + 4 * cl;
    const float* src = W + (size_t)(k0 + h) * N + s0;
    f32x4 r[32]; const float gv = gain ? gain[k0 + lane] : 1.0f;
#pragma unroll
    for (int i = 0; i < 32; ++i) r[i] = *(const GAS f32x4*)(src + (size_t)(2 * i) * N);
    if (gain) {
#pragma unroll
        for (int i = 0; i < 32; ++i) { const float g0 = __builtin_bit_cast(float, __builtin_amdgcn_readlane(__builtin_bit_cast(int, gv), 2 * i)), g1 = __builtin_bit_cast(float, __builtin_amdgcn_readlane(__builtin_bit_cast(int, gv), 2 * i + 1));
            r[i] *= (h ? g1 : g0); } }
#pragma unroll
    for (int c0 = 0; c0 < 4; c0 += 2) {
#pragma unroll
        for (int d = 0; d < 2; ++d) {
            unsigned p[16];
#pragma unroll
            for (int i = 0; i < 16; ++i) { const auto rr = __builtin_amdgcn_permlane32_swap(__float_as_uint(r[i][c0 + d]), __float_as_uint(r[i + 16][c0 + d]), false, false);
                p[i] = pg8::cvt_pk_bf16(__uint_as_float(rr[0]), __uint_as_float(rr[1])); }
            const int rl = 2 * cl + d;
#pragma unroll
            for (int q = 0; q < 4; ++q) { v4u o; o.x = p[4 * q]; o.y = p[4 * q + 1]; o.z = p[4 * q + 2]; o.w = p[4 * q + 3];
                *(LAS v4u*)(scr + rl * 128 + (((4 * h + q) ^ (rl & 7)) << 4)) = o; }
        }
        LDS_WAIT(); asm volatile("" ::: "memory");
        v4u o[8];
#pragma unroll
        for (int j = 0; j < 8; ++j) { const int rl = (lane >> 3) + 8 * j; o[j] = *(const LAS v4u*)(scr + rl * 128 + (((lane & 7) ^ (rl & 7)) << 4)); }
        LDS_WAIT(); asm volatile("" ::: "memory");
#pragma unroll
        for (int j = 0; j < 8; ++j) { const int rl = (lane >> 3) + 8 * j; const int sc = 128 * nb + 4 * (rl >> 1) + c0 + (rl & 1);
            *(GAS v4u*)(WT + (size_t)wt_row<CMAP>(sc) * ldw + k0 + 8 * (lane & 7)) = o[j]; }
    }
}
__device__ __forceinline__ void convert_item(const float* W, bf16* WO, int ldw, int item, int lane, const float* gain) {
    const int kb = item / 64, nb = item % 64, k0 = 64 * kb, n0 = 32 * nb; const int kk = lane >> 3, c4 = (lane & 7) * 4;
    f32x4 v[8]; float g[8];
#pragma unroll
    for (int i = 0; i < 8; ++i) { const int k = k0 + 8 * i + kk; v[i] = *(const GAS f32x4*)(W + (size_t)k * DM_ + n0 + c4); g[i] = gain[k]; }
#pragma unroll
    for (int i = 0; i < 8; ++i) { const int k = k0 + 8 * i + kk;
        *(GAS unsigned long long*)(WO + (size_t)k * ldw + n0 + c4) = (unsigned long long)pk2(v[i].x * g[i], v[i].y * g[i]) | ((unsigned long long)pk2(v[i].z * g[i], v[i].w * g[i]) << 32); }
}
__device__ __forceinline__ void convert_item_w(const float* W, bf16* WO, int ldw, int item, int lane, const float* gain) {
    const int kb = item / 16, nb = item % 16, k0 = 64 * kb, h = lane >> 5, n0 = 128 * nb + 4 * (lane & 31);
    const float* src = W + (size_t)(k0 + h) * DM_ + n0; bf16* dst = WO + (size_t)(k0 + h) * ldw + n0;
    f32x4 r[32]; const float gv = gain[k0 + lane];
#pragma unroll
    for (int i = 0; i < 32; ++i) r[i] = *(const GAS f32x4*)(src + (size_t)(2 * i) * DM_);
#pragma unroll
    for (int i = 0; i < 32; ++i) { const float g0 = __builtin_bit_cast(float, __builtin_amdgcn_readlane(__builtin_bit_cast(int, gv), 2 * i)), g1 = __builtin_bit_cast(float, __builtin_amdgcn_readlane(__builtin_bit_cast(int, gv), 2 * i + 1));
        const f32x4 v = r[i] * (h ? g1 : g0);
        *(GAS unsigned long long*)(dst + (size_t)(2 * i) * ldw) = (unsigned long long)pg8::cvt_pk_bf16(v.x, v.y) | ((unsigned long long)pg8::cvt_pk_bf16(v.z, v.w) << 32); }
}
constexpr int LATE_ITEMS = 6528, LATE_ITEMS_IN = 3840, CHUNK_ITEMS = 32;
typedef const __attribute__((address_space(4))) unsigned char* kargp_t;
__device__ __forceinline__ const float* karg_in(kargp_t kp, int k) { return *(const float* const __attribute__((address_space(4)))*)(kp + 8 * k); }
__device__ __forceinline__ void late_item(kargp_t kp, unsigned char* ws, int l, int r, LAS unsigned char* scr, int lane) {
    if (r < 768) { const int br = r >> 8; transpose_item_w<0, MIXW>(karg_in(kp, 11) + ((size_t)l * 3 + br) * MIXW * DM_, DM_, (bf16*)(ws + W_BR) + (size_t)br * DM_ * LD1K, LD1K, scr, r & 255, lane); return; } r -= 768;
    if (r < 512) { transpose_item_w<0, DM_>(karg_in(kp, 12) + (size_t)l * DM_ * DM_, DM_, (bf16*)(ws + W_OUT), LD2K, scr, r, lane); return; } r -= 512;
    if (r < 512) { convert_item_w(karg_in(kp, 15) + (size_t)l * DM_ * DM_, (bf16*)(ws + W_Q), LD2K, r, lane, karg_in(kp, 13) + (size_t)l * DM_); return; } r -= 512;
    if (r < 512) { transpose_item_w<0, DM_>(karg_in(kp, 17) + (size_t)l * DM_ * DM_, DM_, (bf16*)(ws + W_O), LD2K, scr, r, lane); return; } r -= 512;
    if (r < 2816) { transpose_item_w<1, DM_>(karg_in(kp, 19) + (size_t)l * DM_ * 2 * FFH, 2 * FFH, (bf16*)(ws + W_13), LD2K, scr, r, lane, karg_in(kp, 18) + (size_t)l * DM_); return; } r -= 2816;
    if (r < 1408) { transpose_item_w<0, FFH>(karg_in(kp, 20) + (size_t)l * FFH * DM_, DM_, (bf16*)(ws + W_2), LDFF, scr, r, lane); return; } r -= 1408;
    transpose_item_w<2, DM_>(karg_in(kp, 3) + (size_t)(l + 1) * DM_ * INC, INC, (bf16*)(ws + W_IN), LD2K, scr, r, lane, karg_in(kp, 2) + (size_t)(l + 1) * DM_);
}
template <bool TOF32> __device__ __forceinline__ void rms_row(int lane, const float* xrow, const float* gain, void* orow) {
    const GAS f32x4* xr = (const GAS f32x4*)xrow + lane; const GAS f32x4* gr = (const GAS f32x4*)gain + lane;
    f32x4 v[8]; float s = 0.f;
#pragma unroll
    for (int j = 0; j < 8; ++j) { v[j] = xr[64 * j]; s += (v[j].x * v[j].x + v[j].y * v[j].y) + (v[j].z * v[j].z + v[j].w * v[j].w); }
    const float r = 1.0f / sqrtf(wave_sum(s) * (1.f / 2048.f) + EPSN);
#pragma unroll
    for (int j = 0; j < 8; ++j) { const f32x4 g = gr[64 * j]; const f32x4 y = v[j] * r * g;
        if (TOF32) ((GAS f32x4*)orow + lane)[64 * j] = y;
        else ((GAS unsigned long long*)orow + lane)[64 * j] = (unsigned long long)pk2(y.x, y.y) | ((unsigned long long)pk2(y.z, y.w) << 32); }
}

__device__ __forceinline__ void ph_prep(Frame& F, const Args& args, int l, const float* xcur) {
    PH_ENTER();
    LAS float* scr = (LAS float*)(F.lds + RING_OFF + wave * 16384);
    const int gw = vcu_ * NWAVES + wave, NGW = G_ * NWAVES;
    constexpr int I_IN = 32 * (INC / 128), I_KV = 32 * 32;
    if (l == 0) for (int it = gw; it < I_IN + I_KV; it += NGW) {
        int r = it;
        if (r < I_IN) { transpose_item_w<2, DM_>(args.in[3], INC, (bf16*)(ws + W_IN), LD2K, (LAS unsigned char*)scr, r, lane, args.in[2]); continue; } r -= I_IN;
        transpose_item_w<0, DM_>(args.in[16], 2 * DM_, (bf16*)(ws + W_KV), LD2K, (LAS unsigned char*)scr, r, lane);
        transpose_item_w<0, DM_>(args.in[16] + (size_t)DM_ * 2 * DM_, 2 * DM_, (bf16*)((unsigned char*)args.out + DO_WKV1), LD2K, (LAS unsigned char*)scr, r, lane);
    }
    if (l == 0) for (int m = gw; m < M; m += NGW) {
        const GAS f32x4* xr = (const GAS f32x4*)(xcur + (size_t)m * DM_) + lane; GAS unsigned long long* orow = (GAS unsigned long long*)((bf16*)(ws + WS_XN) + (size_t)m * LD2K) + lane; float sq = 0.f;
#pragma unroll
        for (int j = 0; j < 8; ++j) { const f32x4 v = xr[64 * j]; sq += (v.x * v.x + v.y * v.y) + (v.z * v.z + v.w * v.w); orow[64 * j] = (unsigned long long)pk2(v.x, v.y) | ((unsigned long long)pk2(v.z, v.w) << 32); }
        sq = wave_sum(sq); if (lane < 32) ((float*)(ws + WS_RSS))[(size_t)m * 32 + lane] = lane == 0 ? sq : 0.f; }
    if (l == 0) for (int m = gw; m < MEMROWS; m += NGW) { rms_row<false>(lane, args.in[1] + (size_t)m * DM_, args.in[14], (bf16*)(ws + WS_MN) + (size_t)m * DM_);
                                                         rms_row<false>(lane, args.in[1] + (size_t)m * DM_, args.in[14] + DM_, (bf16*)((unsigned char*)args.out + DO_MN1) + (size_t)m * DM_); }
    if (l == 1) { const int gt = vcu_ * (NWAVES * 64) + tid, NGT = G_ * NWAVES * 64;
        const GAS v4u* src = (const GAS v4u*)((const unsigned char*)args.out + DO_KV1); GAS v4u* dst = (GAS v4u*)(ws + WS_KM);
        for (int e = gt; e < 2 * MEMROWS * LD2K / 8; e += NGT) dst[e] = src[e]; }
    if (l == 0 && vcu_ == 0 && wave == 0) {
#pragma unroll
        for (int ll = 0; ll < DEPTH; ++ll) { const float* dl = args.in[4] + (size_t)ll * 256;
            const float s01 = wave_sum(dl[lane] * dl[64 + lane]), s23 = wave_sum(dl[128 + lane] * dl[192 + lane]);
            const float linit = 0.8f - 0.6f * expf(-0.3f * (float)ll);
            float* fz = (float*)(ws + WS_LAM) + 192 * ll;
            if (lane == 0) { fz[0] = expf(s01) - expf(s23) + linit; fz[1] = 1.0f - linit; }
            fz[2 + lane] = args.in[5][(size_t)ll * 128 + lane] * (1.0f - linit); fz[66 + lane] = args.in[5][(size_t)ll * 128 + 64 + lane] * (1.0f - linit); } }
    if (l == 0) {
        const int gt = vcu_ * (NWAVES * 64) + tid, NGT = G_ * NWAVES * 64;
        for (int e = gt; e < 2048 * 96; e += NGT) {
            const int t = e / 96, i = e % 96; float inv; float* dst;
            if (i < 32) { dst = (float*)(ws + WS_DCS) + ((size_t)t * 32 + i) * 2; }
            else { dst = (float*)(ws + WS_RCS) + ((size_t)t * 64 + (i - 32)) * 2; }
            inv = ROPE_INV[i];
            const float ang = (float)t * inv;
            const float CH = 0.15915494f, CL = 6.4206382e-09f;
            const float p = ang * CH, pe = fmaf(ang, CH, -p) + ang * CL; const float fr = (p - floorf(p)) + pe;
            dst[0] = __builtin_amdgcn_cosf(fr); dst[1] = __builtin_amdgcn_sinf(fr);
        }
    }
}

__device__ __forceinline__ void ph_rope(Frame& F, const Args& args) {
    PH_ENTER();
    const int gw = vcu_ * NWAVES + wave, NGW = G_ * NWAVES;
    for (int it = gw; it < 4 * M; it += NGW) {
        const int sel = it / M, row = it % M, t = row % NT_;
        const int seg = sel == 0 ? 0 : sel == 1 ? 1 : sel == 2 ? 5 : 6;
        bf16* base = (bf16*)(ws + WS_BIG + (size_t)seg * SEG) + (size_t)row * 1024;
        int c1, c2; const float* tab; float sc;
        if (sel < 2) { const int blk = lane >> 2, d0 = (lane & 3) * 8; c1 = blk * 64 + d0; c2 = c1 + 32; tab = (const float*)(ws + WS_DCS) + ((size_t)t * 32 + d0) * 2; sc = sel == 0 ? 0.125f * LOG2E : 1.0f; }
        else { const int blk = lane >> 3, d0 = (lane & 7) * 8; c1 = blk * 128 + d0; c2 = c1 + 64; tab = (const float*)(ws + WS_RCS) + ((size_t)t * 64 + d0) * 2; sc = sel == 2 ? 0.08838834764831845f : 1.0f; }
        const v4u a = *(const GAS v4u*)(base + c1), b = *(const GAS v4u*)(base + c2);
        const GAS f32x4* tb = (const GAS f32x4*)tab; const f32x4 t0 = tb[0], t1 = tb[1], t2 = tb[2], t3 = tb[3];
        const float cs[8] = {t0.x, t0.z, t1.x, t1.z, t2.x, t2.z, t3.x, t3.z}, sn[8] = {t0.y, t0.w, t1.y, t1.w, t2.y, t2.w, t3.y, t3.w};
        const unsigned aw[4] = {a.x, a.y, a.z, a.w}, bw[4] = {b.x, b.y, b.z, b.w}; unsigned oa[4], ob[4];
#pragma unroll
        for (int j = 0; j < 4; ++j) {
            const float x1l = bflo(aw[j]), x1h = bfhi(aw[j]), x2l = bflo(bw[j]), x2h = bfhi(bw[j]);
            const float y1l = (x1l * cs[2 * j] - x2l * sn[2 * j]) * sc, y2l = (x2l * cs[2 * j] + x1l * sn[2 * j]) * sc;
            const float y1h = (x1h * cs[2 * j + 1] - x2h * sn[2 * j + 1]) * sc, y2h = (x2h * cs[2 * j + 1] + x1h * sn[2 * j + 1]) * sc;
            oa[j] = pk2(y1l, y1h); ob[j] = pk2(y2l, y2h);
        }
        v4u wa; wa.x = oa[0]; wa.y = oa[1]; wa.z = oa[2]; wa.w = oa[3]; v4u wb; wb.x = ob[0]; wb.y = ob[1]; wb.z = ob[2]; wb.w = ob[3];
        *(GAS v4u*)(base + c1) = wa; *(GAS v4u*)(base + c2) = wb;
    }
}

__device__ __forceinline__ void ph_conv(Frame& F, const Args& args, int l, int ustart, int uend) {
    PH_ENTER();
    const bf16* U = (const bf16*)(ws + WS_BIG + 3 * SEG);
    bf16* YB = (bf16*)(ws + WS_Y) + SEG_E;
    const int c0 = 2 * tid;
    const float* cw = args.in[6] + (size_t)l * 31 * 1024;
    typedef float f32x2c __attribute__((ext_vector_type(2)));
    f32x2c w2[31];
#pragma unroll
    for (int j = 0; j < 31; ++j) { const float2 w = *(const float2*)(cw + j * 1024 + c0); w2[j] = (f32x2c){w.x, w.y}; }
    const float2 bias = *(const float2*)(args.in[7] + (size_t)l * 1024 + c0), lg = *(const float2*)(args.in[8] + (size_t)l * 1024 + c0), lb = *(const float2*)(args.in[9] + (size_t)l * 1024 + c0);
    LAS unsigned char* Us = F.lds + RING_OFF;
    LAS float* red1 = (LAS float*)(F.lds + RING_OFF + 46 * 2048); LAS float* red2 = red1 + 16 * 8;
    for (int unit = ustart; unit < uend; ++unit) {
        const int b = unit >> 7, t0 = (unit & 127) * 16;
#pragma unroll
        for (int i = 0; i < 12; ++i) { const int idx = tid + 512 * i; const int r = idx >> 7, ch = idx & 127;
            if (idx < 46 * 128) { const int tg = t0 - 30 + r; v4u v; v.x = 0u; v.y = 0u; v.z = 0u; v.w = 0u;
                if (tg >= 0) v = *(const GAS v4u*)(U + ((size_t)b * NT_ + tg) * 1024 + ch * 8);
                *(LAS v4u*)(Us + r * 2048 + ch * 16) = v; } }
        __syncthreads();
        f32x2c acc2[16];
#pragma unroll
        for (int t = 0; t < 16; ++t) acc2[t] = (f32x2c){0.f, 0.f};
#pragma unroll
        for (int r = 0; r < 46; ++r) {
            const unsigned uw = *(const LAS unsigned*)(Us + r * 2048 + tid * 4);
            const f32x2c u2 = {bflo(uw), bfhi(uw)};
#pragma unroll
            for (int t = 0; t < 16; ++t) { const int j = r - t; if (j >= 0 && j <= 30) acc2[t] = __builtin_elementwise_fma(u2, w2[j], acc2[t]); }
        }
        float a0[16], a1[16];
#pragma unroll
        for (int t = 0; t < 16; ++t) { a0[t] = acc2[t].x; a1[t] = acc2[t].y; }
        float mu[16];
#pragma unroll
        for (int t = 0; t < 16; ++t) { a0[t] += bias.x; a1[t] += bias.y; const float s = wave_total(a0[t] + a1[t]); if (lane == 0) red1[t * 8 + wave] = s; }
        __syncthreads();
#pragma unroll
        for (int t = 0; t < 16; ++t) { float s = 0.f;
#pragma unroll
            for (int w = 0; w < 8; ++w) s += red1[t * 8 + w];
            mu[t] = s * (1.f / 1024.f); a0[t] -= mu[t]; a1[t] -= mu[t];
            const float q = wave_total(a0[t] * a0[t] + a1[t] * a1[t]); if (lane == 0) red2[t * 8 + wave] = q; }
        __syncthreads();
#pragma unroll
        for (int t = 0; t < 16; ++t) { float q = 0.f;
#pragma unroll
            for (int w = 0; w < 8; ++w) q += red2[t * 8 + w];
            const float rs = 1.0f / sqrtf(q * (1.f / 1024.f) + EPSN);
            const float y0 = a0[t] * rs * lg.x + lb.x, y1 = a1[t] * rs * lg.y + lb.y;
            *(GAS unsigned*)(YB + ((size_t)b * NT_ + t0 + t) * 1024 + c0) = pk2(y0 * sigm(y0), y1 * sigm(y1)); }
    }
    __syncthreads();
}
__device__ __forceinline__ int sw_off(int row, int col) { return row * 256 + ((((col >> 3) ^ (row & 15)) << 4) | ((col & 7) << 1)); }
__device__ __forceinline__ void ph_ret_seq(Frame& F, const Args& args, int l, int bh) {
    PH_ENTER();
    typedef short bf16x8v __attribute__((ext_vector_type(8)));
    LAS unsigned char* Ks = F.lds + RING_OFF; LAS unsigned char* KTs = Ks + 32768; LAS unsigned char* VTs = KTs + 32768; LAS unsigned char* STs = VTs + 32768;
    const bf16* RQ = (const bf16*)(ws + WS_BIG + 5 * SEG); const bf16* RK = (const bf16*)(ws + WS_BIG + 6 * SEG); const bf16* RV = (const bf16*)(ws + WS_BIG + 7 * SEG); const bf16* RG = (const bf16*)(ws + WS_BIG + 8 * SEG);
    bf16* YRo = (bf16*)(ws + WS_Y) + 2 * SEG_E;
    const float* gng = args.in[10] + (size_t)l * 1024;
    const int wid = wave;
    const int b = bh >> 3, h = bh & 7;
    const float lg2 = log2f(1.0f - exp2f(-5.0f - (float)h));
    const float cdec = exp2f(128.0f * lg2);
    f32x4 st[8];
#pragma unroll
    for (int c = 0; c < 8; ++c) st[c] = (f32x4){0.f, 0.f, 0.f, 0.f};
    for (int e = tid; e < 8192; e += NWAVES * 64) ((LAS unsigned*)STs)[e] = 0u;
    bf16x8v qa[4]; v4u kq[4], vq[4];
    { const size_t r0 = (size_t)b * NT_; const int fr0 = lane & 15, fq0 = lane >> 4;
#pragma unroll
      for (int ks = 0; ks < 4; ++ks) qa[ks] = *(const GAS bf16x8v*)(RQ + (r0 + 16 * wid + fr0) * 1024 + h * 128 + ks * 32 + fq0 * 8);
#pragma unroll
      for (int i = 0; i < 4; ++i) { const int r = lane + 64 * (i & 1), cc = 2 * wid + (i >> 1); const size_t go = (r0 + r) * 1024 + h * 128 + cc * 8;
          kq[i] = *(const GAS v4u*)(RK + go); vq[i] = *(const GAS v4u*)(RV + go); } }
    for (int n = 0; n < 16; ++n) {
        const size_t row0 = (size_t)b * NT_ + (size_t)n * 128;
        int lane_n = lane; asm volatile("" : "+v"(lane_n)); const int fr = lane_n & 15, fq = lane_n >> 4;
        float lgn = lg2; asm volatile("" : "+v"(lgn));
#pragma unroll
        for (int i = 0; i < 4; ++i) { const int r = lane_n + 64 * (i & 1), cc = 2 * wid + (i >> 1);
            const v4u k = kq[i], v = vq[i];
            *(LAS v4u*)(Ks + sw_off(r, cc * 8)) = k;
            const float kd = __builtin_amdgcn_exp2f((float)(127 - r) * lgn); const unsigned kw[4] = {k.x, k.y, k.z, k.w}, vw[4] = {v.x, v.y, v.z, v.w};
#pragma unroll
            for (int j = 0; j < 4; ++j) {
                *(LAS bf16*)(KTs + sw_off(cc * 8 + 2 * j, r)) = (bf16)f2bf(bflo(kw[j]) * kd); *(LAS bf16*)(KTs + sw_off(cc * 8 + 2 * j + 1, r)) = (bf16)f2bf(bfhi(kw[j]) * kd);
                *(LAS bf16*)(VTs + sw_off(cc * 8 + 2 * j, r)) = (bf16)(vw[j] & 0xffffu); *(LAS bf16*)(VTs + sw_off(cc * 8 + 2 * j + 1, r)) = (bf16)(vw[j] >> 16); }
            if (i & 1) asm volatile("" ::: "memory"); }
        __syncthreads();
        unsigned Pk[8][2]; f32x4 o[8];
#pragma unroll
        for (int c = 0; c < 8; ++c) { f32x4 Sc = (f32x4){0.f, 0.f, 0.f, 0.f};
#pragma unroll
            for (int ks = 0; ks < 4; ++ks) { const bf16x8v kb = *(const LAS bf16x8v*)(Ks + sw_off(16 * c + fr, ks * 32 + fq * 8));
                Sc = __builtin_amdgcn_mfma_f32_16x16x32_bf16(qa[ks], kb, Sc, 0, 0, 0); }
            float p4[4];
#pragma unroll
            for (int rg = 0; rg < 4; ++rg) { const int tl = 16 * wid + 4 * fq + rg, sl = 16 * c + fr; p4[rg] = sl <= tl ? Sc[rg] * __builtin_amdgcn_exp2f((float)(tl - sl) * lgn) : 0.f; }
            Pk[c][0] = pk2(p4[0], p4[1]); Pk[c][1] = pk2(p4[2], p4[3]);
            asm volatile("" ::: "memory"); }
#pragma unroll
        for (int c = 0; c < 8; ++c) { o[c] = (f32x4){0.f, 0.f, 0.f, 0.f};
#pragma unroll
            for (int ks = 0; ks < 4; ++ks) { const bf16x8v sb = *(const LAS bf16x8v*)(STs + sw_off(16 * c + fr, ks * 32 + fq * 8));
                o[c] = __builtin_amdgcn_mfma_f32_16x16x32_bf16(qa[ks], sb, o[c], 0, 0, 0); }
#pragma unroll
            for (int rg = 0; rg < 4; ++rg) o[c][rg] *= __builtin_amdgcn_exp2f((float)(16 * wid + 4 * fq + rg + 1) * lgn);
            asm volatile("" ::: "memory"); }
        {
            bf16x8v va[4];
#pragma unroll
            for (int ks = 0; ks < 4; ++ks) va[ks] = *(const LAS bf16x8v*)(VTs + sw_off(16 * wid + fr, ks * 32 + fq * 8));
#pragma unroll
            for (int c = 0; c < 8; ++c) { st[c] = st[c] * cdec;
#pragma unroll
                for (int ks = 0; ks < 4; ++ks) { const bf16x8v kb = *(const LAS bf16x8v*)(KTs + sw_off(16 * c + fr, ks * 32 + fq * 8));
                    st[c] = __builtin_amdgcn_mfma_f32_16x16x32_bf16(va[ks], kb, st[c], 0, 0, 0); }
                asm volatile("" ::: "memory"); }
        }
        __syncthreads();
        v4u gq[4];
#pragma unroll
        for (int i = 0; i < 4; ++i) gq[i] = *(const GAS v4u*)(RG + (row0 + 16 * wid + (lane_n >> 4) + 4 * i) * 1024 + h * 128 + (lane_n & 15) * 8);
        bf16x8v qn[4];
        if (n + 1 < 16) { const size_t r1 = row0 + 128;
#pragma unroll
            for (int ks = 0; ks < 4; ++ks) qn[ks] = *(const GAS bf16x8v*)(RQ + (r1 + 16 * wid + fr) * 1024 + h * 128 + ks * 32 + fq * 8);
#pragma unroll
            for (int i = 0; i < 4; ++i) { const int r = lane_n + 64 * (i & 1), cc = 2 * wid + (i >> 1); const size_t go = (r1 + r) * 1024 + h * 128 + cc * 8;
                kq[i] = *(const GAS v4u*)(RK + go); vq[i] = *(const GAS v4u*)(RV + go); } }
        else {
#pragma unroll
            for (int ks = 0; ks < 4; ++ks) qn[ks] = qa[ks]; }
#pragma unroll
        for (int c = 0; c < 8; ++c)
#pragma unroll
            for (int rg = 0; rg < 4; ++rg) { const int tl = 16 * wid + 4 * fq + rg, sl = 16 * c + fr;
                *(LAS bf16*)(Ks + sw_off(tl, sl)) = (bf16)((rg & 1) ? (Pk[c][rg >> 1] >> 16) : (Pk[c][rg >> 1] & 0xffffu));
                *(LAS bf16*)(STs + sw_off(tl, sl)) = (bf16)f2bf(st[c][rg]); }
        LDS_WAIT(); asm volatile("" ::: "memory");
        bf16x8v pa[4];
#pragma unroll
        for (int ks = 0; ks < 4; ++ks) pa[ks] = *(const LAS bf16x8v*)(Ks + sw_off(16 * wid + fr, ks * 32 + fq * 8));
#pragma unroll
        for (int c = 0; c < 8; ++c) {
#pragma unroll
            for (int ks = 0; ks < 4; ++ks) { const bf16x8v vb = *(const LAS bf16x8v*)(VTs + sw_off(16 * c + fr, ks * 32 + fq * 8));
                o[c] = __builtin_amdgcn_mfma_f32_16x16x32_bf16(pa[ks], vb, o[c], 0, 0, 0); }
            asm volatile("" ::: "memory"); }
        float mu[4], rs[4];
#pragma unroll
        for (int rg = 0; rg < 4; ++rg) { float s = 0.f;
#pragma unroll
            for (int c = 0; c < 8; ++c) s += o[c][rg];
            s = pg8::xadd<1>(s); s = pg8::xadd<2>(s); s = pg8::xadd<4>(s); s = pg8::xadd<8>(s); mu[rg] = s * (1.f / 128.f);
            float q = 0.f;
#pragma unroll
            for (int c = 0; c < 8; ++c) { const float d = o[c][rg] - mu[rg]; q += d * d; }
            q = pg8::xadd<1>(q); q = pg8::xadd<2>(q); q = pg8::xadd<4>(q); q = pg8::xadd<8>(q); rs[rg] = 1.0f / sqrtf(q * (1.f / 128.f) + EPSN); }
#pragma unroll
        for (int c = 0; c < 8; ++c)
#pragma unroll
            for (int rg = 0; rg < 4; ++rg) *(LAS bf16*)(Ks + sw_off(16 * wid + 4 * fq + rg, 16 * c + fr)) = (bf16)f2bf((o[c][rg] - mu[rg]) * rs[rg] * gng[h * 128 + 16 * c + fr]);
        LDS_WAIT(); asm volatile("" ::: "memory");
#pragma unroll
        for (int i = 0; i < 4; ++i) { const int r = 16 * wid + (lane_n >> 4) + 4 * i, cc = lane_n & 15;
            const v4u y = *(const LAS v4u*)(Ks + sw_off(r, cc * 8)); const size_t go = (row0 + r) * 1024 + h * 128 + cc * 8;
            const unsigned yw[4] = {y.x, y.y, y.z, y.w}, gw4[4] = {gq[i].x, gq[i].y, gq[i].z, gq[i].w}; unsigned ow[4];
#pragma unroll
            for (int j = 0; j < 4; ++j) { const float ga = bflo(gw4[j]), gb = bfhi(gw4[j]); ow[j] = pk2(ga * sigm(ga) * bflo(yw[j]), gb * sigm(gb) * bfhi(yw[j])); }
            v4u w; w.x = ow[0]; w.y = ow[1]; w.z = ow[2]; w.w = ow[3]; *(GAS v4u*)(YRo + go) = w; }
        __syncthreads();
#pragma unroll
        for (int ks = 0; ks < 4; ++ks) qa[ks] = qn[ks];
    }
}

__device__ __forceinline__ void ph_combine(Frame& F, const Args& args, int l) {
    PH_ENTER();
    const int gw = vcu_ * NWAVES + wave, NGW = G_ * NWAVES;
    const float* dl = args.in[4] + (size_t)l * 256;
    const float s01 = wave_sum(dl[lane] * dl[64 + lane]), s23 = wave_sum(dl[128 + lane] * dl[192 + lane]);
    const float linit = 0.8f - 0.6f * expf(-0.3f * (float)l);
    const float lam = expf(s01) - expf(s23) + linit;
    const float* subln = args.in[5] + (size_t)l * 128 + (lane & 7) * 16;
    float sl[16];
#pragma unroll
    for (int i = 0; i < 16; ++i) sl[i] = subln[i] * (1.0f - linit);
    const bf16* O0 = (const bf16*)args.out; const bf16* O1 = O0 + SEG_E;
    bf16* YA = (bf16*)(ws + WS_Y);
    for (int m = gw; m < M; m += NGW) {
        const size_t off = (size_t)m * 1024 + lane * 16;
        {   const v4u a0 = *(const GAS v4u*)(O0 + off), a1 = *(const GAS v4u*)(O0 + off + 8), b0 = *(const GAS v4u*)(O1 + off), b1 = *(const GAS v4u*)(O1 + off + 8);
            const unsigned aw[8] = {a0.x, a0.y, a0.z, a0.w, a1.x, a1.y, a1.z, a1.w}, bw[8] = {b0.x, b0.y, b0.z, b0.w, b1.x, b1.y, b1.z, b1.w};
            float d[16]; float ss = 0.f;
#pragma unroll
            for (int j = 0; j < 8; ++j) { d[2 * j] = bflo(aw[j]) - lam * bflo(bw[j]); d[2 * j + 1] = bfhi(aw[j]) - lam * bfhi(bw[j]); ss += d[2 * j] * d[2 * j] + d[2 * j + 1] * d[2 * j + 1]; }
            ss = pg8::xadd<1>(ss); ss = pg8::xadd<2>(ss); ss = pg8::xadd<4>(ss);
            const float r = 1.0f / sqrtf(ss * (1.f / 128.f) + EPSN);
            unsigned ow[8];
#pragma unroll
            for (int j = 0; j < 8; ++j) ow[j] = pk2(d[2 * j] * r * sl[2 * j], d[2 * j + 1] * r * sl[2 * j + 1]);
            v4u w0; w0.x = ow[0]; w0.y = ow[1]; w0.z = ow[2]; w0.w = ow[3]; v4u w1; w1.x = ow[4]; w1.y = ow[5]; w1.z = ow[6]; w1.w = ow[7];
            *(GAS v4u*)(YA + off) = w0; *(GAS v4u*)(YA + off + 8) = w1; }
    }
}

#ifndef MK_MULTI
#define MK_MULTI 0
#endif
template <int KLO, int KHI> __global__ void __launch_bounds__(NWAVES * 64, 2) mk_fwd(Args args) {
    extern __shared__ __attribute__((aligned(16))) unsigned char lds[];
    Frame F;
    F.lds = (LAS unsigned char*)lds;
    F.MISC = (volatile LAS unsigned*)(F.lds + MISC_OFF);
    F.wave = __builtin_amdgcn_readfirstlane((int)threadIdx.x >> 6); F.G = gridDim.x; { const int bx = blockIdx.x; F.vcu = (F.G % 8 == 0) ? (bx % 8) * (F.G / 8) + bx / 8 : bx; }
    for (int u = threadIdx.x; u < (LDS_BYTES - LDSCTL_OFF) / 4; u += NWAVES * 64) ((LAS unsigned*)(F.lds + LDSCTL_OFF))[u] = 0u;
    __syncthreads();
    XcdBarrier bar; bar.bar = (unsigned*)(args.ws + WS_CTL) + CW_BAR; bar.x = 0; bar.st = nullptr;
    if (!MK_MULTI) bar = xcd_barrier_post((unsigned*)(args.ws + WS_CTL) + CW_BAR, F.MISC + 8, threadIdx.x == 0);
#ifndef REP_MASK
#define REP_MASK 0u
#endif
#define NREP(k) ((((REP_MASK) >> (k)) & 1u) ? 2 : 1)
#define IN(k) (KLO <= (k) && (k) < KHI)
#define SEAM(k) do { if (!MK_MULTI && IN(k) && IN((k) + 1)) xcd_barrier(bar, F.wave == 0 && pg8::lane_id() == 0); } while (0)
#define PHP() unsigned char* ws = pg8::uni_ptr(args.ws); bf16* const XN = (bf16*)(ws + WS_XN); bf16* const BIGp = (bf16*)(ws + WS_BIG); const int bx = pg8::opq((int)blockIdx.x), G_ = pg8::opq(F.G); (void)XN; (void)BIGp; (void)bx; (void)G_

    for (int l = args.l_lo; l < args.l_hi; ++l) {
        constexpr int pb = 0;
        const float* xcur = args.in[0];
        if (IN(pb + 0)) for (int rep_ = 0; rep_ < NREP(0); ++rep_) ph_prep(F, args, l, xcur);
        SEAM(pb + 0);
        if (IN(pb + 1)) for (int rep_ = 0; rep_ < NREP(1); ++rep_) { PHP();
            { pg8::Gemm g{XN, (const bf16*)(ws + W_IN), LD2K, LD2K, DM_}; pg8::StaticOrder S; S.init(M, INC, G_, bx, LD2K, LD2K);
              pg8::EpiInProj E{BIGp, (const float*)(ws + WS_DCS), (const float*)(ws + WS_RCS), (const float*)(ws + WS_RSS) + (l == 0 ? 0 : 3 * RSS_STRIDE)};
              pg8::gemm_phase<pg8::EpiInProj, pg8::StaticOrder, true, true>(F.lds + RING_OFF, g, S, E, F.wave); }
            if (l == 0) {
            { pg8::Gemm g{(const bf16*)(ws + WS_MN), (const bf16*)(ws + W_KV), DM_, LD2K, DM_}; pg8::StaticOrder S; S.init(MEMROWS, 2 * DM_, G_, (bx + 128) % G_, DM_, LD2K);
              pg8::EpiBf16 E{(bf16*)(ws + WS_KM), LD2K, DM_, (size_t)MEMROWS * LD2K, 1.0f, nullptr};
              pg8::gemm_phase<pg8::EpiBf16, pg8::StaticOrder, true, true>(F.lds + RING_OFF, g, S, E, F.wave); }
            { pg8::Gemm g{(const bf16*)((unsigned char*)args.out + DO_MN1), (const bf16*)((unsigned char*)args.out + DO_WKV1), DM_, LD2K, DM_}; pg8::StaticOrder S; S.init(MEMROWS, 2 * DM_, G_, bx, DM_, LD2K);
              pg8::EpiBf16 E{(bf16*)((unsigned char*)args.out + DO_KV1), LD2K, DM_, (size_t)MEMROWS * LD2K, 1.0f, nullptr};
              pg8::gemm_phase<pg8::EpiBf16, pg8::StaticOrder, true, true>(F.lds + RING_OFF, g, S, E, F.wave); }
            }
        }
        SEAM(pb + 1);
        if (IN(pb + 3)) for (int rep_ = 0; rep_ < NREP(3); ++rep_) { PHP();
            const attn_body::bf16* Qp = (const attn_body::bf16*)BIGp; const attn_body::bf16* Kp = (const attn_body::bf16*)(BIGp + SEG_E); const attn_body::bf16* Vp = (const attn_body::bf16*)(BIGp + 2 * SEG_E);
            attn_body::bf16* Op = (attn_body::bf16*)args.out;
            unsigned* qctr = (unsigned*)(ws + WS_CTL) + CW_Q + 64 * (2 * l + rep_);
            const float* fzl = (const float*)(ws + WS_LAM) + 192 * l;
            const int nch = (LATE_ITEMS + (l + 1 < DEPTH ? LATE_ITEMS_IN : 0)) / CHUNK_ITEMS;
            for (;;) {
                if (F.wave == 0 && pg8::lane_id() == 0) { const unsigned idq = __hip_atomic_fetch_add(qctr, 1u, __ATOMIC_RELAXED, __HIP_MEMORY_SCOPE_AGENT); F.MISC[12] = idq; }
                __syncthreads();
                const int idq = pg8::opq((int)__builtin_amdgcn_readfirstlane((int)F.MISC[12]));
                if (idq >= 1088 + nch) break;
                int id = idq;
                if (idq >= 64) { const int j = idq - 64;
                    if (j < 3 * nch) { const int q = j / 3, rr = j - 3 * q;
                        if (rr == 2) {
                            LAS unsigned char* scr = (LAS unsigned char*)(F.lds + RING_OFF + F.wave * 16384);
                            kargp_t kp = (kargp_t)__builtin_amdgcn_kernarg_segment_ptr(); asm volatile("" : "+s"(kp)); int lane_q = pg8::lane_id(); asm volatile("" : "+v"(lane_q));
                            for (int i = 0; i < CHUNK_ITEMS / NWAVES; ++i) late_item(kp, ws, pg8::opq(l), CHUNK_ITEMS * q + pg8::opq(F.wave) + NWAVES * i, scr, lane_q);
                            __syncthreads(); continue; }
                        id = 64 + 2 * q + rr; }
                    else id = 64 + j - nch; }
                if (id < 64) ph_ret_seq(F, args, l, id);
                else if (id >= 320 && id < 832) { const int k2 = id - 320; ph_conv(F, args, l, 2 * k2, 2 * k2 + 2); }
                else { const int j = id < 320 ? id - 64 : id - 832 + 256;
                    const int qb = 7 - (j >> 6), g = j & 63, h8 = g & 7, b = g >> 3;
                    attn_body::attn_unit_w(F.wave, b, h8, 0, qb, Qp, Kp, Vp, Op, (char*)lds + RING_OFF, nullptr, nullptr);
                    attn_body::attn_unit_w(F.wave, b, h8, 1, qb, Qp, Kp, Vp, Op, (char*)lds + RING_OFF, (attn_body::bf16*)(ws + WS_Y), fzl); }
            }
            __syncthreads();
        }
        SEAM(pb + 3);
        if (IN(pb + 5)) for (int rep_ = 0; rep_ < NREP(5); ++rep_) { PHP();
            bf16* Y = (bf16*)(ws + WS_Y);
            pg8::Gemm g{Y, (const bf16*)(ws + W_BR), MIXW, LD1K, MIXW}; pg8::MergeOrder S; S.T.init(M, DM_, G_, bx, MIXW, LD1K);
            S.ystride = (unsigned)(SEG_E * 2); S.wstride = (unsigned)((size_t)DM_ * LD1K * 2);
            pg8::EpiMerge E{BIGp + 9 * SEG_E, BIGp};
            pg8::gemm_phase<pg8::EpiMerge, pg8::MergeOrder, true, true>(F.lds + RING_OFF, g, S, E, F.wave);
        }
        SEAM(pb + 5);
        if (IN(pb + 6))
#pragma unroll
        for (int rep_ = 0; rep_ < NREP(6); ++rep_) { PHP();
            { pg8::Gemm g{BIGp, (const bf16*)(ws + W_OUT), DM_, LD2K, DM_}; pg8::StaticOrder S; S.init(M, DM_, G_, bx, DM_, LD2K);
              pg8::EpiRes E{XN, rep_ ? BIGp + 11 * SEG_E : BIGp + 8 * SEG_E, LD2K, (float*)(ws + WS_RSS) + (size_t)(rep_ ? 6 : 1 + 3 * l) * RSS_STRIDE};
              pg8::gemm_phase<pg8::EpiRes, pg8::StaticOrder, true, true>(F.lds + RING_OFF, g, S, E, F.wave); }
            { pg8::Gemm g{(const bf16*)ws, (const bf16*)ws, LD2K, LD2K, 512};
              pg8::XprodOrder S{G_, bx, (unsigned)LD2K, (unsigned)WS_KM, (unsigned)(WS_KM + (size_t)MEMROWS * LD2K * 2), (unsigned)W_Q, (unsigned)W_O};
              pg8::EpiBf16Two E{(bf16*)(ws + WS_YRAW), DM_, (bf16*)(ws + WS_YRAW) + SEG_E, 1024};
              pg8::gemm_phase<pg8::EpiBf16Two, pg8::XprodOrder, true, true>(F.lds + RING_OFF, g, S, E, F.wave); }
        }
        SEAM(pb + 6);
        if (IN(pb + 8)) for (int rep_ = 0; rep_ < NREP(8); ++rep_) { PHP();
            pg8::Gemm g{BIGp + 8 * SEG_E, (const bf16*)(ws + WS_YRAW), LD2K, DM_, DM_}; pg8::XsOrder S{G_, bx, LD2K};
            pg8::EpiSoftmax E{BIGp + 2 * SEG_E, 1024, 0.044194173824159216f * LOG2E, (const float*)(ws + WS_RSS) + (size_t)(1 + 3 * l) * RSS_STRIDE};
            pg8::gemm_phase<pg8::EpiSoftmax, pg8::XsOrder, false, true>(F.lds + RING_OFF, g, S, E, F.wave);
        }
        SEAM(pb + 8);
        if (IN(pb + 12))
#pragma unroll
        for (int rep_ = 0; rep_ < NREP(12); ++rep_) { PHP();
            pg8::Gemm g{BIGp + 2 * SEG_E, (const bf16*)(ws + WS_YRAW) + SEG_E, 1024, 1024, 1024}; pg8::XoOrder S{G_, bx};
            pg8::EpiRes E{BIGp + 8 * SEG_E, rep_ ? BIGp + 11 * SEG_E : XN, LD2K, (float*)(ws + WS_RSS) + (size_t)(rep_ ? 6 : 2 + 3 * l) * RSS_STRIDE};
            pg8::gemm_phase<pg8::EpiRes, pg8::XoOrder, true, true>(F.lds + RING_OFF, g, S, E, F.wave);
        }
        SEAM(pb + 12);
        if (IN(pb + 14)) for (int rep_ = 0; rep_ < NREP(14); ++rep_) { PHP();
            pg8::Gemm g{XN, (const bf16*)(ws + W_13), LD2K, LD2K, DM_}; pg8::StaticOrder S; S.init(M, 2 * FFH, G_, bx, LD2K, LD2K);
            pg8::EpiSwiGLU E{BIGp, FFH, (const float*)(ws + WS_RSS) + (size_t)(2 + 3 * l) * RSS_STRIDE};
            pg8::gemm_phase<pg8::EpiSwiGLU, pg8::StaticOrder, true, true>(F.lds + RING_OFF, g, S, E, F.wave);
        }
        SEAM(pb + 14);
        if (IN(pb + 15))
#pragma unroll
        for (int rep_ = 0; rep_ < NREP(15); ++rep_) { PHP();
            pg8::Gemm g{BIGp, (const bf16*)(ws + W_2), FFH, LDFF, FFH}; pg8::StaticOrder S; S.init(M, DM_, G_, bx, FFH, LDFF);
            pg8::EpiRes E{XN, rep_ ? BIGp + 11 * SEG_E : XN, LD2K, (float*)(ws + WS_RSS) + (size_t)(rep_ ? 6 : 3 + 3 * l) * RSS_STRIDE};
            pg8::gemm_phase<pg8::EpiRes, pg8::StaticOrder, true, true>(F.lds + RING_OFF, g, S, E, F.wave);
        }
        SEAM(pb + 15);
    }
    if (IN(NPH)) { PH_ENTER(); const bf16* XB = (const bf16*)(ws + WS_XN); const float* rp = (const float*)(ws + WS_RSS) + (size_t)(3 * DEPTH) * RSS_STRIDE; const int gw = vcu_ * NWAVES + wave, NGW = G_ * NWAVES;
        for (int m = gw; m < M; m += NGW) {
            float sv = lane < 32 ? rp[(size_t)m * 32 + lane] : 0.f; sv = wave_sum(sv); const float r = 1.0f / sqrtf(sv * (1.f / 2048.f) + EPSN);
            const GAS v4u* xr = (const GAS v4u*)(XB + (size_t)m * LD2K) + lane; const GAS f32x4* gr = (const GAS f32x4*)args.in[21] + 2 * lane; GAS f32x4* orow = (GAS f32x4*)(args.out + (size_t)m * DM_) + 2 * lane;
#pragma unroll
            for (int j = 0; j < 4; ++j) { const v4u x = xr[64 * j]; const f32x4 g0 = gr[128 * j], g1 = gr[128 * j + 1];
                orow[128 * j] = (f32x4){bflo(x.x) * r * g0.x, bfhi(x.x) * r * g0.y, bflo(x.y) * r * g0.z, bfhi(x.y) * r * g0.w};
                orow[128 * j + 1] = (f32x4){bflo(x.z) * r * g1.x, bfhi(x.z) * r * g1.y, bflo(x.w) * r * g1.z, bfhi(x.w) * r * g1.w}; } } }
#undef IN
#undef SEAM
}

extern "C" void kernel_launch(void* const* d_in, const int* in_sizes, int n_in, void* d_out, int out_size, void* d_ws, size_t ws_size, hipStream_t stream) {
    static int grid = 0; static bool first = true;
    if (grid == 0) {
        if (n_in != 22 || in_sizes[0] != M * DM_ || out_size != M * DM_ || ws_size < WS_END) { fprintf(stderr, "kernel_launch: unexpected shapes / workspace (n_in %d, in0 %d, out %d, ws %zu, need %zu); nothing launched\n", n_in, n_in > 0 ? in_sizes[0] : -1, out_size, ws_size, (size_t)WS_END); grid = -1; return; }
        int dev = 0, cus = 0, per_cu = 0;
        if (hipGetDevice(&dev) != hipSuccess || hipDeviceGetAttribute(&cus, hipDeviceAttributeMultiprocessorCount, dev) != hipSuccess) { grid = -1; return; }
        if (hipFuncSetAttribute((const void*)mk_fwd<MK_MULTI ? NPH : 0, NPH + 1>, hipFuncAttributeMaxDynamicSharedMemorySize, LDS_BYTES) != hipSuccess) { fprintf(stderr, "kernel_launch: hipFuncSetAttribute failed\n"); grid = -1; return; }
        if (hipOccupancyMaxActiveBlocksPerMultiprocessor(&per_cu, (const void*)mk_fwd<MK_MULTI ? NPH : 0, NPH + 1>, NWAVES * 64, LDS_BYTES) != hipSuccess || per_cu < 1) fprintf(stderr, "kernel_launch: occupancy query reports %d\n", per_cu);
        (void)hipGetLastError();
        grid = cus;
    }
    if (grid < 0) return;
    if (hipMemsetAsync((char*)d_ws + WS_CTL, 0, CTL_ZERO_BYTES, stream) != hipSuccess) return;
    Args a{};
    for (int i = 0; i < 22; ++i) a.in[i] = (const float*)d_in[i];
    a.out = (float*)d_out; a.ws = (unsigned char*)d_ws;
#if MK_MULTI
#define LAUNCH_K(K) do { if (first) (void)hipFuncSetAttribute((const void*)mk_fwd<K, K + 1>, hipFuncAttributeMaxDynamicSharedMemorySize, LDS_BYTES); hipLaunchKernelGGL((mk_fwd<K, K + 1>), dim3(grid), dim3(NWAVES * 64), LDS_BYTES, stream, a); } while (0)
    for (int l = 0; l < DEPTH; ++l) { a.l_lo = l; a.l_hi = l + 1;
        LAUNCH_K(0); LAUNCH_K(1); LAUNCH_K(2); LAUNCH_K(3); LAUNCH_K(4); LAUNCH_K(5); LAUNCH_K(6); LAUNCH_K(7); LAUNCH_K(8); LAUNCH_K(9); LAUNCH_K(10); LAUNCH_K(11); LAUNCH_K(12); LAUNCH_K(13); LAUNCH_K(14); LAUNCH_K(15); }
    a.l_lo = DEPTH; a.l_hi = DEPTH; LAUNCH_K(16);
    first = false;
#else
    a.l_lo = 0; a.l_hi = DEPTH;
    hipLaunchKernelGGL((mk_fwd<MK_MULTI ? NPH : 0, NPH + 1>), dim3(grid), dim3(NWAVES * 64), LDS_BYTES, stream, a);
#endif
}
```

```cpp
#include <hip/hip_runtime.h>
#include <hip/hip_bf16.h>
#include <cstdio>
#include <cstdint>
#include <cmath>
namespace pg8 {
#define PG8_LAS __attribute__((address_space(3)))
typedef unsigned short bf16_t;
typedef short bf16x8 __attribute__((ext_vector_type(8)));
typedef float f32x4 __attribute__((ext_vector_type(4)));
typedef float f32x2 __attribute__((ext_vector_type(2)));
typedef unsigned u32x4 __attribute__((ext_vector_type(4)));
typedef unsigned u32x2 __attribute__((ext_vector_type(2)));
constexpr int BM = 256, BK = 64, HALF = 128, HTB = HALF * BK * 2  , STAGE_BYTES = 8 * HTB, NXCD = 8, WGM = 8;

__host__ __device__ __forceinline__ int lds_byte(int r, int c) { const int st = (r >> 4) * 2 + (c >> 5), rr = r & 15, cc = c & 31, ob = rr * 64 + cc * 2; return st * 1024 + (ob ^ (((ob >> 9) & 1) << 5)); }
__host__ __device__ __forceinline__ void stage_rc(int b, int& R, int& C) { const int st = b / 1024, sb = b % 1024, swz = sb ^ (((sb >> 9) & 1) << 5); R = (st >> 1) * 16 + swz / 64; C = (st & 1) * 32 + (swz % 64) / 2; }
__host__ __device__ __forceinline__ int perm32(int rho) { const int n = rho >> 4, i = rho & 15; return 8 * (i >> 2) + 4 * n + (i & 3); }

template <class T> __device__ __forceinline__ T* uni_ptr(T* p) { const unsigned long long v = (unsigned long long)p; unsigned lo = (unsigned)v, hi = (unsigned)(v >> 32);
    asm volatile("" : "+s"(lo), "+s"(hi)); return (T*)(((unsigned long long)hi << 32) | lo); }
__device__ __forceinline__ int lane_id() { int l; asm volatile("v_mbcnt_lo_u32_b32 %0, -1, 0\n\tv_mbcnt_hi_u32_b32 %0, -1, %0" : "=v"(l)); return l; }
__device__ __forceinline__ int opq(int x) { asm volatile("" : "+s"(x)); return x; }
template <int M> __device__ __forceinline__ float xadd(float v) {
    if constexpr (M == 32) { const auto rr = __builtin_amdgcn_permlane32_swap(__float_as_uint(v), __float_as_uint(v), false, false); return __uint_as_float(rr[0]) + __uint_as_float(rr[1]); }
    else return v + __int_as_float(__builtin_amdgcn_ds_swizzle(__float_as_int(v), (M << 10) | 0x1f));
}
__device__ __forceinline__ float row_sum16(float v) {
#define PG8_DPPADD(ctrl) v += __int_as_float(__builtin_amdgcn_update_dpp(0, __float_as_int(v), ctrl, 0xf, 0xf, true))
    PG8_DPPADD(0xB1); PG8_DPPADD(0x4E); PG8_DPPADD(0x141); PG8_DPPADD(0x140); return v;
#undef PG8_DPPADD
}
struct Unit { int pm, pn; unsigned offA, offB; int sub = 0; };
struct Gemm { const bf16_t* A; const bf16_t* Bt; int lda, ldb, K; };

struct StaticOrder {
    int nM, nN, nwg, G, c; unsigned tA, tB;
    __device__ void init(int M, int N, int G_, int c_, int lda, int ldb) { nM = M / BM; nN = N / BM; nwg = nM * nN; G = G_; c = c_; tA = (unsigned)BM * lda * 2u; tB = (unsigned)BM * ldb * 2u; }
    __device__ __forceinline__ bool next(int i, Unit& u) const {
        const long L = (long)i * G + c; if (L >= nwg) return false;
        int wgid = (int)L; { const int q = nwg / NXCD, r = nwg % NXCD, xcd = wgid % NXCD, off = wgid / NXCD; wgid = (xcd < r ? xcd * (q + 1) : r * (q + 1) + (xcd - r) * q) + off; }
        const int nig = WGM * nN, gid = wgid / nig, fm = gid * WGM, gsz = (nM - fm) < WGM ? (nM - fm) : WGM;
        u.pm = fm + ((wgid % nig) % gsz); u.pn = (wgid % nig) / gsz; u.offA = (unsigned)u.pm * tA; u.offB = (unsigned)u.pn * tB; return true;
    }
    __device__ __forceinline__ void a_ready(const Unit&) const {}
    __device__ __forceinline__ void done(const Unit&) const {}
};
struct XprodOrder {
    int G, c; unsigned ld, oK, oV, oWq, oWo;
    __device__ __forceinline__ bool next(int i, Unit& u) const {
        const int L = i * G + c; if (L >= 512) return false;
        const int q = L & 255, b = q >> 5, h = (q >> 3) & 3, t = q & 7;
        if (L < 256) { u.sub = 0; u.pm = b * 4 + h; u.pn = t; u.offA = oK + ((unsigned)(b * 256) * ld + h * 512) * 2u; u.offB = oWq + ((unsigned)(t * 256) * ld + h * 512) * 2u; }
        else         { u.sub = 1; u.pm = b * 8 + t; u.pn = h; u.offA = oWo + ((unsigned)(t * 256) * ld + h * 512) * 2u; u.offB = oV + ((unsigned)(b * 256) * ld + h * 512) * 2u; }
        return true;
    }
    __device__ __forceinline__ void a_ready(const Unit&) const {}
    __device__ __forceinline__ void done(const Unit&) const {}
};
struct XsOrder {
    int G, c, lda;
    __device__ __forceinline__ bool next(int i, Unit& u) const {
        const int L = i * G + c; if (L >= 256) return false;
        const int b = L >> 5, rt = (L >> 2) & 7, h = L & 3;
        u.pm = b * 8 + rt; u.pn = h; u.offA = ((unsigned)(b * 2048 + rt * 256) * (unsigned)lda) * 2u; u.offB = ((unsigned)(b * 1024 + h * 256) * 2048u) * 2u; return true;
    }
    __device__ __forceinline__ void a_ready(const Unit&) const {}
    __device__ __forceinline__ void done(const Unit&) const {}
};
struct XoOrder {
    int G, c;
    __device__ __forceinline__ bool next(int i, Unit& u) const {
        const int L = i * G + c; if (L >= 512) return false;
        const int b = L >> 6, rt = (L >> 3) & 7, ct = L & 7;
        u.pm = b * 8 + rt; u.pn = ct; u.offA = ((unsigned)(b * 2048 + rt * 256) * 1024u) * 2u; u.offB = ((unsigned)(b * 2048 + ct * 256) * 1024u) * 2u; return true;
    }
    __device__ __forceinline__ void a_ready(const Unit&) const {}
    __device__ __forceinline__ void done(const Unit&) const {}
};

__device__ __forceinline__ unsigned cvt_pk_bf16(float lo, float hi) { unsigned r; asm volatile("v_cvt_pk_bf16_f32 %0, %1, %2" : "=v"(r) : "v"(lo), "v"(hi)); return r; }
__device__ __forceinline__ float bf_lo(unsigned w) { return __uint_as_float(w << 16); }
__device__ __forceinline__ float bf_hi(unsigned w) { return __uint_as_float(w & 0xffff0000u); }
__device__ __forceinline__ float sigmoidf_(float x) { return __builtin_amdgcn_rcpf(1.0f + __builtin_amdgcn_exp2f(-1.4426950408889634f * x)); }

__device__ __forceinline__ void row_rs8(float (&rs)[2][4], const float* rssp, int row0, int fq) {
    f32x4 a[2][4], b[2][4];
#pragma unroll
    for (int ai = 0; ai < 2; ++ai)
#pragma unroll
        for (int m = 0; m < 4; ++m) { const float* p = rssp + ((size_t)(2 * fq) * 16384 + (size_t)(row0 + ai * HALF + m * 16)) * 4; a[ai][m] = *(const f32x4*)p; b[ai][m] = *(const f32x4*)(p + (size_t)16384 * 4); }
#pragma unroll
    for (int ai = 0; ai < 2; ++ai)
#pragma unroll
        for (int m = 0; m < 4; ++m) { float s = ((a[ai][m][0] + a[ai][m][1]) + (a[ai][m][2] + a[ai][m][3])) + ((b[ai][m][0] + b[ai][m][1]) + (b[ai][m][2] + b[ai][m][3]));
            s = pg8::xadd<16>(s); s = pg8::xadd<32>(s); rs[ai][m] = __builtin_amdgcn_rsqf(s * (1.0f / 2048.0f) + 1e-6f); }
}
struct EpiBf16 {
    static constexpr bool PERM = true, AFTER_DRAIN = false, MULTI = false;
    bf16_t* O; int ldc; int split_cols; size_t split_stride; float scale; const float* rss;
    __device__ __forceinline__ void operator()(const f32x4 (&acc)[2][2][4][2], const Unit& u, int wr, int wc, int fr, int fq) const {
        const int row0 = u.pm * BM + wr * 64 + fr; int colt = u.pn * BM; bf16_t* base = O;
        if (split_cols) { const int t = colt / split_cols; base += (size_t)t * split_stride; colt -= t * split_cols; }
        const int col0 = colt + wc * 32 + 8 * fq; const float sc = scale;
        float rs[2][4];
        if (rss) row_rs8(rs, rss, row0, fq);
#pragma unroll
        for (int ai = 0; ai < 2; ++ai)
#pragma unroll
            for (int m = 0; m < 4; ++m) { bf16_t* rowp = base + (size_t)(row0 + ai * HALF + m * 16) * ldc + col0;
                const float sr = rss ? sc * rs[ai][m] : sc;
#pragma unroll
                for (int bj = 0; bj < 2; ++bj) { const f32x4 v0 = acc[ai][bj][m][0] * sr, v1 = acc[ai][bj][m][1] * sr;
                    u32x4 w; w.x = cvt_pk_bf16(v0[0], v0[1]); w.y = cvt_pk_bf16(v0[2], v0[3]); w.z = cvt_pk_bf16(v1[0], v1[1]); w.w = cvt_pk_bf16(v1[2], v1[3]);
                    *(u32x4*)(rowp + bj * HALF) = w; } }
    }
};
struct EpiBf16Two {
    static constexpr bool PERM = true, AFTER_DRAIN = false, MULTI = false;
    bf16_t* O0; int ld0; bf16_t* O1; int ld1;
    __device__ __forceinline__ void operator()(const f32x4 (&acc)[2][2][4][2], const Unit& u, int wr, int wc, int fr, int fq) const {
        bf16_t* base = u.sub ? O1 : O0; const int ldc = u.sub ? ld1 : ld0;
        const int row0 = u.pm * BM + wr * 64 + fr, col0 = u.pn * BM + wc * 32 + 8 * fq;
#pragma unroll
        for (int ai = 0; ai < 2; ++ai)
#pragma unroll
            for (int m = 0; m < 4; ++m) { bf16_t* rowp = base + (size_t)(row0 + ai * HALF + m * 16) * ldc + col0;
#pragma unroll
                for (int bj = 0; bj < 2; ++bj) { const f32x4 v0 = acc[ai][bj][m][0], v1 = acc[ai][bj][m][1];
                    u32x4 w; w.x = cvt_pk_bf16(v0[0], v0[1]); w.y = cvt_pk_bf16(v0[2], v0[3]); w.z = cvt_pk_bf16(v1[0], v1[1]); w.w = cvt_pk_bf16(v1[2], v1[3]);
                    *(u32x4*)(rowp + bj * HALF) = w; } }
    }
};
struct EpiInProj {
    static constexpr bool PERM = true, AFTER_DRAIN = false, MULTI = false;
    bf16_t* BIG; const float* dcs; const float* rcs; const float* rss;
    __device__ __forceinline__ void operator()(const f32x4 (&acc)[2][2][4][2], const Unit& u, int wr, int wc, int fr, int fq) const {
        const int pn = u.pn; const int row0 = u.pm * BM + wr * 64 + fr; const size_t SEGE = (size_t)16384 * 1024;
        const int cw = wc * 32 + 8 * fq;
        float rs[2][4]; row_rs8(rs, rss, row0, fq);
        if (pn < 8 || (pn >= 20 && pn < 28)) {
            const bool isd = pn < 8; const int seg = isd ? (pn >> 2) : 5 + ((pn - 20) >> 2);
            const float sc = pn < 4 ? 0.125f * 1.4426950408889634f : (pn >= 20 && pn < 24) ? 0.08838834764831845f : 1.0f;
            const int i0 = isd ? ((cw & 63) >> 1) : ((cw & 127) >> 1);
            bf16_t* base = BIG + (size_t)seg * SEGE + (pn & 3) * BM + cw;
#pragma unroll
            for (int ai = 0; ai < 2; ++ai)
#pragma unroll
              for (int mp = 0; mp < 2; ++mp) {
                f32x4 ta[2], tb4[2];
#pragma unroll
                for (int mm = 0; mm < 2; ++mm) { const int t = (row0 + ai * HALF + (2 * mp + mm) * 16) & 2047;
                    const float* tb = isd ? dcs + ((size_t)t * 32 + i0) * 2 : rcs + ((size_t)t * 64 + i0) * 2; ta[mm] = *(const f32x4*)tb; tb4[mm] = *(const f32x4*)(tb + 4); }
#pragma unroll
                for (int mm = 0; mm < 2; ++mm) { const int m = 2 * mp + mm; const int row = row0 + ai * HALF + m * 16; const float sr = sc * rs[ai][m]; const f32x4 t0 = ta[mm], t1 = tb4[mm];
#pragma unroll
                    for (int bj = 0; bj < 2; ++bj) { const f32x4 v0 = acc[ai][bj][m][0], v1 = acc[ai][bj][m][1];
                        const float y0 = (v0[0] * t0[0] - v0[1] * t0[1]) * sr, y1 = (v0[1] * t0[0] + v0[0] * t0[1]) * sr, y2 = (v0[2] * t0[2] - v0[3] * t0[3]) * sr, y3 = (v0[3] * t0[2] + v0[2] * t0[3]) * sr;
                        const float y4 = (v1[0] * t1[0] - v1[1] * t1[1]) * sr, y5 = (v1[1] * t1[0] + v1[0] * t1[1]) * sr, y6 = (v1[2] * t1[2] - v1[3] * t1[3]) * sr, y7 = (v1[3] * t1[2] + v1[2] * t1[3]) * sr;
                        u32x4 w; w.x = cvt_pk_bf16(y0, y1); w.y = cvt_pk_bf16(y2, y3); w.z = cvt_pk_bf16(y4, y5); w.w = cvt_pk_bf16(y6, y7);
                        *(u32x4*)(base + (size_t)row * 1024 + bj * HALF) = w; } }
                asm volatile("" ::: "memory"); }
        } else if (pn >= 12 && pn < 20) {
            bf16_t* base = BIG + 3 * SEGE + (pn - 12) * (BM / 2) + (cw >> 1);
#pragma unroll
            for (int ai = 0; ai < 2; ++ai)
#pragma unroll
                for (int m = 0; m < 4; ++m) { bf16_t* rowp = base + (size_t)(row0 + ai * HALF + m * 16) * 1024; const float sr = rs[ai][m];
#pragma unroll
                    for (int bj = 0; bj < 2; ++bj) { const f32x4 v0 = acc[ai][bj][m][0] * sr, v1 = acc[ai][bj][m][1] * sr;
                        u32x2 w; w.x = cvt_pk_bf16(v0[0] * sigmoidf_(v0[1]), v0[2] * sigmoidf_(v0[3])); w.y = cvt_pk_bf16(v1[0] * sigmoidf_(v1[1]), v1[2] * sigmoidf_(v1[3]));
                        *(u32x2*)(rowp + bj * (HALF / 2)) = w; } }
        } else {
            bf16_t* base = BIG + (size_t)(pn >> 2) * SEGE + (pn & 3) * BM + cw; const bool sg = pn >= 36;
#pragma unroll
            for (int ai = 0; ai < 2; ++ai)
#pragma unroll
                for (int m = 0; m < 4; ++m) { bf16_t* rowp = base + (size_t)(row0 + ai * HALF + m * 16) * 1024; const float sr = rs[ai][m];
#pragma unroll
                    for (int bj = 0; bj < 2; ++bj) { f32x4 v0 = acc[ai][bj][m][0] * sr, v1 = acc[ai][bj][m][1] * sr;
                        if (sg) { v0[0] = sigmoidf_(v0[0]); v0[1] = sigmoidf_(v0[1]); v0[2] = sigmoidf_(v0[2]); v0[3] = sigmoidf_(v0[3]); v1[0] = sigmoidf_(v1[0]); v1[1] = sigmoidf_(v1[1]); v1[2] = sigmoidf_(v1[2]); v1[3] = sigmoidf_(v1[3]); }
                        u32x4 w; w.x = cvt_pk_bf16(v0[0], v0[1]); w.y = cvt_pk_bf16(v0[2], v0[3]); w.z = cvt_pk_bf16(v1[0], v1[1]); w.w = cvt_pk_bf16(v1[2], v1[3]);
                        *(u32x4*)(rowp + bj * HALF) = w; } }
        }
    }
};
struct EpiSoftmax {
    static constexpr bool PERM = true, AFTER_DRAIN = true, MULTI = false;
    bf16_t* P; int ldp; float sc; const float* rss;
    __device__ __forceinline__ void fused(f32x4 (&acc)[2][2][4][2], const Unit& u, int wr, int wc, int fr, int fq, PG8_LAS unsigned char* lds, int wid, int lane) const {
        PG8_LAS float* Ps = (PG8_LAS float*)lds;
        const int row0 = u.pm * BM + wr * 64 + fr;
        float rs[2][4]; row_rs8(rs, rss, row0, fq);
#pragma unroll
        for (int ai = 0; ai < 2; ++ai)
#pragma unroll
            for (int m = 0; m < 4; ++m) { const float k = sc * rs[ai][m]; float t = 0.f;
#pragma unroll
                for (int bj = 0; bj < 2; ++bj)
#pragma unroll
                    for (int n = 0; n < 2; ++n) { f32x4 e = acc[ai][bj][m][n] * k; e[0] = __builtin_amdgcn_exp2f(e[0]); e[1] = __builtin_amdgcn_exp2f(e[1]); e[2] = __builtin_amdgcn_exp2f(e[2]); e[3] = __builtin_amdgcn_exp2f(e[3]);
                        acc[ai][bj][m][n] = e; t += (e[0] + e[1]) + (e[2] + e[3]); }
                t = pg8::xadd<16>(t); t = pg8::xadd<32>(t);
                if (fq == 0) Ps[(ai * HALF + wr * 64 + m * 16 + fr) * 4 + wc] = t; }
        asm volatile("s_waitcnt lgkmcnt(0)" ::: "memory"); __builtin_amdgcn_s_barrier(); asm volatile("" ::: "memory");
#pragma unroll
        for (int ai = 0; ai < 2; ++ai)
#pragma unroll
            for (int m = 0; m < 4; ++m) { const f32x4 q = *(const PG8_LAS f32x4*)(Ps + (ai * HALF + wr * 64 + m * 16 + fr) * 4); const float inv = 1.0f / ((q[0] + q[1]) + (q[2] + q[3]));
                bf16_t* rowp = P + (size_t)(row0 + ai * HALF + m * 16) * ldp + u.pn * BM + wc * 32 + 8 * fq;
#pragma unroll
                for (int bj = 0; bj < 2; ++bj) { const f32x4 v0 = acc[ai][bj][m][0] * inv, v1 = acc[ai][bj][m][1] * inv;
                    u32x4 w; w.x = cvt_pk_bf16(v0[0], v0[1]); w.y = cvt_pk_bf16(v0[2], v0[3]); w.z = cvt_pk_bf16(v1[0], v1[1]); w.w = cvt_pk_bf16(v1[2], v1[3]);
                    *(u32x4*)(rowp + bj * HALF) = w; } }
        asm volatile("s_waitcnt lgkmcnt(0)" ::: "memory"); __builtin_amdgcn_s_barrier(); asm volatile("" ::: "memory");
    }
};
struct EpiRes {
    static constexpr bool PERM = true, AFTER_DRAIN = false, MULTI = false;
    const bf16_t* xo; bf16_t* xb; int ldx; float* rssp;
    __device__ __forceinline__ void operator()(const f32x4 (&acc)[2][2][4][2], const Unit& u, int wr, int wc, int fr, int fq) const {
        const int col0 = u.pn * BM + wc * 32 + 8 * fq;
#pragma unroll
        for (int ai = 0; ai < 2; ++ai) {
            u32x4 ro[4][2];
#pragma unroll
            for (int m = 0; m < 4; ++m)
#pragma unroll
                for (int bj = 0; bj < 2; ++bj) ro[m][bj] = *(const u32x4*)(xo + (size_t)(u.pm * BM + ai * HALF + wr * 64 + m * 16 + fr) * ldx + col0 + bj * HALF);
#pragma unroll
            for (int m = 0; m < 4; ++m) { const int row = u.pm * BM + ai * HALF + wr * 64 + m * 16 + fr; float ss = 0.f;
#pragma unroll
                for (int bj = 0; bj < 2; ++bj) { const u32x4 o = ro[m][bj];
                    f32x4 v0 = acc[ai][bj][m][0], v1 = acc[ai][bj][m][1];
                    v0[0] += bf_lo(o.x); v0[1] += bf_hi(o.x); v0[2] += bf_lo(o.y); v0[3] += bf_hi(o.y); v1[0] += bf_lo(o.z); v1[1] += bf_hi(o.z); v1[2] += bf_lo(o.w); v1[3] += bf_hi(o.w);
                    ss += ((v0[0] * v0[0] + v0[1] * v0[1]) + (v0[2] * v0[2] + v0[3] * v0[3])) + ((v1[0] * v1[0] + v1[1] * v1[1]) + (v1[2] * v1[2] + v1[3] * v1[3]));
                    u32x4 w; w.x = cvt_pk_bf16(v0[0], v0[1]); w.y = cvt_pk_bf16(v0[2], v0[3]); w.z = cvt_pk_bf16(v1[0], v1[1]); w.w = cvt_pk_bf16(v1[2], v1[3]);
                    *(u32x4*)(xb + (size_t)row * ldx + col0 + bj * HALF) = w; }
                ss = pg8::xadd<16>(ss); ss = pg8::xadd<32>(ss);
                if (fq == 0) rssp[((size_t)u.pn * 16384 + (size_t)row) * 4 + wc] = ss; }
            asm volatile("" ::: "memory"); }
    }
};
struct EpiMerge {
    static constexpr bool PERM = true, AFTER_DRAIN = false, MULTI = true;
    const bf16_t* gates; bf16_t* merged;
    __device__ __forceinline__ void step(f32x4 (&acc)[2][2][4][2], const Unit& u, int wr, int wc, int fr, int fq) const {
        const size_t SEGE = (size_t)16384 * 1024; const int sub = u.sub; const bool last = sub == 2;
        const int row0 = u.pm * BM + wr * 64 + fr; const int gcol = (u.pn & 3) * BM + wc * 32 + 8 * fq;
        const bf16_t* ga = gates + (size_t)(2 * sub + (u.pn >> 2)) * SEGE + gcol;
        const bf16_t* gb = last ? ga : ga + 2 * SEGE;
#pragma unroll
        for (int ai = 0; ai < 2; ++ai)
#pragma unroll
            for (int m = 0; m < 4; ++m) {
                u32x4 za[2], zb[2];
#pragma unroll
                for (int bj = 0; bj < 2; ++bj) { const size_t p = (size_t)(row0 + ai * HALF + m * 16) * 1024 + bj * HALF; za[bj] = *(const u32x4*)(ga + p); zb[bj] = *(const u32x4*)(gb + p); }
#pragma unroll
                for (int bj = 0; bj < 2; ++bj) { const unsigned aw[4] = {za[bj].x, za[bj].y, za[bj].z, za[bj].w}; unsigned bw[4] = {zb[bj].x, zb[bj].y, zb[bj].z, zb[bj].w};
                    float f[8];
#pragma unroll
                    for (int j = 0; j < 4; ++j) { if (last) bw[j] = 0x3f803f80u; f[2 * j] = bf_lo(aw[j]) * __builtin_amdgcn_rcpf(bf_lo(bw[j])); f[2 * j + 1] = bf_hi(aw[j]) * __builtin_amdgcn_rcpf(bf_hi(bw[j])); }
                    f32x4 v0 = acc[ai][bj][m][0], v1 = acc[ai][bj][m][1];
                    v0[0] *= f[0]; v0[1] *= f[1]; v0[2] *= f[2]; v0[3] *= f[3]; v1[0] *= f[4]; v1[1] *= f[5]; v1[2] *= f[6]; v1[3] *= f[7];
                    acc[ai][bj][m][0] = v0; acc[ai][bj][m][1] = v1;
                    if (last) { u32x4 w; w.x = cvt_pk_bf16(v0[0], v0[1]); w.y = cvt_pk_bf16(v0[2], v0[3]); w.z = cvt_pk_bf16(v1[0], v1[1]); w.w = cvt_pk_bf16(v1[2], v1[3]);
                        *(u32x4*)(merged + (size_t)(row0 + ai * HALF + m * 16) * 2048 + u.pn * BM + wc * 32 + 8 * fq + bj * HALF) = w; } }
                if (m & 1) asm volatile("" ::: "memory"); }
    }
};
struct MergeOrder {
    StaticOrder T; unsigned ystride, wstride;
    __device__ __forceinline__ bool next(int i, Unit& u) const {
        const int ti = i / 3, sub = i - 3 * ti;
        if (!T.next(ti, u)) return false;
        u.sub = sub; u.offA += (unsigned)sub * ystride; u.offB += (unsigned)sub * wstride; return true;
    }
    __device__ __forceinline__ void a_ready(const Unit&) const {}
    __device__ __forceinline__ void done(const Unit&) const {}
};
struct EpiSwiGLU {
    static constexpr bool PERM = true, AFTER_DRAIN = false, MULTI = false;
    bf16_t* O; int ldo; const float* rss;
    __device__ __forceinline__ void operator()(const f32x4 (&acc)[2][2][4][2], const Unit& u, int wr, int wc, int fr, int fq) const {
        const int row0 = u.pm * BM + wr * 64 + fr; const int j0 = (u.pn * BM + wc * 32 + 8 * fq) >> 1;
        float rs[2][4]; row_rs8(rs, rss, row0, fq);
#pragma unroll
        for (int ai = 0; ai < 2; ++ai)
#pragma unroll
            for (int m = 0; m < 4; ++m) { bf16_t* rowp = O + (size_t)(row0 + ai * HALF + m * 16) * ldo + j0; const float sr = rs[ai][m];
#pragma unroll
                for (int bj = 0; bj < 2; ++bj) { const f32x4 v0 = acc[ai][bj][m][0] * sr, v1 = acc[ai][bj][m][1] * sr;
                    const float o0 = v0[0] * sigmoidf_(v0[0]) * v0[1], o1 = v0[2] * sigmoidf_(v0[2]) * v0[3], o2 = v1[0] * sigmoidf_(v1[0]) * v1[1], o3 = v1[2] * sigmoidf_(v1[2]) * v1[3];
                    u32x2 w; w.x = cvt_pk_bf16(o0, o1); w.y = cvt_pk_bf16(o2, o3);
                    *(u32x2*)(rowp + bj * (HALF / 2)) = w; } }
    }
};

template <class Epi, class Sched, bool ALIGN_EPI = false, bool SP2 = false>
__device__ __forceinline__ void gemm_phase(PG8_LAS unsigned char* lds, const Gemm g, const Sched& S, const Epi& E, const int wave_sg) {
    int tid_ = opq(wave_sg) * 64 + lane_id(); asm volatile("" : "+v"(tid_));
    const char* gA = uni_ptr((const char*)g.A); const char* gB = uni_ptr((const char*)g.Bt);
    const int tid = tid_, wid = __builtin_amdgcn_readfirstlane(tid >> 6), lane = tid & 63, wr = wid >> 2, wc = wid & 3, fr = lane & 15, fq = lane >> 4;
    int K_ = g.K; asm volatile("" : "+s"(K_));
    const int K = K_, nt = K / BK;
    unsigned voffA[2], voffB[2];
#pragma unroll
    for (int i = 0; i < 2; ++i) { int R, C; stage_rc(tid * 16 + i * 8192, R, C); const int Rb = Epi::PERM ? ((R & ~31) + perm32(R & 31)) : R;
        voffA[i] = (unsigned)(R * g.lda + C) * 2u; voffB[i] = (unsigned)(Rb * g.ldb + C) * 2u; }
    const size_t kstep = (size_t)(BK * 2);
    const unsigned hsA = (unsigned)HALF * g.lda * 2u, hsB = (unsigned)HALF * g.ldb * 2u;
    const unsigned ldsw = (unsigned)wid * 1024u;
    const int aoff = lds_byte(wr * 64 + fr, fq * 8), boff = lds_byte(wc * 32 + fr, fq * 8);
#define PG8_SA(b, h) (((b) * 2 + (h)) * HTB)
#define PG8_SB(b, h) ((4 + (b) * 2 + (h)) * HTB)
#define PG8_STAGE(bufoff, gbase, voff) do { _Pragma("unroll") for (int _i = 0; _i < 2; ++_i) \
        __builtin_amdgcn_global_load_lds((const unsigned*)((const char*)(gbase) + (voff)[_i]), (PG8_LAS unsigned*)(lds + (bufoff) + ldsw + _i * 8192), 16, 0, 0); } while (0)
#define PG8_LDA(dst, b, h) do { _Pragma("unroll") for (int m = 0; m < 4; ++m) _Pragma("unroll") for (int k = 0; k < 2; ++k) dst[m][k] = *(const PG8_LAS bf16x8*)(lds + PG8_SA(b, h) + aoff + m * 2048 + k * 1024); } while (0)
#define PG8_LDB(dst, b, h) do { _Pragma("unroll") for (int n = 0; n < 2; ++n) _Pragma("unroll") for (int k = 0; k < 2; ++k) dst[n][k] = *(const PG8_LAS bf16x8*)(lds + PG8_SB(b, h) + boff + n * 2048 + k * 1024); } while (0)
#define PG8_MMA(ai, bj, At, Bt) do { __builtin_amdgcn_s_setprio(1); _Pragma("unroll") for (int m = 0; m < 4; ++m) _Pragma("unroll") for (int n = 0; n < 2; ++n) _Pragma("unroll") for (int k = 0; k < 2; ++k) \
        asm volatile("v_mfma_f32_16x16x32_bf16 %0, %1, %2, %0" : "+v"(acc[ai][bj][m][n]) : "v"(Bt[n][k]), "v"(At[m][k])); __builtin_amdgcn_s_setprio(0); } while (0)
#define PG8_WAIT_V(n) asm volatile("s_waitcnt vmcnt(" #n ")" ::: "memory")
#define PG8_WAIT_L(n) asm volatile("s_waitcnt lgkmcnt(" #n ")" ::: "memory")
#define PG8_BAR __builtin_amdgcn_s_barrier()
#define PG8_SCHED __builtin_amdgcn_sched_barrier(0)
    Unit cur, nxt; int ui = 0;
    if (!S.next(0, cur)) return;
    f32x4 acc[2][2][4][2];
#pragma unroll
    for (int a = 0; a < 2; ++a)
#pragma unroll
        for (int b = 0; b < 2; ++b)
#pragma unroll
            for (int m = 0; m < 4; ++m)
#pragma unroll
                for (int n = 0; n < 2; ++n) acc[a][b][m][n] = (f32x4){0.f, 0.f, 0.f, 0.f};
    bf16x8 At[4][2], B0[2][2], B1[2][2];
    const char* cA = gA + cur.offA; const char* cB = gB + cur.offB;
    S.a_ready(cur);
    if constexpr (SP2) {
        PG8_STAGE(PG8_SB(0, 0), cB, voffB); PG8_STAGE(PG8_SB(0, 1), cB + hsB, voffB); PG8_STAGE(PG8_SA(0, 0), cA, voffA); PG8_STAGE(PG8_SA(0, 1), cA + hsA, voffA);
        if (wr == 1) PG8_BAR;
        PG8_WAIT_V(2); PG8_BAR;
        PG8_STAGE(PG8_SB(1, 0), cB + kstep, voffB); PG8_STAGE(PG8_SA(1, 0), cA + kstep, voffA); PG8_STAGE(PG8_SB(1, 1), cB + hsB + kstep, voffB);
        PG8_WAIT_V(6); PG8_BAR;
    } else {
        PG8_STAGE(PG8_SB(0, 0), cB, voffB); PG8_STAGE(PG8_SA(0, 0), cA, voffA); PG8_STAGE(PG8_SB(0, 1), cB + hsB, voffB); PG8_STAGE(PG8_SA(0, 1), cA + hsA, voffA);
        if (wr == 1) PG8_BAR;
        PG8_WAIT_V(4); PG8_BAR;
        PG8_STAGE(PG8_SB(1, 0), cB + kstep, voffB); PG8_STAGE(PG8_SA(1, 0), cA + kstep, voffA); PG8_STAGE(PG8_SB(1, 1), cB + hsB + kstep, voffB);
        PG8_WAIT_V(6); PG8_BAR;
    }
    for (;;) {
        const bool has_next = S.next(ui + 1, nxt);
        const char* nA = has_next ? gA + nxt.offA : cA; const char* nB = has_next ? gB + nxt.offB : cB;
        for (int t = 0; t < nt; t += 2) {
            const bool last = (t == nt - 2);
            const char* a1 = cA + (size_t)(t + 1) * kstep;
            const char* a2 = last ? nA : cA + (size_t)(t + 2) * kstep; const char* b2 = last ? nB : cB + (size_t)(t + 2) * kstep;
            const char* a3 = a2 + kstep; const char* b3 = b2 + kstep;
            if (last && has_next) S.a_ready(nxt);
            if constexpr (SP2) {
            PG8_LDB(B0, 0, 0); PG8_LDB(B1, 0, 1); PG8_SCHED; PG8_LDA(At, 0, 0); PG8_STAGE(PG8_SA(1, 1), a1 + hsA, voffA);
            PG8_WAIT_V(8); PG8_WAIT_L(0); PG8_BAR; PG8_MMA(0, 0, At, B0); PG8_MMA(0, 1, At, B1); PG8_BAR; PG8_SCHED;
            PG8_LDA(At, 0, 1); PG8_STAGE(PG8_SB(0, 0), b2, voffB); PG8_STAGE(PG8_SB(0, 1), b2 + hsB, voffB); PG8_STAGE(PG8_SA(0, 0), a2, voffA);
            PG8_WAIT_V(8); PG8_WAIT_L(0); PG8_BAR; PG8_MMA(1, 0, At, B0); PG8_MMA(1, 1, At, B1); PG8_BAR; PG8_SCHED;
            PG8_LDB(B0, 1, 0); PG8_LDB(B1, 1, 1); PG8_SCHED; PG8_LDA(At, 1, 0); PG8_STAGE(PG8_SA(0, 1), a2 + hsA, voffA);
            PG8_WAIT_V(8); PG8_WAIT_L(0); PG8_BAR; PG8_MMA(0, 0, At, B0); PG8_MMA(0, 1, At, B1); PG8_BAR; PG8_SCHED;
            PG8_LDA(At, 1, 1); PG8_STAGE(PG8_SB(1, 0), b3, voffB); PG8_STAGE(PG8_SB(1, 1), b3 + hsB, voffB); PG8_STAGE(PG8_SA(1, 0), a3, voffA);
            PG8_WAIT_V(8); PG8_WAIT_L(0); PG8_BAR; PG8_MMA(1, 0, At, B0); PG8_MMA(1, 1, At, B1); PG8_BAR; PG8_SCHED;
            } else {
            PG8_LDB(B0, 0, 0); PG8_SCHED; PG8_LDA(At, 0, 0); PG8_STAGE(PG8_SA(1, 1), a1 + hsA, voffA);
            PG8_WAIT_L(8); PG8_BAR; PG8_WAIT_L(0); PG8_MMA(0, 0, At, B0); PG8_BAR; PG8_SCHED;
            PG8_LDB(B1, 0, 1); PG8_STAGE(PG8_SB(0, 0), b2, voffB);
            PG8_BAR; PG8_WAIT_L(0); PG8_MMA(0, 1, At, B1); PG8_BAR;
            PG8_LDA(At, 0, 1); PG8_STAGE(PG8_SA(0, 0), a2, voffA);
            PG8_BAR; PG8_WAIT_L(0); PG8_MMA(1, 0, At, B0); PG8_BAR; PG8_SCHED;
            PG8_STAGE(PG8_SB(0, 1), b2 + hsB, voffB);
            PG8_WAIT_V(6); PG8_BAR; PG8_MMA(1, 1, At, B1); PG8_BAR;
            PG8_LDB(B0, 1, 0); PG8_SCHED; PG8_LDA(At, 1, 0); PG8_STAGE(PG8_SA(0, 1), a2 + hsA, voffA);
            PG8_WAIT_L(8); PG8_BAR; PG8_WAIT_L(0); PG8_MMA(0, 0, At, B0); PG8_BAR; PG8_SCHED;
            PG8_LDB(B1, 1, 1); PG8_STAGE(PG8_SB(1, 0), b3, voffB);
            PG8_BAR; PG8_WAIT_L(0); PG8_MMA(0, 1, At, B1); PG8_BAR;
            PG8_LDA(At, 1, 1); PG8_STAGE(PG8_SA(1, 0), a3, voffA);
            PG8_BAR; PG8_WAIT_L(0); PG8_MMA(1, 0, At, B0); PG8_BAR; PG8_SCHED;
            PG8_STAGE(PG8_SB(1, 1), b3 + hsB, voffB);
            PG8_WAIT_V(6); PG8_BAR; PG8_MMA(1, 1, At, B1); PG8_BAR;
            }
        }
        if constexpr (ALIGN_EPI) { if (wr == 0) PG8_BAR; }
        asm volatile("s_nop 15\n\ts_nop 15" ::: "memory");
        if constexpr (Epi::MULTI) { E.step(acc, cur, wr, wc, fr, fq); S.done(cur); }
        else if constexpr (!Epi::AFTER_DRAIN) { E(acc, cur, wr, wc, fr, fq);
#if defined(EPI_TWICE)
            if constexpr (Epi::PERM) { asm volatile("" ::: "memory"); E(acc, cur, wr, wc, fr, fq); }
#endif
            S.done(cur); }
        if (!has_next) break;
        if (!Epi::MULTI || cur.sub == 2) {
#pragma unroll
        for (int a = 0; a < 2; ++a)
#pragma unroll
            for (int b = 0; b < 2; ++b)
#pragma unroll
                for (int m = 0; m < 4; ++m)
#pragma unroll
                    for (int n = 0; n < 2; ++n) acc[a][b][m][n] = (f32x4){0.f, 0.f, 0.f, 0.f}; }
        cur = nxt; cA = nA; cB = nB; ++ui;
        if constexpr (ALIGN_EPI) { if (wr == 1) PG8_BAR; }
    }
    PG8_WAIT_V(0);
    if constexpr (!ALIGN_EPI) { if (wr == 0) PG8_BAR; }
    PG8_BAR;
    if constexpr (Epi::AFTER_DRAIN) { E.fused(acc, cur, wr, wc, fr, fq, lds, wid, lane); S.done(cur); }
#undef PG8_SA
#undef PG8_SB
#undef PG8_STAGE
#undef PG8_LDA
#undef PG8_LDB
#undef PG8_MMA
#undef PG8_WAIT_V
#undef PG8_WAIT_L
#undef PG8_BAR
#undef PG8_SCHED
}
}

#include <hip/hip_bf16.h>
#include <cmath>
namespace attn_body {
using bf16=__hip_bfloat16;
using bf16x8=__attribute__((ext_vector_type(8)))short;
using s16x4=__attribute__((ext_vector_type(4)))short;
using f32x16=__attribute__((ext_vector_type(16)))float;
using u32x4=__attribute__((ext_vector_type(4)))unsigned;
constexpr int BATCH=8,NHEAD=16,SEQ=2048,D=64,DM=NHEAD*D;
constexpr int NW=8,QBLK=32,QB=QBLK*NW,KVBLK=64,NQB=SEQ/QB;
constexpr int ATTN_PITCH=DM, ATTN_UNIT_ROWS=QB;
__device__ __forceinline__ int crow(int r,int hi){return (r&3)+8*(r>>2)+4*hi;}
#define SBAR() __builtin_amdgcn_sched_barrier(0)
__device__ __forceinline__ void cmask(f32x16&p0,f32x16&p1,int jb,int qrel,int hi){
  const float NEG=-INFINITY; int kb=64*jb+4*hi;
  #pragma unroll
  for(int r=0;r<16;++r){int kv=kb+(r&3)+8*(r>>2); if(kv>qrel)p0[r]=NEG; if(kv+32>qrel)p1[r]=NEG;}
}

constexpr int NSLOT=3, SLOTB=8192;
constexpr int LDS_K=0, LDS_V=NSLOT*SLOTB, LDS_WS=2*NSLOT*SLOTB, LDS_OST=LDS_WS+NW*64*4, LDS_BYTES=LDS_OST+NW*4096;
constexpr float C2=0.125f*1.4426950408889634f;
__device__ __forceinline__ void glds16(const void*gsrc,unsigned lds_dst){unsigned keep;
  asm volatile("s_mov_b32 %0, m0\n\ts_mov_b32 m0, %2\n\ts_nop 0\n\tglobal_load_lds_dwordx4 %1, off\n\ts_mov_b32 m0, %0":"=&s"(keep):"v"(gsrc),"s"(lds_dst):"memory");}
__device__ __forceinline__ float max3f(float a,float b,float c){float r;asm("v_max3_f32 %0, %1, %2, %3":"=v"(r):"v"(a),"v"(b),"v"(c));return r;}
__device__ __forceinline__ float max2f(float a,float b){float r;asm("v_max_f32_e32 %0, %1, %2":"=v"(r):"v"(a),"v"(b));return r;}
__device__ __forceinline__ float fadd_s(float a,float b){float r;asm("v_add_f32_e32 %0, %1, %2":"=v"(r):"v"(a),"v"(b));return r;}
__device__ __forceinline__ float fsub_s(float a,float b){float r;asm("v_sub_f32_e32 %0, %1, %2":"=v"(r):"v"(a),"v"(b));return r;}
typedef float f32x2_t __attribute__((ext_vector_type(2))); typedef __bf16 bf16x2_t __attribute__((ext_vector_type(2)));
__device__ __forceinline__ unsigned cvtpk_s(float lo,float hi){f32x2_t v={lo,hi};bf16x2_t b=__builtin_convertvector(v,bf16x2_t);return __builtin_bit_cast(unsigned,b);}
#define WAIT_BAR(N) asm volatile("s_waitcnt vmcnt(" #N ") lgkmcnt(0)\n\ts_barrier":::"memory")

__device__ __forceinline__ void qkt(f32x16&p0,f32x16&p1,const char*Kslot,const bf16x8*qr,const f32x16&negm,int r32,int hi){
  const char*kb=Kslot+hi*1024+r32*16;
  #pragma unroll
  for(int d0=0;d0<4;++d0){
    const bf16x8 b0=*reinterpret_cast<const bf16x8*>(kb+d0*2048);
    const bf16x8 b1=*reinterpret_cast<const bf16x8*>(kb+d0*2048+512);
    if(d0==0){p0=__builtin_amdgcn_mfma_f32_32x32x16_bf16(b0,qr[0],negm,0,0,0);p1=__builtin_amdgcn_mfma_f32_32x32x16_bf16(b1,qr[0],negm,0,0,0);}
    else{p0=__builtin_amdgcn_mfma_f32_32x32x16_bf16(b0,qr[d0],p0,0,0,0);p1=__builtin_amdgcn_mfma_f32_32x32x16_bf16(b1,qr[d0],p1,0,0,0);}}
}
typedef __attribute__((address_space(3))) const char* lds_cptr;
typedef short v4i16_t __attribute__((ext_vector_type(4)));
__device__ __forceinline__ void kload8(bf16x8*kf,lds_cptr kp){
  kf[0]=*(const __attribute__((address_space(3))) bf16x8*)(kp);      kf[1]=*(const __attribute__((address_space(3))) bf16x8*)(kp+512);
  kf[2]=*(const __attribute__((address_space(3))) bf16x8*)(kp+2048); kf[3]=*(const __attribute__((address_space(3))) bf16x8*)(kp+2560);
  kf[4]=*(const __attribute__((address_space(3))) bf16x8*)(kp+4096); kf[5]=*(const __attribute__((address_space(3))) bf16x8*)(kp+4608);
  kf[6]=*(const __attribute__((address_space(3))) bf16x8*)(kp+6144); kf[7]=*(const __attribute__((address_space(3))) bf16x8*)(kp+6656);
}
__device__ __forceinline__ void kload2(bf16x8*kf,lds_cptr kp,int j){ kf[2*j]=*(const __attribute__((address_space(3))) bf16x8*)(kp+j*2048); kf[2*j+1]=*(const __attribute__((address_space(3))) bf16x8*)(kp+j*2048+512); }
__device__ __forceinline__ s16x4 vtr(lds_cptr p){ return __builtin_bit_cast(s16x4,__builtin_amdgcn_ds_read_tr16_b64_v4i16((__attribute__((address_space(3))) v4i16_t*)p)); }
__device__ __forceinline__ float rowmax(const f32x16&p0,const f32x16&p1){
  float a=max3f(p0[0],p0[1],p1[0]),b=max3f(p0[2],p0[3],p1[1]);a=max3f(a,p1[2],p1[3]);
  #pragma unroll
  for(int r=4;r<16;r+=4){a=max3f(a,p0[r],p0[r+1]);b=max3f(b,p0[r+2],p0[r+3]);a=max3f(a,p1[r],p1[r+1]);b=max3f(b,p1[r+2],p1[r+3]);}
  const float m=max2f(a,b);
  auto rr=__builtin_amdgcn_permlane32_swap(__float_as_uint(m),__float_as_uint(m),false,false);
  return max2f(__uint_as_float(rr[0]),__uint_as_float(rr[1]));
}
__device__ __forceinline__ void pv(f32x16*o,int vb,bf16x8 pa0,bf16x8 pa1,bf16x8 pa2,bf16x8 pa3){
  #pragma unroll
  for(int d0=0;d0<2;++d0){s16x4 lo[4],hi[4];
    #pragma unroll
    for(int ks=0;ks<4;++ks){
      asm volatile("ds_read_b64_tr_b16 %0,%1 offset:%c2":"=&v"(lo[ks]):"v"(vb),"i"(d0*4096+ks*1024):"memory");
      asm volatile("ds_read_b64_tr_b16 %0,%1 offset:%c2":"=&v"(hi[ks]):"v"(vb),"i"(d0*4096+ks*1024+512):"memory");}
    asm volatile("s_waitcnt lgkmcnt(0)":::"memory");SBAR();
    #define PK(k) (bf16x8){lo[k][0],lo[k][1],lo[k][2],lo[k][3],hi[k][0],hi[k][1],hi[k][2],hi[k][3]}
    o[d0]=__builtin_amdgcn_mfma_f32_32x32x16_bf16(pa0,PK(0),o[d0],0,0,0);
    o[d0]=__builtin_amdgcn_mfma_f32_32x32x16_bf16(pa1,PK(1),o[d0],0,0,0);
    o[d0]=__builtin_amdgcn_mfma_f32_32x32x16_bf16(pa2,PK(2),o[d0],0,0,0);
    o[d0]=__builtin_amdgcn_mfma_f32_32x32x16_bf16(pa3,PK(3),o[d0],0,0,0);
    #undef PK
  }
}

#ifndef ATTN_STORE16
#define ATTN_STORE16(p,v) (*(u32x4*)(p)=(v))
#endif
template<int THRL> __device__ __forceinline__ void attn_unit(int wave_sg,int b,int h,int hv,int qb,const bf16*Q,const bf16*__restrict__ K,const bf16*__restrict__ V,bf16*O,char*shm){
  int tid_=pg8::opq(wave_sg)*64+pg8::lane_id(); asm volatile("":"+v"(tid_)); const int tid=tid_,lane=tid&63,r32=lane&31,hi=lane>>5; const int wid=__builtin_amdgcn_readfirstlane(tid>>6);
  const long rowbase=(long)b*SEQ; const int q0=qb*QB;
  const bf16*Qw=Q+(rowbase+q0+wid*QBLK)*DM+h*D;
  const bf16*Kh=K+rowbase*DM+h*D,*Vh=V+rowbase*DM+hv*D;
  const unsigned lds0=(unsigned)(uintptr_t)shm;
  float*wsf=(float*)(shm+LDS_WS)+wid*64;
  const bf16*ksrc=Kh+(long)lane*DM+wid*8;
  const bf16*vsrc=Vh+(long)(16*(wid&3)+(lane>>2))*DM+(wid>>2)*32+(lane&3)*8;
  const unsigned kdst=lds0+LDS_K+wid*1024, vdst=lds0+LDS_V+wid*1024;
  #define DMA_K(t,slot) glds16(ksrc+(long)(t)*KVBLK*DM,(unsigned)__builtin_amdgcn_readfirstlane(kdst+(slot)))
  #define DMA_V(t,slot) glds16(vsrc+(long)(t)*KVBLK*DM,(unsigned)__builtin_amdgcn_readfirstlane(vdst+(slot)))
  const int vb0=(int)(lds0+LDS_V)+((lane>>4)&1)*32+(lane&3)*8+(4*hi+((lane&15)>>2))*64;
  const char*Kbase=shm+LDS_K; bf16x8 kf[8];
  const lds_cptr shm3=(lds_cptr)shm; const lds_cptr kp0=shm3+LDS_K+hi*1024+r32*16; const lds_cptr vp0=shm3+LDS_V+((lane>>4)&1)*32+(lane&3)*8+(4*hi+((lane&15)>>2))*64;
  const int NT=(q0+QB)/KVBLK;
  DMA_K(0,0);DMA_V(0,0);DMA_K(1,SLOTB);
  bf16x8 qr[4];
  #pragma unroll
  for(int d0=0;d0<4;++d0)qr[d0]=*reinterpret_cast<const bf16x8*>(&Qw[(long)r32*DM+d0*16+hi*8]);
  float mhat=0.f,l_reg=0.f;f32x16 o[2];o[0]=f32x16{};o[1]=f32x16{};f32x16 negm=f32x16{};asm volatile("":"+v"(negm));
  const int qrel=wid*QBLK+r32;
  #define CMASK(P0,P1,t) do{int jb_=(t)-(NT-4); if(jb_>=0)cmask(P0,P1,jb_,qrel,hi);}while(0)
  bool resc=false;
  #define START(P0,P1) do{ const float rm=rowmax(P0,P1); resc=false; \
    { const float dl=rm; mhat=fadd_s(mhat,dl); \
      _Pragma("unroll") for(int r=0;r<16;++r){P0[r]=fsub_s(P0[r],dl);P1[r]=fsub_s(P1[r],dl);} \
      _Pragma("unroll") for(int r=0;r<16;++r)negm[r]=-mhat; asm volatile("":"+v"(negm)); } \
    _Pragma("unroll") for(int r=0;r<16;++r)P0[r]=__builtin_amdgcn_exp2f(P0[r]); }while(0)
  #define RESC() do{ if(resc){ asm volatile("s_waitcnt lgkmcnt(0)":::"memory"); \
      _Pragma("unroll") for(int d_=0;d_<2;++d_) _Pragma("unroll") for(int r=0;r<16;++r)o[d_][r]*=wsf[crow(r,hi)]; } }while(0)
  f32x16 pA0,pA1,pB0,pB1;
  int sl_prev=0,sl_cur=0,sl_next=SLOTB;
  #define ROT() do{sl_prev=sl_cur;sl_cur=sl_next;sl_next=(sl_next==(NSLOT-1)*SLOTB)?0:sl_next+SLOTB;}while(0)
  DMA_K(2,2*SLOTB);
  WAIT_BAR(3);
  qkt(pA0,pA1,Kbase,qr,negm,r32,hi);asm volatile("s_nop 15\n\ts_nop 7":"+v"(pA0),"+v"(pA1));CMASK(pA0,pA1,0);
  START(pA0,pA1);
  _Pragma("unroll") for(int r=0;r<16;++r)pA1[r]=__builtin_amdgcn_exp2f(pA1[r]);
  WAIT_BAR(0);
  DMA_K(3,0);DMA_V(1,SLOTB);
  ROT();
  kload8(kf,kp0+sl_cur);
  WAIT_BAR(2);
  s16x4 vlo[8],vhi[8]; u32x4 pw0,pw1,pw2,pw3;
  #define PKW(P,B) cvtpk_s(P[B],P[B+1])
  #define PAF(k) __builtin_bit_cast(bf16x8,pw##k)
  #define VFR(i) (bf16x8){vlo[i][0],vlo[i][1],vlo[i][2],vlo[i][3],vhi[i][0],vhi[i][1],vhi[i][2],vhi[i][3]}
  #define PIN(x) asm volatile("":"+v"(x))
  #define MX3(a,b,c) __builtin_fmaxf(__builtin_fmaxf((a),(b)),(c))
  #define GAPA(MF,A0,A1,A2,A3,W0,W1,PW) do{ MF; sacc+=A0; sacc+=A1; sacc+=A2; sacc+=A3; PIN(sacc); W0; W1; PIN(PW); SBAR(); }while(0)
  #define EX(v) __builtin_amdgcn_exp2f(v)
  #define GAPB(MF,X,B) do{ MF; X[B]=EX(X[B]); X[B+1]=EX(X[B+1]); X[B+2]=EX(X[B+2]); X[B+3]=EX(X[B+3]); PIN(X); SBAR(); }while(0)
  #define VRD(i) do{ vlo[i]=vtr(vp_+(((i)>>2)*4096+((i)&3)*1024)); vhi[i]=vtr(vp_+(((i)>>2)*4096+((i)&3)*1024+512)); }while(0)
  #define KRD(G,j) do{ if(G){ kload2(kf,kp0+sl_next,j); SBAR(); } }while(0)
  #define STEP(C0,C1,P0,P1,t,GK,GV,GL) do{ SBAR(); \
    const lds_cptr vp_=vp0+sl_prev; \
    VRD(0); SBAR(); float sacc=(P0[0]+P0[1]); \
    GAPA(C0=__builtin_amdgcn_mfma_f32_32x32x16_bf16(kf[0],qr[0],negm,0,0,0), P0[2],P0[3],P0[4],P0[5],     pw0[0]=PKW(P0,0), pw0[1]=PKW(P0,2), pw0); \
    VRD(4); SBAR(); GAPA(C1=__builtin_amdgcn_mfma_f32_32x32x16_bf16(kf[1],qr[0],negm,0,0,0), P0[6],P0[7],P0[8],P0[9],     pw0[2]=PKW(P0,4), pw0[3]=PKW(P0,6), pw0); \
    VRD(1); SBAR(); GAPA(C0=__builtin_amdgcn_mfma_f32_32x32x16_bf16(kf[2],qr[1],C0,0,0,0),   P0[10],P0[11],P0[12],P0[13], pw1[0]=PKW(P0,8), pw1[1]=PKW(P0,10), pw1); \
    VRD(5); SBAR(); GAPA(C1=__builtin_amdgcn_mfma_f32_32x32x16_bf16(kf[3],qr[1],C1,0,0,0),   P0[14],P0[15],P1[0],P1[1],   pw1[2]=PKW(P0,12),pw1[3]=PKW(P0,14), pw1); \
    VRD(2); SBAR(); GAPA(C0=__builtin_amdgcn_mfma_f32_32x32x16_bf16(kf[4],qr[2],C0,0,0,0),   P1[2],P1[3],P1[4],P1[5],     pw2[0]=PKW(P1,0), pw2[1]=PKW(P1,2), pw2); \
    VRD(6); SBAR(); GAPA(C1=__builtin_amdgcn_mfma_f32_32x32x16_bf16(kf[5],qr[2],C1,0,0,0),   P1[6],P1[7],P1[8],P1[9],     pw2[2]=PKW(P1,4), pw2[3]=PKW(P1,6), pw2); \
    VRD(3); SBAR(); GAPA(C0=__builtin_amdgcn_mfma_f32_32x32x16_bf16(kf[6],qr[3],C0,0,0,0),   P1[10],P1[11],P1[12],P1[13], pw3[0]=PKW(P1,8), pw3[1]=PKW(P1,10), pw3); \
    VRD(7); SBAR(); GAPA(C1=__builtin_amdgcn_mfma_f32_32x32x16_bf16(kf[7],qr[3],C1,0,0,0),   P1[14],P1[15],0.f,0.f,       pw3[2]=PKW(P1,12),pw3[3]=PKW(P1,14), pw3); \
    l_reg+=sacc; \
    if(GK){DMA_K((t)+3,sl_cur);} if(GV){DMA_V((t)+1,sl_next);} \
    CMASK(C0,C1,t); \
    { float a=MX3(C0[0],C0[1],C1[0]),b=MX3(C0[2],C0[3],C1[1]); a=MX3(a,C1[2],C1[3]); \
      _Pragma("unroll") for(int r=4;r<16;r+=4){a=MX3(a,C0[r],C0[r+1]);b=MX3(b,C0[r+2],C0[r+3]);a=MX3(a,C1[r],C1[r+1]);b=MX3(b,C1[r+2],C1[r+3]);} \
      float rm=__builtin_fmaxf(a,b); { auto rr=__builtin_amdgcn_permlane32_swap(__float_as_uint(rm),__float_as_uint(rm),false,false); rm=__builtin_fmaxf(__uint_as_float(rr[0]),__uint_as_float(rr[1])); } \
      resc=false; \
      if(__builtin_expect(__any(rm>(float)THRL),0)){ const float dl=__builtin_fmaxf(rm,0.f); mhat+=dl; \
        _Pragma("unroll") for(int r=0;r<16;++r){C0[r]-=dl;C1[r]-=dl;} \
        _Pragma("unroll") for(int r=0;r<16;++r)negm[r]=-mhat; asm volatile("":"+v"(negm)); \
        const float f=__builtin_amdgcn_exp2f(-dl); l_reg*=f; if(hi==0)wsf[r32]=f; resc=true; } } \
    SBAR(); \
    GAPB(o[0]=__builtin_amdgcn_mfma_f32_32x32x16_bf16(PAF(0),VFR(0),o[0],0,0,0), C0,0); \
    GAPB(o[1]=__builtin_amdgcn_mfma_f32_32x32x16_bf16(PAF(0),VFR(4),o[1],0,0,0), C0,4); \
    KRD(GL,0); GAPB(o[0]=__builtin_amdgcn_mfma_f32_32x32x16_bf16(PAF(1),VFR(1),o[0],0,0,0), C0,8); \
    KRD(GL,1); GAPB(o[1]=__builtin_amdgcn_mfma_f32_32x32x16_bf16(PAF(1),VFR(5),o[1],0,0,0), C0,12); \
    KRD(GL,2); GAPB(o[0]=__builtin_amdgcn_mfma_f32_32x32x16_bf16(PAF(2),VFR(2),o[0],0,0,0), C1,0); \
    KRD(GL,3); GAPB(o[1]=__builtin_amdgcn_mfma_f32_32x32x16_bf16(PAF(2),VFR(6),o[1],0,0,0), C1,4); \
    GAPB(o[0]=__builtin_amdgcn_mfma_f32_32x32x16_bf16(PAF(3),VFR(3),o[0],0,0,0), C1,8); \
    GAPB(o[1]=__builtin_amdgcn_mfma_f32_32x32x16_bf16(PAF(3),VFR(7),o[1],0,0,0), C1,12); \
    }while(0)
  int t=1;
  #undef CMASK
  #define CMASK(P0,P1,t) do{}while(0)
  for(;t+5<NT;t+=2){
    STEP(pB0,pB1,pA0,pA1,t,true,true,true);     WAIT_BAR(2); RESC(); ROT();
    STEP(pA0,pA1,pB0,pB1,t+1,true,true,true);   WAIT_BAR(2); RESC(); ROT();
  }
  #undef CMASK
  #define CMASK(P0,P1,t) do{int jb_=(t)-(NT-4); if(jb_>=0)cmask(P0,P1,jb_,qrel,hi);}while(0)
  #define ENDW(tt) do{ if((tt)+3<NT){WAIT_BAR(2);} else if((tt)+2<NT){WAIT_BAR(1);} else {WAIT_BAR(0);} }while(0)
  for(;t+1<NT;t+=2){
    STEP(pB0,pB1,pA0,pA1,t,(t+3<NT),(t+1<NT),(t+1<NT));       ENDW(t);   RESC(); ROT();
    STEP(pA0,pA1,pB0,pB1,t+1,(t+4<NT),(t+2<NT),(t+2<NT));     ENDW(t+1); RESC(); ROT();
  }
  STEP(pB0,pB1,pA0,pA1,NT-1,false,false,false); RESC();
  { float sacc=pB0[0]+pB0[1]; _Pragma("unroll") for(int r=2;r<16;++r)sacc+=pB0[r]; _Pragma("unroll") for(int r=0;r<16;++r)sacc+=pB1[r]; l_reg+=sacc;
    pw0=(u32x4){PKW(pB0,0),PKW(pB0,2),PKW(pB0,4),PKW(pB0,6)};pw1=(u32x4){PKW(pB0,8),PKW(pB0,10),PKW(pB0,12),PKW(pB0,14)};pw2=(u32x4){PKW(pB1,0),PKW(pB1,2),PKW(pB1,4),PKW(pB1,6)};pw3=(u32x4){PKW(pB1,8),PKW(pB1,10),PKW(pB1,12),PKW(pB1,14)};
    SBAR(); pv(o,vb0+sl_cur,PAF(0),PAF(1),PAF(2),PAF(3)); }
  #undef PKW
  #undef PAF
  #undef VFR
  #undef PIN
  #undef MX3
  #undef GAPA
  #undef GAPB
  #undef EX
  #undef VRD
  #undef KRD
  #undef STEP
  #undef ENDW
  {auto rr=__builtin_amdgcn_permlane32_swap(__float_as_uint(l_reg),__float_as_uint(l_reg),false,false);l_reg=__uint_as_float(rr[0])+__uint_as_float(rr[1]);}
  if(hi==0)wsf[32+r32]=l_reg;asm volatile("s_waitcnt lgkmcnt(0)":::"memory");
  float rli[16];
  #pragma unroll
  for(int r=0;r<16;++r)rli[r]=__builtin_amdgcn_rcpf(wsf[32+crow(r,hi)]);
  bf16*Ow=O+(rowbase+q0+wid*QBLK)*DM+hv*D;
  { bf16*stg=(bf16*)(shm+LDS_OST)+wid*2048;
    #pragma unroll
    for(int r=0;r<16;++r){const int orow=crow(r,hi);
      #pragma unroll
      for(int d0=0;d0<2;++d0)stg[orow*64+d0*32+r32]=__float2bfloat16(o[d0][r]*rli[r]);}
    asm volatile("s_waitcnt lgkmcnt(0)":::"memory");
    #pragma unroll
    for(int i=0;i<4;++i){const int row=i*8+(lane>>3),ch=lane&7; const u32x4 v=*(const u32x4*)(stg+row*64+ch*8); ATTN_STORE16(Ow+(long)row*DM+ch*8,v);} }
  asm volatile("s_waitcnt lgkmcnt(0)\n\ts_barrier":::"memory");
  #undef DMA_K
  #undef DMA_V
  #undef CMASK
  #undef START
  #undef RESC
  #undef ROT
}
constexpr int VSLOTB=16384, LW_K=0, LW_V=NSLOT*SLOTB, LW_WS=LW_V+NSLOT*VSLOTB, LW_BYTES=LW_WS+NW*64*4;
static_assert(NW*8192<=LW_WS,"O stage overlays the K/V rings");
__device__ __forceinline__ void pv4(f32x16*o,int vb,bf16x8 pa0,bf16x8 pa1,bf16x8 pa2,bf16x8 pa3){
  #pragma unroll
  for(int d0=0;d0<4;++d0){s16x4 lo[4],hi[4];
    #pragma unroll
    for(int ks=0;ks<4;++ks){
      asm volatile("ds_read_b64_tr_b16 %0,%1 offset:%c2":"=&v"(lo[ks]):"v"(vb),"i"(d0*4096+ks*1024):"memory");
      asm volatile("ds_read_b64_tr_b16 %0,%1 offset:%c2":"=&v"(hi[ks]):"v"(vb),"i"(d0*4096+ks*1024+512):"memory");}
    asm volatile("s_waitcnt lgkmcnt(0)":::"memory");SBAR();
    #define PK(k) (bf16x8){lo[k][0],lo[k][1],lo[k][2],lo[k][3],hi[k][0],hi[k][1],hi[k][2],hi[k][3]}
    o[d0]=__builtin_amdgcn_mfma_f32_32x32x16_bf16(pa0,PK(0),o[d0],0,0,0);
    o[d0]=__builtin_amdgcn_mfma_f32_32x32x16_bf16(pa1,PK(1),o[d0],0,0,0);
    o[d0]=__builtin_amdgcn_mfma_f32_32x32x16_bf16(pa2,PK(2),o[d0],0,0,0);
    o[d0]=__builtin_amdgcn_mfma_f32_32x32x16_bf16(pa3,PK(3),o[d0],0,0,0);
    #undef PK
  }
}
__device__ __forceinline__ void attn_unit_w(int wave_sg,int b,int h8,int m,int qb,const bf16*Q,const bf16*__restrict__ K,const bf16*__restrict__ V,bf16*O,char*shm,bf16*YAo,const float*fz){
  int tid_=pg8::opq(wave_sg)*64+pg8::lane_id(); asm volatile("":"+v"(tid_)); const int tid=tid_,lane=tid&63,r32=lane&31,hi=lane>>5; const int wid=__builtin_amdgcn_readfirstlane(tid>>6);
  const long rowbase=(long)b*SEQ; const int q0=qb*QB; const int hq=2*h8+m;
  const bf16*Qw=Q+(rowbase+q0+wid*QBLK)*DM+hq*D;
  const bf16*Kh=K+rowbase*DM+hq*D,*Vh=V+rowbase*DM+h8*128;
  const unsigned lds0=(unsigned)(uintptr_t)shm;
  float*wsf=(float*)(shm+LW_WS)+wid*64;
  const bf16*ksrc=Kh+(long)lane*DM+wid*8;
  const bf16*vsrcA=Vh+(long)(16*(wid&3)+(lane>>2))*DM+(wid>>2)*32+(lane&3)*8;
  const bf16*vsrcB=vsrcA+64;
  const unsigned kdst=lds0+LW_K+wid*1024, vdstA=lds0+LW_V+wid*1024, vdstB=vdstA+8192;
  #define DMA_K(t,slot) glds16(ksrc+(long)(t)*KVBLK*DM,(unsigned)__builtin_amdgcn_readfirstlane(kdst+(slot)))
  #define DMA_V(t,slot) do{ glds16(vsrcA+(long)(t)*KVBLK*DM,(unsigned)__builtin_amdgcn_readfirstlane(vdstA+2*(slot))); glds16(vsrcB+(long)(t)*KVBLK*DM,(unsigned)__builtin_amdgcn_readfirstlane(vdstB+2*(slot))); }while(0)
  const int vb0=(int)(lds0+LW_V)+((lane>>4)&1)*32+(lane&3)*8+(4*hi+((lane&15)>>2))*64;
  const char*Kbase=shm+LW_K; bf16x8 kf[8];
  const lds_cptr shm3=(lds_cptr)shm; const lds_cptr kp0=shm3+LW_K+hi*1024+r32*16; const lds_cptr vp0=shm3+LW_V+((lane>>4)&1)*32+(lane&3)*8+(4*hi+((lane&15)>>2))*64;
  const int NT=(q0+QB)/KVBLK;
  DMA_K(0,0);DMA_V(0,0);DMA_K(1,SLOTB);
  bf16x8 qr[4];
  #pragma unroll
  for(int d0=0;d0<4;++d0)qr[d0]=*reinterpret_cast<const bf16x8*>(&Qw[(long)r32*DM+d0*16+hi*8]);
  float l_reg=0.f;f32x16 o[4];o[0]=f32x16{};o[1]=f32x16{};o[2]=f32x16{};o[3]=f32x16{};
  const int qrel=wid*QBLK+r32;
  #define CMASK(P0,P1,t) do{int jb_=(t)-(NT-4); if(jb_>=0)cmask(P0,P1,jb_,qrel,hi);}while(0)
  f32x16 pA0,pA1,pB0,pB1;
  int sl_prev=0,sl_cur=0,sl_next=SLOTB;
  #define ROT() do{sl_prev=sl_cur;sl_cur=sl_next;sl_next=(sl_next==(NSLOT-1)*SLOTB)?0:sl_next+SLOTB;}while(0)
  DMA_K(2,2*SLOTB);
  WAIT_BAR(4);
  { const char*kb=Kbase+hi*1024+r32*16;
    #pragma unroll
    for(int d0=0;d0<4;++d0){
      const bf16x8 b0=*reinterpret_cast<const bf16x8*>(kb+d0*2048);
      const bf16x8 b1=*reinterpret_cast<const bf16x8*>(kb+d0*2048+512);
      if(d0==0){pA0=__builtin_amdgcn_mfma_f32_32x32x16_bf16(b0,qr[0],f32x16{},0,0,0);pA1=__builtin_amdgcn_mfma_f32_32x32x16_bf16(b1,qr[0],f32x16{},0,0,0);}
      else{pA0=__builtin_amdgcn_mfma_f32_32x32x16_bf16(b0,qr[d0],pA0,0,0,0);pA1=__builtin_amdgcn_mfma_f32_32x32x16_bf16(b1,qr[d0],pA1,0,0,0);}} }
  asm volatile("s_nop 15\n\ts_nop 7":"+v"(pA0),"+v"(pA1));CMASK(pA0,pA1,0);
  _Pragma("unroll") for(int r=0;r<16;++r){pA0[r]=__builtin_amdgcn_exp2f(pA0[r]);pA1[r]=__builtin_amdgcn_exp2f(pA1[r]);}
  WAIT_BAR(0);
  DMA_K(3,0);DMA_V(1,SLOTB);
  ROT();
  kload8(kf,kp0+sl_cur);
  WAIT_BAR(3);
  s16x4 vlo[8],vhi[8]; u32x4 pw0,pw1,pw2,pw3;
  #define PKW(P,B) cvtpk_s(P[B],P[B+1])
  #define PAF(k) __builtin_bit_cast(bf16x8,pw##k)
  #define VFR(i) (bf16x8){vlo[i][0],vlo[i][1],vlo[i][2],vlo[i][3],vhi[i][0],vhi[i][1],vhi[i][2],vhi[i][3]}
  #define PIN(x) asm volatile("":"+v"(x))
  #define GAPA(MF,A0,A1,A2,A3,W0,W1,PW) do{ MF; sacc+=A0; sacc+=A1; sacc+=A2; sacc+=A3; PIN(sacc); W0; W1; PIN(PW); SBAR(); }while(0)
  #define EX(v) __builtin_amdgcn_exp2f(v)
  #define GAPB(MF,X,B) do{ MF; X[B]=EX(X[B]); X[B+1]=EX(X[B+1]); PIN(X); SBAR(); }while(0)
  #define VRD(j,i) do{ vlo[j]=vtr(vp_+(((i)>>2)*4096+((i)&3)*1024)); vhi[j]=vtr(vp_+(((i)>>2)*4096+((i)&3)*1024+512)); }while(0)
  #define KRD(G,j) do{ if(G){ kload2(kf,kp0+sl_next,j); SBAR(); } }while(0)
  #define STEP(C0,C1,P0,P1,t,GK,GV,GL) do{ SBAR(); \
    const lds_cptr vp_=vp0+2*sl_prev; \
    VRD(0,0); SBAR(); float sacc=(P0[0]+P0[1]); \
    GAPA(C0=__builtin_amdgcn_mfma_f32_32x32x16_bf16(kf[0],qr[0],f32x16{},0,0,0), P0[2],P0[3],P0[4],P0[5],     pw0[0]=PKW(P0,0), pw0[1]=PKW(P0,2), pw0); \
    VRD(4,4); SBAR(); GAPA(C1=__builtin_amdgcn_mfma_f32_32x32x16_bf16(kf[1],qr[0],f32x16{},0,0,0), P0[6],P0[7],P0[8],P0[9],     pw0[2]=PKW(P0,4), pw0[3]=PKW(P0,6), pw0); \
    VRD(1,1); SBAR(); GAPA(C0=__builtin_amdgcn_mfma_f32_32x32x16_bf16(kf[2],qr[1],C0,0,0,0),   P0[10],P0[11],P0[12],P0[13], pw1[0]=PKW(P0,8), pw1[1]=PKW(P0,10), pw1); \
    VRD(5,5); SBAR(); GAPA(C1=__builtin_amdgcn_mfma_f32_32x32x16_bf16(kf[3],qr[1],C1,0,0,0),   P0[14],P0[15],P1[0],P1[1],   pw1[2]=PKW(P0,12),pw1[3]=PKW(P0,14), pw1); \
    VRD(2,2); SBAR(); GAPA(C0=__builtin_amdgcn_mfma_f32_32x32x16_bf16(kf[4],qr[2],C0,0,0,0),   P1[2],P1[3],P1[4],P1[5],     pw2[0]=PKW(P1,0), pw2[1]=PKW(P1,2), pw2); \
    VRD(6,6); SBAR(); GAPA(C1=__builtin_amdgcn_mfma_f32_32x32x16_bf16(kf[5],qr[2],C1,0,0,0),   P1[6],P1[7],P1[8],P1[9],     pw2[2]=PKW(P1,4), pw2[3]=PKW(P1,6), pw2); \
    VRD(3,3); SBAR(); GAPA(C0=__builtin_amdgcn_mfma_f32_32x32x16_bf16(kf[6],qr[3],C0,0,0,0),   P1[10],P1[11],P1[12],P1[13], pw3[0]=PKW(P1,8), pw3[1]=PKW(P1,10), pw3); \
    VRD(7,7); SBAR(); GAPA(C1=__builtin_amdgcn_mfma_f32_32x32x16_bf16(kf[7],qr[3],C1,0,0,0),   P1[14],P1[15],0.f,0.f,       pw3[2]=PKW(P1,12),pw3[3]=PKW(P1,14), pw3); \
    l_reg+=sacc; \
    if(GK){DMA_K((t)+3,sl_cur);} if(GV){DMA_V((t)+1,sl_next);} \
    CMASK(C0,C1,t); \
    SBAR(); \
    GAPB(o[0]=__builtin_amdgcn_mfma_f32_32x32x16_bf16(PAF(0),VFR(0),o[0],0,0,0), C0,0);  VRD(0,8);  SBAR(); \
    GAPB(o[1]=__builtin_amdgcn_mfma_f32_32x32x16_bf16(PAF(0),VFR(4),o[1],0,0,0), C0,2);  VRD(4,12); SBAR(); \
    KRD(GL,0); GAPB(o[0]=__builtin_amdgcn_mfma_f32_32x32x16_bf16(PAF(1),VFR(1),o[0],0,0,0), C0,4);  VRD(1,9);  SBAR(); \
    KRD(GL,1); GAPB(o[1]=__builtin_amdgcn_mfma_f32_32x32x16_bf16(PAF(1),VFR(5),o[1],0,0,0), C0,6);  VRD(5,13); SBAR(); \
    KRD(GL,2); GAPB(o[0]=__builtin_amdgcn_mfma_f32_32x32x16_bf16(PAF(2),VFR(2),o[0],0,0,0), C0,8);  VRD(2,10); SBAR(); \
    KRD(GL,3); GAPB(o[1]=__builtin_amdgcn_mfma_f32_32x32x16_bf16(PAF(2),VFR(6),o[1],0,0,0), C0,10); VRD(6,14); SBAR(); \
    GAPB(o[0]=__builtin_amdgcn_mfma_f32_32x32x16_bf16(PAF(3),VFR(3),o[0],0,0,0), C0,12); VRD(3,11); SBAR(); \
    GAPB(o[1]=__builtin_amdgcn_mfma_f32_32x32x16_bf16(PAF(3),VFR(7),o[1],0,0,0), C0,14); VRD(7,15); SBAR(); \
    GAPB(o[2]=__builtin_amdgcn_mfma_f32_32x32x16_bf16(PAF(0),VFR(0),o[2],0,0,0), C1,0); \
    GAPB(o[3]=__builtin_amdgcn_mfma_f32_32x32x16_bf16(PAF(0),VFR(4),o[3],0,0,0), C1,2); \
    GAPB(o[2]=__builtin_amdgcn_mfma_f32_32x32x16_bf16(PAF(1),VFR(1),o[2],0,0,0), C1,4); \
    GAPB(o[3]=__builtin_amdgcn_mfma_f32_32x32x16_bf16(PAF(1),VFR(5),o[3],0,0,0), C1,6); \
    GAPB(o[2]=__builtin_amdgcn_mfma_f32_32x32x16_bf16(PAF(2),VFR(2),o[2],0,0,0), C1,8); \
    GAPB(o[3]=__builtin_amdgcn_mfma_f32_32x32x16_bf16(PAF(2),VFR(6),o[3],0,0,0), C1,10); \
    GAPB(o[2]=__builtin_amdgcn_mfma_f32_32x32x16_bf16(PAF(3),VFR(3),o[2],0,0,0), C1,12); \
    GAPB(o[3]=__builtin_amdgcn_mfma_f32_32x32x16_bf16(PAF(3),VFR(7),o[3],0,0,0), C1,14); \
    }while(0)
  int t=1;
  #undef CMASK
  #define CMASK(P0,P1,t) do{}while(0)
  for(;t+5<NT;t+=2){
    STEP(pB0,pB1,pA0,pA1,t,true,true,true);     WAIT_BAR(3); ROT();
    STEP(pA0,pA1,pB0,pB1,t+1,true,true,true);   WAIT_BAR(3); ROT();
  }
  #undef CMASK
  #define CMASK(P0,P1,t) do{int jb_=(t)-(NT-4); if(jb_>=0)cmask(P0,P1,jb_,qrel,hi);}while(0)
  #define ENDW(tt) do{ if((tt)+3<NT){WAIT_BAR(3);} else if((tt)+2<NT){WAIT_BAR(2);} else {WAIT_BAR(0);} }while(0)
  for(;t+1<NT;t+=2){
    STEP(pB0,pB1,pA0,pA1,t,(t+3<NT),(t+1<NT),(t+1<NT));       ENDW(t);   ROT();
    STEP(pA0,pA1,pB0,pB1,t+1,(t+4<NT),(t+2<NT),(t+2<NT));     ENDW(t+1); ROT();
  }
  STEP(pB0,pB1,pA0,pA1,NT-1,false,false,false);
  { float sacc=pB0[0]+pB0[1]; _Pragma("unroll") for(int r=2;r<16;++r)sacc+=pB0[r]; _Pragma("unroll") for(int r=0;r<16;++r)sacc+=pB1[r]; l_reg+=sacc;
    pw0=(u32x4){PKW(pB0,0),PKW(pB0,2),PKW(pB0,4),PKW(pB0,6)};pw1=(u32x4){PKW(pB0,8),PKW(pB0,10),PKW(pB0,12),PKW(pB0,14)};pw2=(u32x4){PKW(pB1,0),PKW(pB1,2),PKW(pB1,4),PKW(pB1,6)};pw3=(u32x4){PKW(pB1,8),PKW(pB1,10),PKW(pB1,12),PKW(pB1,14)};
    SBAR(); pv4(o,vb0+2*sl_cur,PAF(0),PAF(1),PAF(2),PAF(3)); }
  #undef PKW
  #undef PAF
  #undef VFR
  #undef PIN
  #undef GAPA
  #undef GAPB
  #undef EX
  #undef VRD
  #undef KRD
  #undef STEP
  #undef ENDW
  {auto rr=__builtin_amdgcn_permlane32_swap(__float_as_uint(l_reg),__float_as_uint(l_reg),false,false);l_reg=__uint_as_float(rr[0])+__uint_as_float(rr[1]);}
  if(hi==0)wsf[32+r32]=l_reg;
  asm volatile("s_waitcnt lgkmcnt(0)\n\ts_barrier":::"memory");
  float rli[16];
  #pragma unroll
  for(int r=0;r<16;++r)rli[r]=__builtin_amdgcn_rcpf(wsf[32+crow(r,hi)]);
  bf16*Ow=O+(rowbase+q0+wid*QBLK)*DM+h8*128;
  { bf16*stg=(bf16*)shm+wid*4096;
    #pragma unroll
    for(int r=0;r<16;++r){const int orow=crow(r,hi);
      #pragma unroll
      for(int d0=0;d0<4;++d0)stg[orow*128+d0*32+r32]=__float2bfloat16(o[d0][r]*rli[r]);}
    asm volatile("s_waitcnt lgkmcnt(0)":::"memory");
    if(fz==nullptr){
    #pragma unroll
    for(int i=0;i<8;++i){const int row=i*4+(lane>>4),ch=lane&15; const u32x4 v=*(const u32x4*)(stg+row*128+ch*8); ATTN_STORE16(Ow+(long)row*DM+ch*8,v);} }
    else{ const bf16*O0w=Ow; bf16*Yw=YAo+(rowbase+q0+wid*QBLK)*DM+h8*128; const int ch=lane&15; const float lam=fz[0];
      asm volatile("s_waitcnt vmcnt(0)":::"memory");
      u32x4 a0[8];
      #pragma unroll
      for(int i=0;i<8;++i)a0[i]=*(const u32x4*)(O0w+(long)(i*4+(lane>>4))*DM+ch*8);
      float sl8[8];
      #pragma unroll
      for(int e=0;e<8;++e)sl8[e]=fz[2+ch*8+e];
      #pragma unroll
      for(int i=0;i<8;++i){const int row=i*4+(lane>>4); const u32x4 v1=*(const u32x4*)(stg+row*128+ch*8);
        const unsigned aw[4]={a0[i].x,a0[i].y,a0[i].z,a0[i].w},bw[4]={v1.x,v1.y,v1.z,v1.w}; float d[8]; float ss=0.f;
        #pragma unroll
        for(int j=0;j<4;++j){d[2*j]=__uint_as_float(aw[j]<<16)-lam*__uint_as_float(bw[j]<<16); d[2*j+1]=__uint_as_float(aw[j]&0xffff0000u)-lam*__uint_as_float(bw[j]&0xffff0000u); ss+=d[2*j]*d[2*j]+d[2*j+1]*d[2*j+1];}
        ss=pg8::row_sum16(ss);
        const float rr=1.0f/sqrtf(ss*(1.f/128.f)+1e-6f);
        u32x4 w; w.x=cvtpk_s(d[0]*rr*sl8[0],d[1]*rr*sl8[1]); w.y=cvtpk_s(d[2]*rr*sl8[2],d[3]*rr*sl8[3]); w.z=cvtpk_s(d[4]*rr*sl8[4],d[5]*rr*sl8[5]); w.w=cvtpk_s(d[6]*rr*sl8[6],d[7]*rr*sl8[7]);
        ATTN_STORE16(Yw+(long)row*DM+ch*8,w);} } }
  asm volatile("s_waitcnt lgkmcnt(0)\n\ts_barrier":::"memory");
  #undef DMA_K
  #undef DMA_V
  #undef CMASK
  #undef ROT
}
constexpr int ATTN_LDS_BYTES=LDS_BYTES;
struct AttnTensors { const bf16* Q; const bf16* K; const bf16* V; bf16* O; };
struct AttnUnit { int b, hq, hv, m, qb; };
struct StaticOrder {
  int vcu, G;
  __device__ __forceinline__ explicit StaticOrder(int grid,int block):vcu((grid%8==0)?(block%8)*(grid/8)+block/8:block),G(grid){}
  __device__ __forceinline__ bool next(int i,AttnUnit&u)const{ const int g=vcu+(i>>3)*G; if(g>=256)return false; const int vh=g&1,m=(g>>1)&1,h8=(g>>2)&7; u.b=g>>5; u.hq=2*h8+m; u.hv=2*h8+vh; u.m=m; u.qb=7-(i&7); return true; }
  __device__ __forceinline__ void a_ready(const AttnUnit&)const{}
  __device__ __forceinline__ void done(const AttnUnit&)const{}
};
template<class Sched,int THRL=8> __device__ __forceinline__ void attn_phase(char*lds,const AttnTensors&T,const Sched&S,const int wave_sg){
  AttnUnit u; const bf16*Qp=pg8::uni_ptr(T.Q),*Kp=pg8::uni_ptr(T.K),*Vp=pg8::uni_ptr(T.V); bf16*Op=pg8::uni_ptr(T.O);
  for(int i=0;S.next(i,u);++i){ S.a_ready(u); attn_unit<THRL>(wave_sg,u.b,u.hq,u.hv,u.qb,Qp,Kp,Vp,Op+(size_t)u.m*((size_t)BATCH*SEQ*DM),lds); S.done(u); }
}
#undef SBAR
#undef WAIT_BAR
}
#define GAS __attribute__((address_space(1)))
#define LAS __attribute__((address_space(3)))
typedef unsigned short bf16;
typedef unsigned v4u __attribute__((ext_vector_type(4)));
typedef float f32x4 __attribute__((ext_vector_type(4)));
typedef short bf16x8 __attribute__((ext_vector_type(8)));
typedef GAS unsigned gu32;
typedef GAS unsigned long long gu64;
#define RLX_AGENT __ATOMIC_RELAXED, __HIP_MEMORY_SCOPE_AGENT
#define LDS_WAIT() asm volatile("s_waitcnt lgkmcnt(0)" ::: "memory")
#define VM_WAIT() asm volatile("s_waitcnt vmcnt(0)" ::: "memory")
__device__ __forceinline__ unsigned long long rt() { return __builtin_amdgcn_s_memrealtime(); }
__device__ __forceinline__ unsigned f2bf(float f) { unsigned u = __builtin_bit_cast(unsigned, f); return (u + 0x7fffu + ((u >> 16) & 1u)) >> 16; }
__device__ __forceinline__ unsigned pk2(float lo, float hi) { return f2bf(lo) | (f2bf(hi) << 16); }

#define XB_TMO      128
#define XB_XCNT(j)  (256  + 64 * (j))
#define XB_XSUB(j)  (1280 + 64 * (j))
#define XB_XGEN(j)  (2304 + 64 * (j))
#define XB_TOP      3328
#define XB_TOPGEN   3392
#define XCD_BAR_WORDS 3456
#define XB_SPIN_CAP (1u << 18)

__device__ __forceinline__ unsigned xb_ld(unsigned* p)              { return __hip_atomic_load(p, __ATOMIC_RELAXED, __HIP_MEMORY_SCOPE_AGENT); }
__device__ __forceinline__ unsigned xb_add(unsigned* p, unsigned v) { return __hip_atomic_fetch_add(p, v, __ATOMIC_RELAXED, __HIP_MEMORY_SCOPE_AGENT); }
__device__ __forceinline__ unsigned xb_xcc_id() { return (unsigned)__builtin_amdgcn_s_getreg((3 << 11) | 20) & 0xFu; }
#define XB_SPIN(cond, bar) do { unsigned _sp = 0; while (cond) { __builtin_amdgcn_s_sleep(1); \
    if ((++_sp & 255u) == 0u) { if (xb_ld(&(bar)[XB_TMO])) break; if (_sp > XB_SPIN_CAP) { atomicAdd(&(bar)[XB_TMO], 1u); break; } } } } while (0)

struct XcdBarrier {
    unsigned* bar; unsigned x;
    volatile LAS unsigned* st;
};

__device__ __forceinline__ XcdBarrier xcd_barrier_post(unsigned* bar, volatile LAS unsigned* st, const bool t0) {
    XcdBarrier b; b.bar = bar; b.x = xb_xcc_id(); b.st = st;
    if (t0) (void)xb_add(&bar[XB_XCNT(b.x)], 1u);
    return b;
}
__device__ __forceinline__ void xcd_barrier_complete(unsigned* bar, unsigned x, unsigned& nloc, unsigned& nx) {
    const unsigned G = gridDim.x * gridDim.y * gridDim.z;
    unsigned sum, cnt, mine, sp = 0u;
    for (;;) {
        sum = 0u; cnt = 0u; mine = 0u;
#pragma unroll
        for (unsigned j = 0; j < 16; ++j) { const unsigned c = xb_ld(&bar[XB_XCNT(j)]); sum += c; cnt += (c > 0u) ? 1u : 0u; mine = (j == x) ? c : mine; }
        if (sum == G) break;
        __builtin_amdgcn_s_sleep(1);
        if ((++sp & 255u) == 0u) { if (xb_ld(&bar[XB_TMO])) break; if (sp > XB_SPIN_CAP) { atomicAdd(&bar[XB_TMO], 1u); break; } }
    }
    nloc = mine > 0u ? mine : 1u; nx = cnt > 0u ? cnt : 1u;
}

__device__ __forceinline__ void xcd_barrier(const XcdBarrier& b, const bool t0) {
    asm volatile("s_waitcnt vmcnt(0)" ::: "memory");
    __syncthreads();
    if (t0) {
        unsigned* bar = pg8::uni_ptr(b.bar);
        __builtin_amdgcn_s_waitcnt(0);
        unsigned nloc = b.st[0], nx = b.st[1];
        if (nloc == 0u) { xcd_barrier_complete(bar, b.x, nloc, nx); b.st[0] = nloc; b.st[1] = nx; }
        const unsigned old = xb_add(&bar[XB_XSUB(b.x)], 1u);
        const unsigned gen = old / nloc;
        if (old + 1u == (gen + 1u) * nloc) {
            __builtin_amdgcn_fence(__ATOMIC_RELEASE, "agent");
            asm volatile("s_waitcnt vmcnt(0)" ::: "memory");
            const unsigned og = xb_add(&bar[XB_TOP], 1u);
            const unsigned tg = og / nx;
            if (og + 1u == (tg + 1u) * nx) xb_add(&bar[XB_TOPGEN], 1u);
            else XB_SPIN(xb_ld(&bar[XB_TOPGEN]) == tg, bar);
            __builtin_amdgcn_fence(__ATOMIC_ACQUIRE, "agent");
            xb_add(&bar[XB_XGEN(b.x)], 1u);
            asm volatile("s_waitcnt vmcnt(0)" ::: "memory");
        } else {
            XB_SPIN(xb_ld(&bar[XB_XGEN(b.x)]) == gen, bar);
            __builtin_amdgcn_fence(__ATOMIC_ACQUIRE, "agent");
            asm volatile("s_waitcnt vmcnt(0)" ::: "memory");
        }
    }
    __syncthreads();
}

constexpr int NWAVES = 8;
constexpr int NB = 8, NT_ = 2048, DM_ = 2048, M = NB * NT_;
constexpr int MIXW = 1024, INC = 15360, FFH = 5632, MEMROWS = 2048;
constexpr int DEPTH = 2, NPH = 16;
constexpr float EPSN = 1e-6f;
constexpr float LOG2E = 1.4426950408889634f;

constexpr size_t MiB = 1u << 20;
constexpr size_t WS_CTL = 0, CTL_ZERO_BYTES = 1 * MiB;
constexpr size_t WS_LAM = 1 * MiB + 512 * 1024;
constexpr size_t WS_DCS = 1 * MiB, WS_RCS = 2 * MiB;
constexpr size_t WS_W = 4 * MiB;
constexpr int KPAD = 64;
constexpr int LD2K = DM_ + KPAD, LD1K = MIXW + KPAD, LDFF = FFH + KPAD;
constexpr size_t W_IN = WS_W, W_BR = W_IN + 62 * MiB, W_OUT = W_BR + 13 * MiB, W_Q = W_OUT + 9 * MiB, W_KV = W_Q + 9 * MiB, W_O = W_KV + 17 * MiB, W_13 = W_O + 9 * MiB, W_2 = W_13 + 46 * MiB, W_END = W_2 + 23 * MiB;
constexpr size_t WS_XN = W_END;
constexpr size_t WS_MN = WS_XN + 66 * MiB, WS_KM = WS_MN + 8 * MiB, WS_VT = WS_KM + 9 * MiB;
constexpr size_t WS_Y = WS_VT + 8 * MiB;
constexpr size_t WS_YRAW = WS_Y + 96 * MiB;
constexpr size_t WS_BIG = WS_YRAW + 64 * MiB;
constexpr size_t SEG = 32 * MiB, SEG_E = (size_t)16384 * 1024;
constexpr size_t WS_END_BIG = WS_BIG + 15 * SEG;
constexpr size_t RSS_STRIDE = (size_t)16384 * 32;
constexpr size_t WS_END = WS_END_BIG + 7 * RSS_STRIDE * 4;
static_assert(W_END == 192 * MiB && WS_END == 937 * MiB, "d_ws map");
constexpr size_t DO_WKV1 = 64 * MiB, DO_MN1 = 81 * MiB, DO_KV1 = 90 * MiB;
constexpr int CW_TMO = 0, CW_BAR = 4096, CW_Q = 8192;
constexpr size_t WS_RSS = WS_END_BIG;

constexpr int RING_OFF = 0, RING_BYTES = 131072;
constexpr int LDSCTL_OFF = RING_BYTES, MISC_OFF = LDSCTL_OFF + 320;
constexpr int LDS_BYTES = 147456;
static_assert(MISC_OFF + 128 <= LDS_BYTES, "LDS map");

struct Args { const float* in[22]; float* out; unsigned char* ws; int l_lo, l_hi; };
__device__ const float ROPE_INV[96] = {1.0f, 0.749894202f, 0.562341332f, 0.421696514f, 0.316227764f, 0.237137377f, 0.177827939f, 0.133352146f, 0.100000001f, 0.0749894232f, 0.0562341325f, 0.0421696492f, 0.0316227749f, 0.0237137377f, 0.0177827943f, 0.013335214f, 0.00999999978f, 0.00749894232f, 0.00562341325f, 0.00421696482f, 0.00316227763f, 0.00237137382f, 0.00177827943f, 0.00133352145f, 0.00100000005f, 0.000749894185f, 0.000562341302f, 0.000421696517f, 0.000316227757f, 0.00023713737f, 0.00017782794f, 0.00013335215f, 1.0f, 0.863988459f, 0.746476054f, 0.644946694f, 0.557226479f, 0.481437236f, 0.415956229f, 0.359381378f, 0.310501337f, 0.268269569f, 0.231781825f, 0.20025681f, 0.173019573f, 0.149486914f, 0.129154965f, 0.111588396f, 0.0964110866f, 0.0832980648f, 0.0719685704f, 0.0621800125f, 0.05372281f, 0.0464158878f, 0.040102791f, 0.0346483476f, 0.0299357735f, 0.0258641616f, 0.0223463364f, 0.0193069782f, 0.0166810062f, 0.0144121964f, 0.0124519709f, 0.010758359f, 0.00929509755f, 0.00803085696f, 0.00693856785f, 0.00599484239f, 0.0051794746f, 0.00447500637f, 0.00386635377f, 0.00334048504f, 0.00288614049f, 0.00249359198f, 0.0021544348f, 0.00186140672f, 0.0016082339f, 0.00138949545f, 0.00120050809f, 0.00103722513f, 0.000896150479f, 0.000774263695f, 0.000668954861f, 0.000577969302f, 0.000499358808f, 0.000431440218f, 0.000372759358f, 0.000322059786f, 0.000278255931f, 0.000240409921f, 0.00020771139f, 0.000179460243f, 0.000155051574f, 0.000133962778f, 0.000115742288f, 9.99999975e-05f};
struct Frame {
    LAS unsigned char* lds;
    volatile LAS unsigned* MISC;
    int vcu, G, wave;
};
#define PH_ENTER() const int wave = pg8::opq(F.wave), vcu_ = pg8::opq(F.vcu), G_ = pg8::opq(F.G); int tid = wave * 64 + pg8::lane_id(); asm volatile("" : "+v"(tid)); const int lane = tid & 63; (void)vcu_; (void)G_; \
    unsigned char* ws = pg8::uni_ptr(args.ws); (void)lane; (void)wave; (void)tid
__device__ __forceinline__ float wave_sum(float v) {
    v = pg8::xadd<1>(v); v = pg8::xadd<2>(v); v = pg8::xadd<4>(v); v = pg8::xadd<8>(v); v = pg8::xadd<16>(v); v = pg8::xadd<32>(v);
    return v;
}
__device__ __forceinline__ float wave_total(float v) {
#define DPPADD(ctrl, rmask) v += __int_as_float(__builtin_amdgcn_update_dpp(0, __float_as_int(v), ctrl, rmask, 0xf, true))
    DPPADD(0xB1, 0xf); DPPADD(0x4E, 0xf); DPPADD(0x141, 0xf); DPPADD(0x140, 0xf); DPPADD(0x142, 0xa); DPPADD(0x143, 0xc);
#undef DPPADD
    return __int_as_float(__builtin_amdgcn_readlane(__float_as_int(v), 63));
}
__device__ __forceinline__ float bflo(unsigned w) { return __uint_as_float(w << 16); }
__device__ __forceinline__ float bfhi(unsigned w) { return __uint_as_float(w & 0xffff0000u); }
__device__ __forceinline__ float sigm(float x) { return __builtin_amdgcn_rcpf(1.0f + __builtin_amdgcn_exp2f(-LOG2E * x)); }

template <int CMAP> __device__ __forceinline__ void transpose_item(const float* W, int K, int N, bf16* WT, int ldw, LAS float* scr, int item, int lane, const float* gain = nullptr) {
    const int nblk = N / 32, kb = item / nblk, nb = item % nblk, k0 = 64 * kb, n0 = 32 * nb;
    const int nn = n0 + (lane & 31); int sc = nn;
    if (CMAP == 1) sc = (nn & 1) * FFH + (nn >> 1);
    if (CMAP == 2) {
        if (nn < 2048) { const int w = nn & 63; sc = (nn & ~63) + (w & 1) * 32 + (w >> 1); }
        else if (nn >= 3072 && nn < 5120) { const int j = nn - 3072; sc = 3072 + (j & 1) * 1024 + (j >> 1); }
        else if (nn >= 5120 && nn < 7168) { const int w = (nn - 5120) & 127; sc = 5120 + ((nn - 5120) & ~127) + (w & 1) * 64 + (w >> 1); } }
    float wv[32]; const float gv = gain ? gain[k0 + lane] : 1.0f;
#pragma unroll
    for (int i = 0; i < 32; ++i) wv[i] = W[(size_t)(k0 + 2 * i + (lane >> 5)) * N + sc];
#pragma unroll
    for (int i = 0; i < 32; ++i) { const float g0 = __builtin_bit_cast(float, __builtin_amdgcn_readlane(__builtin_bit_cast(int, gv), 2 * i)), g1 = __builtin_bit_cast(float, __builtin_amdgcn_readlane(__builtin_bit_cast(int, gv), 2 * i + 1));
        scr[(2 * i + (lane >> 5)) * 33 + (lane & 31)] = wv[i] * ((lane >> 5) ? g1 : g0); }
    LDS_WAIT(); asm volatile("" ::: "memory");
    const int c = lane & 7;
#pragma unroll
    for (int j = 0; j < 4; ++j) { const int n = (lane >> 3) + 8 * j; const LAS float* s = scr + (8 * c) * 33 + n;
        v4u o; o.x = pk2(s[0 * 33], s[1 * 33]); o.y = pk2(s[2 * 33], s[3 * 33]); o.z = pk2(s[4 * 33], s[5 * 33]); o.w = pk2(s[6 * 33], s[7 * 33]);
        *(GAS v4u*)(WT + (size_t)(n0 + n) * ldw + k0 + 8 * c) = o; }
    LDS_WAIT(); asm volatile("" ::: "memory");
}
template <int CMAP> __device__ __forceinline__ int wt_row(int s) {
    if (CMAP == 1) return s < FFH ? 2 * s : 2 * (s - FFH) + 1;
    if (CMAP == 2) {
        if (s < 2048) { const int ws = s & 63; return (s & ~63) + (ws < 32 ? 2 * ws : 2 * (ws - 32) + 1); }
        if (s >= 3072 && s < 5120) { const int j = s - 3072; return 3072 + (j < 1024 ? 2 * j : 2 * (j - 1024) + 1); }
        if (s >= 5120 && s < 7168) { const int ws = (s - 5120) & 127; return 5120 + ((s - 5120) & ~127) + (ws < 64 ? 2 * ws : 2 * (ws - 64) + 1); } }
    return s;
}
template <int CMAP, int K> __device__ __forceinline__ void transpose_item_w(const float* W, int N, bf16* WT, int ldw, LAS unsigned char* scr, int item, int lane, const float* gain = nullptr) {
    constexpr int nkb = K / 64; const int nb = item / nkb, kb = item % nkb,
        k0 = 64 * kb, h = lane >> 5, cl = lane & 31, s0 = 128 * nb + 4 * cl;
    const float* src = W + (size_t)(k0 + h) * N + s0;
    f32x4 r[32]; const float gv = gain ? gain[k0 + lane] : 1.0f;
#pragma unroll
    for (int i = 0; i < 32; ++i) r[i] = *(const GAS f32x4*)(src + (size_t)(2 * i) * N);
    if (gain) {
#pragma unroll
        for (int i = 0; i < 32; ++i) { const float g0 = __builtin_bit_cast(float, __builtin_amdgcn_readlane(__builtin_bit_cast(int, gv), 2 * i)), g1 = __builtin_bit_cast(float, __builtin_amdgcn_readlane(__builtin_bit_cast(int, gv), 2 * i + 1));
            r[i] *= (h ? g1 : g0); } }
#pragma unroll
    for (int c0 = 0; c0 < 4; c0 += 2) {
#pragma unroll
        for (int d = 0; d < 2; ++d) {
            unsigned p[16];
#pragma unroll
            for (int i = 0; i < 16; ++i) { const auto rr = __builtin_amdgcn_permlane32_swap(__float_as_uint(r[i][c0 + d]), __float_as_uint(r[i + 16][c0 + d]), false, false);
                p[i] = pg8::cvt_pk_bf16(__uint_as_float(rr[0]), __uint_as_float(rr[1])); }
            const int rl = 2 * cl + d;
#pragma unroll
            for (int q = 0; q < 4; ++q) { v4u o; o.x = p[4 * q]; o.y = p[4 * q + 1]; o.z = p[4 * q + 2]; o.w = p[4 * q + 3];
                *(LAS v4u*)(scr + rl * 128 + (((4 * h + q) ^ (rl & 7)) << 4)) = o; }
        }
        LDS_WAIT(); asm volatile("" ::: "memory");
        v4u o[8];
#pragma unroll
        for (int j = 0; j < 8; ++j) { const int rl = (lane >> 3) + 8 * j; o[j] = *(const LAS v4u*)(scr + rl * 128 + (((lane & 7) ^ (rl & 7)) << 4)); }
        LDS_WAIT(); asm volatile("" ::: "memory");
#pragma unroll
        for (int j = 0; j < 8; ++j) { const int rl = (lane >> 3) + 8 * j; const int sc = 128 * nb + 4 * (rl >> 1) + c0 + (rl & 1);
            *(GAS v4u*)(WT + (size_t)wt_row<CMAP>(sc) * ldw + k0 + 8 * (lane & 7)) = o[j]; }
    }
}
__device__ __forceinline__ void convert_item(const float* W, bf16* WO, int ldw, int item, int lane, const float* gain) {
    const int kb = item / 64, nb = item % 64, k0 = 64 * kb, n0 = 32 * nb; const int kk = lane >> 3, c4 = (lane & 7) * 4;
    f32x4 v[8]; float g[8];
#pragma unroll
    for (int i = 0; i < 8; ++i) { const int k = k0 + 8 * i + kk; v[i] = *(const GAS f32x4*)(W + (size_t)k * DM_ + n0 + c4); g[i] = gain[k]; }
#pragma unroll
    for (int i = 0; i < 8; ++i) { const int k = k0 + 8 * i + kk;
        *(GAS unsigned long long*)(WO + (size_t)k * ldw + n0 + c4) = (unsigned long long)pk2(v[i].x * g[i], v[i].y * g[i]) | ((unsigned long long)pk2(v[i].z * g[i], v[i].w * g[i]) << 32); }
}
__device__ __forceinline__ void convert_item_w(const float* W, bf16* WO, int ldw, int item, int lane, const float* gain) {
    const int kb = item / 16, nb = item % 16, k0 = 64 * kb, h = lane >> 5, n0 = 128 * nb + 4 * (lane & 31);
    const float* src = W + (size_t)(k0 + h) * DM_ + n0; bf16* dst = WO + (size_t)(k0 + h) * ldw + n0;
    f32x4 r[32]; const float gv = gain[k0 + lane];
#pragma unroll
    for (int i = 0; i < 32; ++i) r[i] = *(const GAS f32x4*)(src + (size_t)(2 * i) * DM_);
#pragma unroll
    for (int i = 0; i < 32; ++i) { const float g0 = __builtin_bit_cast(float, __builtin_amdgcn_readlane(__builtin_bit_cast(int, gv), 2 * i)), g1 = __builtin_bit_cast(float, __builtin_amdgcn_readlane(__builtin_bit_cast(int, gv), 2 * i + 1));
        const f32x4 v = r[i] * (h ? g1 : g0);
        *(GAS unsigned long long*)(dst + (size_t)(2 * i) * ldw) = (unsigned long long)pg8::cvt_pk_bf16(v.x, v.y) | ((unsigned long long)pg8::cvt_pk_bf16(v.z, v.w) << 32); }
}
constexpr int LATE_ITEMS = 6528, LATE_ITEMS_IN = 3840, CHUNK_ITEMS = 32;
typedef const __attribute__((address_space(4))) unsigned char* kargp_t;
__device__ __forceinline__ const float* karg_in(kargp_t kp, int k) { return *(const float* const __attribute__((address_space(4)))*)(kp + 8 * k); }
__device__ __forceinline__ void late_item(kargp_t kp, unsigned char* ws, int l, int r, LAS unsigned char* scr, int lane) {
    if (r < 768) { const int br = r >> 8; transpose_item_w<0, MIXW>(karg_in(kp, 11) + ((size_t)l * 3 + br) * MIXW * DM_, DM_, (bf16*)(ws + W_BR) + (size_t)br * DM_ * LD1K, LD1K, scr, r & 255, lane); return; } r -= 768;
    if (r < 512) { transpose_item_w<0, DM_>(karg_in(kp, 12) + (size_t)l * DM_ * DM_, DM_, (bf16*)(ws + W_OUT), LD2K, scr, r, lane); return; } r -= 512;
    if (r < 512) { convert_item_w(karg_in(kp, 15) + (size_t)l * DM_ * DM_, (bf16*)(ws + W_Q), LD2K, r, lane, karg_in(kp, 13) + (size_t)l * DM_); return; } r -= 512;
    if (r < 512) { transpose_item_w<0, DM_>(karg_in(kp, 17) + (size_t)l * DM_ * DM_, DM_, (bf16*)(ws + W_O), LD2K, scr, r, lane); return; } r -= 512;
    if (r < 2816) { transpose_item_w<1, DM_>(karg_in(kp, 19) + (size_t)l * DM_ * 2 * FFH, 2 * FFH, (bf16*)(ws + W_13), LD2K, scr, r, lane, karg_in(kp, 18) + (size_t)l * DM_); return; } r -= 2816;
    if (r < 1408) { transpose_item_w<0, FFH>(karg_in(kp, 20) + (size_t)l * FFH * DM_, DM_, (bf16*)(ws + W_2), LDFF, scr, r, lane); return; } r -= 1408;
    transpose_item_w<2, DM_>(karg_in(kp, 3) + (size_t)(l + 1) * DM_ * INC, INC, (bf16*)(ws + W_IN), LD2K, scr, r, lane, karg_in(kp, 2) + (size_t)(l + 1) * DM_);
}
template <bool TOF32> __device__ __forceinline__ void rms_row(int lane, const float* xrow, const float* gain, void* orow) {
    const GAS f32x4* xr = (const GAS f32x4*)xrow + lane; const GAS f32x4* gr = (const GAS f32x4*)gain + lane;
    f32x4 v[8]; float s = 0.f;
#pragma unroll
    for (int j = 0; j < 8; ++j) { v[j] = xr[64 * j]; s += (v[j].x * v[j].x + v[j].y * v[j].y) + (v[j].z * v[j].z + v[j].w * v[j].w); }
    const float r = 1.0f / sqrtf(wave_sum(s) * (1.f / 2048.f) + EPSN);
#pragma unroll
    for (int j = 0; j < 8; ++j) { const f32x4 g = gr[64 * j]; const f32x4 y = v[j] * r * g;
        if (TOF32) ((GAS f32x4*)orow + lane)[64 * j] = y;
        else ((GAS unsigned long long*)orow + lane)[64 * j] = (unsigned long long)pk2(y.x, y.y) | ((unsigned long long)pk2(y.z, y.w) << 32); }
}

__device__ __forceinline__ void ph_prep(Frame& F, const Args& args, int l, const float* xcur) {
    PH_ENTER();
    LAS float* scr = (LAS float*)(F.lds + RING_OFF + wave * 16384);
    const int gw = vcu_ * NWAVES + wave, NGW = G_ * NWAVES;
    constexpr int I_IN = 32 * (INC / 128), I_KV = 32 * 32;
    if (l == 0) for (int it = gw; it < I_IN + I_KV; it += NGW) {
        int r = it;
        if (r < I_IN) { transpose_item_w<2, DM_>(args.in[3], INC, (bf16*)(ws + W_IN), LD2K, (LAS unsigned char*)scr, r, lane, args.in[2]); continue; } r -= I_IN;
        transpose_item_w<0, DM_>(args.in[16], 2 * DM_, (bf16*)(ws + W_KV), LD2K, (LAS unsigned char*)scr, r, lane);
        transpose_item_w<0, DM_>(args.in[16] + (size_t)DM_ * 2 * DM_, 2 * DM_, (bf16*)((unsigned char*)args.out + DO_WKV1), LD2K, (LAS unsigned char*)scr, r, lane);
    }
    if (l == 0) for (int m = gw; m < M; m += NGW) {
        const GAS f32x4* xr = (const GAS f32x4*)(xcur + (size_t)m * DM_) + lane; GAS unsigned long long* orow = (GAS unsigned long long*)((bf16*)(ws + WS_XN) + (size_t)m * LD2K) + lane; float sq = 0.f;
#pragma unroll
        for (int j = 0; j < 8; ++j) { const f32x4 v = xr[64 * j]; sq += (v.x * v.x + v.y * v.y) + (v.z * v.z + v.w * v.w); orow[64 * j] = (unsigned long long)pk2(v.x, v.y) | ((unsigned long long)pk2(v.z, v.w) << 32); }
        sq = wave_sum(sq); if (lane < 32) ((float*)(ws + WS_RSS))[((size_t)(lane >> 2) * M + (size_t)m) * 4 + (lane & 3)] = lane == 0 ? sq : 0.f; }
    if (l == 0) for (int m = gw; m < MEMROWS; m += NGW) { rms_row<false>(lane, args.in[1] + (size_t)m * DM_, args.in[14], (bf16*)(ws + WS_MN) + (size_t)m * DM_);
                                                         rms_row<false>(lane, args.in[1] + (size_t)m * DM_, args.in[14] + DM_, (bf16*)((unsigned char*)args.out + DO_MN1) + (size_t)m * DM_); }
    if (l == 1) { const int gt = vcu_ * (NWAVES * 64) + tid, NGT = G_ * NWAVES * 64;
        const GAS v4u* src = (const GAS v4u*)((const unsigned char*)args.out + DO_KV1); GAS v4u* dst = (GAS v4u*)(ws + WS_KM);
        for (int e = gt; e < 2 * MEMROWS * LD2K / 8; e += NGT) dst[e] = src[e]; }
    if (l == 0 && vcu_ == 0 && wave == 0) {
#pragma unroll
        for (int ll = 0; ll < DEPTH; ++ll) { const float* dl = args.in[4] + (size_t)ll * 256;
            const float s01 = wave_sum(dl[lane] * dl[64 + lane]), s23 = wave_sum(dl[128 + lane] * dl[192 + lane]);
            const float linit = 0.8f - 0.6f * expf(-0.3f * (float)ll);
            float* fz = (float*)(ws + WS_LAM) + 192 * ll;
            if (lane == 0) { fz[0] = expf(s01) - expf(s23) + linit; fz[1] = 1.0f - linit; }
            fz[2 + lane] = args.in[5][(size_t)ll * 128 + lane] * (1.0f - linit); fz[66 + lane] = args.in[5][(size_t)ll * 128 + 64 + lane] * (1.0f - linit); } }
    if (l == 0) {
        const int gt = vcu_ * (NWAVES * 64) + tid, NGT = G_ * NWAVES * 64;
        for (int e = gt; e < 2048 * 96; e += NGT) {
            const int t = e / 96, i = e % 96; float inv; float* dst;
            if (i < 32) { dst = (float*)(ws + WS_DCS) + ((size_t)t * 32 + i) * 2; }
            else { dst = (float*)(ws + WS_RCS) + ((size_t)t * 64 + (i - 32)) * 2; }
            inv = ROPE_INV[i];
            const float ang = (float)t * inv;
            const float CH = 0.15915494f, CL = 6.4206382e-09f;
            const float p = ang * CH, pe = fmaf(ang, CH, -p) + ang * CL; const float fr = (p - floorf(p)) + pe;
            dst[0] = __builtin_amdgcn_cosf(fr); dst[1] = __builtin_amdgcn_sinf(fr);
        }
    }
}

__device__ __forceinline__ void ph_rope(Frame& F, const Args& args) {
    PH_ENTER();
    const int gw = vcu_ * NWAVES + wave, NGW = G_ * NWAVES;
    for (int it = gw; it < 4 * M; it += NGW) {
        const int sel = it / M, row = it % M, t = row % NT_;
        const int seg = sel == 0 ? 0 : sel == 1 ? 1 : sel == 2 ? 5 : 6;
        bf16* base = (bf16*)(ws + WS_BIG + (size_t)seg * SEG) + (size_t)row * 1024;
        int c1, c2; const float* tab; float sc;
        if (sel < 2) { const int blk = lane >> 2, d0 = (lane & 3) * 8; c1 = blk * 64 + d0; c2 = c1 + 32; tab = (const float*)(ws + WS_DCS) + ((size_t)t * 32 + d0) * 2; sc = sel == 0 ? 0.125f * LOG2E : 1.0f; }
        else { const int blk = lane >> 3, d0 = (lane & 7) * 8; c1 = blk * 128 + d0; c2 = c1 + 64; tab = (const float*)(ws + WS_RCS) + ((size_t)t * 64 + d0) * 2; sc = sel == 2 ? 0.08838834764831845f : 1.0f; }
        const v4u a = *(const GAS v4u*)(base + c1), b = *(const GAS v4u*)(base + c2);
        const GAS f32x4* tb = (const GAS f32x4*)tab; const f32x4 t0 = tb[0], t1 = tb[1], t2 = tb[2], t3 = tb[3];
        const float cs[8] = {t0.x, t0.z, t1.x, t1.z, t2.x, t2.z, t3.x, t3.z}, sn[8] = {t0.y, t0.w, t1.y, t1.w, t2.y, t2.w, t3.y, t3.w};
        const unsigned aw[4] = {a.x, a.y, a.z, a.w}, bw[4] = {b.x, b.y, b.z, b.w}; unsigned oa[4], ob[4];
#pragma unroll
        for (int j = 0; j < 4; ++j) {
            const float x1l = bflo(aw[j]), x1h = bfhi(aw[j]), x2l = bflo(bw[j]), x2h = bfhi(bw[j]);
            const float y1l = (x1l * cs[2 * j] - x2l * sn[2 * j]) * sc, y2l = (x2l * cs[2 * j] + x1l * sn[2 * j]) * sc;
            const float y1h = (x1h * cs[2 * j + 1] - x2h * sn[2 * j + 1]) * sc, y2h = (x2h * cs[2 * j + 1] + x1h * sn[2 * j + 1]) * sc;
            oa[j] = pk2(y1l, y1h); ob[j] = pk2(y2l, y2h);
        }
        v4u wa; wa.x = oa[0]; wa.y = oa[1]; wa.z = oa[2]; wa.w = oa[3]; v4u wb; wb.x = ob[0]; wb.y = ob[1]; wb.z = ob[2]; wb.w = ob[3];
        *(GAS v4u*)(base + c1) = wa; *(GAS v4u*)(base + c2) = wb;
    }
}

__device__ __forceinline__ void ph_conv(Frame& F, const Args& args, int l, int ustart, int uend) {
    PH_ENTER();
    const bf16* U = (const bf16*)(ws + WS_BIG + 3 * SEG);
    bf16* YB = (bf16*)(ws + WS_Y) + SEG_E;
    const int c0 = 2 * tid;
    const float* cw = args.in[6] + (size_t)l * 31 * 1024;
    typedef float f32x2c __attribute__((ext_vector_type(2)));
    f32x2c w2[31];
#pragma unroll
    for (int j = 0; j < 31; ++j) { const float2 w = *(const float2*)(cw + j * 1024 + c0); w2[j] = (f32x2c){w.x, w.y}; }
    const float2 bias = *(const float2*)(args.in[7] + (size_t)l * 1024 + c0), lg = *(const float2*)(args.in[8] + (size_t)l * 1024 + c0), lb = *(const float2*)(args.in[9] + (size_t)l * 1024 + c0);
    LAS unsigned char* Us = F.lds + RING_OFF;
    LAS float* red1 = (LAS float*)(F.lds + RING_OFF + 46 * 2048); LAS float* red2 = red1 + 16 * 8;
    for (int unit = ustart; unit < uend; ++unit) {
        const int b = unit >> 7, t0 = (unit & 127) * 16;
#pragma unroll
        for (int i = 0; i < 12; ++i) { const int idx = tid + 512 * i; const int r = idx >> 7, ch = idx & 127;
            if (idx < 46 * 128) { const int tg = t0 - 30 + r; v4u v; v.x = 0u; v.y = 0u; v.z = 0u; v.w = 0u;
                if (tg >= 0) v = *(const GAS v4u*)(U + ((size_t)b * NT_ + tg) * 1024 + ch * 8);
                *(LAS v4u*)(Us + r * 2048 + ch * 16) = v; } }
        __syncthreads();
        f32x2c acc2[16];
#pragma unroll
        for (int t = 0; t < 16; ++t) acc2[t] = (f32x2c){0.f, 0.f};
#pragma unroll
        for (int r = 0; r < 46; ++r) {
            const unsigned uw = *(const LAS unsigned*)(Us + r * 2048 + tid * 4);
            const f32x2c u2 = {bflo(uw), bfhi(uw)};
#pragma unroll
            for (int t = 0; t < 16; ++t) { const int j = r - t; if (j >= 0 && j <= 30) acc2[t] = __builtin_elementwise_fma(u2, w2[j], acc2[t]); }
        }
        float a0[16], a1[16];
#pragma unroll
        for (int t = 0; t < 16; ++t) { a0[t] = acc2[t].x; a1[t] = acc2[t].y; }
        float mu[16];
#pragma unroll
        for (int t = 0; t < 16; ++t) { a0[t] += bias.x; a1[t] += bias.y; const float s = wave_total(a0[t] + a1[t]); if (lane == 0) red1[t * 8 + wave] = s; }
        __syncthreads();
#pragma unroll
        for (int t = 0; t < 16; ++t) { float s = 0.f;
#pragma unroll
            for (int w = 0; w < 8; ++w) s += red1[t * 8 + w];
            mu[t] = s * (1.f / 1024.f); a0[t] -= mu[t]; a1[t] -= mu[t];
            const float q = wave_total(a0[t] * a0[t] + a1[t] * a1[t]); if (lane == 0) red2[t * 8 + wave] = q; }
        __syncthreads();
#pragma unroll
        for (int t = 0; t < 16; ++t) { float q = 0.f;
#pragma unroll
            for (int w = 0; w < 8; ++w) q += red2[t * 8 + w];
            const float rs = 1.0f / sqrtf(q * (1.f / 1024.f) + EPSN);
            const float y0 = a0[t] * rs * lg.x + lb.x, y1 = a1[t] * rs * lg.y + lb.y;
            *(GAS unsigned*)(YB + ((size_t)b * NT_ + t0 + t) * 1024 + c0) = pk2(y0 * sigm(y0), y1 * sigm(y1)); }
    }
    __syncthreads();
}
__device__ __forceinline__ int sw_off(int row, int col) { return row * 256 + ((((col >> 3) ^ (row & 15)) << 4) | ((col & 7) << 1)); }
__device__ __forceinline__ void ph_ret_seq(Frame& F, const Args& args, int l, int bh) {
    PH_ENTER();
    typedef short bf16x8v __attribute__((ext_vector_type(8)));
    LAS unsigned char* Ks = F.lds + RING_OFF; LAS unsigned char* KTs = Ks + 32768; LAS unsigned char* VTs = KTs + 32768; LAS unsigned char* STs = VTs + 32768;
    const bf16* RQ = (const bf16*)(ws + WS_BIG + 5 * SEG); const bf16* RK = (const bf16*)(ws + WS_BIG + 6 * SEG); const bf16* RV = (const bf16*)(ws + WS_BIG + 7 * SEG); const bf16* RG = (const bf16*)(ws + WS_BIG + 8 * SEG);
    bf16* YRo = (bf16*)(ws + WS_Y) + 2 * SEG_E;
    const float* gng = args.in[10] + (size_t)l * 1024;
    const int wid = wave;
    const int b = bh >> 3, h = bh & 7;
    const float lg2 = log2f(1.0f - exp2f(-5.0f - (float)h));
    const float cdec = exp2f(128.0f * lg2);
    f32x4 st[8];
#pragma unroll
    for (int c = 0; c < 8; ++c) st[c] = (f32x4){0.f, 0.f, 0.f, 0.f};
    for (int e = tid; e < 8192; e += NWAVES * 64) ((LAS unsigned*)STs)[e] = 0u;
    bf16x8v qa[4]; v4u kq[4], vq[4];
    { const size_t r0 = (size_t)b * NT_; const int fr0 = lane & 15, fq0 = lane >> 4;
#pragma unroll
      for (int ks = 0; ks < 4; ++ks) qa[ks] = *(const GAS bf16x8v*)(RQ + (r0 + 16 * wid + fr0) * 1024 + h * 128 + ks * 32 + fq0 * 8);
#pragma unroll
      for (int i = 0; i < 4; ++i) { const int r = lane + 64 * (i & 1), cc = 2 * wid + (i >> 1); const size_t go = (r0 + r) * 1024 + h * 128 + cc * 8;
          kq[i] = *(const GAS v4u*)(RK + go); vq[i] = *(const GAS v4u*)(RV + go); } }
    for (int n = 0; n < 16; ++n) {
        const size_t row0 = (size_t)b * NT_ + (size_t)n * 128;
        int lane_n = lane; asm volatile("" : "+v"(lane_n)); const int fr = lane_n & 15, fq = lane_n >> 4;
        float lgn = lg2; asm volatile("" : "+v"(lgn));
#pragma unroll
        for (int i = 0; i < 4; ++i) { const int r = lane_n + 64 * (i & 1), cc = 2 * wid + (i >> 1);
            const v4u k = kq[i], v = vq[i];
            *(LAS v4u*)(Ks + sw_off(r, cc * 8)) = k;
            const float kd = __builtin_amdgcn_exp2f((float)(127 - r) * lgn); const unsigned kw[4] = {k.x, k.y, k.z, k.w}, vw[4] = {v.x, v.y, v.z, v.w};
#pragma unroll
            for (int j = 0; j < 4; ++j) {
                *(LAS bf16*)(KTs + sw_off(cc * 8 + 2 * j, r)) = (bf16)f2bf(bflo(kw[j]) * kd); *(LAS bf16*)(KTs + sw_off(cc * 8 + 2 * j + 1, r)) = (bf16)f2bf(bfhi(kw[j]) * kd);
                *(LAS bf16*)(VTs + sw_off(cc * 8 + 2 * j, r)) = (bf16)(vw[j] & 0xffffu); *(LAS bf16*)(VTs + sw_off(cc * 8 + 2 * j + 1, r)) = (bf16)(vw[j] >> 16); }
            if (i & 1) asm volatile("" ::: "memory"); }
        __syncthreads();
        unsigned Pk[8][2]; f32x4 o[8];
#pragma unroll
        for (int c = 0; c < 8; ++c) { f32x4 Sc = (f32x4){0.f, 0.f, 0.f, 0.f};
#pragma unroll
            for (int ks = 0; ks < 4; ++ks) { const bf16x8v kb = *(const LAS bf16x8v*)(Ks + sw_off(16 * c + fr, ks * 32 + fq * 8));
                Sc = __builtin_amdgcn_mfma_f32_16x16x32_bf16(qa[ks], kb, Sc, 0, 0, 0); }
            float p4[4];
#pragma unroll
            for (int rg = 0; rg < 4; ++rg) { const int tl = 16 * wid + 4 * fq + rg, sl = 16 * c + fr; p4[rg] = sl <= tl ? Sc[rg] * __builtin_amdgcn_exp2f((float)(tl - sl) * lgn) : 0.f; }
            Pk[c][0] = pk2(p4[0], p4[1]); Pk[c][1] = pk2(p4[2], p4[3]);
            asm volatile("" ::: "memory"); }
#pragma unroll
        for (int c = 0; c < 8; ++c) { o[c] = (f32x4){0.f, 0.f, 0.f, 0.f};
#pragma unroll
            for (int ks = 0; ks < 4; ++ks) { const bf16x8v sb = *(const LAS bf16x8v*)(STs + sw_off(16 * c + fr, ks * 32 + fq * 8));
                o[c] = __builtin_amdgcn_mfma_f32_16x16x32_bf16(qa[ks], sb, o[c], 0, 0, 0); }
#pragma unroll
            for (int rg = 0; rg < 4; ++rg) o[c][rg] *= __builtin_amdgcn_exp2f((float)(16 * wid + 4 * fq + rg + 1) * lgn);
            asm volatile("" ::: "memory"); }
        {
            bf16x8v va[4];
#pragma unroll
            for (int ks = 0; ks < 4; ++ks) va[ks] = *(const LAS bf16x8v*)(VTs + sw_off(16 * wid + fr, ks * 32 + fq * 8));
#pragma unroll
            for (int c = 0; c < 8; ++c) { st[c] = st[c] * cdec;
#pragma unroll
                for (int ks = 0; ks < 4; ++ks) { const bf16x8v kb = *(const LAS bf16x8v*)(KTs + sw_off(16 * c + fr, ks * 32 + fq * 8));
                    st[c] = __builtin_amdgcn_mfma_f32_16x16x32_bf16(va[ks], kb, st[c], 0, 0, 0); }
                asm volatile("" ::: "memory"); }
        }
        __syncthreads();
        v4u gq[4];
#pragma unroll
        for (int i = 0; i < 4; ++i) gq[i] = *(const GAS v4u*)(RG + (row0 + 16 * wid + (lane_n >> 4) + 4 * i) * 1024 + h * 128 + (lane_n & 15) * 8);
        bf16x8v qn[4];
        if (n + 1 < 16) { const size_t r1 = row0 + 128;
#pragma unroll
            for (int ks = 0; ks < 4; ++ks) qn[ks] = *(const GAS bf16x8v*)(RQ + (r1 + 16 * wid + fr) * 1024 + h * 128 + ks * 32 + fq * 8);
#pragma unroll
            for (int i = 0; i < 4; ++i) { const int r = lane_n + 64 * (i & 1), cc = 2 * wid + (i >> 1); const size_t go = (r1 + r) * 1024 + h * 128 + cc * 8;
                kq[i] = *(const GAS v4u*)(RK + go); vq[i] = *(const GAS v4u*)(RV + go); } }
        else {
#pragma unroll
            for (int ks = 0; ks < 4; ++ks) qn[ks] = qa[ks]; }
#pragma unroll
        for (int c = 0; c < 8; ++c)
#pragma unroll
            for (int rg = 0; rg < 4; ++rg) { const int tl = 16 * wid + 4 * fq + rg, sl = 16 * c + fr;
                *(LAS bf16*)(Ks + sw_off(tl, sl)) = (bf16)((rg & 1) ? (Pk[c][rg >> 1] >> 16) : (Pk[c][rg >> 1] & 0xffffu));
                *(LAS bf16*)(STs + sw_off(tl, sl)) = (bf16)f2bf(st[c][rg]); }
        LDS_WAIT(); asm volatile("" ::: "memory");
        bf16x8v pa[4];
#pragma unroll
        for (int ks = 0; ks < 4; ++ks) pa[ks] = *(const LAS bf16x8v*)(Ks + sw_off(16 * wid + fr, ks * 32 + fq * 8));
#pragma unroll
        for (int c = 0; c < 8; ++c) {
#pragma unroll
            for (int ks = 0; ks < 4; ++ks) { const bf16x8v vb = *(const LAS bf16x8v*)(VTs + sw_off(16 * c + fr, ks * 32 + fq * 8));
                o[c] = __builtin_amdgcn_mfma_f32_16x16x32_bf16(pa[ks], vb, o[c], 0, 0, 0); }
            asm volatile("" ::: "memory"); }
        float mu[4], rs[4];
#pragma unroll
        for (int rg = 0; rg < 4; ++rg) { float s = 0.f;
#pragma unroll
            for (int c = 0; c < 8; ++c) s += o[c][rg];
            s = pg8::xadd<1>(s); s = pg8::xadd<2>(s); s = pg8::xadd<4>(s); s = pg8::xadd<8>(s); mu[rg] = s * (1.f / 128.f);
            float q = 0.f;
#pragma unroll
            for (int c = 0; c < 8; ++c) { const float d = o[c][rg] - mu[rg]; q += d * d; }
            q = pg8::xadd<1>(q); q = pg8::xadd<2>(q); q = pg8::xadd<4>(q); q = pg8::xadd<8>(q); rs[rg] = 1.0f / sqrtf(q * (1.f / 128.f) + EPSN); }
#pragma unroll
        for (int c = 0; c < 8; ++c)
#pragma unroll
            for (int rg = 0; rg < 4; ++rg) *(LAS bf16*)(Ks + sw_off(16 * wid + 4 * fq + rg, 16 * c + fr)) = (bf16)f2bf((o[c][rg] - mu[rg]) * rs[rg] * gng[h * 128 + 16 * c + fr]);
        LDS_WAIT(); asm volatile("" ::: "memory");
#pragma unroll
        for (int i = 0; i < 4; ++i) { const int r = 16 * wid + (lane_n >> 4) + 4 * i, cc = lane_n & 15;
            const v4u y = *(const LAS v4u*)(Ks + sw_off(r, cc * 8)); const size_t go = (row0 + r) * 1024 + h * 128 + cc * 8;
            const unsigned yw[4] = {y.x, y.y, y.z, y.w}, gw4[4] = {gq[i].x, gq[i].y, gq[i].z, gq[i].w}; unsigned ow[4];
#pragma unroll
            for (int j = 0; j < 4; ++j) { const float ga = bflo(gw4[j]), gb = bfhi(gw4[j]); ow[j] = pk2(ga * sigm(ga) * bflo(yw[j]), gb * sigm(gb) * bfhi(yw[j])); }
            v4u w; w.x = ow[0]; w.y = ow[1]; w.z = ow[2]; w.w = ow[3]; *(GAS v4u*)(YRo + go) = w; }
        __syncthreads();
#pragma unroll
        for (int ks = 0; ks < 4; ++ks) qa[ks] = qn[ks];
    }
}

__device__ __forceinline__ void ph_combine(Frame& F, const Args& args, int l) {
    PH_ENTER();
    const int gw = vcu_ * NWAVES + wave, NGW = G_ * NWAVES;
    const float* dl = args.in[4] + (size_t)l * 256;
    const float s01 = wave_sum(dl[lane] * dl[64 + lane]), s23 = wave_sum(dl[128 + lane] * dl[192 + lane]);
    const float linit = 0.8f - 0.6f * expf(-0.3f * (float)l);
    const float lam = expf(s01) - expf(s23) + linit;
    const float* subln = args.in[5] + (size_t)l * 128 + (lane & 7) * 16;
    float sl[16];
#pragma unroll
    for (int i = 0; i < 16; ++i) sl[i] = subln[i] * (1.0f - linit);
    const bf16* O0 = (const bf16*)args.out; const bf16* O1 = O0 + SEG_E;
    bf16* YA = (bf16*)(ws + WS_Y);
    for (int m = gw; m < M; m += NGW) {
        const size_t off = (size_t)m * 1024 + lane * 16;
        {   const v4u a0 = *(const GAS v4u*)(O0 + off), a1 = *(const GAS v4u*)(O0 + off + 8), b0 = *(const GAS v4u*)(O1 + off), b1 = *(const GAS v4u*)(O1 + off + 8);
            const unsigned aw[8] = {a0.x, a0.y, a0.z, a0.w, a1.x, a1.y, a1.z, a1.w}, bw[8] = {b0.x, b0.y, b0.z, b0.w, b1.x, b1.y, b1.z, b1.w};
            float d[16]; float ss = 0.f;
#pragma unroll
            for (int j = 0; j < 8; ++j) { d[2 * j] = bflo(aw[j]) - lam * bflo(bw[j]); d[2 * j + 1] = bfhi(aw[j]) - lam * bfhi(bw[j]); ss += d[2 * j] * d[2 * j] + d[2 * j + 1] * d[2 * j + 1]; }
            ss = pg8::xadd<1>(ss); ss = pg8::xadd<2>(ss); ss = pg8::xadd<4>(ss);
            const float r = 1.0f / sqrtf(ss * (1.f / 128.f) + EPSN);
            unsigned ow[8];
#pragma unroll
            for (int j = 0; j < 8; ++j) ow[j] = pk2(d[2 * j] * r * sl[2 * j], d[2 * j + 1] * r * sl[2 * j + 1]);
            v4u w0; w0.x = ow[0]; w0.y = ow[1]; w0.z = ow[2]; w0.w = ow[3]; v4u w1; w1.x = ow[4]; w1.y = ow[5]; w1.z = ow[6]; w1.w = ow[7];
            *(GAS v4u*)(YA + off) = w0; *(GAS v4u*)(YA + off + 8) = w1; }
    }
}

#ifndef MK_MULTI
#define MK_MULTI 0
#endif
template <int KLO, int KHI> __global__ void __launch_bounds__(NWAVES * 64, 2) mk_fwd(Args args) {
    extern __shared__ __attribute__((aligned(16))) unsigned char lds[];
    Frame F;
    F.lds = (LAS unsigned char*)lds;
    F.MISC = (volatile LAS unsigned*)(F.lds + MISC_OFF);
    F.wave = __builtin_amdgcn_readfirstlane((int)threadIdx.x >> 6); F.G = gridDim.x; { const int bx = blockIdx.x; F.vcu = (F.G % 8 == 0) ? (bx % 8) * (F.G / 8) + bx / 8 : bx; }
    for (int u = threadIdx.x; u < (LDS_BYTES - LDSCTL_OFF) / 4; u += NWAVES * 64) ((LAS unsigned*)(F.lds + LDSCTL_OFF))[u] = 0u;
    __syncthreads();
    XcdBarrier bar; bar.bar = (unsigned*)(args.ws + WS_CTL) + CW_BAR; bar.x = 0; bar.st = nullptr;
    if (!MK_MULTI) bar = xcd_barrier_post((unsigned*)(args.ws + WS_CTL) + CW_BAR, F.MISC + 8, threadIdx.x == 0);
#ifndef REP_MASK
#define REP_MASK 0u
#endif
#define NREP(k) ((((REP_MASK) >> (k)) & 1u) ? 2 : 1)
#define IN(k) (KLO <= (k) && (k) < KHI)
#define SEAM(k) do { if (!MK_MULTI && IN(k) && IN((k) + 1)) xcd_barrier(bar, F.wave == 0 && pg8::lane_id() == 0); } while (0)
#define PHP() unsigned char* ws = pg8::uni_ptr(args.ws); bf16* const XN = (bf16*)(ws + WS_XN); bf16* const BIGp = (bf16*)(ws + WS_BIG); const int bx = pg8::opq((int)blockIdx.x), G_ = pg8::opq(F.G); (void)XN; (void)BIGp; (void)bx; (void)G_

    for (int l = args.l_lo; l < args.l_hi; ++l) {
        constexpr int pb = 0;
        const float* xcur = args.in[0];
        if (IN(pb + 0)) for (int rep_ = 0; rep_ < NREP(0); ++rep_) ph_prep(F, args, l, xcur);
        SEAM(pb + 0);
        if (IN(pb + 1)) for (int rep_ = 0; rep_ < NREP(1); ++rep_) { PHP();
            { pg8::Gemm g{XN, (const bf16*)(ws + W_IN), LD2K, LD2K, DM_}; pg8::StaticOrder S; S.init(M, INC, G_, bx, LD2K, LD2K);
              pg8::EpiInProj E{BIGp, (const float*)(ws + WS_DCS), (const float*)(ws + WS_RCS), (const float*)(ws + WS_RSS) + (l == 0 ? 0 : 3 * RSS_STRIDE)};
              pg8::gemm_phase<pg8::EpiInProj, pg8::StaticOrder, true, true>(F.lds + RING_OFF, g, S, E, F.wave); }
            if (l == 0) {
            { pg8::Gemm g{(const bf16*)(ws + WS_MN), (const bf16*)(ws + W_KV), DM_, LD2K, DM_}; pg8::StaticOrder S; S.init(MEMROWS, 2 * DM_, G_, (bx + 128) % G_, DM_, LD2K);
              pg8::EpiBf16 E{(bf16*)(ws + WS_KM), LD2K, DM_, (size_t)MEMROWS * LD2K, 1.0f, nullptr};
              pg8::gemm_phase<pg8::EpiBf16, pg8::StaticOrder, true, true>(F.lds + RING_OFF, g, S, E, F.wave); }
            { pg8::Gemm g{(const bf16*)((unsigned char*)args.out + DO_MN1), (const bf16*)((unsigned char*)args.out + DO_WKV1), DM_, LD2K, DM_}; pg8::StaticOrder S; S.init(MEMROWS, 2 * DM_, G_, bx, DM_, LD2K);
              pg8::EpiBf16 E{(bf16*)((unsigned char*)args.out + DO_KV1), LD2K, DM_, (size_t)MEMROWS * LD2K, 1.0f, nullptr};
              pg8::gemm_phase<pg8::EpiBf16, pg8::StaticOrder, true, true>(F.lds + RING_OFF, g, S, E, F.wave); }
            }
        }
        SEAM(pb + 1);
        if (IN(pb + 3)) for (int rep_ = 0; rep_ < NREP(3); ++rep_) { PHP();
            const attn_body::bf16* Qp = (const attn_body::bf16*)BIGp; const attn_body::bf16* Kp = (const attn_body::bf16*)(BIGp + SEG_E); const attn_body::bf16* Vp = (const attn_body::bf16*)(BIGp + 2 * SEG_E);
            attn_body::bf16* Op = (attn_body::bf16*)args.out;
            unsigned* qctr = (unsigned*)(ws + WS_CTL) + CW_Q + 64 * (2 * l + rep_);
            const float* fzl = (const float*)(ws + WS_LAM) + 192 * l;
            const int nch = (LATE_ITEMS + (l + 1 < DEPTH ? LATE_ITEMS_IN : 0)) / CHUNK_ITEMS;
            for (;;) {
                if (F.wave == 0 && pg8::lane_id() == 0) { const unsigned idq = __hip_atomic_fetch_add(qctr, 1u, __ATOMIC_RELAXED, __HIP_MEMORY_SCOPE_AGENT); F.MISC[12] = idq; }
                __syncthreads();
                const int idq = pg8::opq((int)__builtin_amdgcn_readfirstlane((int)F.MISC[12]));
                if (idq >= 1088 + nch) break;
                int id = idq;
                if (idq >= 64) { const int j = idq - 64;
                    if (j < 3 * nch) { const int q = j / 3, rr = j - 3 * q;
                        if (rr == 2) {
                            LAS unsigned char* scr = (LAS unsigned char*)(F.lds + RING_OFF + F.wave * 16384);
                            kargp_t kp = (kargp_t)__builtin_amdgcn_kernarg_segment_ptr(); asm volatile("" : "+s"(kp)); int lane_q = pg8::lane_id(); asm volatile("" : "+v"(lane_q));
                            for (int i = 0; i < CHUNK_ITEMS / NWAVES; ++i) late_item(kp, ws, pg8::opq(l), CHUNK_ITEMS * q + pg8::opq(F.wave) + NWAVES * i, scr, lane_q);
                            __syncthreads(); continue; }
                        id = 64 + 2 * q + rr; }
                    else id = 64 + j - nch; }
                if (id < 64) ph_ret_seq(F, args, l, id);
                else if (id >= 320 && id < 832) { const int k2 = id - 320; ph_conv(F, args, l, 2 * k2, 2 * k2 + 2); }
                else { const int j = id < 320 ? id - 64 : id - 832 + 256;
                    const int qb = 7 - (j >> 6), g = j & 63, h8 = g & 7, b = g >> 3;
                    attn_body::attn_unit_w(F.wave, b, h8, 0, qb, Qp, Kp, Vp, Op, (char*)lds + RING_OFF, nullptr, nullptr);
                    attn_body::attn_unit_w(F.wave, b, h8, 1, qb, Qp, Kp, Vp, Op, (char*)lds + RING_OFF, (attn_body::bf16*)(ws + WS_Y), fzl); }
            }
            __syncthreads();
        }
        SEAM(pb + 3);
        if (IN(pb + 5)) for (int rep_ = 0; rep_ < NREP(5); ++rep_) { PHP();
            bf16* Y = (bf16*)(ws + WS_Y);
            pg8::Gemm g{Y, (const bf16*)(ws + W_BR), MIXW, LD1K, MIXW}; pg8::MergeOrder S; S.T.init(M, DM_, G_, bx, MIXW, LD1K);
            S.ystride = (unsigned)(SEG_E * 2); S.wstride = (unsigned)((size_t)DM_ * LD1K * 2);
            pg8::EpiMerge E{BIGp + 9 * SEG_E, BIGp};
            pg8::gemm_phase<pg8::EpiMerge, pg8::MergeOrder, true, true>(F.lds + RING_OFF, g, S, E, F.wave);
        }
        SEAM(pb + 5);
        if (IN(pb + 6))
#pragma unroll
        for (int rep_ = 0; rep_ < NREP(6); ++rep_) { PHP();
            { pg8::Gemm g{BIGp, (const bf16*)(ws + W_OUT), DM_, LD2K, DM_}; pg8::StaticOrder S; S.init(M, DM_, G_, bx, DM_, LD2K);
              pg8::EpiRes E{XN, rep_ ? BIGp + 11 * SEG_E : BIGp + 8 * SEG_E, LD2K, (float*)(ws + WS_RSS) + (size_t)(rep_ ? 6 : 1 + 3 * l) * RSS_STRIDE};
              pg8::gemm_phase<pg8::EpiRes, pg8::StaticOrder, true, true>(F.lds + RING_OFF, g, S, E, F.wave); }
            { pg8::Gemm g{(const bf16*)ws, (const bf16*)ws, LD2K, LD2K, 512};
              pg8::XprodOrder S{G_, bx, (unsigned)LD2K, (unsigned)WS_KM, (unsigned)(WS_KM + (size_t)MEMROWS * LD2K * 2), (unsigned)W_Q, (unsigned)W_O};
              pg8::EpiBf16Two E{(bf16*)(ws + WS_YRAW), DM_, (bf16*)(ws + WS_YRAW) + SEG_E, 1024};
              pg8::gemm_phase<pg8::EpiBf16Two, pg8::XprodOrder, true, true>(F.lds + RING_OFF, g, S, E, F.wave); }
        }
        SEAM(pb + 6);
        if (IN(pb + 8)) for (int rep_ = 0; rep_ < NREP(8); ++rep_) { PHP();
            pg8::Gemm g{BIGp + 8 * SEG_E, (const bf16*)(ws + WS_YRAW), LD2K, DM_, DM_}; pg8::XsOrder S{G_, bx, LD2K};
            pg8::EpiSoftmax E{BIGp + 2 * SEG_E, 1024, 0.044194173824159216f * LOG2E, (const float*)(ws + WS_RSS) + (size_t)(1 + 3 * l) * RSS_STRIDE};
            pg8::gemm_phase<pg8::EpiSoftmax, pg8::XsOrder, false, true>(F.lds + RING_OFF, g, S, E, F.wave);
        }
        SEAM(pb + 8);
        if (IN(pb + 12))
#pragma unroll
        for (int rep_ = 0; rep_ < NREP(12); ++rep_) { PHP();
            pg8::Gemm g{BIGp + 2 * SEG_E, (const bf16*)(ws + WS_YRAW) + SEG_E, 1024, 1024, 1024}; pg8::XoOrder S{G_, bx};
            pg8::EpiRes E{BIGp + 8 * SEG_E, rep_ ? BIGp + 11 * SEG_E : XN, LD2K, (float*)(ws + WS_RSS) + (size_t)(rep_ ? 6 : 2 + 3 * l) * RSS_STRIDE};
            pg8::gemm_phase<pg8::EpiRes, pg8::XoOrder, true, true>(F.lds + RING_OFF, g, S, E, F.wave);
        }
        SEAM(pb + 12);
        if (IN(pb + 14)) for (int rep_ = 0; rep_ < NREP(14); ++rep_) { PHP();
            pg8::Gemm g{XN, (const bf16*)(ws + W_13), LD2K, LD2K, DM_}; pg8::StaticOrder S; S.init(M, 2 * FFH, G_, bx, LD2K, LD2K);
            pg8::EpiSwiGLU E{BIGp, FFH, (const float*)(ws + WS_RSS) + (size_t)(2 + 3 * l) * RSS_STRIDE};
            pg8::gemm_phase<pg8::EpiSwiGLU, pg8::StaticOrder, true, true>(F.lds + RING_OFF, g, S, E, F.wave);
        }
        SEAM(pb + 14);
        if (IN(pb + 15))
#pragma unroll
        for (int rep_ = 0; rep_ < NREP(15); ++rep_) { PHP();
            pg8::Gemm g{BIGp, (const bf16*)(ws + W_2), FFH, LDFF, FFH}; pg8::StaticOrder S; S.init(M, DM_, G_, bx, FFH, LDFF);
            pg8::EpiRes E{XN, rep_ ? BIGp + 11 * SEG_E : XN, LD2K, (float*)(ws + WS_RSS) + (size_t)(rep_ ? 6 : 3 + 3 * l) * RSS_STRIDE};
            pg8::gemm_phase<pg8::EpiRes, pg8::StaticOrder, true, true>(F.lds + RING_OFF, g, S, E, F.wave);
        }
        SEAM(pb + 15);
    }
    if (IN(NPH)) { PH_ENTER(); const bf16* XB = (const bf16*)(ws + WS_XN); const float* rp = (const float*)(ws + WS_RSS) + (size_t)(3 * DEPTH) * RSS_STRIDE; const int gw = vcu_ * NWAVES + wave, NGW = G_ * NWAVES;
        for (int m = gw; m < M; m += NGW) {
            float sv = lane < 32 ? rp[((size_t)(lane >> 2) * M + (size_t)m) * 4 + (lane & 3)] : 0.f; sv = wave_sum(sv); const float r = 1.0f / sqrtf(sv * (1.f / 2048.f) + EPSN);
            const GAS v4u* xr = (const GAS v4u*)(XB + (size_t)m * LD2K) + lane; const GAS f32x4* gr = (const GAS f32x4*)args.in[21] + 2 * lane; GAS f32x4* orow = (GAS f32x4*)(args.out + (size_t)m * DM_) + 2 * lane;
#pragma unroll
            for (int j = 0; j < 4; ++j) { const v4u x = xr[64 * j]; const f32x4 g0 = gr[128 * j], g1 = gr[128 * j + 1];
                orow[128 * j] = (f32x4){bflo(x.x) * r * g0.x, bfhi(x.x) * r * g0.y, bflo(x.y) * r * g0.z, bfhi(x.y) * r * g0.w};
                orow[128 * j + 1] = (f32x4){bflo(x.z) * r * g1.x, bfhi(x.z) * r * g1.y, bflo(x.w) * r * g1.z, bfhi(x.w) * r * g1.w}; } } }
#undef IN
#undef SEAM
}

extern "C" void kernel_launch(void* const* d_in, const int* in_sizes, int n_in, void* d_out, int out_size, void* d_ws, size_t ws_size, hipStream_t stream) {
    static int grid = 0; static bool first = true;
    if (grid == 0) {
        if (n_in != 22 || in_sizes[0] != M * DM_ || out_size != M * DM_ || ws_size < WS_END) { fprintf(stderr, "kernel_launch: unexpected shapes / workspace (n_in %d, in0 %d, out %d, ws %zu, need %zu); nothing launched\n", n_in, n_in > 0 ? in_sizes[0] : -1, out_size, ws_size, (size_t)WS_END); grid = -1; return; }
        int dev = 0, cus = 0, per_cu = 0;
        if (hipGetDevice(&dev) != hipSuccess || hipDeviceGetAttribute(&cus, hipDeviceAttributeMultiprocessorCount, dev) != hipSuccess) { grid = -1; return; }
        if (hipFuncSetAttribute((const void*)mk_fwd<MK_MULTI ? NPH : 0, NPH + 1>, hipFuncAttributeMaxDynamicSharedMemorySize, LDS_BYTES) != hipSuccess) { fprintf(stderr, "kernel_launch: hipFuncSetAttribute failed\n"); grid = -1; return; }
        if (hipOccupancyMaxActiveBlocksPerMultiprocessor(&per_cu, (const void*)mk_fwd<MK_MULTI ? NPH : 0, NPH + 1>, NWAVES * 64, LDS_BYTES) != hipSuccess || per_cu < 1) fprintf(stderr, "kernel_launch: occupancy query reports %d\n", per_cu);
        (void)hipGetLastError();
        grid = cus;
    }
    if (grid < 0) return;
    if (hipMemsetAsync((char*)d_ws + WS_CTL, 0, CTL_ZERO_BYTES, stream) != hipSuccess) return;
    Args a{};
    for (int i = 0; i < 22; ++i) a.in[i] = (const float*)d_in[i];
    a.out = (float*)d_out; a.ws = (unsigned char*)d_ws;
#if MK_MULTI
#define LAUNCH_K(K) do { if (first) (void)hipFuncSetAttribute((const void*)mk_fwd<K, K + 1>, hipFuncAttributeMaxDynamicSharedMemorySize, LDS_BYTES); hipLaunchKernelGGL((mk_fwd<K, K + 1>), dim3(grid), dim3(NWAVES * 64), LDS_BYTES, stream, a); } while (0)
    for (int l = 0; l < DEPTH; ++l) { a.l_lo = l; a.l_hi = l + 1;
        LAUNCH_K(0); LAUNCH_K(1); LAUNCH_K(2); LAUNCH_K(3); LAUNCH_K(4); LAUNCH_K(5); LAUNCH_K(6); LAUNCH_K(7); LAUNCH_K(8); LAUNCH_K(9); LAUNCH_K(10); LAUNCH_K(11); LAUNCH_K(12); LAUNCH_K(13); LAUNCH_K(14); LAUNCH_K(15); }
    a.l_lo = DEPTH; a.l_hi = DEPTH; LAUNCH_K(16);
    first = false;
#else
    a.l_lo = 0; a.l_hi = DEPTH;
    hipLaunchKernelGGL((mk_fwd<MK_MULTI ? NPH : 0, NPH + 1>), dim3(grid), dim3(NWAVES * 64), LDS_BYTES, stream, a);
#endif
}
```

```cpp
#include <hip/hip_runtime.h>
#include <hip/hip_bf16.h>
#include <cstdio>
#include <cstdint>
#include <cmath>
namespace pg8 {
#define PG8_LAS __attribute__((address_space(3)))
typedef unsigned short bf16_t;
typedef short bf16x8 __attribute__((ext_vector_type(8)));
typedef float f32x4 __attribute__((ext_vector_type(4)));
typedef float f32x2 __attribute__((ext_vector_type(2)));
typedef unsigned u32x4 __attribute__((ext_vector_type(4)));
typedef unsigned u32x2 __attribute__((ext_vector_type(2)));
constexpr int BM = 256, BK = 64, HALF = 128, HTB = HALF * BK * 2  , STAGE_BYTES = 8 * HTB, NXCD = 8, WGM = 8;

__host__ __device__ __forceinline__ int lds_byte(int r, int c) { const int st = (r >> 4) * 2 + (c >> 5), rr = r & 15, cc = c & 31, ob = rr * 64 + cc * 2; return st * 1024 + (ob ^ (((ob >> 9) & 1) << 5)); }
__host__ __device__ __forceinline__ void stage_rc(int b, int& R, int& C) { const int st = b / 1024, sb = b % 1024, swz = sb ^ (((sb >> 9) & 1) << 5); R = (st >> 1) * 16 + swz / 64; C = (st & 1) * 32 + (swz % 64) / 2; }
__host__ __device__ __forceinline__ int perm32(int rho) { const int n = rho >> 4, i = rho & 15; return 8 * (i >> 2) + 4 * n + (i & 3); }

template <class T> __device__ __forceinline__ T* uni_ptr(T* p) { const unsigned long long v = (unsigned long long)p; unsigned lo = (unsigned)v, hi = (unsigned)(v >> 32);
    asm volatile("" : "+s"(lo), "+s"(hi)); return (T*)(((unsigned long long)hi << 32) | lo); }
__device__ __forceinline__ int lane_id() { int l; asm volatile("v_mbcnt_lo_u32_b32 %0, -1, 0\n\tv_mbcnt_hi_u32_b32 %0, -1, %0" : "=v"(l)); return l; }
__device__ __forceinline__ int opq(int x) { asm volatile("" : "+s"(x)); return x; }
template <int M> __device__ __forceinline__ float xadd(float v) {
    if constexpr (M == 32) { const auto rr = __builtin_amdgcn_permlane32_swap(__float_as_uint(v), __float_as_uint(v), false, false); return __uint_as_float(rr[0]) + __uint_as_float(rr[1]); }
    else return v + __int_as_float(__builtin_amdgcn_ds_swizzle(__float_as_int(v), (M << 10) | 0x1f));
}
__device__ __forceinline__ float row_sum16(float v) {
#define PG8_DPPADD(ctrl) v += __int_as_float(__builtin_amdgcn_update_dpp(0, __float_as_int(v), ctrl, 0xf, 0xf, true))
    PG8_DPPADD(0xB1); PG8_DPPADD(0x4E); PG8_DPPADD(0x141); PG8_DPPADD(0x140); return v;
#undef PG8_DPPADD
}
struct Unit { int pm, pn; unsigned offA, offB; int sub = 0; };
struct Gemm { const bf16_t* A; const bf16_t* Bt; int lda, ldb, K; };

struct StaticOrder {
    int nM, nN, nwg, G, c; unsigned tA, tB;
    __device__ void init(int M, int N, int G_, int c_, int lda, int ldb) { nM = M / BM; nN = N / BM; nwg = nM * nN; G = G_; c = c_; tA = (unsigned)BM * lda * 2u; tB = (unsigned)BM * ldb * 2u; }
    __device__ __forceinline__ bool next(int i, Unit& u) const {
        const long L = (long)i * G + c; if (L >= nwg) return false;
        int wgid = (int)L; { const int q = nwg / NXCD, r = nwg % NXCD, xcd = wgid % NXCD, off = wgid / NXCD; wgid = (xcd < r ? xcd * (q + 1) : r * (q + 1) + (xcd - r) * q) + off; }
        const int nig = WGM * nN, gid = wgid / nig, fm = gid * WGM, gsz = (nM - fm) < WGM ? (nM - fm) : WGM;
        u.pm = fm + ((wgid % nig) % gsz); u.pn = (wgid % nig) / gsz; u.offA = (unsigned)u.pm * tA; u.offB = (unsigned)u.pn * tB; return true;
    }
    __device__ __forceinline__ void a_ready(const Unit&) const {}
    __device__ __forceinline__ void done(const Unit&) const {}
};
struct XprodOrder {
    int G, c; unsigned ld, oK, oV, oWq, oWo;
    __device__ __forceinline__ bool next(int i, Unit& u) const {
        const int L = i * G + c; if (L >= 512) return false;
        const int q = L & 255, b = q >> 5, h = (q >> 3) & 3, t = q & 7;
        if (L < 256) { u.sub = 0; u.pm = b * 4 + h; u.pn = t; u.offA = oK + ((unsigned)(b * 256) * ld + h * 512) * 2u; u.offB = oWq + ((unsigned)(t * 256) * ld + h * 512) * 2u; }
        else         { u.sub = 1; u.pm = b * 8 + t; u.pn = h; u.offA = oWo + ((unsigned)(t * 256) * ld + h * 512) * 2u; u.offB = oV + ((unsigned)(b * 256) * ld + h * 512) * 2u; }
        return true;
    }
    __device__ __forceinline__ void a_ready(const Unit&) const {}
    __device__ __forceinline__ void done(const Unit&) const {}
};
struct XsOrder {
    int G, c, lda;
    __device__ __forceinline__ bool next(int i, Unit& u) const {
        const int L = i * G + c; if (L >= 256) return false;
        const int b = L >> 5, rt = (L >> 2) & 7, h = L & 3;
        u.pm = b * 8 + rt; u.pn = h; u.offA = ((unsigned)(b * 2048 + rt * 256) * (unsigned)lda) * 2u; u.offB = ((unsigned)(b * 1024 + h * 256) * 2048u) * 2u; return true;
    }
    __device__ __forceinline__ void a_ready(const Unit&) const {}
    __device__ __forceinline__ void done(const Unit&) const {}
};
struct XoOrder {
    int G, c;
    __device__ __forceinline__ bool next(int i, Unit& u) const {
        const int L = i * G + c; if (L >= 512) return false;
        const int b = L >> 6, rt = (L >> 3) & 7, ct = L & 7;
        u.pm = b * 8 + rt; u.pn = ct; u.offA = ((unsigned)(b * 2048 + rt * 256) * 1024u) * 2u; u.offB = ((unsigned)(b * 2048 + ct * 256) * 1024u) * 2u; return true;
    }
    __device__ __forceinline__ void a_ready(const Unit&) const {}
    __device__ __forceinline__ void done(const Unit&) const {}
};

__device__ __forceinline__ unsigned cvt_pk_bf16(float lo, float hi) { unsigned r; asm volatile("v_cvt_pk_bf16_f32 %0, %1, %2" : "=v"(r) : "v"(lo), "v"(hi)); return r; }
__device__ __forceinline__ float bf_lo(unsigned w) { return __uint_as_float(w << 16); }
__device__ __forceinline__ float bf_hi(unsigned w) { return __uint_as_float(w & 0xffff0000u); }
__device__ __forceinline__ float sigmoidf_(float x) { return __builtin_amdgcn_rcpf(1.0f + __builtin_amdgcn_exp2f(-1.4426950408889634f * x)); }

__device__ __forceinline__ void row_rs8(float (&rs)[2][4], const float* rssp, int row0, int fq) {
    f32x4 a[2][4], b[2][4];
#pragma unroll
    for (int ai = 0; ai < 2; ++ai)
#pragma unroll
        for (int m = 0; m < 4; ++m) { const float* p = rssp + ((size_t)(2 * fq) * 16384 + (size_t)(row0 + ai * HALF + m * 16)) * 4; a[ai][m] = *(const f32x4*)p; b[ai][m] = *(const f32x4*)(p + (size_t)16384 * 4); }
#pragma unroll
    for (int ai = 0; ai < 2; ++ai)
#pragma unroll
        for (int m = 0; m < 4; ++m) { float s = ((a[ai][m][0] + a[ai][m][1]) + (a[ai][m][2] + a[ai][m][3])) + ((b[ai][m][0] + b[ai][m][1]) + (b[ai][m][2] + b[ai][m][3]));
            s = pg8::xadd<16>(s); s = pg8::xadd<32>(s); rs[ai][m] = __builtin_amdgcn_rsqf(s * (1.0f / 2048.0f) + 1e-6f); }
}
struct EpiBf16 {
    static constexpr bool PERM = true, AFTER_DRAIN = false, MULTI = false;
    bf16_t* O; int ldc; int split_cols; size_t split_stride; float scale; const float* rss;
    __device__ __forceinline__ void operator()(const f32x4 (&acc)[2][2][4][2], const Unit& u, int wr, int wc, int fr, int fq) const {
        const int row0 = u.pm * BM + wr * 64 + fr; int colt = u.pn * BM; bf16_t* base = O;
        if (split_cols) { const int t = colt / split_cols; base += (size_t)t * split_stride; colt -= t * split_cols; }
        const int col0 = colt + wc * 32 + 8 * fq; const float sc = scale;
        float rs[2][4];
        if (rss) row_rs8(rs, rss, row0, fq);
#pragma unroll
        for (int ai = 0; ai < 2; ++ai)
#pragma unroll
            for (int m = 0; m < 4; ++m) { bf16_t* rowp = base + (size_t)(row0 + ai * HALF + m * 16) * ldc + col0;
                const float sr = rss ? sc * rs[ai][m] : sc;
#pragma unroll
                for (int bj = 0; bj < 2; ++bj) { const f32x4 v0 = acc[ai][bj][m][0] * sr, v1 = acc[ai][bj][m][1] * sr;
                    u32x4 w; w.x = cvt_pk_bf16(v0[0], v0[1]); w.y = cvt_pk_bf16(v0[2], v0[3]); w.z = cvt_pk_bf16(v1[0], v1[1]); w.w = cvt_pk_bf16(v1[2], v1[3]);
                    *(u32x4*)(rowp + bj * HALF) = w; } }
    }
};
struct EpiBf16Two {
    static constexpr bool PERM = true, AFTER_DRAIN = false, MULTI = false;
    bf16_t* O0; int ld0; bf16_t* O1; int ld1;
    __device__ __forceinline__ void operator()(const f32x4 (&acc)[2][2][4][2], const Unit& u, int wr, int wc, int fr, int fq) const {
        bf16_t* base = u.sub ? O1 : O0; const int ldc = u.sub ? ld1 : ld0;
        const int row0 = u.pm * BM + wr * 64 + fr, col0 = u.pn * BM + wc * 32 + 8 * fq;
#pragma unroll
        for (int ai = 0; ai < 2; ++ai)
#pragma unroll
            for (int m = 0; m < 4; ++m) { bf16_t* rowp = base + (size_t)(row0 + ai * HALF + m * 16) * ldc + col0;
#pragma unroll
                for (int bj = 0; bj < 2; ++bj) { const f32x4 v0 = acc[ai][bj][m][0], v1 = acc[ai][bj][m][1];
                    u32x4 w; w.x = cvt_pk_bf16(v0[0], v0[1]); w.y = cvt_pk_bf16(v0[2], v0[3]); w.z = cvt_pk_bf16(v1[0], v1[1]); w.w = cvt_pk_bf16(v1[2], v1[3]);
                    *(u32x4*)(rowp + bj * HALF) = w; } }
    }
};
struct EpiInProj {
    static constexpr bool PERM = true, AFTER_DRAIN = false, MULTI = false;
    bf16_t* BIG; const float* dcs; const float* rcs; const float* rss;
    __device__ __forceinline__ void operator()(const f32x4 (&acc)[2][2][4][2], const Unit& u, int wr, int wc, int fr, int fq) const {
        const int pn = u.pn; const int row0 = u.pm * BM + wr * 64 + fr; const size_t SEGE = (size_t)16384 * 1024;
        const int cw = wc * 32 + 8 * fq;
        float rs[2][4]; row_rs8(rs, rss, row0, fq);
        if (pn < 8 || (pn >= 20 && pn < 28)) {
            const bool isd = pn < 8; const int seg = isd ? (pn >> 2) : 5 + ((pn - 20) >> 2);
            const float sc = pn < 4 ? 0.125f * 1.4426950408889634f : (pn >= 20 && pn < 24) ? 0.08838834764831845f : 1.0f;
            const int i0 = isd ? ((cw & 63) >> 1) : ((cw & 127) >> 1);
            bf16_t* base = BIG + (size_t)seg * SEGE + (pn & 3) * BM + cw;
#pragma unroll
            for (int ai = 0; ai < 2; ++ai)
#pragma unroll
              for (int mp = 0; mp < 2; ++mp) {
                f32x4 ta[2], tb4[2];
#pragma unroll
                for (int mm = 0; mm < 2; ++mm) { const int t = (row0 + ai * HALF + (2 * mp + mm) * 16) & 2047;
                    const float* tb = isd ? dcs + ((size_t)t * 32 + i0) * 2 : rcs + ((size_t)t * 64 + i0) * 2; ta[mm] = *(const f32x4*)tb; tb4[mm] = *(const f32x4*)(tb + 4); }
#pragma unroll
                for (int mm = 0; mm < 2; ++mm) { const int m = 2 * mp + mm; const int row = row0 + ai * HALF + m * 16; const float sr = sc * rs[ai][m]; const f32x4 t0 = ta[mm], t1 = tb4[mm];
#pragma unroll
                    for (int bj = 0; bj < 2; ++bj) { const f32x4 v0 = acc[ai][bj][m][0], v1 = acc[ai][bj][m][1];
                        const float y0 = (v0[0] * t0[0] - v0[1] * t0[1]) * sr, y1 = (v0[1] * t0[0] + v0[0] * t0[1]) * sr, y2 = (v0[2] * t0[2] - v0[3] * t0[3]) * sr, y3 = (v0[3] * t0[2] + v0[2] * t0[3]) * sr;
                        const float y4 = (v1[0] * t1[0] - v1[1] * t1[1]) * sr, y5 = (v1[1] * t1[0] + v1[0] * t1[1]) * sr, y6 = (v1[2] * t1[2] - v1[3] * t1[3]) * sr, y7 = (v1[3] * t1[2] + v1[2] * t1[3]) * sr;
                        u32x4 w; w.x = cvt_pk_bf16(y0, y1); w.y = cvt_pk_bf16(y2, y3); w.z = cvt_pk_bf16(y4, y5); w.w = cvt_pk_bf16(y6, y7);
                        *(u32x4*)(base + (size_t)row * 1024 + bj * HALF) = w; } }
                asm volatile("" ::: "memory"); }
        } else if (pn >= 12 && pn < 20) {
            bf16_t* base = BIG + 3 * SEGE + (pn - 12) * (BM / 2) + (cw >> 1);
#pragma unroll
            for (int ai = 0; ai < 2; ++ai)
#pragma unroll
                for (int m = 0; m < 4; ++m) { bf16_t* rowp = base + (size_t)(row0 + ai * HALF + m * 16) * 1024; const float sr = rs[ai][m];
#pragma unroll
                    for (int bj = 0; bj < 2; ++bj) { const f32x4 v0 = acc[ai][bj][m][0] * sr, v1 = acc[ai][bj][m][1] * sr;
                        u32x2 w; w.x = cvt_pk_bf16(v0[0] * sigmoidf_(v0[1]), v0[2] * sigmoidf_(v0[3])); w.y = cvt_pk_bf16(v1[0] * sigmoidf_(v1[1]), v1[2] * sigmoidf_(v1[3]));
                        *(u32x2*)(rowp + bj * (HALF / 2)) = w; } }
        } else {
            bf16_t* base = BIG + (size_t)(pn >> 2) * SEGE + (pn & 3) * BM + cw; const bool sg = pn >= 36;
#pragma unroll
            for (int ai = 0; ai < 2; ++ai)
#pragma unroll
                for (int m = 0; m < 4; ++m) { bf16_t* rowp = base + (size_t)(row0 + ai * HALF + m * 16) * 1024; const float sr = rs[ai][m];
#pragma unroll
                    for (int bj = 0; bj < 2; ++bj) { f32x4 v0 = acc[ai][bj][m][0] * sr, v1 = acc[ai][bj][m][1] * sr;
                        if (sg) { v0[0] = sigmoidf_(v0[0]); v0[1] = sigmoidf_(v0[1]); v0[2] = sigmoidf_(v0[2]); v0[3] = sigmoidf_(v0[3]); v1[0] = sigmoidf_(v1[0]); v1[1] = sigmoidf_(v1[1]); v1[2] = sigmoidf_(v1[2]); v1[3] = sigmoidf_(v1[3]); }
                        u32x4 w; w.x = cvt_pk_bf16(v0[0], v0[1]); w.y = cvt_pk_bf16(v0[2], v0[3]); w.z = cvt_pk_bf16(v1[0], v1[1]); w.w = cvt_pk_bf16(v1[2], v1[3]);
                        *(u32x4*)(rowp + bj * HALF) = w; } }
        }
    }
};
struct EpiSoftmax {
    static constexpr bool PERM = true, AFTER_DRAIN = true, MULTI = false;
    bf16_t* P; int ldp; float sc; const float* rss;
    __device__ __forceinline__ void fused(f32x4 (&acc)[2][2][4][2], const Unit& u, int wr, int wc, int fr, int fq, PG8_LAS unsigned char* lds, int wid, int lane) const {
        PG8_LAS float* Ps = (PG8_LAS float*)lds;
        const int row0 = u.pm * BM + wr * 64 + fr;
        float rs[2][4]; row_rs8(rs, rss, row0, fq);
#pragma unroll
        for (int ai = 0; ai < 2; ++ai)
#pragma unroll
            for (int m = 0; m < 4; ++m) { const float k = sc * rs[ai][m]; float t = 0.f;
#pragma unroll
                for (int bj = 0; bj < 2; ++bj)
#pragma unroll
                    for (int n = 0; n < 2; ++n) { f32x4 e = acc[ai][bj][m][n] * k; e[0] = __builtin_amdgcn_exp2f(e[0]); e[1] = __builtin_amdgcn_exp2f(e[1]); e[2] = __builtin_amdgcn_exp2f(e[2]); e[3] = __builtin_amdgcn_exp2f(e[3]);
                        acc[ai][bj][m][n] = e; t += (e[0] + e[1]) + (e[2] + e[3]); }
                t = pg8::xadd<16>(t); t = pg8::xadd<32>(t);
                if (fq == 0) Ps[(ai * HALF + wr * 64 + m * 16 + fr) * 4 + wc] = t; }
        asm volatile("s_waitcnt lgkmcnt(0)" ::: "memory"); __builtin_amdgcn_s_barrier(); asm volatile("" ::: "memory");
#pragma unroll
        for (int ai = 0; ai < 2; ++ai)
#pragma unroll
            for (int m = 0; m < 4; ++m) { const f32x4 q = *(const PG8_LAS f32x4*)(Ps + (ai * HALF + wr * 64 + m * 16 + fr) * 4); const float inv = 1.0f / ((q[0] + q[1]) + (q[2] + q[3]));
                bf16_t* rowp = P + (size_t)(row0 + ai * HALF + m * 16) * ldp + u.pn * BM + wc * 32 + 8 * fq;
#pragma unroll
                for (int bj = 0; bj < 2; ++bj) { const f32x4 v0 = acc[ai][bj][m][0] * inv, v1 = acc[ai][bj][m][1] * inv;
                    u32x4 w; w.x = cvt_pk_bf16(v0[0], v0[1]); w.y = cvt_pk_bf16(v0[2], v0[3]); w.z = cvt_pk_bf16(v1[0], v1[1]); w.w = cvt_pk_bf16(v1[2], v1[3]);
                    *(u32x4*)(rowp + bj * HALF) = w; } }
        asm volatile("s_waitcnt lgkmcnt(0)" ::: "memory"); __builtin_amdgcn_s_barrier(); asm volatile("" ::: "memory");
    }
};
struct EpiRes {
    static constexpr bool PERM = true, AFTER_DRAIN = false, MULTI = false;
    const bf16_t* xo; bf16_t* xb; int ldx; float* rssp;
    __device__ __forceinline__ void operator()(const f32x4 (&acc)[2][2][4][2], const Unit& u, int wr, int wc, int fr, int fq) const {
        const int col0 = u.pn * BM + wc * 32 + 8 * fq;
#pragma unroll
        for (int ai = 0; ai < 2; ++ai) {
            u32x4 ro[4][2];
#pragma unroll
            for (int m = 0; m < 4; ++m)
#pragma unroll
                for (int bj = 0; bj < 2; ++bj) ro[m][bj] = *(const u32x4*)(xo + (size_t)(u.pm * BM + ai * HALF + wr * 64 + m * 16 + fr) * ldx + col0 + bj * HALF);
#pragma unroll
            for (int m = 0; m < 4; ++m) { const int row = u.pm * BM + ai * HALF + wr * 64 + m * 16 + fr; float ss = 0.f;
#pragma unroll
                for (int bj = 0; bj < 2; ++bj) { const u32x4 o = ro[m][bj];
                    f32x4 v0 = acc[ai][bj][m][0], v1 = acc[ai][bj][m][1];
                    v0[0] += bf_lo(o.x); v0[1] += bf_hi(o.x); v0[2] += bf_lo(o.y); v0[3] += bf_hi(o.y); v1[0] += bf_lo(o.z); v1[1] += bf_hi(o.z); v1[2] += bf_lo(o.w); v1[3] += bf_hi(o.w);
                    ss += ((v0[0] * v0[0] + v0[1] * v0[1]) + (v0[2] * v0[2] + v0[3] * v0[3])) + ((v1[0] * v1[0] + v1[1] * v1[1]) + (v1[2] * v1[2] + v1[3] * v1[3]));
                    u32x4 w; w.x = cvt_pk_bf16(v0[0], v0[1]); w.y = cvt_pk_bf16(v0[2], v0[3]); w.z = cvt_pk_bf16(v1[0], v1[1]); w.w = cvt_pk_bf16(v1[2], v1[3]);
                    *(u32x4*)(xb + (size_t)row * ldx + col0 + bj * HALF) = w; }
                ss = pg8::xadd<16>(ss); ss = pg8::xadd<32>(ss);
                if (fq == 0) rssp[((size_t)u.pn * 16384 + (size_t)row) * 4 + wc] = ss; }
            asm volatile("" ::: "memory"); }
    }
};
struct EpiMerge {
    static constexpr bool PERM = true, AFTER_DRAIN = false, MULTI = true;
    const bf16_t* gates; bf16_t* merged;
    __device__ __forceinline__ void step(f32x4 (&acc)[2][2][4][2], const Unit& u, int wr, int wc, int fr, int fq) const {
        const size_t SEGE = (size_t)16384 * 1024; const int sub = u.sub; const bool last = sub == 2;
        const int row0 = u.pm * BM + wr * 64 + fr; const int gcol = (u.pn & 3) * BM + wc * 32 + 8 * fq;
        const bf16_t* ga = gates + (size_t)(2 * sub + (u.pn >> 2)) * SEGE + gcol;
        const bf16_t* gb = last ? ga : ga + 2 * SEGE;
#pragma unroll
        for (int ai = 0; ai < 2; ++ai)
#pragma unroll
            for (int m = 0; m < 4; ++m) {
                u32x4 za[2], zb[2];
#pragma unroll
                for (int bj = 0; bj < 2; ++bj) { const size_t p = (size_t)(row0 + ai * HALF + m * 16) * 1024 + bj * HALF; za[bj] = *(const u32x4*)(ga + p); zb[bj] = *(const u32x4*)(gb + p); }
#pragma unroll
                for (int bj = 0; bj < 2; ++bj) { const unsigned aw[4] = {za[bj].x, za[bj].y, za[bj].z, za[bj].w}; unsigned bw[4] = {zb[bj].x, zb[bj].y, zb[bj].z, zb[bj].w};
                    float f[8];
#pragma unroll
                    for (int j = 0; j < 4; ++j) { if (last) bw[j] = 0x3f803f80u; f[2 * j] = bf_lo(aw[j]) * __builtin_amdgcn_rcpf(bf_lo(bw[j])); f[2 * j + 1] = bf_hi(aw[j]) * __builtin_amdgcn_rcpf(bf_hi(bw[j])); }
                    f32x4 v0 = acc[ai][bj][m][0], v1 = acc[ai][bj][m][1];
                    v0[0] *= f[0]; v0[1] *= f[1]; v0[2] *= f[2]; v0[3] *= f[3]; v1[0] *= f[4]; v1[1] *= f[5]; v1[2] *= f[6]; v1[3] *= f[7];
                    acc[ai][bj][m][0] = v0; acc[ai][bj][m][1] = v1;
                    if (last) { u32x4 w; w.x = cvt_pk_bf16(v0[0], v0[1]); w.y = cvt_pk_bf16(v0[2], v0[3]); w.z = cvt_pk_bf16(v1[0], v1[1]); w.w = cvt_pk_bf16(v1[2], v1[3]);
                        *(u32x4*)(merged + (size_t)(row0 + ai * HALF + m * 16) * 2048 + u.pn * BM + wc * 32 + 8 * fq + bj * HALF) = w; } }
                if (m & 1) asm volatile("" ::: "memory"); }
    }
};
struct MergeOrder {
    StaticOrder T; unsigned ystride, wstride;
    __device__ __forceinline__ bool next(int i, Unit& u) const {
        const int ti = i / 3, sub = i - 3 * ti;
        if (!T.next(ti, u)) return false;
        u.sub = sub; u.offA += (unsigned)sub * ystride; u.offB += (unsigned)sub * wstride; return true;
    }
    __device__ __forceinline__ void a_ready(const Unit&) const {}
    __device__ __forceinline__ void done(const Unit&) const {}
};
struct EpiSwiGLU {
    static constexpr bool PERM = true, AFTER_DRAIN = false, MULTI = false;
    bf16_t* O; int ldo; const float* rss;
    __device__ __forceinline__ void operator()(const f32x4 (&acc)[2][2][4][2], const Unit& u, int wr, int wc, int fr, int fq) const {
        const int row0 = u.pm * BM + wr * 64 + fr; const int j0 = (u.pn * BM + wc * 32 + 8 * fq) >> 1;
        float rs[2][4]; row_rs8(rs, rss, row0, fq);
#pragma unroll
        for (int ai = 0; ai < 2; ++ai)
#pragma unroll
            for (int m = 0; m < 4; ++m) { bf16_t* rowp = O + (size_t)(row0 + ai * HALF + m * 16) * ldo + j0; const float sr = rs[ai][m];
#pragma unroll
                for (int bj = 0; bj < 2; ++bj) { const f32x4 v0 = acc[ai][bj][m][0] * sr, v1 = acc[ai][bj][m][1] * sr;
                    const float o0 = v0[0] * sigmoidf_(v0[0]) * v0[1], o1 = v0[2] * sigmoidf_(v0[2]) * v0[3], o2 = v1[0] * sigmoidf_(v1[0]) * v1[1], o3 = v1[2] * sigmoidf_(v1[2]) * v1[3];
                    u32x2 w; w.x = cvt_pk_bf16(o0, o1); w.y = cvt_pk_bf16(o2, o3);
                    *(u32x2*)(rowp + bj * (HALF / 2)) = w; } }
    }
};

template <class Epi, class Sched, bool ALIGN_EPI = false, bool SP2 = false>
__device__ __forceinline__ void gemm_phase(PG8_LAS unsigned char* lds, const Gemm g, const Sched& S, const Epi& E, const int wave_sg) {
    int tid_ = opq(wave_sg) * 64 + lane_id(); asm volatile("" : "+v"(tid_));
    const char* gA = uni_ptr((const char*)g.A); const char* gB = uni_ptr((const char*)g.Bt);
    const int tid = tid_, wid = __builtin_amdgcn_readfirstlane(tid >> 6), lane = tid & 63, wr = wid >> 2, wc = wid & 3, fr = lane & 15, fq = lane >> 4;
    int K_ = g.K; asm volatile("" : "+s"(K_));
    const int K = K_, nt = K / BK;
    unsigned voffA[2], voffB[2];
#pragma unroll
    for (int i = 0; i < 2; ++i) { int R, C; stage_rc(tid * 16 + i * 8192, R, C); const int Rb = Epi::PERM ? ((R & ~31) + perm32(R & 31)) : R;
        voffA[i] = (unsigned)(R * g.lda + C) * 2u; voffB[i] = (unsigned)(Rb * g.ldb + C) * 2u; }
    const size_t kstep = (size_t)(BK * 2);
    const unsigned hsA = (unsigned)HALF * g.lda * 2u, hsB = (unsigned)HALF * g.ldb * 2u;
    const unsigned ldsw = (unsigned)wid * 1024u;
    const int aoff = lds_byte(wr * 64 + fr, fq * 8), boff = lds_byte(wc * 32 + fr, fq * 8);
#define PG8_SA(b, h) (((b) * 2 + (h)) * HTB)
#define PG8_SB(b, h) ((4 + (b) * 2 + (h)) * HTB)
#define PG8_STAGE(bufoff, gbase, voff) do { _Pragma("unroll") for (int _i = 0; _i < 2; ++_i) \
        __builtin_amdgcn_global_load_lds((const unsigned*)((const char*)(gbase) + (voff)[_i]), (PG8_LAS unsigned*)(lds + (bufoff) + ldsw + _i * 8192), 16, 0, 0); } while (0)
#define PG8_LDA(dst, b, h) do { _Pragma("unroll") for (int m = 0; m < 4; ++m) _Pragma("unroll") for (int k = 0; k < 2; ++k) dst[m][k] = *(const PG8_LAS bf16x8*)(lds + PG8_SA(b, h) + aoff + m * 2048 + k * 1024); } while (0)
#define PG8_LDB(dst, b, h) do { _Pragma("unroll") for (int n = 0; n < 2; ++n) _Pragma("unroll") for (int k = 0; k < 2; ++k) dst[n][k] = *(const PG8_LAS bf16x8*)(lds + PG8_SB(b, h) + boff + n * 2048 + k * 1024); } while (0)
#define PG8_MMA(ai, bj, At, Bt) do { __builtin_amdgcn_s_setprio(1); _Pragma("unroll") for (int m = 0; m < 4; ++m) _Pragma("unroll") for (int n = 0; n < 2; ++n) _Pragma("unroll") for (int k = 0; k < 2; ++k) \
        asm volatile("v_mfma_f32_16x16x32_bf16 %0, %1, %2, %0" : "+v"(acc[ai][bj][m][n]) : "v"(Bt[n][k]), "v"(At[m][k])); __builtin_amdgcn_s_setprio(0); } while (0)
#define PG8_WAIT_V(n) asm volatile("s_waitcnt vmcnt(" #n ")" ::: "memory")
#define PG8_PIN_ACC() do { _Pragma("unroll") for (int a_ = 0; a_ < 2; ++a_) _Pragma("unroll") for (int b_ = 0; b_ < 2; ++b_) _Pragma("unroll") for (int m_ = 0; m_ < 4; ++m_) asm volatile("" : "+v"(acc[a_][b_][m_][0]), "+v"(acc[a_][b_][m_][1])); asm volatile("s_nop 7" ::: "memory"); } while (0)
#define PG8_WAIT_L(n) asm volatile("s_waitcnt lgkmcnt(" #n ")" ::: "memory")
#define PG8_BAR __builtin_amdgcn_s_barrier()
#define PG8_SCHED __builtin_amdgcn_sched_barrier(0)
    Unit cur, nxt; int ui = 0;
    if (!S.next(0, cur)) return;
    f32x4 acc[2][2][4][2];
#pragma unroll
    for (int a = 0; a < 2; ++a)
#pragma unroll
        for (int b = 0; b < 2; ++b)
#pragma unroll
            for (int m = 0; m < 4; ++m)
#pragma unroll
                for (int n = 0; n < 2; ++n) acc[a][b][m][n] = (f32x4){0.f, 0.f, 0.f, 0.f};
    PG8_PIN_ACC();
    bf16x8 At[4][2], B0[2][2], B1[2][2];
    const char* cA = gA + cur.offA; const char* cB = gB + cur.offB;
    S.a_ready(cur);
    if constexpr (SP2) {
        PG8_STAGE(PG8_SB(0, 0), cB, voffB); PG8_STAGE(PG8_SB(0, 1), cB + hsB, voffB); PG8_STAGE(PG8_SA(0, 0), cA, voffA); PG8_STAGE(PG8_SA(0, 1), cA + hsA, voffA);
        if (wr == 1) PG8_BAR;
        PG8_WAIT_V(2); PG8_BAR;
        PG8_STAGE(PG8_SB(1, 0), cB + kstep, voffB); PG8_STAGE(PG8_SA(1, 0), cA + kstep, voffA); PG8_STAGE(PG8_SB(1, 1), cB + hsB + kstep, voffB);
        PG8_WAIT_V(6); PG8_BAR;
    } else {
        PG8_STAGE(PG8_SB(0, 0), cB, voffB); PG8_STAGE(PG8_SA(0, 0), cA, voffA); PG8_STAGE(PG8_SB(0, 1), cB + hsB, voffB); PG8_STAGE(PG8_SA(0, 1), cA + hsA, voffA);
        if (wr == 1) PG8_BAR;
        PG8_WAIT_V(4); PG8_BAR;
        PG8_STAGE(PG8_SB(1, 0), cB + kstep, voffB); PG8_STAGE(PG8_SA(1, 0), cA + kstep, voffA); PG8_STAGE(PG8_SB(1, 1), cB + hsB + kstep, voffB);
        PG8_WAIT_V(6); PG8_BAR;
    }
    for (;;) {
        const bool has_next = S.next(ui + 1, nxt);
        const char* nA = has_next ? gA + nxt.offA : cA; const char* nB = has_next ? gB + nxt.offB : cB;
        for (int t = 0; t < nt; t += 2) {
            const bool last = (t == nt - 2);
            const char* a1 = cA + (size_t)(t + 1) * kstep;
            const char* a2 = last ? nA : cA + (size_t)(t + 2) * kstep; const char* b2 = last ? nB : cB + (size_t)(t + 2) * kstep;
            const char* a3 = a2 + kstep; const char* b3 = b2 + kstep;
            if (last && has_next) S.a_ready(nxt);
            if constexpr (SP2) {
            PG8_LDB(B0, 0, 0); PG8_LDB(B1, 0, 1); PG8_SCHED; PG8_LDA(At, 0, 0); PG8_STAGE(PG8_SA(1, 1), a1 + hsA, voffA);
            PG8_WAIT_V(8); PG8_WAIT_L(0); PG8_BAR; PG8_MMA(0, 0, At, B0); PG8_MMA(0, 1, At, B1); PG8_BAR; PG8_SCHED;
            PG8_LDA(At, 0, 1); PG8_STAGE(PG8_SB(0, 0), b2, voffB); PG8_STAGE(PG8_SB(0, 1), b2 + hsB, voffB); PG8_STAGE(PG8_SA(0, 0), a2, voffA);
            PG8_WAIT_V(8); PG8_WAIT_L(0); PG8_BAR; PG8_MMA(1, 0, At, B0); PG8_MMA(1, 1, At, B1); PG8_BAR; PG8_SCHED;
            PG8_LDB(B0, 1, 0); PG8_LDB(B1, 1, 1); PG8_SCHED; PG8_LDA(At, 1, 0); PG8_STAGE(PG8_SA(0, 1), a2 + hsA, voffA);
            PG8_WAIT_V(8); PG8_WAIT_L(0); PG8_BAR; PG8_MMA(0, 0, At, B0); PG8_MMA(0, 1, At, B1); PG8_BAR; PG8_SCHED;
            PG8_LDA(At, 1, 1); PG8_STAGE(PG8_SB(1, 0), b3, voffB); PG8_STAGE(PG8_SB(1, 1), b3 + hsB, voffB); PG8_STAGE(PG8_SA(1, 0), a3, voffA);
            PG8_WAIT_V(8); PG8_WAIT_L(0); PG8_BAR; PG8_MMA(1, 0, At, B0); PG8_MMA(1, 1, At, B1); PG8_BAR; PG8_SCHED;
            } else {
            PG8_LDB(B0, 0, 0); PG8_SCHED; PG8_LDA(At, 0, 0); PG8_STAGE(PG8_SA(1, 1), a1 + hsA, voffA);
            PG8_WAIT_L(8); PG8_BAR; PG8_WAIT_L(0); PG8_MMA(0, 0, At, B0); PG8_BAR; PG8_SCHED;
            PG8_LDB(B1, 0, 1); PG8_STAGE(PG8_SB(0, 0), b2, voffB);
            PG8_BAR; PG8_WAIT_L(0); PG8_MMA(0, 1, At, B1); PG8_BAR;
            PG8_LDA(At, 0, 1); PG8_STAGE(PG8_SA(0, 0), a2, voffA);
            PG8_BAR; PG8_WAIT_L(0); PG8_MMA(1, 0, At, B0); PG8_BAR; PG8_SCHED;
            PG8_STAGE(PG8_SB(0, 1), b2 + hsB, voffB);
            PG8_WAIT_V(6); PG8_BAR; PG8_MMA(1, 1, At, B1); PG8_BAR;
            PG8_LDB(B0, 1, 0); PG8_SCHED; PG8_LDA(At, 1, 0); PG8_STAGE(PG8_SA(0, 1), a2 + hsA, voffA);
            PG8_WAIT_L(8); PG8_BAR; PG8_WAIT_L(0); PG8_MMA(0, 0, At, B0); PG8_BAR; PG8_SCHED;
            PG8_LDB(B1, 1, 1); PG8_STAGE(PG8_SB(1, 0), b3, voffB);
            PG8_BAR; PG8_WAIT_L(0); PG8_MMA(0, 1, At, B1); PG8_BAR;
            PG8_LDA(At, 1, 1); PG8_STAGE(PG8_SA(1, 0), a3, voffA);
            PG8_BAR; PG8_WAIT_L(0); PG8_MMA(1, 0, At, B0); PG8_BAR; PG8_SCHED;
            PG8_STAGE(PG8_SB(1, 1), b3 + hsB, voffB);
            PG8_WAIT_V(6); PG8_BAR; PG8_MMA(1, 1, At, B1); PG8_BAR;
            }
        }
        if constexpr (ALIGN_EPI) { if (wr == 0) PG8_BAR; }
        asm volatile("s_nop 15\n\ts_nop 15" ::: "memory");
        if constexpr (Epi::MULTI) { E.step(acc, cur, wr, wc, fr, fq); S.done(cur); }
        else if constexpr (!Epi::AFTER_DRAIN) { E(acc, cur, wr, wc, fr, fq);
#if defined(EPI_TWICE)
            if constexpr (Epi::PERM) { asm volatile("" ::: "memory"); E(acc, cur, wr, wc, fr, fq); }
#endif
            S.done(cur); }
        if (!has_next) break;
        if (!Epi::MULTI || cur.sub == 2) {
#pragma unroll
        for (int a = 0; a < 2; ++a)
#pragma unroll
            for (int b = 0; b < 2; ++b)
#pragma unroll
                for (int m = 0; m < 4; ++m)
#pragma unroll
                    for (int n = 0; n < 2; ++n) acc[a][b][m][n] = (f32x4){0.f, 0.f, 0.f, 0.f}; }
        PG8_PIN_ACC();
        cur = nxt; cA = nA; cB = nB; ++ui;
        if constexpr (ALIGN_EPI) { if (wr == 1) PG8_BAR; }
    }
    PG8_WAIT_V(0);
    if constexpr (!ALIGN_EPI) { if (wr == 0) PG8_BAR; }
    PG8_BAR;
    if constexpr (Epi::AFTER_DRAIN) { E.fused(acc, cur, wr, wc, fr, fq, lds, wid, lane); S.done(cur); }
#undef PG8_SA
#undef PG8_SB
#undef PG8_STAGE
#undef PG8_LDA
#undef PG8_LDB
#undef PG8_MMA
#undef PG8_WAIT_V
#undef PG8_WAIT_L
#undef PG8_PIN_ACC
#undef PG8_BAR
#undef PG8_SCHED
}
}

#include <hip/hip_bf16.h>
#include <cmath>
namespace attn_body {
using bf16=__hip_bfloat16;
using bf16x8=__attribute__((ext_vector_type(8)))short;
using s16x4=__attribute__((ext_vector_type(4)))short;
using f32x16=__attribute__((ext_vector_type(16)))float;
using u32x4=__attribute__((ext_vector_type(4)))unsigned;
constexpr int BATCH=8,NHEAD=16,SEQ=2048,D=64,DM=NHEAD*D;
constexpr int NW=8,QBLK=32,QB=QBLK*NW,KVBLK=64,NQB=SEQ/QB;
constexpr int ATTN_PITCH=DM, ATTN_UNIT_ROWS=QB;
__device__ __forceinline__ int crow(int r,int hi){return (r&3)+8*(r>>2)+4*hi;}
#define SBAR() __builtin_amdgcn_sched_barrier(0)
__device__ __forceinline__ void cmask(f32x16&p0,f32x16&p1,int jb,int qrel,int hi){
  const float NEG=-INFINITY; int kb=64*jb+4*hi;
  #pragma unroll
  for(int r=0;r<16;++r){int kv=kb+(r&3)+8*(r>>2); if(kv>qrel)p0[r]=NEG; if(kv+32>qrel)p1[r]=NEG;}
}

constexpr int NSLOT=3, SLOTB=8192;
constexpr int LDS_K=0, LDS_V=NSLOT*SLOTB, LDS_WS=2*NSLOT*SLOTB, LDS_OST=LDS_WS+NW*64*4, LDS_BYTES=LDS_OST+NW*4096;
constexpr float C2=0.125f*1.4426950408889634f;
__device__ __forceinline__ void glds16(const void*gsrc,unsigned lds_dst){unsigned keep;
  asm volatile("s_mov_b32 %0, m0\n\ts_mov_b32 m0, %2\n\ts_nop 0\n\tglobal_load_lds_dwordx4 %1, off\n\ts_mov_b32 m0, %0":"=&s"(keep):"v"(gsrc),"s"(lds_dst):"memory");}
__device__ __forceinline__ float max3f(float a,float b,float c){float r;asm("v_max3_f32 %0, %1, %2, %3":"=v"(r):"v"(a),"v"(b),"v"(c));return r;}
__device__ __forceinline__ float max2f(float a,float b){float r;asm("v_max_f32_e32 %0, %1, %2":"=v"(r):"v"(a),"v"(b));return r;}
__device__ __forceinline__ float fadd_s(float a,float b){float r;asm("v_add_f32_e32 %0, %1, %2":"=v"(r):"v"(a),"v"(b));return r;}
__device__ __forceinline__ float fsub_s(float a,float b){float r;asm("v_sub_f32_e32 %0, %1, %2":"=v"(r):"v"(a),"v"(b));return r;}
typedef float f32x2_t __attribute__((ext_vector_type(2))); typedef __bf16 bf16x2_t __attribute__((ext_vector_type(2)));
__device__ __forceinline__ unsigned cvtpk_s(float lo,float hi){f32x2_t v={lo,hi};bf16x2_t b=__builtin_convertvector(v,bf16x2_t);return __builtin_bit_cast(unsigned,b);}
#define WAIT_BAR(N) asm volatile("s_waitcnt vmcnt(" #N ") lgkmcnt(0)\n\ts_barrier":::"memory")

__device__ __forceinline__ void qkt(f32x16&p0,f32x16&p1,const char*Kslot,const bf16x8*qr,const f32x16&negm,int r32,int hi){
  const char*kb=Kslot+hi*1024+r32*16;
  #pragma unroll
  for(int d0=0;d0<4;++d0){
    const bf16x8 b0=*reinterpret_cast<const bf16x8*>(kb+d0*2048);
    const bf16x8 b1=*reinterpret_cast<const bf16x8*>(kb+d0*2048+512);
    if(d0==0){p0=__builtin_amdgcn_mfma_f32_32x32x16_bf16(b0,qr[0],negm,0,0,0);p1=__builtin_amdgcn_mfma_f32_32x32x16_bf16(b1,qr[0],negm,0,0,0);}
    else{p0=__builtin_amdgcn_mfma_f32_32x32x16_bf16(b0,qr[d0],p0,0,0,0);p1=__builtin_amdgcn_mfma_f32_32x32x16_bf16(b1,qr[d0],p1,0,0,0);}}
}
typedef __attribute__((address_space(3))) const char* lds_cptr;
typedef short v4i16_t __attribute__((ext_vector_type(4)));
__device__ __forceinline__ void kload8(bf16x8*kf,lds_cptr kp){
  kf[0]=*(const __attribute__((address_space(3))) bf16x8*)(kp);      kf[1]=*(const __attribute__((address_space(3))) bf16x8*)(kp+512);
  kf[2]=*(const __attribute__((address_space(3))) bf16x8*)(kp+2048); kf[3]=*(const __attribute__((address_space(3))) bf16x8*)(kp+2560);
  kf[4]=*(const __attribute__((address_space(3))) bf16x8*)(kp+4096); kf[5]=*(const __attribute__((address_space(3))) bf16x8*)(kp+4608);
  kf[6]=*(const __attribute__((address_space(3))) bf16x8*)(kp+6144); kf[7]=*(const __attribute__((address_space(3))) bf16x8*)(kp+6656);
}
__device__ __forceinline__ void kload2(bf16x8*kf,lds_cptr kp,int j){ kf[2*j]=*(const __attribute__((address_space(3))) bf16x8*)(kp+j*2048); kf[2*j+1]=*(const __attribute__((address_space(3))) bf16x8*)(kp+j*2048+512); }
__device__ __forceinline__ s16x4 vtr(lds_cptr p){ return __builtin_bit_cast(s16x4,__builtin_amdgcn_ds_read_tr16_b64_v4i16((__attribute__((address_space(3))) v4i16_t*)p)); }
__device__ __forceinline__ float rowmax(const f32x16&p0,const f32x16&p1){
  float a=max3f(p0[0],p0[1],p1[0]),b=max3f(p0[2],p0[3],p1[1]);a=max3f(a,p1[2],p1[3]);
  #pragma unroll
  for(int r=4;r<16;r+=4){a=max3f(a,p0[r],p0[r+1]);b=max3f(b,p0[r+2],p0[r+3]);a=max3f(a,p1[r],p1[r+1]);b=max3f(b,p1[r+2],p1[r+3]);}
  const float m=max2f(a,b);
  auto rr=__builtin_amdgcn_permlane32_swap(__float_as_uint(m),__float_as_uint(m),false,false);
  return max2f(__uint_as_float(rr[0]),__uint_as_float(rr[1]));
}
__device__ __forceinline__ void pv(f32x16*o,int vb,bf16x8 pa0,bf16x8 pa1,bf16x8 pa2,bf16x8 pa3){
  #pragma unroll
  for(int d0=0;d0<2;++d0){s16x4 lo[4],hi[4];
    #pragma unroll
    for(int ks=0;ks<4;++ks){
      asm volatile("ds_read_b64_tr_b16 %0,%1 offset:%c2":"=&v"(lo[ks]):"v"(vb),"i"(d0*4096+ks*1024):"memory");
      asm volatile("ds_read_b64_tr_b16 %0,%1 offset:%c2":"=&v"(hi[ks]):"v"(vb),"i"(d0*4096+ks*1024+512):"memory");}
    asm volatile("s_waitcnt lgkmcnt(0)":::"memory");SBAR();
    #define PK(k) (bf16x8){lo[k][0],lo[k][1],lo[k][2],lo[k][3],hi[k][0],hi[k][1],hi[k][2],hi[k][3]}
    o[d0]=__builtin_amdgcn_mfma_f32_32x32x16_bf16(pa0,PK(0),o[d0],0,0,0);
    o[d0]=__builtin_amdgcn_mfma_f32_32x32x16_bf16(pa1,PK(1),o[d0],0,0,0);
    o[d0]=__builtin_amdgcn_mfma_f32_32x32x16_bf16(pa2,PK(2),o[d0],0,0,0);
    o[d0]=__builtin_amdgcn_mfma_f32_32x32x16_bf16(pa3,PK(3),o[d0],0,0,0);
    #undef PK
  }
}

#ifndef ATTN_STORE16
#define ATTN_STORE16(p,v) (*(u32x4*)(p)=(v))
#endif
template<int THRL> __device__ __forceinline__ void attn_unit(int wave_sg,int b,int h,int hv,int qb,const bf16*Q,const bf16*__restrict__ K,const bf16*__restrict__ V,bf16*O,char*shm){
  int tid_=pg8::opq(wave_sg)*64+pg8::lane_id(); asm volatile("":"+v"(tid_)); const int tid=tid_,lane=tid&63,r32=lane&31,hi=lane>>5; const int wid=__builtin_amdgcn_readfirstlane(tid>>6);
  const long rowbase=(long)b*SEQ; const int q0=qb*QB;
  const bf16*Qw=Q+(rowbase+q0+wid*QBLK)*DM+h*D;
  const bf16*Kh=K+rowbase*DM+h*D,*Vh=V+rowbase*DM+hv*D;
  const unsigned lds0=(unsigned)(uintptr_t)shm;
  float*wsf=(float*)(shm+LDS_WS)+wid*64;
  const bf16*ksrc=Kh+(long)lane*DM+wid*8;
  const bf16*vsrc=Vh+(long)(16*(wid&3)+(lane>>2))*DM+(wid>>2)*32+(lane&3)*8;
  const unsigned kdst=lds0+LDS_K+wid*1024, vdst=lds0+LDS_V+wid*1024;
  #define DMA_K(t,slot) glds16(ksrc+(long)(t)*KVBLK*DM,(unsigned)__builtin_amdgcn_readfirstlane(kdst+(slot)))
  #define DMA_V(t,slot) glds16(vsrc+(long)(t)*KVBLK*DM,(unsigned)__builtin_amdgcn_readfirstlane(vdst+(slot)))
  const int vb0=(int)(lds0+LDS_V)+((lane>>4)&1)*32+(lane&3)*8+(4*hi+((lane&15)>>2))*64;
  const char*Kbase=shm+LDS_K; bf16x8 kf[8];
  const lds_cptr shm3=(lds_cptr)shm; const lds_cptr kp0=shm3+LDS_K+hi*1024+r32*16; const lds_cptr vp0=shm3+LDS_V+((lane>>4)&1)*32+(lane&3)*8+(4*hi+((lane&15)>>2))*64;
  const int NT=(q0+QB)/KVBLK;
  DMA_K(0,0);DMA_V(0,0);DMA_K(1,SLOTB);
  bf16x8 qr[4];
  #pragma unroll
  for(int d0=0;d0<4;++d0)qr[d0]=*reinterpret_cast<const bf16x8*>(&Qw[(long)r32*DM+d0*16+hi*8]);
  float mhat=0.f,l_reg=0.f;f32x16 o[2];o[0]=f32x16{};o[1]=f32x16{};f32x16 negm=f32x16{};asm volatile("":"+v"(negm));
  const int qrel=wid*QBLK+r32;
  #define CMASK(P0,P1,t) do{int jb_=(t)-(NT-4); if(jb_>=0)cmask(P0,P1,jb_,qrel,hi);}while(0)
  bool resc=false;
  #define START(P0,P1) do{ const float rm=rowmax(P0,P1); resc=false; \
    { const float dl=rm; mhat=fadd_s(mhat,dl); \
      _Pragma("unroll") for(int r=0;r<16;++r){P0[r]=fsub_s(P0[r],dl);P1[r]=fsub_s(P1[r],dl);} \
      _Pragma("unroll") for(int r=0;r<16;++r)negm[r]=-mhat; asm volatile("":"+v"(negm)); } \
    _Pragma("unroll") for(int r=0;r<16;++r)P0[r]=__builtin_amdgcn_exp2f(P0[r]); }while(0)
  #define RESC() do{ if(resc){ asm volatile("s_waitcnt lgkmcnt(0)":::"memory"); \
      _Pragma("unroll") for(int d_=0;d_<2;++d_) _Pragma("unroll") for(int r=0;r<16;++r)o[d_][r]*=wsf[crow(r,hi)]; } }while(0)
  f32x16 pA0,pA1,pB0,pB1;
  int sl_prev=0,sl_cur=0,sl_next=SLOTB;
  #define ROT() do{sl_prev=sl_cur;sl_cur=sl_next;sl_next=(sl_next==(NSLOT-1)*SLOTB)?0:sl_next+SLOTB;}while(0)
  DMA_K(2,2*SLOTB);
  WAIT_BAR(3);
  qkt(pA0,pA1,Kbase,qr,negm,r32,hi);asm volatile("s_nop 15\n\ts_nop 7":"+v"(pA0),"+v"(pA1));CMASK(pA0,pA1,0);
  START(pA0,pA1);
  _Pragma("unroll") for(int r=0;r<16;++r)pA1[r]=__builtin_amdgcn_exp2f(pA1[r]);
  WAIT_BAR(0);
  DMA_K(3,0);DMA_V(1,SLOTB);
  ROT();
  kload8(kf,kp0+sl_cur);
  WAIT_BAR(2);
  s16x4 vlo[8],vhi[8]; u32x4 pw0,pw1,pw2,pw3;
  #define PKW(P,B) cvtpk_s(P[B],P[B+1])
  #define PAF(k) __builtin_bit_cast(bf16x8,pw##k)
  #define VFR(i) (bf16x8){vlo[i][0],vlo[i][1],vlo[i][2],vlo[i][3],vhi[i][0],vhi[i][1],vhi[i][2],vhi[i][3]}
  #define PIN(x) asm volatile("":"+v"(x))
  #define MX3(a,b,c) __builtin_fmaxf(__builtin_fmaxf((a),(b)),(c))
  #define GAPA(MF,A0,A1,A2,A3,W0,W1,PW) do{ MF; sacc+=A0; sacc+=A1; sacc+=A2; sacc+=A3; PIN(sacc); W0; W1; PIN(PW); SBAR(); }while(0)
  #define EX(v) __builtin_amdgcn_exp2f(v)
  #define GAPB(MF,X,B) do{ MF; X[B]=EX(X[B]); X[B+1]=EX(X[B+1]); X[B+2]=EX(X[B+2]); X[B+3]=EX(X[B+3]); PIN(X); SBAR(); }while(0)
  #define VRD(i) do{ vlo[i]=vtr(vp_+(((i)>>2)*4096+((i)&3)*1024)); vhi[i]=vtr(vp_+(((i)>>2)*4096+((i)&3)*1024+512)); }while(0)
  #define KRD(G,j) do{ if(G){ kload2(kf,kp0+sl_next,j); SBAR(); } }while(0)
  #define STEP(C0,C1,P0,P1,t,GK,GV,GL) do{ SBAR(); \
    const lds_cptr vp_=vp0+sl_prev; \
    VRD(0); SBAR(); float sacc=(P0[0]+P0[1]); \
    GAPA(C0=__builtin_amdgcn_mfma_f32_32x32x16_bf16(kf[0],qr[0],negm,0,0,0), P0[2],P0[3],P0[4],P0[5],     pw0[0]=PKW(P0,0), pw0[1]=PKW(P0,2), pw0); \
    VRD(4); SBAR(); GAPA(C1=__builtin_amdgcn_mfma_f32_32x32x16_bf16(kf[1],qr[0],negm,0,0,0), P0[6],P0[7],P0[8],P0[9],     pw0[2]=PKW(P0,4), pw0[3]=PKW(P0,6), pw0); \
    VRD(1); SBAR(); GAPA(C0=__builtin_amdgcn_mfma_f32_32x32x16_bf16(kf[2],qr[1],C0,0,0,0),   P0[10],P0[11],P0[12],P0[13], pw1[0]=PKW(P0,8), pw1[1]=PKW(P0,10), pw1); \
    VRD(5); SBAR(); GAPA(C1=__builtin_amdgcn_mfma_f32_32x32x16_bf16(kf[3],qr[1],C1,0,0,0),   P0[14],P0[15],P1[0],P1[1],   pw1[2]=PKW(P0,12),pw1[3]=PKW(P0,14), pw1); \
    VRD(2); SBAR(); GAPA(C0=__builtin_amdgcn_mfma_f32_32x32x16_bf16(kf[4],qr[2],C0,0,0,0),   P1[2],P1[3],P1[4],P1[5],     pw2[0]=PKW(P1,0), pw2[1]=PKW(P1,2), pw2); \
    VRD(6); SBAR(); GAPA(C1=__builtin_amdgcn_mfma_f32_32x32x16_bf16(kf[5],qr[2],C1,0,0,0),   P1[6],P1[7],P1[8],P1[9],     pw2[2]=PKW(P1,4), pw2[3]=PKW(P1,6), pw2); \
    VRD(3); SBAR(); GAPA(C0=__builtin_amdgcn_mfma_f32_32x32x16_bf16(kf[6],qr[3],C0,0,0,0),   P1[10],P1[11],P1[12],P1[13], pw3[0]=PKW(P1,8), pw3[1]=PKW(P1,10), pw3); \
    VRD(7); SBAR(); GAPA(C1=__builtin_amdgcn_mfma_f32_32x32x16_bf16(kf[7],qr[3],C1,0,0,0),   P1[14],P1[15],0.f,0.f,       pw3[2]=PKW(P1,12),pw3[3]=PKW(P1,14), pw3); \
    l_reg+=sacc; \
    if(GK){DMA_K((t)+3,sl_cur);} if(GV){DMA_V((t)+1,sl_next);} \
    CMASK(C0,C1,t); \
    { float a=MX3(C0[0],C0[1],C1[0]),b=MX3(C0[2],C0[3],C1[1]); a=MX3(a,C1[2],C1[3]); \
      _Pragma("unroll") for(int r=4;r<16;r+=4){a=MX3(a,C0[r],C0[r+1]);b=MX3(b,C0[r+2],C0[r+3]);a=MX3(a,C1[r],C1[r+1]);b=MX3(b,C1[r+2],C1[r+3]);} \
      float rm=__builtin_fmaxf(a,b); { auto rr=__builtin_amdgcn_permlane32_swap(__float_as_uint(rm),__float_as_uint(rm),false,false); rm=__builtin_fmaxf(__uint_as_float(rr[0]),__uint_as_float(rr[1])); } \
      resc=false; \
      if(__builtin_expect(__any(rm>(float)THRL),0)){ const float dl=__builtin_fmaxf(rm,0.f); mhat+=dl; \
        _Pragma("unroll") for(int r=0;r<16;++r){C0[r]-=dl;C1[r]-=dl;} \
        _Pragma("unroll") for(int r=0;r<16;++r)negm[r]=-mhat; asm volatile("":"+v"(negm)); \
        const float f=__builtin_amdgcn_exp2f(-dl); l_reg*=f; if(hi==0)wsf[r32]=f; resc=true; } } \
    SBAR(); \
    GAPB(o[0]=__builtin_amdgcn_mfma_f32_32x32x16_bf16(PAF(0),VFR(0),o[0],0,0,0), C0,0); \
    GAPB(o[1]=__builtin_amdgcn_mfma_f32_32x32x16_bf16(PAF(0),VFR(4),o[1],0,0,0), C0,4); \
    KRD(GL,0); GAPB(o[0]=__builtin_amdgcn_mfma_f32_32x32x16_bf16(PAF(1),VFR(1),o[0],0,0,0), C0,8); \
    KRD(GL,1); GAPB(o[1]=__builtin_amdgcn_mfma_f32_32x32x16_bf16(PAF(1),VFR(5),o[1],0,0,0), C0,12); \
    KRD(GL,2); GAPB(o[0]=__builtin_amdgcn_mfma_f32_32x32x16_bf16(PAF(2),VFR(2),o[0],0,0,0), C1,0); \
    KRD(GL,3); GAPB(o[1]=__builtin_amdgcn_mfma_f32_32x32x16_bf16(PAF(2),VFR(6),o[1],0,0,0), C1,4); \
    GAPB(o[0]=__builtin_amdgcn_mfma_f32_32x32x16_bf16(PAF(3),VFR(3),o[0],0,0,0), C1,8); \
    GAPB(o[1]=__builtin_amdgcn_mfma_f32_32x32x16_bf16(PAF(3),VFR(7),o[1],0,0,0), C1,12); \
    }while(0)
  int t=1;
  #undef CMASK
  #define CMASK(P0,P1,t) do{}while(0)
  for(;t+5<NT;t+=2){
    STEP(pB0,pB1,pA0,pA1,t,true,true,true);     WAIT_BAR(2); RESC(); ROT();
    STEP(pA0,pA1,pB0,pB1,t+1,true,true,true);   WAIT_BAR(2); RESC(); ROT();
  }
  #undef CMASK
  #define CMASK(P0,P1,t) do{int jb_=(t)-(NT-4); if(jb_>=0)cmask(P0,P1,jb_,qrel,hi);}while(0)
  #define ENDW(tt) do{ if((tt)+3<NT){WAIT_BAR(2);} else if((tt)+2<NT){WAIT_BAR(1);} else {WAIT_BAR(0);} }while(0)
  for(;t+1<NT;t+=2){
    STEP(pB0,pB1,pA0,pA1,t,(t+3<NT),(t+1<NT),(t+1<NT));       ENDW(t);   RESC(); ROT();
    STEP(pA0,pA1,pB0,pB1,t+1,(t+4<NT),(t+2<NT),(t+2<NT));     ENDW(t+1); RESC(); ROT();
  }
  STEP(pB0,pB1,pA0,pA1,NT-1,false,false,false); RESC();
  { float sacc=pB0[0]+pB0[1]; _Pragma("unroll") for(int r=2;r<16;++r)sacc+=pB0[r]; _Pragma("unroll") for(int r=0;r<16;++r)sacc+=pB1[r]; l_reg+=sacc;
    pw0=(u32x4){PKW(pB0,0),PKW(pB0,2),PKW(pB0,4),PKW(pB0,6)};pw1=(u32x4){PKW(pB0,8),PKW(pB0,10),PKW(pB0,12),PKW(pB0,14)};pw2=(u32x4){PKW(pB1,0),PKW(pB1,2),PKW(pB1,4),PKW(pB1,6)};pw3=(u32x4){PKW(pB1,8),PKW(pB1,10),PKW(pB1,12),PKW(pB1,14)};
    SBAR(); pv(o,vb0+sl_cur,PAF(0),PAF(1),PAF(2),PAF(3)); }
  #undef PKW
  #undef PAF
  #undef VFR
  #undef PIN
  #undef MX3
  #undef GAPA
  #undef GAPB
  #undef EX
  #undef VRD
  #undef KRD
  #undef STEP
  #undef ENDW
  {auto rr=__builtin_amdgcn_permlane32_swap(__float_as_uint(l_reg),__float_as_uint(l_reg),false,false);l_reg=__uint_as_float(rr[0])+__uint_as_float(rr[1]);}
  if(hi==0)wsf[32+r32]=l_reg;asm volatile("s_waitcnt lgkmcnt(0)":::"memory");
  float rli[16];
  #pragma unroll
  for(int r=0;r<16;++r)rli[r]=__builtin_amdgcn_rcpf(wsf[32+crow(r,hi)]);
  bf16*Ow=O+(rowbase+q0+wid*QBLK)*DM+hv*D;
  { bf16*stg=(bf16*)(shm+LDS_OST)+wid*2048;
    #pragma unroll
    for(int r=0;r<16;++r){const int orow=crow(r,hi);
      #pragma unroll
      for(int d0=0;d0<2;++d0)stg[orow*64+d0*32+r32]=__float2bfloat16(o[d0][r]*rli[r]);}
    asm volatile("s_waitcnt lgkmcnt(0)":::"memory");
    #pragma unroll
    for(int i=0;i<4;++i){const int row=i*8+(lane>>3),ch=lane&7; const u32x4 v=*(const u32x4*)(stg+row*64+ch*8); ATTN_STORE16(Ow+(long)row*DM+ch*8,v);} }
  asm volatile("s_waitcnt lgkmcnt(0)\n\ts_barrier":::"memory");
  #undef DMA_K
  #undef DMA_V
  #undef CMASK
  #undef START
  #undef RESC
  #undef ROT
}
constexpr int VSLOTB=16384, LW_K=0, LW_V=NSLOT*SLOTB, LW_WS=LW_V+NSLOT*VSLOTB, LW_BYTES=LW_WS+NW*64*4;
static_assert(NW*8192<=LW_WS,"O stage overlays the K/V rings");
__device__ __forceinline__ void pv4(f32x16*o,int vb,bf16x8 pa0,bf16x8 pa1,bf16x8 pa2,bf16x8 pa3){
  #pragma unroll
  for(int d0=0;d0<4;++d0){s16x4 lo[4],hi[4];
    #pragma unroll
    for(int ks=0;ks<4;++ks){
      asm volatile("ds_read_b64_tr_b16 %0,%1 offset:%c2":"=&v"(lo[ks]):"v"(vb),"i"(d0*4096+ks*1024):"memory");
      asm volatile("ds_read_b64_tr_b16 %0,%1 offset:%c2":"=&v"(hi[ks]):"v"(vb),"i"(d0*4096+ks*1024+512):"memory");}
    asm volatile("s_waitcnt lgkmcnt(0)":::"memory");SBAR();
    #define PK(k) (bf16x8){lo[k][0],lo[k][1],lo[k][2],lo[k][3],hi[k][0],hi[k][1],hi[k][2],hi[k][3]}
    o[d0]=__builtin_amdgcn_mfma_f32_32x32x16_bf16(pa0,PK(0),o[d0],0,0,0);
    o[d0]=__builtin_amdgcn_mfma_f32_32x32x16_bf16(pa1,PK(1),o[d0],0,0,0);
    o[d0]=__builtin_amdgcn_mfma_f32_32x32x16_bf16(pa2,PK(2),o[d0],0,0,0);
    o[d0]=__builtin_amdgcn_mfma_f32_32x32x16_bf16(pa3,PK(3),o[d0],0,0,0);
    #undef PK
  }
}
__device__ __forceinline__ void attn_unit_w(int wave_sg,int b,int h8,int m,int qb,const bf16*Q,const bf16*__restrict__ K,const bf16*__restrict__ V,bf16*O,char*shm,bf16*YAo,const float*fz){
  int tid_=pg8::opq(wave_sg)*64+pg8::lane_id(); asm volatile("":"+v"(tid_)); const int tid=tid_,lane=tid&63,r32=lane&31,hi=lane>>5; const int wid=__builtin_amdgcn_readfirstlane(tid>>6);
  const long rowbase=(long)b*SEQ; const int q0=qb*QB; const int hq=2*h8+m;
  const bf16*Qw=Q+(rowbase+q0+wid*QBLK)*DM+hq*D;
  const bf16*Kh=K+rowbase*DM+hq*D,*Vh=V+rowbase*DM+h8*128;
  const unsigned lds0=(unsigned)(uintptr_t)shm;
  float*wsf=(float*)(shm+LW_WS)+wid*64;
  const bf16*ksrc=Kh+(long)lane*DM+wid*8;
  const bf16*vsrcA=Vh+(long)(16*(wid&3)+(lane>>2))*DM+(wid>>2)*32+(lane&3)*8;
  const bf16*vsrcB=vsrcA+64;
  const unsigned kdst=lds0+LW_K+wid*1024, vdstA=lds0+LW_V+wid*1024, vdstB=vdstA+8192;
  #define DMA_K(t,slot) glds16(ksrc+(long)(t)*KVBLK*DM,(unsigned)__builtin_amdgcn_readfirstlane(kdst+(slot)))
  #define DMA_V(t,slot) do{ glds16(vsrcA+(long)(t)*KVBLK*DM,(unsigned)__builtin_amdgcn_readfirstlane(vdstA+2*(slot))); glds16(vsrcB+(long)(t)*KVBLK*DM,(unsigned)__builtin_amdgcn_readfirstlane(vdstB+2*(slot))); }while(0)
  const int vb0=(int)(lds0+LW_V)+((lane>>4)&1)*32+(lane&3)*8+(4*hi+((lane&15)>>2))*64;
  const char*Kbase=shm+LW_K; bf16x8 kf[8];
  const lds_cptr shm3=(lds_cptr)shm; const lds_cptr kp0=shm3+LW_K+hi*1024+r32*16; const lds_cptr vp0=shm3+LW_V+((lane>>4)&1)*32+(lane&3)*8+(4*hi+((lane&15)>>2))*64;
  const int NT=(q0+QB)/KVBLK;
  DMA_K(0,0);DMA_V(0,0);DMA_K(1,SLOTB);
  bf16x8 qr[4];
  #pragma unroll
  for(int d0=0;d0<4;++d0)qr[d0]=*reinterpret_cast<const bf16x8*>(&Qw[(long)r32*DM+d0*16+hi*8]);
  float l_reg=0.f;f32x16 o[4];o[0]=f32x16{};o[1]=f32x16{};o[2]=f32x16{};o[3]=f32x16{};
  const int qrel=wid*QBLK+r32;
  #define CMASK(P0,P1,t) do{int jb_=(t)-(NT-4); if(jb_>=0)cmask(P0,P1,jb_,qrel,hi);}while(0)
  f32x16 pA0,pA1,pB0,pB1;
  int sl_prev=0,sl_cur=0,sl_next=SLOTB;
  #define ROT() do{sl_prev=sl_cur;sl_cur=sl_next;sl_next=(sl_next==(NSLOT-1)*SLOTB)?0:sl_next+SLOTB;}while(0)
  DMA_K(2,2*SLOTB);
  WAIT_BAR(4);
  { const char*kb=Kbase+hi*1024+r32*16;
    #pragma unroll
    for(int d0=0;d0<4;++d0){
      const bf16x8 b0=*reinterpret_cast<const bf16x8*>(kb+d0*2048);
      const bf16x8 b1=*reinterpret_cast<const bf16x8*>(kb+d0*2048+512);
      if(d0==0){pA0=__builtin_amdgcn_mfma_f32_32x32x16_bf16(b0,qr[0],f32x16{},0,0,0);pA1=__builtin_amdgcn_mfma_f32_32x32x16_bf16(b1,qr[0],f32x16{},0,0,0);}
      else{pA0=__builtin_amdgcn_mfma_f32_32x32x16_bf16(b0,qr[d0],pA0,0,0,0);pA1=__builtin_amdgcn_mfma_f32_32x32x16_bf16(b1,qr[d0],pA1,0,0,0);}} }
  asm volatile("s_nop 15\n\ts_nop 7":"+v"(pA0),"+v"(pA1));CMASK(pA0,pA1,0);
  _Pragma("unroll") for(int r=0;r<16;++r){pA0[r]=__builtin_amdgcn_exp2f(pA0[r]);pA1[r]=__builtin_amdgcn_exp2f(pA1[r]);}
  WAIT_BAR(0);
  DMA_K(3,0);DMA_V(1,SLOTB);
  ROT();
  kload8(kf,kp0+sl_cur);
  WAIT_BAR(3);
  s16x4 vlo[8],vhi[8]; u32x4 pw0,pw1,pw2,pw3;
  #define PKW(P,B) cvtpk_s(P[B],P[B+1])
  #define PAF(k) __builtin_bit_cast(bf16x8,pw##k)
  #define VFR(i) (bf16x8){vlo[i][0],vlo[i][1],vlo[i][2],vlo[i][3],vhi[i][0],vhi[i][1],vhi[i][2],vhi[i][3]}
  #define PIN(x) asm volatile("":"+v"(x))
  #define GAPA(MF,A0,A1,A2,A3,W0,W1,PW) do{ MF; sacc+=A0; sacc+=A1; sacc+=A2; sacc+=A3; PIN(sacc); W0; W1; PIN(PW); SBAR(); }while(0)
  #define EX(v) __builtin_amdgcn_exp2f(v)
  #define GAPB(MF,X,B) do{ MF; X[B]=EX(X[B]); X[B+1]=EX(X[B+1]); PIN(X); SBAR(); }while(0)
  #define VRD(j,i) do{ vlo[j]=vtr(vp_+(((i)>>2)*4096+((i)&3)*1024)); vhi[j]=vtr(vp_+(((i)>>2)*4096+((i)&3)*1024+512)); }while(0)
  #define KRD(G,j) do{ if(G){ kload2(kf,kp0+sl_next,j); SBAR(); } }while(0)
  #define STEP(C0,C1,P0,P1,t,GK,GV,GL) do{ SBAR(); \
    const lds_cptr vp_=vp0+2*sl_prev; \
    VRD(0,0); SBAR(); float sacc=(P0[0]+P0[1]); \
    GAPA(C0=__builtin_amdgcn_mfma_f32_32x32x16_bf16(kf[0],qr[0],f32x16{},0,0,0), P0[2],P0[3],P0[4],P0[5],     pw0[0]=PKW(P0,0), pw0[1]=PKW(P0,2), pw0); \
    VRD(4,4); SBAR(); GAPA(C1=__builtin_amdgcn_mfma_f32_32x32x16_bf16(kf[1],qr[0],f32x16{},0,0,0), P0[6],P0[7],P0[8],P0[9],     pw0[2]=PKW(P0,4), pw0[3]=PKW(P0,6), pw0); \
    VRD(1,1); SBAR(); GAPA(C0=__builtin_amdgcn_mfma_f32_32x32x16_bf16(kf[2],qr[1],C0,0,0,0),   P0[10],P0[11],P0[12],P0[13], pw1[0]=PKW(P0,8), pw1[1]=PKW(P0,10), pw1); \
    VRD(5,5); SBAR(); GAPA(C1=__builtin_amdgcn_mfma_f32_32x32x16_bf16(kf[3],qr[1],C1,0,0,0),   P0[14],P0[15],P1[0],P1[1],   pw1[2]=PKW(P0,12),pw1[3]=PKW(P0,14), pw1); \
    VRD(2,2); SBAR(); GAPA(C0=__builtin_amdgcn_mfma_f32_32x32x16_bf16(kf[4],qr[2],C0,0,0,0),   P1[2],P1[3],P1[4],P1[5],     pw2[0]=PKW(P1,0), pw2[1]=PKW(P1,2), pw2); \
    VRD(6,6); SBAR(); GAPA(C1=__builtin_amdgcn_mfma_f32_32x32x16_bf16(kf[5],qr[2],C1,0,0,0),   P1[6],P1[7],P1[8],P1[9],     pw2[2]=PKW(P1,4), pw2[3]=PKW(P1,6), pw2); \
    VRD(3,3); SBAR(); GAPA(C0=__builtin_amdgcn_mfma_f32_32x32x16_bf16(kf[6],qr[3],C0,0,0,0),   P1[10],P1[11],P1[12],P1[13], pw3[0]=PKW(P1,8), pw3[1]=PKW(P1,10), pw3); \
    VRD(7,7); SBAR(); GAPA(C1=__builtin_amdgcn_mfma_f32_32x32x16_bf16(kf[7],qr[3],C1,0,0,0),   P1[14],P1[15],0.f,0.f,       pw3[2]=PKW(P1,12),pw3[3]=PKW(P1,14), pw3); \
    l_reg+=sacc; \
    if(GK){DMA_K((t)+3,sl_cur);} if(GV){DMA_V((t)+1,sl_next);} \
    CMASK(C0,C1,t); \
    SBAR(); \
    GAPB(o[0]=__builtin_amdgcn_mfma_f32_32x32x16_bf16(PAF(0),VFR(0),o[0],0,0,0), C0,0);  VRD(0,8);  SBAR(); \
    GAPB(o[1]=__builtin_amdgcn_mfma_f32_32x32x16_bf16(PAF(0),VFR(4),o[1],0,0,0), C0,2);  VRD(4,12); SBAR(); \
    KRD(GL,0); GAPB(o[0]=__builtin_amdgcn_mfma_f32_32x32x16_bf16(PAF(1),VFR(1),o[0],0,0,0), C0,4);  VRD(1,9);  SBAR(); \
    KRD(GL,1); GAPB(o[1]=__builtin_amdgcn_mfma_f32_32x32x16_bf16(PAF(1),VFR(5),o[1],0,0,0), C0,6);  VRD(5,13); SBAR(); \
    KRD(GL,2); GAPB(o[0]=__builtin_amdgcn_mfma_f32_32x32x16_bf16(PAF(2),VFR(2),o[0],0,0,0), C0,8);  VRD(2,10); SBAR(); \
    KRD(GL,3); GAPB(o[1]=__builtin_amdgcn_mfma_f32_32x32x16_bf16(PAF(2),VFR(6),o[1],0,0,0), C0,10); VRD(6,14); SBAR(); \
    GAPB(o[0]=__builtin_amdgcn_mfma_f32_32x32x16_bf16(PAF(3),VFR(3),o[0],0,0,0), C0,12); VRD(3,11); SBAR(); \
    GAPB(o[1]=__builtin_amdgcn_mfma_f32_32x32x16_bf16(PAF(3),VFR(7),o[1],0,0,0), C0,14); VRD(7,15); SBAR(); \
    GAPB(o[2]=__builtin_amdgcn_mfma_f32_32x32x16_bf16(PAF(0),VFR(0),o[2],0,0,0), C1,0); \
    GAPB(o[3]=__builtin_amdgcn_mfma_f32_32x32x16_bf16(PAF(0),VFR(4),o[3],0,0,0), C1,2); \
    GAPB(o[2]=__builtin_amdgcn_mfma_f32_32x32x16_bf16(PAF(1),VFR(1),o[2],0,0,0), C1,4); \
    GAPB(o[3]=__builtin_amdgcn_mfma_f32_32x32x16_bf16(PAF(1),VFR(5),o[3],0,0,0), C1,6); \
    GAPB(o[2]=__builtin_amdgcn_mfma_f32_32x32x16_bf16(PAF(2),VFR(2),o[2],0,0,0), C1,8); \
    GAPB(o[3]=__builtin_amdgcn_mfma_f32_32x32x16_bf16(PAF(2),VFR(6),o[3],0,0,0), C1,10); \
    GAPB(o[2]=__builtin_amdgcn_mfma_f32_32x32x16_bf16(PAF(3),VFR(3),o[2],0,0,0), C1,12); \
    GAPB(o[3]=__builtin_amdgcn_mfma_f32_32x32x16_bf16(PAF(3),VFR(7),o[3],0,0,0), C1,14); \
    }while(0)
  int t=1;
  #undef CMASK
  #define CMASK(P0,P1,t) do{}while(0)
  for(;t+5<NT;t+=2){
    STEP(pB0,pB1,pA0,pA1,t,true,true,true);     WAIT_BAR(3); ROT();
    STEP(pA0,pA1,pB0,pB1,t+1,true,true,true);   WAIT_BAR(3); ROT();
  }
  #undef CMASK
  #define CMASK(P0,P1,t) do{int jb_=(t)-(NT-4); if(jb_>=0)cmask(P0,P1,jb_,qrel,hi);}while(0)
  #define ENDW(tt) do{ if((tt)+3<NT){WAIT_BAR(3);} else if((tt)+2<NT){WAIT_BAR(2);} else {WAIT_BAR(0);} }while(0)
  for(;t+1<NT;t+=2){
    STEP(pB0,pB1,pA0,pA1,t,(t+3<NT),(t+1<NT),(t+1<NT));       ENDW(t);   ROT();
    STEP(pA0,pA1,pB0,pB1,t+1,(t+4<NT),(t+2<NT),(t+2<NT));     ENDW(t+1); ROT();
  }
  STEP(pB0,pB1,pA0,pA1,NT-1,false,false,false);
  { float sacc=pB0[0]+pB0[1]; _Pragma("unroll") for(int r=2;r<16;++r)sacc+=pB0[r]; _Pragma("unroll") for(int r=0;r<16;++r)sacc+=pB1[r]; l_reg+=sacc;
    pw0=(u32x4){PKW(pB0,0),PKW(pB0,2),PKW(pB0,4),PKW(pB0,6)};pw1=(u32x4){PKW(pB0,8),PKW(pB0,10),PKW(pB0,12),PKW(pB0,14)};pw2=(u32x4){PKW(pB1,0),PKW(pB1,2),PKW(pB1,4),PKW(pB1,6)};pw3=(u32x4){PKW(pB1,8),PKW(pB1,10),PKW(pB1,12),PKW(pB1,14)};
    SBAR(); pv4(o,vb0+2*sl_cur,PAF(0),PAF(1),PAF(2),PAF(3)); }
  #undef PKW
  #undef PAF
  #undef VFR
  #undef PIN
  #undef GAPA
  #undef GAPB
  #undef EX
  #undef VRD
  #undef KRD
  #undef STEP
  #undef ENDW
  {auto rr=__builtin_amdgcn_permlane32_swap(__float_as_uint(l_reg),__float_as_uint(l_reg),false,false);l_reg=__uint_as_float(rr[0])+__uint_as_float(rr[1]);}
  if(hi==0)wsf[32+r32]=l_reg;
  asm volatile("s_waitcnt lgkmcnt(0)\n\ts_barrier":::"memory");
  float rli[16];
  #pragma unroll
  for(int r=0;r<16;++r)rli[r]=__builtin_amdgcn_rcpf(wsf[32+crow(r,hi)]);
  bf16*Ow=O+(rowbase+q0+wid*QBLK)*DM+h8*128;
  { bf16*stg=(bf16*)shm+wid*4096;
    #pragma unroll
    for(int r=0;r<16;++r){const int orow=crow(r,hi);
      #pragma unroll
      for(int d0=0;d0<4;++d0)stg[orow*128+d0*32+r32]=__float2bfloat16(o[d0][r]*rli[r]);}
    asm volatile("s_waitcnt lgkmcnt(0)":::"memory");
    if(fz==nullptr){
    #pragma unroll
    for(int i=0;i<8;++i){const int row=i*4+(lane>>4),ch=lane&15; const u32x4 v=*(const u32x4*)(stg+row*128+ch*8); ATTN_STORE16(Ow+(long)row*DM+ch*8,v);} }
    else{ const bf16*O0w=Ow; bf16*Yw=YAo+(rowbase+q0+wid*QBLK)*DM+h8*128; const int ch=lane&15; const float lam=fz[0];
      asm volatile("s_waitcnt vmcnt(0)":::"memory");
      u32x4 a0[8];
      #pragma unroll
      for(int i=0;i<8;++i)a0[i]=*(const u32x4*)(O0w+(long)(i*4+(lane>>4))*DM+ch*8);
      float sl8[8];
      #pragma unroll
      for(int e=0;e<8;++e)sl8[e]=fz[2+ch*8+e];
      #pragma unroll
      for(int i=0;i<8;++i){const int row=i*4+(lane>>4); const u32x4 v1=*(const u32x4*)(stg+row*128+ch*8);
        const unsigned aw[4]={a0[i].x,a0[i].y,a0[i].z,a0[i].w},bw[4]={v1.x,v1.y,v1.z,v1.w}; float d[8]; float ss=0.f;
        #pragma unroll
        for(int j=0;j<4;++j){d[2*j]=__uint_as_float(aw[j]<<16)-lam*__uint_as_float(bw[j]<<16); d[2*j+1]=__uint_as_float(aw[j]&0xffff0000u)-lam*__uint_as_float(bw[j]&0xffff0000u); ss+=d[2*j]*d[2*j]+d[2*j+1]*d[2*j+1];}
        ss=pg8::row_sum16(ss);
        const float rr=1.0f/sqrtf(ss*(1.f/128.f)+1e-6f);
        u32x4 w; w.x=cvtpk_s(d[0]*rr*sl8[0],d[1]*rr*sl8[1]); w.y=cvtpk_s(d[2]*rr*sl8[2],d[3]*rr*sl8[3]); w.z=cvtpk_s(d[4]*rr*sl8[4],d[5]*rr*sl8[5]); w.w=cvtpk_s(d[6]*rr*sl8[6],d[7]*rr*sl8[7]);
        ATTN_STORE16(Yw+(long)row*DM+ch*8,w);} } }
  asm volatile("s_waitcnt lgkmcnt(0)\n\ts_barrier":::"memory");
  #undef DMA_K
  #undef DMA_V
  #undef CMASK
  #undef ROT
}
constexpr int ATTN_LDS_BYTES=LDS_BYTES;
struct AttnTensors { const bf16* Q; const bf16* K; const bf16* V; bf16* O; };
struct AttnUnit { int b, hq, hv, m, qb; };
struct StaticOrder {
  int vcu, G;
  __device__ __forceinline__ explicit StaticOrder(int grid,int block):vcu((grid%8==0)?(block%8)*(grid/8)+block/8:block),G(grid){}
  __device__ __forceinline__ bool next(int i,AttnUnit&u)const{ const int g=vcu+(i>>3)*G; if(g>=256)return false; const int vh=g&1,m=(g>>1)&1,h8=(g>>2)&7; u.b=g>>5; u.hq=2*h8+m; u.hv=2*h8+vh; u.m=m; u.qb=7-(i&7); return true; }
  __device__ __forceinline__ void a_ready(const AttnUnit&)const{}
  __device__ __forceinline__ void done(const AttnUnit&)const{}
};
template<class Sched,int THRL=8> __device__ __forceinline__ void attn_phase(char*lds,const AttnTensors&T,const Sched&S,const int wave_sg){
  AttnUnit u; const bf16*Qp=pg8::uni_ptr(T.Q),*Kp=pg8::uni_ptr(T.K),*Vp=pg8::uni_ptr(T.V); bf16*Op=pg8::uni_ptr(T.O);
  for(int i=0;S.next(i,u);++i){ S.a_ready(u); attn_unit<THRL>(wave_sg,u.b,u.hq,u.hv,u.qb,Qp,Kp,Vp,Op+(size_t)u.m*((size_t)BATCH*SEQ*DM),lds); S.done(u); }
}
#undef SBAR
#undef WAIT_BAR
}
#define GAS __attribute__((address_space(1)))
#define LAS __attribute__((address_space(3)))
typedef unsigned short bf16;
typedef unsigned v4u __attribute__((ext_vector_type(4)));
typedef float f32x4 __attribute__((ext_vector_type(4)));
typedef short bf16x8 __attribute__((ext_vector_type(8)));
typedef GAS unsigned gu32;
typedef GAS unsigned long long gu64;
#define RLX_AGENT __ATOMIC_RELAXED, __HIP_MEMORY_SCOPE_AGENT
#define LDS_WAIT() asm volatile("s_waitcnt lgkmcnt(0)" ::: "memory")
#define VM_WAIT() asm volatile("s_waitcnt vmcnt(0)" ::: "memory")
__device__ __forceinline__ unsigned long long rt() { return __builtin_amdgcn_s_memrealtime(); }
__device__ __forceinline__ unsigned f2bf(float f) { unsigned u = __builtin_bit_cast(unsigned, f); return (u + 0x7fffu + ((u >> 16) & 1u)) >> 16; }
__device__ __forceinline__ unsigned pk2(float lo, float hi) { return f2bf(lo) | (f2bf(hi) << 16); }

#define XB_TMO      128
#define XB_XCNT(j)  (256  + 64 * (j))
#define XB_XSUB(j)  (1280 + 64 * (j))
#define XB_XGEN(j)  (2304 + 64 * (j))
#define XB_TOP      3328
#define XB_TOPGEN   3392
#define XCD_BAR_WORDS 3456
#define XB_SPIN_CAP (1u << 18)

__device__ __forceinline__ unsigned xb_ld(unsigned* p)              { return __hip_atomic_load(p, __ATOMIC_RELAXED, __HIP_MEMORY_SCOPE_AGENT); }
__device__ __forceinline__ unsigned xb_add(unsigned* p, unsigned v) { return __hip_atomic_fetch_add(p, v, __ATOMIC_RELAXED, __HIP_MEMORY_SCOPE_AGENT); }
__device__ __forceinline__ unsigned xb_xcc_id() { return (unsigned)__builtin_amdgcn_s_getreg((3 << 11) | 20) & 0xFu; }
#define XB_SPIN(cond, bar) do { unsigned _sp = 0; while (cond) { __builtin_amdgcn_s_sleep(1); \
    if ((++_sp & 255u) == 0u) { if (xb_ld(&(bar)[XB_TMO])) break; if (_sp > XB_SPIN_CAP) { atomicAdd(&(bar)[XB_TMO], 1u); break; } } } } while (0)

struct XcdBarrier {
    unsigned* bar; unsigned x;
    volatile LAS unsigned* st;
};

__device__ __forceinline__ XcdBarrier xcd_barrier_post(unsigned* bar, volatile LAS unsigned* st, const bool t0) {
    XcdBarrier b; b.bar = bar; b.x = xb_xcc_id(); b.st = st;
    if (t0) (void)xb_add(&bar[XB_XCNT(b.x)], 1u);
    return b;
}
__device__ __forceinline__ void xcd_barrier_complete(unsigned* bar, unsigned x, unsigned& nloc, unsigned& nx) {
    const unsigned G = gridDim.x * gridDim.y * gridDim.z;
    unsigned sum, cnt, mine, sp = 0u;
    for (;;) {
        sum = 0u; cnt = 0u; mine = 0u;
#pragma unroll
        for (unsigned j = 0; j < 16; ++j) { const unsigned c = xb_ld(&bar[XB_XCNT(j)]); sum += c; cnt += (c > 0u) ? 1u : 0u; mine = (j == x) ? c : mine; }
        if (sum == G) break;
        __builtin_amdgcn_s_sleep(1);
        if ((++sp & 255u) == 0u) { if (xb_ld(&bar[XB_TMO])) break; if (sp > XB_SPIN_CAP) { atomicAdd(&bar[XB_TMO], 1u); break; } }
    }
    nloc = mine > 0u ? mine : 1u; nx = cnt > 0u ? cnt : 1u;
}

__device__ __forceinline__ void xcd_barrier(const XcdBarrier& b, const bool t0) {
    asm volatile("s_waitcnt vmcnt(0)" ::: "memory");
    __syncthreads();
    if (t0) {
        unsigned* bar = pg8::uni_ptr(b.bar);
        __builtin_amdgcn_s_waitcnt(0);
        unsigned nloc = b.st[0], nx = b.st[1];
        if (nloc == 0u) { xcd_barrier_complete(bar, b.x, nloc, nx); b.st[0] = nloc; b.st[1] = nx; }
        const unsigned old = xb_add(&bar[XB_XSUB(b.x)], 1u);
        const unsigned gen = old / nloc;
        if (old + 1u == (gen + 1u) * nloc) {
            __builtin_amdgcn_fence(__ATOMIC_RELEASE, "agent");
            asm volatile("s_waitcnt vmcnt(0)" ::: "memory");
            const unsigned og = xb_add(&bar[XB_TOP], 1u);
            const unsigned tg = og / nx;
            if (og + 1u == (tg + 1u) * nx) xb_add(&bar[XB_TOPGEN], 1u);
            else XB_SPIN(xb_ld(&bar[XB_TOPGEN]) == tg, bar);
            __builtin_amdgcn_fence(__ATOMIC_ACQUIRE, "agent");
            xb_add(&bar[XB_XGEN(b.x)], 1u);
            asm volatile("s_waitcnt vmcnt(0)" ::: "memory");
        } else {
            XB_SPIN(xb_ld(&bar[XB_XGEN(b.x)]) == gen, bar);
            __builtin_amdgcn_fence(__ATOMIC_ACQUIRE, "agent");
            asm volatile("s_waitcnt vmcnt(0)" ::: "memory");
        }
    }
    __syncthreads();
}

constexpr int NWAVES = 8;
constexpr int NB = 8, NT_ = 2048, DM_ = 2048, M = NB * NT_;
constexpr int MIXW = 1024, INC = 15360, FFH = 5632, MEMROWS = 2048;
constexpr int DEPTH = 2, NPH = 16;
constexpr float EPSN = 1e-6f;
constexpr float LOG2E = 1.4426950408889634f;

constexpr size_t MiB = 1u << 20;
constexpr size_t WS_CTL = 0, CTL_ZERO_BYTES = 1 * MiB;
constexpr size_t WS_LAM = 1 * MiB + 512 * 1024;
constexpr size_t WS_DCS = 1 * MiB, WS_RCS = 2 * MiB;
constexpr size_t WS_W = 4 * MiB;
constexpr int KPAD = 64;
constexpr int LD2K = DM_ + KPAD, LD1K = MIXW + KPAD, LDFF = FFH + KPAD;
constexpr size_t W_IN = WS_W, W_BR = W_IN + 62 * MiB, W_OUT = W_BR + 13 * MiB, W_Q = W_OUT + 9 * MiB, W_KV = W_Q + 9 * MiB, W_O = W_KV + 17 * MiB, W_13 = W_O + 9 * MiB, W_2 = W_13 + 46 * MiB, W_END = W_2 + 23 * MiB;
constexpr size_t WS_XN = W_END;
constexpr size_t WS_MN = WS_XN + 66 * MiB, WS_KM = WS_MN + 8 * MiB, WS_VT = WS_KM + 9 * MiB;
constexpr size_t WS_Y = WS_VT + 8 * MiB;
constexpr size_t WS_YRAW = WS_Y + 96 * MiB;
constexpr size_t WS_BIG = WS_YRAW + 64 * MiB;
constexpr size_t SEG = 32 * MiB, SEG_E = (size_t)16384 * 1024;
constexpr size_t WS_END_BIG = WS_BIG + 15 * SEG;
constexpr size_t RSS_STRIDE = (size_t)16384 * 32;
constexpr size_t WS_END = WS_END_BIG + 7 * RSS_STRIDE * 4;
static_assert(W_END == 192 * MiB && WS_END == 937 * MiB, "d_ws map");
constexpr size_t DO_WKV1 = 64 * MiB, DO_MN1 = 81 * MiB, DO_KV1 = 90 * MiB;
constexpr int CW_TMO = 0, CW_BAR = 4096, CW_Q = 8192;
constexpr size_t WS_RSS = WS_END_BIG;

constexpr int RING_OFF = 0, RING_BYTES = 131072;
constexpr int LDSCTL_OFF = RING_BYTES, MISC_OFF = LDSCTL_OFF + 320;
constexpr int LDS_BYTES = 147456;
static_assert(MISC_OFF + 128 <= LDS_BYTES, "LDS map");

struct Args { const float* in[22]; float* out; unsigned char* ws; int l_lo, l_hi; };
__device__ const float ROPE_INV[96] = {1.0f, 0.749894202f, 0.562341332f, 0.421696514f, 0.316227764f, 0.237137377f, 0.177827939f, 0.133352146f, 0.100000001f, 0.0749894232f, 0.0562341325f, 0.0421696492f, 0.0316227749f, 0.0237137377f, 0.0177827943f, 0.013335214f, 0.00999999978f, 0.00749894232f, 0.00562341325f, 0.00421696482f, 0.00316227763f, 0.00237137382f, 0.00177827943f, 0.00133352145f, 0.00100000005f, 0.000749894185f, 0.000562341302f, 0.000421696517f, 0.000316227757f, 0.00023713737f, 0.00017782794f, 0.00013335215f, 1.0f, 0.863988459f, 0.746476054f, 0.644946694f, 0.557226479f, 0.481437236f, 0.415956229f, 0.359381378f, 0.310501337f, 0.268269569f, 0.231781825f, 0.20025681f, 0.173019573f, 0.149486914f, 0.129154965f, 0.111588396f, 0.0964110866f, 0.0832980648f, 0.0719685704f, 0.0621800125f, 0.05372281f, 0.0464158878f, 0.040102791f, 0.0346483476f, 0.0299357735f, 0.0258641616f, 0.0223463364f, 0.0193069782f, 0.0166810062f, 0.0144121964f, 0.0124519709f, 0.010758359f, 0.00929509755f, 0.00803085696f, 0.00693856785f, 0.00599484239f, 0.0051794746f, 0.00447500637f, 0.00386635377f, 0.00334048504f, 0.00288614049f, 0.00249359198f, 0.0021544348f, 0.00186140672f, 0.0016082339f, 0.00138949545f, 0.00120050809f, 0.00103722513f, 0.000896150479f, 0.000774263695f, 0.000668954861f, 0.000577969302f, 0.000499358808f, 0.000431440218f, 0.000372759358f, 0.000322059786f, 0.000278255931f, 0.000240409921f, 0.00020771139f, 0.000179460243f, 0.000155051574f, 0.000133962778f, 0.000115742288f, 9.99999975e-05f};
struct Frame {
    LAS unsigned char* lds;
    volatile LAS unsigned* MISC;
    int vcu, G, wave;
};
#define PH_ENTER() const int wave = pg8::opq(F.wave), vcu_ = pg8::opq(F.vcu), G_ = pg8::opq(F.G); int tid = wave * 64 + pg8::lane_id(); asm volatile("" : "+v"(tid)); const int lane = tid & 63; (void)vcu_; (void)G_; \
    unsigned char* ws = pg8::uni_ptr(args.ws); (void)lane; (void)wave; (void)tid
__device__ __forceinline__ float wave_sum(float v) {
    v = pg8::xadd<1>(v); v = pg8::xadd<2>(v); v = pg8::xadd<4>(v); v = pg8::xadd<8>(v); v = pg8::xadd<16>(v); v = pg8::xadd<32>(v);
    return v;
}
__device__ __forceinline__ float wave_total(float v) {
#define DPPADD(ctrl, rmask) v += __int_as_float(__builtin_amdgcn_update_dpp(0, __float_as_int(v), ctrl, rmask, 0xf, true))
    DPPADD(0xB1, 0xf); DPPADD(0x4E, 0xf); DPPADD(0x141, 0xf); DPPADD(0x140, 0xf); DPPADD(0x142, 0xa); DPPADD(0x143, 0xc);
#undef DPPADD
    return __int_as_float(__builtin_amdgcn_readlane(__float_as_int(v), 63));
}
__device__ __forceinline__ float bflo(unsigned w) { return __uint_as_float(w << 16); }
__device__ __forceinline__ float bfhi(unsigned w) { return __uint_as_float(w & 0xffff0000u); }
__device__ __forceinline__ float sigm(float x) { return __builtin_amdgcn_rcpf(1.0f + __builtin_amdgcn_exp2f(-LOG2E * x)); }

template <int CMAP> __device__ __forceinline__ void transpose_item(const float* W, int K, int N, bf16* WT, int ldw, LAS float* scr, int item, int lane, const float* gain = nullptr) {
    const int nblk = N / 32, kb = item / nblk, nb = item % nblk, k0 = 64 * kb, n0 = 32 * nb;
    const int nn = n0 + (lane & 31); int sc = nn;
    if (CMAP == 1) sc = (nn & 1) * FFH + (nn >> 1);
    if (CMAP == 2) {
        if (nn < 2048) { const int w = nn & 63; sc = (nn & ~63) + (w & 1) * 32 + (w >> 1); }
        else if (nn >= 3072 && nn < 5120) { const int j = nn - 3072; sc = 3072 + (j & 1) * 1024 + (j >> 1); }
        else if (nn >= 5120 && nn < 7168) { const int w = (nn - 5120) & 127; sc = 5120 + ((nn - 5120) & ~127) + (w & 1) * 64 + (w >> 1); } }
    float wv[32]; const float gv = gain ? gain[k0 + lane] : 1.0f;
#pragma unroll
    for (int i = 0; i < 32; ++i) wv[i] = W[(size_t)(k0 + 2 * i + (lane >> 5)) * N + sc];
#pragma unroll
    for (int i = 0; i < 32; ++i) { const float g0 = __builtin_bit_cast(float, __builtin_amdgcn_readlane(__builtin_bit_cast(int, gv), 2 * i)), g1 = __builtin_bit_cast(float, __builtin_amdgcn_readlane(__builtin_bit_cast(int, gv), 2 * i + 1));
        scr[(2 * i + (lane >> 5)) * 33 + (lane & 31)] = wv[i] * ((lane >> 5) ? g1 : g0); }
    LDS_WAIT(); asm volatile("" ::: "memory");
    const int c = lane & 7;
#pragma unroll
    for (int j = 0; j < 4; ++j) { const int n = (lane >> 3) + 8 * j; const LAS float* s = scr + (8 * c) * 33 + n;
        v4u o; o.x = pk2(s[0 * 33], s[1 * 33]); o.y = pk2(s[2 * 33], s[3 * 33]); o.z = pk2(s[4 * 33], s[5 * 33]); o.w = pk2(s[6 * 33], s[7 * 33]);
        *(GAS v4u*)(WT + (size_t)(n0 + n) * ldw + k0 + 8 * c) = o; }
    LDS_WAIT(); asm volatile("" ::: "memory");
}
template <int CMAP> __device__ __forceinline__ int wt_row(int s) {
    if (CMAP == 1) return s < FFH ? 2 * s : 2 * (s - FFH) + 1;
    if (CMAP == 2) {
        if (s < 2048) { const int ws = s & 63; return (s & ~63) + (ws < 32 ? 2 * ws : 2 * (ws - 32) + 1); }
        if (s >= 3072 && s < 5120) { const int j = s - 3072; return 3072 + (j < 1024 ? 2 * j : 2 * (j - 1024) + 1); }
        if (s >= 5120 && s < 7168) { const int ws = (s - 5120) & 127; return 5120 + ((s - 5120) & ~127) + (ws < 64 ? 2 * ws : 2 * (ws - 64) + 1); } }
    return s;
}
template <int CMAP, int K> __device__ __forceinline__ void transpose_item_w(const float* W, int N, bf16* WT, int ldw, LAS unsigned char* scr, int item, int lane, const float* gain = nullptr) {
    constexpr int nkb = K / 64; const int nb = item / nkb, kb = item % nkb,
        k0 = 64 * kb, h = lane >> 5, cl = lane & 31, s0 = 128 * nb + 4 * cl;
    const float* src = W + (size_t)(k0 + h) * N + s0;
    f32x4 r[32]; const float gv = gain ? gain[k0 + lane] : 1.0f;
#pragma unroll
    for (int i = 0; i < 32; ++i) r[i] = *(const GAS f32x4*)(src + (size_t)(2 * i) * N);
    if (gain) {
#pragma unroll
        for (int i = 0; i < 32; ++i) { const float g0 = __builtin_bit_cast(float, __builtin_amdgcn_readlane(__builtin_bit_cast(int, gv), 2 * i)), g1 = __builtin_bit_cast(float, __builtin_amdgcn_readlane(__builtin_bit_cast(int, gv), 2 * i + 1));
            r[i] *= (h ? g1 : g0); } }
#pragma unroll
    for (int c0 = 0; c0 < 4; c0 += 2) {
#pragma unroll
        for (int d = 0; d < 2; ++d) {
            unsigned p[16];
#pragma unroll
            for (int i = 0; i < 16; ++i) { const auto rr = __builtin_amdgcn_permlane32_swap(__float_as_uint(r[i][c0 + d]), __float_as_uint(r[i + 16][c0 + d]), false, false);
                p[i] = pg8::cvt_pk_bf16(__uint_as_float(rr[0]), __uint_as_float(rr[1])); }
            const int rl = 2 * cl + d;
#pragma unroll
            for (int q = 0; q < 4; ++q) { v4u o; o.x = p[4 * q]; o.y = p[4 * q + 1]; o.z = p[4 * q + 2]; o.w = p[4 * q + 3];
                *(LAS v4u*)(scr + rl * 128 + (((4 * h + q) ^ (rl & 7)) << 4)) = o; }
        }
        LDS_WAIT(); asm volatile("" ::: "memory");
        v4u o[8];
#pragma unroll
        for (int j = 0; j < 8; ++j) { const int rl = (lane >> 3) + 8 * j; o[j] = *(const LAS v4u*)(scr + rl * 128 + (((lane & 7) ^ (rl & 7)) << 4)); }
        LDS_WAIT(); asm volatile("" ::: "memory");
#pragma unroll
        for (int j = 0; j < 8; ++j) { const int rl = (lane >> 3) + 8 * j; const int sc = 128 * nb + 4 * (rl >> 1) + c0 + (rl & 1);
            *(GAS v4u*)(WT + (size_t)wt_row<CMAP>(sc) * ldw + k0 + 8 * (lane & 7)) = o[j]; }
    }
}
__device__ __forceinline__ void convert_item(const float* W, bf16* WO, int ldw, int item, int lane, const float* gain) {
    const int kb = item / 64, nb = item % 64, k0 = 64 * kb, n0 = 32 * nb; const int kk = lane >> 3, c4 = (lane & 7) * 4;
    f32x4 v[8]; float g[8];
#pragma unroll
    for (int i = 0; i < 8; ++i) { const int k = k0 + 8 * i + kk; v[i] = *(const GAS f32x4*)(W + (size_t)k * DM_ + n0 + c4); g[i] = gain[k]; }
#pragma unroll
    for (int i = 0; i < 8; ++i) { const int k = k0 + 8 * i + kk;
        *(GAS unsigned long long*)(WO + (size_t)k * ldw + n0 + c4) = (unsigned long long)pk2(v[i].x * g[i], v[i].y * g[i]) | ((unsigned long long)pk2(v[i].z * g[i], v[i].w * g[i]) << 32); }
}
__device__ __forceinline__ void convert_item_w(const float* W, bf16* WO, int ldw, int item, int lane, const float* gain) {
    const int kb = item / 16, nb = item % 16, k0 = 64 * kb, h = lane >> 5, n0 = 128 * nb + 4 * (lane & 31);
    const float* src = W + (size_t)(k0 + h) * DM_ + n0; bf16* dst = WO + (size_t)(k0 + h) * ldw + n0;
    f32x4 r[32]; const float gv = gain[k0 + lane];
#pragma unroll
    for (int i = 0; i < 32; ++i) r[i] = *(const GAS f32x4*)(src + (size_t)(2 * i) * DM_);
#pragma unroll
    for (int i = 0; i < 32; ++i) { const float g0 = __builtin_bit_cast(float, __builtin_amdgcn_readlane(__builtin_bit_cast(int, gv), 2 * i)), g1 = __builtin_bit_cast(float, __builtin_amdgcn_readlane(__builtin_bit_cast(int, gv), 2 * i + 1));
        const f32x4 v = r[i] * (h ? g1 : g0);
        *(GAS unsigned long long*)(dst + (size_t)(2 * i) * ldw) = (unsigned long long)pg8::cvt_pk_bf16(v.x, v.y) | ((unsigned long long)pg8::cvt_pk_bf16(v.z, v.w) << 32); }
}
constexpr int LATE_ITEMS = 6528, LATE_ITEMS_IN = 3840, CHUNK_ITEMS = 32;
typedef const __attribute__((address_space(4))) unsigned char* kargp_t;
__device__ __forceinline__ const float* karg_in(kargp_t kp, int k) { return *(const float* const __attribute__((address_space(4)))*)(kp + 8 * k); }
__device__ __forceinline__ void late_item(kargp_t kp, unsigned char* ws, int l, int r, LAS unsigned char* scr, int lane) {
    if (r < 768) { const int br = r >> 8; transpose_item_w<0, MIXW>(karg_in(kp, 11) + ((size_t)l * 3 + br) * MIXW * DM_, DM_, (bf16*)(ws + W_BR) + (size_t)br * DM_ * LD1K, LD1K, scr, r & 255, lane); return; } r -= 768;
    if (r < 512) { transpose_item_w<0, DM_>(karg_in(kp, 12) + (size_t)l * DM_ * DM_, DM_, (bf16*)(ws + W_OUT), LD2K, scr, r, lane); return; } r -= 512;
    if (r < 512) { convert_item_w(karg_in(kp, 15) + (size_t)l * DM_ * DM_, (bf16*)(ws + W_Q), LD2K, r, lane, karg_in(kp, 13) + (size_t)l * DM_); return; } r -= 512;
    if (r < 512) { transpose_item_w<0, DM_>(karg_in(kp, 17) + (size_t)l * DM_ * DM_, DM_, (bf16*)(ws + W_O), LD2K, scr, r, lane); return; } r -= 512;
    if (r < 2816) { transpose_item_w<1, DM_>(karg_in(kp, 19) + (size_t)l * DM_ * 2 * FFH, 2 * FFH, (bf16*)(ws + W_13), LD2K, scr, r, lane, karg_in(kp, 18) + (size_t)l * DM_); return; } r -= 2816;
    if (r < 1408) { transpose_item_w<0, FFH>(karg_in(kp, 20) + (size_t)l * FFH * DM_, DM_, (bf16*)(ws + W_2), LDFF, scr, r, lane); return; } r -= 1408;
    transpose_item_w<2, DM_>(karg_in(kp, 3) + (size_t)(l + 1) * DM_ * INC, INC, (bf16*)(ws + W_IN), LD2K, scr, r, lane, karg_in(kp, 2) + (size_t)(l + 1) * DM_);
}
template <bool TOF32> __device__ __forceinline__ void rms_row(int lane, const float* xrow, const float* gain, void* orow) {
    const GAS f32x4* xr = (const GAS f32x4*)xrow + lane; const GAS f32x4* gr = (const GAS f32x4*)gain + lane;
    f32x4 v[8]; float s = 0.f;
#pragma unroll
    for (int j = 0; j < 8; ++j) { v[j] = xr[64 * j]; s += (v[j].x * v[j].x + v[j].y * v[j].y) + (v[j].z * v[j].z + v[j].w * v[j].w); }
    const float r = 1.0f / sqrtf(wave_sum(s) * (1.f / 2048.f) + EPSN);
#pragma unroll
    for (int j = 0; j < 8; ++j) { const f32x4 g = gr[64 * j]; const f32x4 y = v[j] * r * g;
        if (TOF32) ((GAS f32x4*)orow + lane)[64 * j] = y;
        else ((GAS unsigned long long*)orow + lane)[64 * j] = (unsigned long long)pk2(y.x, y.y) | ((unsigned long long)pk2(y.z, y.w) << 32); }
}

__device__ __forceinline__ void ph_prep(Frame& F, const Args& args, int l, const float* xcur) {
    PH_ENTER();
    LAS float* scr = (LAS float*)(F.lds + RING_OFF + wave * 16384);
    const int gw = vcu_ * NWAVES + wave, NGW = G_ * NWAVES;
    constexpr int I_IN = 32 * (INC / 128), I_KV = 32 * 32;
    if (l == 0) for (int it = gw; it < I_IN + I_KV; it += NGW) {
        int r = it;
        if (r < I_IN) { transpose_item_w<2, DM_>(args.in[3], INC, (bf16*)(ws + W_IN), LD2K, (LAS unsigned char*)scr, r, lane, args.in[2]); continue; } r -= I_IN;
        transpose_item_w<0, DM_>(args.in[16], 2 * DM_, (bf16*)(ws + W_KV), LD2K, (LAS unsigned char*)scr, r, lane);
        transpose_item_w<0, DM_>(args.in[16] + (size_t)DM_ * 2 * DM_, 2 * DM_, (bf16*)((unsigned char*)args.out + DO_WKV1), LD2K, (LAS unsigned char*)scr, r, lane);
    }
    if (l == 0) for (int m = gw; m < M; m += NGW) {
        const GAS f32x4* xr = (const GAS f32x4*)(xcur + (size_t)m * DM_) + lane; GAS unsigned long long* orow = (GAS unsigned long long*)((bf16*)(ws + WS_XN) + (size_t)m * LD2K) + lane; float sq = 0.f;
#pragma unroll
        for (int j = 0; j < 8; ++j) { const f32x4 v = xr[64 * j]; sq += (v.x * v.x + v.y * v.y) + (v.z * v.z + v.w * v.w); orow[64 * j] = (unsigned long long)pk2(v.x, v.y) | ((unsigned long long)pk2(v.z, v.w) << 32); }
        sq = wave_sum(sq); if (lane < 32) ((float*)(ws + WS_RSS))[((size_t)(lane >> 2) * M + (size_t)m) * 4 + (lane & 3)] = lane == 0 ? sq : 0.f; }
    if (l == 0) for (int m = gw; m < MEMROWS; m += NGW) { rms_row<false>(lane, args.in[1] + (size_t)m * DM_, args.in[14], (bf16*)(ws + WS_MN) + (size_t)m * DM_);
                                                         rms_row<false>(lane, args.in[1] + (size_t)m * DM_, args.in[14] + DM_, (bf16*)((unsigned char*)args.out + DO_MN1) + (size_t)m * DM_); }
    if (l == 1) { const int gt = vcu_ * (NWAVES * 64) + tid, NGT = G_ * NWAVES * 64;
        const GAS v4u* src = (const GAS v4u*)((const unsigned char*)args.out + DO_KV1); GAS v4u* dst = (GAS v4u*)(ws + WS_KM);
        for (int e = gt; e < 2 * MEMROWS * LD2K / 8; e += NGT) dst[e] = src[e]; }
    if (l == 0 && vcu_ == 0 && wave == 0) {
#pragma unroll
        for (int ll = 0; ll < DEPTH; ++ll) { const float* dl = args.in[4] + (size_t)ll * 256;
            const float s01 = wave_sum(dl[lane] * dl[64 + lane]), s23 = wave_sum(dl[128 + lane] * dl[192 + lane]);
            const float linit = 0.8f - 0.6f * expf(-0.3f * (float)ll);
            float* fz = (float*)(ws + WS_LAM) + 192 * ll;
            if (lane == 0) { fz[0] = expf(s01) - expf(s23) + linit; fz[1] = 1.0f - linit; }
            fz[2 + lane] = args.in[5][(size_t)ll * 128 + lane] * (1.0f - linit); fz[66 + lane] = args.in[5][(size_t)ll * 128 + 64 + lane] * (1.0f - linit); } }
    if (l == 0) {
        const int gt = vcu_ * (NWAVES * 64) + tid, NGT = G_ * NWAVES * 64;
        for (int e = gt; e < 2048 * 96; e += NGT) {
            const int t = e / 96, i = e % 96; float inv; float* dst;
            if (i < 32) { dst = (float*)(ws + WS_DCS) + ((size_t)t * 32 + i) * 2; }
            else { dst = (float*)(ws + WS_RCS) + ((size_t)t * 64 + (i - 32)) * 2; }
            inv = ROPE_INV[i];
            const float ang = (float)t * inv;
            const float CH = 0.15915494f, CL = 6.4206382e-09f;
            const float p = ang * CH, pe = fmaf(ang, CH, -p) + ang * CL; const float fr = (p - floorf(p)) + pe;
            dst[0] = __builtin_amdgcn_cosf(fr); dst[1] = __builtin_amdgcn_sinf(fr);
        }
    }
}

__device__ __forceinline__ void ph_rope(Frame& F, const Args& args) {
    PH_ENTER();
    const int gw = vcu_ * NWAVES + wave, NGW = G_ * NWAVES;
    for (int it = gw; it < 4 * M; it += NGW) {
        const int sel = it / M, row = it % M, t = row % NT_;
        const int seg = sel == 0 ? 0 : sel == 1 ? 1 : sel == 2 ? 5 : 6;
        bf16* base = (bf16*)(ws + WS_BIG + (size_t)seg * SEG) + (size_t)row * 1024;
        int c1, c2; const float* tab; float sc;
        if (sel < 2) { const int blk = lane >> 2, d0 = (lane & 3) * 8; c1 = blk * 64 + d0; c2 = c1 + 32; tab = (const float*)(ws + WS_DCS) + ((size_t)t * 32 + d0) * 2; sc = sel == 0 ? 0.125f * LOG2E : 1.0f; }
        else { const int blk = lane >> 3, d0 = (lane & 7) * 8; c1 = blk * 128 + d0; c2 = c1 + 64; tab = (const float*)(ws + WS_RCS) + ((size_t)t * 64 + d0) * 2; sc = sel == 2 ? 0.08838834764831845f : 1.0f; }
        const v4u a = *(const GAS v4u*)(base + c1), b = *(const GAS v4u*)(base + c2);
        const GAS f32x4* tb = (const GAS f32x4*)tab; const f32x4 t0 = tb[0], t1 = tb[1], t2 = tb[2], t3 = tb[3];
        const float cs[8] = {t0.x, t0.z, t1.x, t1.z, t2.x, t2.z, t3.x, t3.z}, sn[8] = {t0.y, t0.w, t1.y, t1.w, t2.y, t2.w, t3.y, t3.w};
        const unsigned aw[4] = {a.x, a.y, a.z, a.w}, bw[4] = {b.x, b.y, b.z, b.w}; unsigned oa[4], ob[4];
#pragma unroll
        for (int j = 0; j < 4; ++j) {
            const float x1l = bflo(aw[j]), x1h = bfhi(aw[j]), x2l = bflo(bw[j]), x2h = bfhi(bw[j]);
            const float y1l = (x1l * cs[2 * j] - x2l * sn[2 * j]) * sc, y2l = (x2l * cs[2 * j] + x1l * sn[2 * j]) * sc;
            const float y1h = (x1h * cs[2 * j + 1] - x2h * sn[2 * j + 1]) * sc, y2h = (x2h * cs[2 * j + 1] + x1h * sn[2 * j + 1]) * sc;
            oa[j] = pk2(y1l, y1h); ob[j] = pk2(y2l, y2h);
        }
        v4u wa; wa.x = oa[0]; wa.y = oa[1]; wa.z = oa[2]; wa.w = oa[3]; v4u wb; wb.x = ob[0]; wb.y = ob[1]; wb.z = ob[2]; wb.w = ob[3];
        *(GAS v4u*)(base + c1) = wa; *(GAS v4u*)(base + c2) = wb;
    }
}

__device__ __forceinline__ void ph_conv(Frame& F, const Args& args, int l, int ustart, int uend) {
    PH_ENTER();
    const bf16* U = (const bf16*)(ws + WS_BIG + 3 * SEG);
    bf16* YB = (bf16*)(ws + WS_Y) + SEG_E;
    const int c0 = 2 * tid;
    const float* cw = args.in[6] + (size_t)l * 31 * 1024;
    typedef float f32x2c __attribute__((ext_vector_type(2)));
    f32x2c w2[31];
#pragma unroll
    for (int j = 0; j < 31; ++j) { const float2 w = *(const float2*)(cw + j * 1024 + c0); w2[j] = (f32x2c){w.x, w.y}; }
    const float2 bias = *(const float2*)(args.in[7] + (size_t)l * 1024 + c0), lg = *(const float2*)(args.in[8] + (size_t)l * 1024 + c0), lb = *(const float2*)(args.in[9] + (size_t)l * 1024 + c0);
    LAS unsigned char* Us = F.lds + RING_OFF;
    LAS float* red1 = (LAS float*)(F.lds + RING_OFF + 46 * 2048); LAS float* red2 = red1 + 16 * 8;
    for (int unit = ustart; unit < uend; ++unit) {
        const int b = unit >> 7, t0 = (unit & 127) * 16;
#pragma unroll
        for (int i = 0; i < 12; ++i) { const int idx = tid + 512 * i; const int r = idx >> 7, ch = idx & 127;
            if (idx < 46 * 128) { const int tg = t0 - 30 + r; v4u v; v.x = 0u; v.y = 0u; v.z = 0u; v.w = 0u;
                if (tg >= 0) v = *(const GAS v4u*)(U + ((size_t)b * NT_ + tg) * 1024 + ch * 8);
                *(LAS v4u*)(Us + r * 2048 + ch * 16) = v; } }
        __syncthreads();
        f32x2c acc2[16];
#pragma unroll
        for (int t = 0; t < 16; ++t) acc2[t] = (f32x2c){0.f, 0.f};
#pragma unroll
        for (int r = 0; r < 46; ++r) {
            const unsigned uw = *(const LAS unsigned*)(Us + r * 2048 + tid * 4);
            const f32x2c u2 = {bflo(uw), bfhi(uw)};
#pragma unroll
            for (int t = 0; t < 16; ++t) { const int j = r - t; if (j >= 0 && j <= 30) acc2[t] = __builtin_elementwise_fma(u2, w2[j], acc2[t]); }
        }
        float a0[16], a1[16];
#pragma unroll
        for (int t = 0; t < 16; ++t) { a0[t] = acc2[t].x; a1[t] = acc2[t].y; }
        float mu[16];
#pragma unroll
        for (int t = 0; t < 16; ++t) { a0[t] += bias.x; a1[t] += bias.y; const float s = wave_total(a0[t] + a1[t]); if (lane == 0) red1[t * 8 + wave] = s; }
        __syncthreads();
#pragma unroll
        for (int t = 0; t < 16; ++t) { float s = 0.f;
#pragma unroll
            for (int w = 0; w < 8; ++w) s += red1[t * 8 + w];
            mu[t] = s * (1.f / 1024.f); a0[t] -= mu[t]; a1[t] -= mu[t];
            const float q = wave_total(a0[t] * a0[t] + a1[t] * a1[t]); if (lane == 0) red2[t * 8 + wave] = q; }
        __syncthreads();
#pragma unroll
        for (int t = 0; t < 16; ++t) { float q = 0.f;
#pragma unroll
            for (int w = 0; w < 8; ++w) q += red2[t * 8 + w];
            const float rs = 1.0f / sqrtf(q * (1.f / 1024.f) + EPSN);
            const float y0 = a0[t] * rs * lg.x + lb.x, y1 = a1[t] * rs * lg.y + lb.y;
            *(GAS unsigned*)(YB + ((size_t)b * NT_ + t0 + t) * 1024 + c0) = pk2(y0 * sigm(y0), y1 * sigm(y1)); }
    }
    __syncthreads();
}
__device__ __forceinline__ int sw_off(int row, int col) { return row * 256 + ((((col >> 3) ^ (row & 15)) << 4) | ((col & 7) << 1)); }
__device__ __forceinline__ void ph_ret_seq(Frame& F, const Args& args, int l, int bh) {
    PH_ENTER();
    typedef short bf16x8v __attribute__((ext_vector_type(8)));
    LAS unsigned char* Ks = F.lds + RING_OFF; LAS unsigned char* KTs = Ks + 32768; LAS unsigned char* VTs = KTs + 32768; LAS unsigned char* STs = VTs + 32768;
    const bf16* RQ = (const bf16*)(ws + WS_BIG + 5 * SEG); const bf16* RK = (const bf16*)(ws + WS_BIG + 6 * SEG); const bf16* RV = (const bf16*)(ws + WS_BIG + 7 * SEG); const bf16* RG = (const bf16*)(ws + WS_BIG + 8 * SEG);
    bf16* YRo = (bf16*)(ws + WS_Y) + 2 * SEG_E;
    const float* gng = args.in[10] + (size_t)l * 1024;
    const int wid = wave;
    const int b = bh >> 3, h = bh & 7;
    const float lg2 = log2f(1.0f - exp2f(-5.0f - (float)h));
    const float cdec = exp2f(128.0f * lg2);
    f32x4 st[8];
#pragma unroll
    for (int c = 0; c < 8; ++c) st[c] = (f32x4){0.f, 0.f, 0.f, 0.f};
    for (int e = tid; e < 8192; e += NWAVES * 64) ((LAS unsigned*)STs)[e] = 0u;
    bf16x8v qa[4]; v4u kq[4], vq[4];
    { const size_t r0 = (size_t)b * NT_; const int fr0 = lane & 15, fq0 = lane >> 4;
#pragma unroll
      for (int ks = 0; ks < 4; ++ks) qa[ks] = *(const GAS bf16x8v*)(RQ + (r0 + 16 * wid + fr0) * 1024 + h * 128 + ks * 32 + fq0 * 8);
#pragma unroll
      for (int i = 0; i < 4; ++i) { const int r = lane + 64 * (i & 1), cc = 2 * wid + (i >> 1); const size_t go = (r0 + r) * 1024 + h * 128 + cc * 8;
          kq[i] = *(const GAS v4u*)(RK + go); vq[i] = *(const GAS v4u*)(RV + go); } }
    for (int n = 0; n < 16; ++n) {
        const size_t row0 = (size_t)b * NT_ + (size_t)n * 128;
        int lane_n = lane; asm volatile("" : "+v"(lane_n)); const int fr = lane_n & 15, fq = lane_n >> 4;
        float lgn = lg2; asm volatile("" : "+v"(lgn));
#pragma unroll
        for (int i = 0; i < 4; ++i) { const int r = lane_n + 64 * (i & 1), cc = 2 * wid + (i >> 1);
            const v4u k = kq[i], v = vq[i];
            *(LAS v4u*)(Ks + sw_off(r, cc * 8)) = k;
            const float kd = __builtin_amdgcn_exp2f((float)(127 - r) * lgn); const unsigned kw[4] = {k.x, k.y, k.z, k.w}, vw[4] = {v.x, v.y, v.z, v.w};
#pragma unroll
            for (int j = 0; j < 4; ++j) {
                *(LAS bf16*)(KTs + sw_off(cc * 8 + 2 * j, r)) = (bf16)f2bf(bflo(kw[j]) * kd); *(LAS bf16*)(KTs + sw_off(cc * 8 + 2 * j + 1, r)) = (bf16)f2bf(bfhi(kw[j]) * kd);
                *(LAS bf16*)(VTs + sw_off(cc * 8 + 2 * j, r)) = (bf16)(vw[j] & 0xffffu); *(LAS bf16*)(VTs + sw_off(cc * 8 + 2 * j + 1, r)) = (bf16)(vw[j] >> 16); }
            if (i & 1) asm volatile("" ::: "memory"); }
        __syncthreads();
        unsigned Pk[8][2]; f32x4 o[8];
#pragma unroll
        for (int c = 0; c < 8; ++c) { f32x4 Sc = (f32x4){0.f, 0.f, 0.f, 0.f};
#pragma unroll
            for (int ks = 0; ks < 4; ++ks) { const bf16x8v kb = *(const LAS bf16x8v*)(Ks + sw_off(16 * c + fr, ks * 32 + fq * 8));
                Sc = __builtin_amdgcn_mfma_f32_16x16x32_bf16(qa[ks], kb, Sc, 0, 0, 0); }
            float p4[4];
#pragma unroll
            for (int rg = 0; rg < 4; ++rg) { const int tl = 16 * wid + 4 * fq + rg, sl = 16 * c + fr; p4[rg] = sl <= tl ? Sc[rg] * __builtin_amdgcn_exp2f((float)(tl - sl) * lgn) : 0.f; }
            Pk[c][0] = pk2(p4[0], p4[1]); Pk[c][1] = pk2(p4[2], p4[3]);
            asm volatile("" ::: "memory"); }
#pragma unroll
        for (int c = 0; c < 8; ++c) { o[c] = (f32x4){0.f, 0.f, 0.f, 0.f};
#pragma unroll
            for (int ks = 0; ks < 4; ++ks) { const bf16x8v sb = *(const LAS bf16x8v*)(STs + sw_off(16 * c + fr, ks * 32 + fq * 8));
                o[c] = __builtin_amdgcn_mfma_f32_16x16x32_bf16(qa[ks], sb, o[c], 0, 0, 0); }
#pragma unroll
            for (int rg = 0; rg < 4; ++rg) o[c][rg] *= __builtin_amdgcn_exp2f((float)(16 * wid + 4 * fq + rg + 1) * lgn);
            asm volatile("" ::: "memory"); }
        {
            bf16x8v va[4];
#pragma unroll
            for (int ks = 0; ks < 4; ++ks) va[ks] = *(const LAS bf16x8v*)(VTs + sw_off(16 * wid + fr, ks * 32 + fq * 8));
#pragma unroll
            for (int c = 0; c < 8; ++c) { st[c] = st[c] * cdec;
#pragma unroll
                for (int ks = 0; ks < 4; ++ks) { const bf16x8v kb = *(const LAS bf16x8v*)(KTs + sw_off(16 * c + fr, ks * 32 + fq * 8));
                    st[c] = __builtin_amdgcn_mfma_f32_16x16x32_bf16(va[ks], kb, st[c], 0, 0, 0); }
                asm volatile("" ::: "memory"); }
        }
        __syncthreads();
        v4u gq[4];
#pragma unroll
        for (int i = 0; i < 4; ++i) gq[i] = *(const GAS v4u*)(RG + (row0 + 16 * wid + (lane_n >> 4) + 4 * i) * 1024 + h * 128 + (lane_n & 15) * 8);
        bf16x8v qn[4];
        if (n + 1 < 16) { const size_t r1 = row0 + 128;
#pragma unroll
            for (int ks = 0; ks < 4; ++ks) qn[ks] = *(const GAS bf16x8v*)(RQ + (r1 + 16 * wid + fr) * 1024 + h * 128 + ks * 32 + fq * 8);
#pragma unroll
            for (int i = 0; i < 4; ++i) { const int r = lane_n + 64 * (i & 1), cc = 2 * wid + (i >> 1); const size_t go = (r1 + r) * 1024 + h * 128 + cc * 8;
                kq[i] = *(const GAS v4u*)(RK + go); vq[i] = *(const GAS v4u*)(RV + go); } }
        else {
#pragma unroll
            for (int ks = 0; ks < 4; ++ks) qn[ks] = qa[ks]; }
#pragma unroll
        for (int c = 0; c < 8; ++c)
#pragma unroll
            for (int rg = 0; rg < 4; ++rg) { const int tl = 16 * wid + 4 * fq + rg, sl = 16 * c + fr;
                *(LAS bf16*)(Ks + sw_off(tl, sl)) = (bf16)((rg & 1) ? (Pk[c][rg >> 1] >> 16) : (Pk[c][rg >> 1] & 0xffffu));
                *(LAS bf16*)(STs + sw_off(tl, sl)) = (bf16)f2bf(st[c][rg]); }
        LDS_WAIT(); asm volatile("" ::: "memory");
        bf16x8v pa[4];
#pragma unroll
        for (int ks = 0; ks < 4; ++ks) pa[ks] = *(const LAS bf16x8v*)(Ks + sw_off(16 * wid + fr, ks * 32 + fq * 8));
#pragma unroll
        for (int c = 0; c < 8; ++c) {
#pragma unroll
            for (int ks = 0; ks < 4; ++ks) { const bf16x8v vb = *(const LAS bf16x8v*)(VTs + sw_off(16 * c + fr, ks * 32 + fq * 8));
                o[c] = __builtin_amdgcn_mfma_f32_16x16x32_bf16(pa[ks], vb, o[c], 0, 0, 0); }
            asm volatile("" ::: "memory"); }
        float mu[4], rs[4];
#pragma unroll
        for (int rg = 0; rg < 4; ++rg) { float s = 0.f;
#pragma unroll
            for (int c = 0; c < 8; ++c) s += o[c][rg];
            s = pg8::xadd<1>(s); s = pg8::xadd<2>(s); s = pg8::xadd<4>(s); s = pg8::xadd<8>(s); mu[rg] = s * (1.f / 128.f);
            float q = 0.f;
#pragma unroll
            for (int c = 0; c < 8; ++c) { const float d = o[c][rg] - mu[rg]; q += d * d; }
            q = pg8::xadd<1>(q); q = pg8::xadd<2>(q); q = pg8::xadd<4>(q); q = pg8::xadd<8>(q); rs[rg] = 1.0f / sqrtf(q * (1.f / 128.f) + EPSN); }
#pragma unroll
        for (int c = 0; c < 8; ++c)
#pragma unroll
            for (int rg = 0; rg < 4; ++rg) *(LAS bf16*)(Ks + sw_off(16 * wid + 4 * fq + rg, 16 * c + fr)) = (bf16)f2bf((o[c][rg] - mu[rg]) * rs[rg] * gng[h * 128 + 16 * c + fr]);
        LDS_WAIT(); asm volatile("" ::: "memory");
#pragma unroll
        for (int i = 0; i < 4; ++i) { const int r = 16 * wid + (lane_n >> 4) + 4 * i, cc = lane_n & 15;
            const v4u y = *(const LAS v4u*)(Ks + sw_off(r, cc * 8)); const size_t go = (row0 + r) * 1024 + h * 128 + cc * 8;
            const unsigned yw[4] = {y.x, y.y, y.z, y.w}, gw4[4] = {gq[i].x, gq[i].y, gq[i].z, gq[i].w}; unsigned ow[4];
#pragma unroll
            for (int j = 0; j < 4; ++j) { const float ga = bflo(gw4[j]), gb = bfhi(gw4[j]); ow[j] = pk2(ga * sigm(ga) * bflo(yw[j]), gb * sigm(gb) * bfhi(yw[j])); }
            v4u w; w.x = ow[0]; w.y = ow[1]; w.z = ow[2]; w.w = ow[3]; *(GAS v4u*)(YRo + go) = w; }
        __syncthreads();
#pragma unroll
        for (int ks = 0; ks < 4; ++ks) qa[ks] = qn[ks];
    }
}

__device__ __forceinline__ void ph_combine(Frame& F, const Args& args, int l) {
    PH_ENTER();
    const int gw = vcu_ * NWAVES + wave, NGW = G_ * NWAVES;
    const float* dl = args.in[4] + (size_t)l * 256;
    const float s01 = wave_sum(dl[lane] * dl[64 + lane]), s23 = wave_sum(dl[128 + lane] * dl[192 + lane]);
    const float linit = 0.8f - 0.6f * expf(-0.3f * (float)l);
    const float lam = expf(s01) - expf(s23) + linit;
    const float* subln = args.in[5] + (size_t)l * 128 + (lane & 7) * 16;
    float sl[16];
#pragma unroll
    for (int i = 0; i < 16; ++i) sl[i] = subln[i] * (1.0f - linit);
    const bf16* O0 = (const bf16*)args.out; const bf16* O1 = O0 + SEG_E;
    bf16* YA = (bf16*)(ws + WS_Y);
    for (int m = gw; m < M; m += NGW) {
        const size_t off = (size_t)m * 1024 + lane * 16;
        {   const v4u a0 = *(const GAS v4u*)(O0 + off), a1 = *(const GAS v4u*)(O0 + off + 8), b0 = *(const GAS v4u*)(O1 + off), b1 = *(const GAS v4u*)(O1 + off + 8);
            const unsigned aw[8] = {a0.x, a0.y, a0.z, a0.w, a1.x, a1.y, a1.z, a1.w}, bw[8] = {b0.x, b0.y, b0.z, b0.w, b1.x, b1.y, b1.z, b1.w};
            float d[16]; float ss = 0.f;
#pragma unroll
            for (int j = 0; j < 8; ++j) { d[2 * j] = bflo(aw[j]) - lam * bflo(bw[j]); d[2 * j + 1] = bfhi(aw[j]) - lam * bfhi(bw[j]); ss += d[2 * j] * d[2 * j] + d[2 * j + 1] * d[2 * j + 1]; }
            ss = pg8::xadd<1>(ss); ss = pg8::xadd<2>(ss); ss = pg8::xadd<4>(ss);
            const float r = 1.0f / sqrtf(ss * (1.f / 128.f) + EPSN);
            unsigned ow[8];
#pragma unroll
            for (int j = 0; j < 8; ++j) ow[j] = pk2(d[2 * j] * r * sl[2 * j], d[2 * j + 1] * r * sl[2 * j + 1]);
            v4u w0; w0.x = ow[0]; w0.y = ow[1]; w0.z = ow[2]; w0.w = ow[3]; v4u w1; w1.x = ow[4]; w1.y = ow[5]; w1.z = ow[6]; w1.w = ow[7];
            *(GAS v4u*)(YA + off) = w0; *(GAS v4u*)(YA + off + 8) = w1; }
    }
}

#ifndef MK_MULTI
#define MK_MULTI 0
#endif
template <int KLO, int KHI> __global__ void __launch_bounds__(NWAVES * 64, 2) mk_fwd(Args args) {
    extern __shared__ __attribute__((aligned(16))) unsigned char lds[];
    Frame F;
    F.lds = (LAS unsigned char*)lds;
    F.MISC = (volatile LAS unsigned*)(F.lds + MISC_OFF);
    F.wave = __builtin_amdgcn_readfirstlane((int)threadIdx.x >> 6); F.G = gridDim.x; { const int bx = blockIdx.x; F.vcu = (F.G % 8 == 0) ? (bx % 8) * (F.G / 8) + bx / 8 : bx; }
    for (int u = threadIdx.x; u < (LDS_BYTES - LDSCTL_OFF) / 4; u += NWAVES * 64) ((LAS unsigned*)(F.lds + LDSCTL_OFF))[u] = 0u;
    __syncthreads();
    XcdBarrier bar; bar.bar = (unsigned*)(args.ws + WS_CTL) + CW_BAR; bar.x = 0; bar.st = nullptr;
    if (!MK_MULTI) bar = xcd_barrier_post((unsigned*)(args.ws + WS_CTL) + CW_BAR, F.MISC + 8, threadIdx.x == 0);
#ifndef REP_MASK
#define REP_MASK 0u
#endif
#define NREP(k) ((((REP_MASK) >> (k)) & 1u) ? 2 : 1)
#define IN(k) (KLO <= (k) && (k) < KHI)
#define SEAM(k) do { if (!MK_MULTI && IN(k) && IN((k) + 1)) xcd_barrier(bar, F.wave == 0 && pg8::lane_id() == 0); } while (0)
#define PHP() unsigned char* ws = pg8::uni_ptr(args.ws); bf16* const XN = (bf16*)(ws + WS_XN); bf16* const BIGp = (bf16*)(ws + WS_BIG); const int bx = pg8::opq((int)blockIdx.x), G_ = pg8::opq(F.G); (void)XN; (void)BIGp; (void)bx; (void)G_

    for (int l = args.l_lo; l < args.l_hi; ++l) {
        constexpr int pb = 0;
        const float* xcur = args.in[0];
        if (IN(pb + 0)) for (int rep_ = 0; rep_ < NREP(0); ++rep_) ph_prep(F, args, l, xcur);
        SEAM(pb + 0);
        if (IN(pb + 1)) for (int rep_ = 0; rep_ < NREP(1); ++rep_) { PHP();
            { pg8::Gemm g{XN, (const bf16*)(ws + W_IN), LD2K, LD2K, DM_}; pg8::StaticOrder S; S.init(M, INC, G_, bx, LD2K, LD2K);
              pg8::EpiInProj E{BIGp, (const float*)(ws + WS_DCS), (const float*)(ws + WS_RCS), (const float*)(ws + WS_RSS) + (l == 0 ? 0 : 3 * RSS_STRIDE)};
              pg8::gemm_phase<pg8::EpiInProj, pg8::StaticOrder, true, true>(F.lds + RING_OFF, g, S, E, F.wave); }
            if (l == 0) {
            { pg8::Gemm g{(const bf16*)(ws + WS_MN), (const bf16*)(ws + W_KV), DM_, LD2K, DM_}; pg8::StaticOrder S; S.init(MEMROWS, 2 * DM_, G_, (bx + 128) % G_, DM_, LD2K);
              pg8::EpiBf16 E{(bf16*)(ws + WS_KM), LD2K, DM_, (size_t)MEMROWS * LD2K, 1.0f, nullptr};
              pg8::gemm_phase<pg8::EpiBf16, pg8::StaticOrder, true, true>(F.lds + RING_OFF, g, S, E, F.wave); }
            { pg8::Gemm g{(const bf16*)((unsigned char*)args.out + DO_MN1), (const bf16*)((unsigned char*)args.out + DO_WKV1), DM_, LD2K, DM_}; pg8::StaticOrder S; S.init(MEMROWS, 2 * DM_, G_, bx, DM_, LD2K);
              pg8::EpiBf16 E{(bf16*)((unsigned char*)args.out + DO_KV1), LD2K, DM_, (size_t)MEMROWS * LD2K, 1.0f, nullptr};
              pg8::gemm_phase<pg8::EpiBf16, pg8::StaticOrder, true, true>(F.lds + RING_OFF, g, S, E, F.wave); }
            }
        }
        SEAM(pb + 1);
        if (IN(pb + 3)) for (int rep_ = 0; rep_ < NREP(3); ++rep_) { PHP();
            const attn_body::bf16* Qp = (const attn_body::bf16*)BIGp; const attn_body::bf16* Kp = (const attn_body::bf16*)(BIGp + SEG_E); const attn_body::bf16* Vp = (const attn_body::bf16*)(BIGp + 2 * SEG_E);
            attn_body::bf16* Op = (attn_body::bf16*)args.out;
            unsigned* qctr = (unsigned*)(ws + WS_CTL) + CW_Q + 64 * (2 * l + rep_);
            const float* fzl = (const float*)(ws + WS_LAM) + 192 * l;
            const int nch = (LATE_ITEMS + (l + 1 < DEPTH ? LATE_ITEMS_IN : 0)) / CHUNK_ITEMS;
            for (;;) {
                if (F.wave == 0 && pg8::lane_id() == 0) { const unsigned idq = __hip_atomic_fetch_add(qctr, 1u, __ATOMIC_RELAXED, __HIP_MEMORY_SCOPE_AGENT); F.MISC[12] = idq; }
                __syncthreads();
                const int idq = pg8::opq((int)__builtin_amdgcn_readfirstlane((int)F.MISC[12]));
                if (idq >= 1088 + nch) break;
                int id = idq;
                if (idq >= 64) { const int j = idq - 64;
                    if (j < 3 * nch) { const int q = j / 3, rr = j - 3 * q;
                        if (rr == 2) {
                            LAS unsigned char* scr = (LAS unsigned char*)(F.lds + RING_OFF + F.wave * 16384);
                            kargp_t kp = (kargp_t)__builtin_amdgcn_kernarg_segment_ptr(); asm volatile("" : "+s"(kp)); int lane_q = pg8::lane_id(); asm volatile("" : "+v"(lane_q));
                            for (int i = 0; i < CHUNK_ITEMS / NWAVES; ++i) late_item(kp, ws, pg8::opq(l), CHUNK_ITEMS * q + pg8::opq(F.wave) + NWAVES * i, scr, lane_q);
                            __syncthreads(); continue; }
                        id = 64 + 2 * q + rr; }
                    else id = 64 + j - nch; }
                if (id < 64) ph_ret_seq(F, args, l, id);
                else if (id >= 320 && id < 832) { const int k2 = id - 320; ph_conv(F, args, l, 2 * k2, 2 * k2 + 2); }
                else { const int j = id < 320 ? id - 64 : id - 832 + 256;
                    const int qb = 7 - (j >> 6), g = j & 63, h8 = g & 7, b = g >> 3;
                    attn_body::attn_unit_w(F.wave, b, h8, 0, qb, Qp, Kp, Vp, Op, (char*)lds + RING_OFF, nullptr, nullptr);
                    attn_body::attn_unit_w(F.wave, b, h8, 1, qb, Qp, Kp, Vp, Op, (char*)lds + RING_OFF, (attn_body::bf16*)(ws + WS_Y), fzl); }
            }
            __syncthreads();
        }
        SEAM(pb + 3);
        if (IN(pb + 5)) for (int rep_ = 0; rep_ < NREP(5); ++rep_) { PHP();
            bf16* Y = (bf16*)(ws + WS_Y);
            pg8::Gemm g{Y, (const bf16*)(ws + W_BR), MIXW, LD1K, MIXW}; pg8::MergeOrder S; S.T.init(M, DM_, G_, bx, MIXW, LD1K);
            S.ystride = (unsigned)(SEG_E * 2); S.wstride = (unsigned)((size_t)DM_ * LD1K * 2);
            pg8::EpiMerge E{BIGp + 9 * SEG_E, BIGp};
            pg8::gemm_phase<pg8::EpiMerge, pg8::MergeOrder, true, true>(F.lds + RING_OFF, g, S, E, F.wave);
        }
        SEAM(pb + 5);
        if (IN(pb + 6))
#pragma unroll
        for (int rep_ = 0; rep_ < NREP(6); ++rep_) { PHP();
            { pg8::Gemm g{BIGp, (const bf16*)(ws + W_OUT), DM_, LD2K, DM_}; pg8::StaticOrder S; S.init(M, DM_, G_, bx, DM_, LD2K);
              pg8::EpiRes E{XN, rep_ ? BIGp + 11 * SEG_E : BIGp + 8 * SEG_E, LD2K, (float*)(ws + WS_RSS) + (size_t)(rep_ ? 6 : 1 + 3 * l) * RSS_STRIDE};
              pg8::gemm_phase<pg8::EpiRes, pg8::StaticOrder, true, true>(F.lds + RING_OFF, g, S, E, F.wave); }
            { pg8::Gemm g{(const bf16*)ws, (const bf16*)ws, LD2K, LD2K, 512};
              pg8::XprodOrder S{G_, bx, (unsigned)LD2K, (unsigned)WS_KM, (unsigned)(WS_KM + (size_t)MEMROWS * LD2K * 2), (unsigned)W_Q, (unsigned)W_O};
              pg8::EpiBf16Two E{(bf16*)(ws + WS_YRAW), DM_, (bf16*)(ws + WS_YRAW) + SEG_E, 1024};
              pg8::gemm_phase<pg8::EpiBf16Two, pg8::XprodOrder, true, true>(F.lds + RING_OFF, g, S, E, F.wave); }
        }
        SEAM(pb + 6);
        if (IN(pb + 8)) for (int rep_ = 0; rep_ < NREP(8); ++rep_) { PHP();
            pg8::Gemm g{BIGp + 8 * SEG_E, (const bf16*)(ws + WS_YRAW), LD2K, DM_, DM_}; pg8::XsOrder S{G_, bx, LD2K};
            pg8::EpiSoftmax E{BIGp + 2 * SEG_E, 1024, 0.044194173824159216f * LOG2E, (const float*)(ws + WS_RSS) + (size_t)(1 + 3 * l) * RSS_STRIDE};
            pg8::gemm_phase<pg8::EpiSoftmax, pg8::XsOrder, false, true>(F.lds + RING_OFF, g, S, E, F.wave);
        }
        SEAM(pb + 8);
        if (IN(pb + 12))
#pragma unroll
        for (int rep_ = 0; rep_ < NREP(12); ++rep_) { PHP();
            pg8::Gemm g{BIGp + 2 * SEG_E, (const bf16*)(ws + WS_YRAW) + SEG_E, 1024, 1024, 1024}; pg8::XoOrder S{G_, bx};
            pg8::EpiRes E{BIGp + 8 * SEG_E, rep_ ? BIGp + 11 * SEG_E : XN, LD2K, (float*)(ws + WS_RSS) + (size_t)(rep_ ? 6 : 2 + 3 * l) * RSS_STRIDE};
            pg8::gemm_phase<pg8::EpiRes, pg8::XoOrder, true, true>(F.lds + RING_OFF, g, S, E, F.wave);
        }
        SEAM(pb + 12);
        if (IN(pb + 14)) for (int rep_ = 0; rep_ < NREP(14); ++rep_) { PHP();
            pg8::Gemm g{XN, (const bf16*)(ws + W_13), LD2K, LD2K, DM_}; pg8::StaticOrder S; S.init(M, 2 * FFH, G_, bx, LD2K, LD2K);
            pg8::EpiSwiGLU E{BIGp, FFH, (const float*)(ws + WS_RSS) + (size_t)(2 + 3 * l) * RSS_STRIDE};
            pg8::gemm_phase<pg8::EpiSwiGLU, pg8::StaticOrder, true, true>(F.lds + RING_OFF, g, S, E, F.wave);
        }
        SEAM(pb + 14);
        if (IN(pb + 15))
#pragma unroll
        for (int rep_ = 0; rep_ < NREP(15); ++rep_) { PHP();
            pg8::Gemm g{BIGp, (const bf16*)(ws + W_2), FFH, LDFF, FFH}; pg8::StaticOrder S; S.init(M, DM_, G_, bx, FFH, LDFF);
            pg8::EpiRes E{XN, rep_ ? BIGp + 11 * SEG_E : XN, LD2K, (float*)(ws + WS_RSS) + (size_t)(rep_ ? 6 : 3 + 3 * l) * RSS_STRIDE};
            pg8::gemm_phase<pg8::EpiRes, pg8::StaticOrder, true, true>(F.lds + RING_OFF, g, S, E, F.wave);
        }
        SEAM(pb + 15);
    }
    if (IN(NPH)) { PH_ENTER(); const bf16* XB = (const bf16*)(ws + WS_XN); const float* rp = (const float*)(ws + WS_RSS) + (size_t)(3 * DEPTH) * RSS_STRIDE; const int gw = vcu_ * NWAVES + wave, NGW = G_ * NWAVES;
        for (int m = gw; m < M; m += NGW) {
            float sv = lane < 32 ? rp[((size_t)(lane >> 2) * M + (size_t)m) * 4 + (lane & 3)] : 0.f; sv = wave_sum(sv); const float r = 1.0f / sqrtf(sv * (1.f / 2048.f) + EPSN);
            const GAS v4u* xr = (const GAS v4u*)(XB + (size_t)m * LD2K) + lane; const GAS f32x4* gr = (const GAS f32x4*)args.in[21] + 2 * lane; GAS f32x4* orow = (GAS f32x4*)(args.out + (size_t)m * DM_) + 2 * lane;
#pragma unroll
            for (int j = 0; j < 4; ++j) { const v4u x = xr[64 * j]; const f32x4 g0 = gr[128 * j], g1 = gr[128 * j + 1];
                orow[128 * j] = (f32x4){bflo(x.x) * r * g0.x, bfhi(x.x) * r * g0.y, bflo(x.y) * r * g0.z, bfhi(x.y) * r * g0.w};
                orow[128 * j + 1] = (f32x4){bflo(x.z) * r * g1.x, bfhi(x.z) * r * g1.y, bflo(x.w) * r * g1.z, bfhi(x.w) * r * g1.w}; } } }
#undef IN
#undef SEAM
}

extern "C" void kernel_launch(void* const* d_in, const int* in_sizes, int n_in, void* d_out, int out_size, void* d_ws, size_t ws_size, hipStream_t stream) {
    static int grid = 0; static bool first = true;
    if (grid == 0) {
        if (n_in != 22 || in_sizes[0] != M * DM_ || out_size != M * DM_ || ws_size < WS_END) { fprintf(stderr, "kernel_launch: unexpected shapes / workspace (n_in %d, in0 %d, out %d, ws %zu, need %zu); nothing launched\n", n_in, n_in > 0 ? in_sizes[0] : -1, out_size, ws_size, (size_t)WS_END); grid = -1; return; }
        int dev = 0, cus = 0, per_cu = 0;
        if (hipGetDevice(&dev) != hipSuccess || hipDeviceGetAttribute(&cus, hipDeviceAttributeMultiprocessorCount, dev) != hipSuccess) { grid = -1; return; }
        if (hipFuncSetAttribute((const void*)mk_fwd<MK_MULTI ? NPH : 0, NPH + 1>, hipFuncAttributeMaxDynamicSharedMemorySize, LDS_BYTES) != hipSuccess) { fprintf(stderr, "kernel_launch: hipFuncSetAttribute failed\n"); grid = -1; return; }
        if (hipOccupancyMaxActiveBlocksPerMultiprocessor(&per_cu, (const void*)mk_fwd<MK_MULTI ? NPH : 0, NPH + 1>, NWAVES * 64, LDS_BYTES) != hipSuccess || per_cu < 1) fprintf(stderr, "kernel_launch: occupancy query reports %d\n", per_cu);
        (void)hipGetLastError();
        grid = cus;
    }
    if (grid < 0) return;
    if (hipMemsetAsync((char*)d_ws + WS_CTL, 0, CTL_ZERO_BYTES, stream) != hipSuccess) return;
    Args a{};
    for (int i = 0; i < 22; ++i) a.in[i] = (const float*)d_in[i];
    a.out = (float*)d_out; a.ws = (unsigned char*)d_ws;
#if MK_MULTI
#define LAUNCH_K(K) do { if (first) (void)hipFuncSetAttribute((const void*)mk_fwd<K, K + 1>, hipFuncAttributeMaxDynamicSharedMemorySize, LDS_BYTES); hipLaunchKernelGGL((mk_fwd<K, K + 1>), dim3(grid), dim3(NWAVES * 64), LDS_BYTES, stream, a); } while (0)
    for (int l = 0; l < DEPTH; ++l) { a.l_lo = l; a.l_hi = l + 1;
        LAUNCH_K(0); LAUNCH_K(1); LAUNCH_K(2); LAUNCH_K(3); LAUNCH_K(4); LAUNCH_K(5); LAUNCH_K(6); LAUNCH_K(7); LAUNCH_K(8); LAUNCH_K(9); LAUNCH_K(10); LAUNCH_K(11); LAUNCH_K(12); LAUNCH_K(13); LAUNCH_K(14); LAUNCH_K(15); }
    a.l_lo = DEPTH; a.l_hi = DEPTH; LAUNCH_K(16);
    first = false;
#else
    a.l_lo = 0; a.l_hi = DEPTH;
    hipLaunchKernelGGL((mk_fwd<MK_MULTI ? NPH : 0, NPH + 1>), dim3(grid), dim3(NWAVES * 64), LDS_BYTES, stream, a);
#endif
}
```

```cpp
#include <hip/hip_runtime.h>
#include <hip/hip_bf16.h>
#include <cstdio>
#include <cstdint>
#include <cmath>
namespace pg8 {
#define PG8_LAS __attribute__((address_space(3)))
typedef unsigned short bf16_t;
typedef short bf16x8 __attribute__((ext_vector_type(8)));
typedef float f32x4 __attribute__((ext_vector_type(4)));
typedef float f32x2 __attribute__((ext_vector_type(2)));
typedef unsigned u32x4 __attribute__((ext_vector_type(4)));
typedef unsigned u32x2 __attribute__((ext_vector_type(2)));
constexpr int BM = 256, BK = 64, HALF = 128, HTB = HALF * BK * 2  , STAGE_BYTES = 8 * HTB, NXCD = 8, WGM = 8;

__host__ __device__ __forceinline__ int lds_byte(int r, int c) { const int st = (r >> 4) * 2 + (c >> 5), rr = r & 15, cc = c & 31, ob = rr * 64 + cc * 2; return st * 1024 + (ob ^ (((ob >> 9) & 1) << 5)); }
__host__ __device__ __forceinline__ void stage_rc(int b, int& R, int& C) { const int st = b / 1024, sb = b % 1024, swz = sb ^ (((sb >> 9) & 1) << 5); R = (st >> 1) * 16 + swz / 64; C = (st & 1) * 32 + (swz % 64) / 2; }
__host__ __device__ __forceinline__ int perm32(int rho) { const int n = rho >> 4, i = rho & 15; return 8 * (i >> 2) + 4 * n + (i & 3); }

template <class T> __device__ __forceinline__ T* uni_ptr(T* p) { const unsigned long long v = (unsigned long long)p; unsigned lo = (unsigned)v, hi = (unsigned)(v >> 32);
    asm volatile("" : "+s"(lo), "+s"(hi)); return (T*)(((unsigned long long)hi << 32) | lo); }
__device__ __forceinline__ int lane_id() { int l; asm volatile("v_mbcnt_lo_u32_b32 %0, -1, 0\n\tv_mbcnt_hi_u32_b32 %0, -1, %0" : "=v"(l)); return l; }
__device__ __forceinline__ int opq(int x) { asm volatile("" : "+s"(x)); return x; }
template <int M> __device__ __forceinline__ float xadd(float v) {
    if constexpr (M == 32) { const auto rr = __builtin_amdgcn_permlane32_swap(__float_as_uint(v), __float_as_uint(v), false, false); return __uint_as_float(rr[0]) + __uint_as_float(rr[1]); }
    else return v + __int_as_float(__builtin_amdgcn_ds_swizzle(__float_as_int(v), (M << 10) | 0x1f));
}
__device__ __forceinline__ float row_sum16(float v) {
#define PG8_DPPADD(ctrl) v += __int_as_float(__builtin_amdgcn_update_dpp(0, __float_as_int(v), ctrl, 0xf, 0xf, true))
    PG8_DPPADD(0xB1); PG8_DPPADD(0x4E); PG8_DPPADD(0x141); PG8_DPPADD(0x140); return v;
#undef PG8_DPPADD
}
struct Unit { int pm, pn; unsigned offA, offB; int sub = 0; };
struct Gemm { const bf16_t* A; const bf16_t* Bt; int lda, ldb, K; };

struct StaticOrder {
    int nM, nN, nwg, G, c; unsigned tA, tB;
    __device__ void init(int M, int N, int G_, int c_, int lda, int ldb) { nM = M / BM; nN = N / BM; nwg = nM * nN; G = G_; c = c_; tA = (unsigned)BM * lda * 2u; tB = (unsigned)BM * ldb * 2u; }
    __device__ __forceinline__ bool next(int i, Unit& u) const {
        const long L = (long)i * G + c; if (L >= nwg) return false;
        int wgid = (int)L; { const int q = nwg / NXCD, r = nwg % NXCD, xcd = wgid % NXCD, off = wgid / NXCD; wgid = (xcd < r ? xcd * (q + 1) : r * (q + 1) + (xcd - r) * q) + off; }
        const int nig = WGM * nN, gid = wgid / nig, fm = gid * WGM, gsz = (nM - fm) < WGM ? (nM - fm) : WGM;
        u.pm = fm + ((wgid % nig) % gsz); u.pn = (wgid % nig) / gsz; u.offA = (unsigned)u.pm * tA; u.offB = (unsigned)u.pn * tB; return true;
    }
    __device__ __forceinline__ void a_ready(const Unit&) const {}
    __device__ __forceinline__ void done(const Unit&) const {}
};
struct XprodOrder {
    int G, c; unsigned ld, oK, oV, oWq, oWo;
    __device__ __forceinline__ bool next(int i, Unit& u) const {
        const int L = i * G + c; if (L >= 512) return false;
        const int q = L & 255, b = q >> 5, h = (q >> 3) & 3, t = q & 7;
        if (L < 256) { u.sub = 0; u.pm = b * 4 + h; u.pn = t; u.offA = oK + ((unsigned)(b * 256) * ld + h * 512) * 2u; u.offB = oWq + ((unsigned)(t * 256) * ld + h * 512) * 2u; }
        else         { u.sub = 1; u.pm = b * 8 + t; u.pn = h; u.offA = oWo + ((unsigned)(t * 256) * ld + h * 512) * 2u; u.offB = oV + ((unsigned)(b * 256) * ld + h * 512) * 2u; }
        return true;
    }
    __device__ __forceinline__ void a_ready(const Unit&) const {}
    __device__ __forceinline__ void done(const Unit&) const {}
};
struct XsOrder {
    int G, c, lda;
    __device__ __forceinline__ bool next(int i, Unit& u) const {
        const int L = i * G + c; if (L >= 256) return false;
        const int b = L >> 5, rt = (L >> 2) & 7, h = L & 3;
        u.pm = b * 8 + rt; u.pn = h; u.offA = ((unsigned)(b * 2048 + rt * 256) * (unsigned)lda) * 2u; u.offB = ((unsigned)(b * 1024 + h * 256) * 2048u) * 2u; return true;
    }
    __device__ __forceinline__ void a_ready(const Unit&) const {}
    __device__ __forceinline__ void done(const Unit&) const {}
};
struct XoOrder {
    int G, c;
    __device__ __forceinline__ bool next(int i, Unit& u) const {
        const int L = i * G + c; if (L >= 512) return false;
        const int b = L >> 6, rt = (L >> 3) & 7, ct = L & 7;
        u.pm = b * 8 + rt; u.pn = ct; u.offA = ((unsigned)(b * 2048 + rt * 256) * 1024u) * 2u; u.offB = ((unsigned)(b * 2048 + ct * 256) * 1024u) * 2u; return true;
    }
    __device__ __forceinline__ void a_ready(const Unit&) const {}
    __device__ __forceinline__ void done(const Unit&) const {}
};

__device__ __forceinline__ unsigned cvt_pk_bf16(float lo, float hi) { unsigned r; asm volatile("v_cvt_pk_bf16_f32 %0, %1, %2" : "=v"(r) : "v"(lo), "v"(hi)); return r; }
__device__ __forceinline__ float bf_lo(unsigned w) { return __uint_as_float(w << 16); }
__device__ __forceinline__ float bf_hi(unsigned w) { return __uint_as_float(w & 0xffff0000u); }
__device__ __forceinline__ float sigmoidf_(float x) { return __builtin_amdgcn_rcpf(1.0f + __builtin_amdgcn_exp2f(-1.4426950408889634f * x)); }

__device__ __forceinline__ void row_rs8(float (&rs)[2][4], const float* rssp, int row0, int fq) {
    f32x4 a[2][4], b[2][4];
#pragma unroll
    for (int ai = 0; ai < 2; ++ai)
#pragma unroll
        for (int m = 0; m < 4; ++m) { const float* p = rssp + ((size_t)(2 * fq) * 16384 + (size_t)(row0 + ai * HALF + m * 16)) * 4; a[ai][m] = *(const f32x4*)p; b[ai][m] = *(const f32x4*)(p + (size_t)16384 * 4); }
#pragma unroll
    for (int ai = 0; ai < 2; ++ai)
#pragma unroll
        for (int m = 0; m < 4; ++m) { float s = ((a[ai][m][0] + a[ai][m][1]) + (a[ai][m][2] + a[ai][m][3])) + ((b[ai][m][0] + b[ai][m][1]) + (b[ai][m][2] + b[ai][m][3]));
            s = pg8::xadd<16>(s); s = pg8::xadd<32>(s); rs[ai][m] = __builtin_amdgcn_rsqf(s * (1.0f / 2048.0f) + 1e-6f); }
}
struct EpiBf16 {
    static constexpr bool PERM = true, AFTER_DRAIN = false, MULTI = false;
    bf16_t* O; int ldc; int split_cols; size_t split_stride; float scale; const float* rss;
    __device__ __forceinline__ void operator()(const f32x4 (&acc)[2][2][4][2], const Unit& u, int wr, int wc, int fr, int fq) const {
        const int row0 = u.pm * BM + wr * 64 + fr; int colt = u.pn * BM; bf16_t* base = O;
        if (split_cols) { const int t = colt / split_cols; base += (size_t)t * split_stride; colt -= t * split_cols; }
        const int col0 = colt + wc * 32 + 8 * fq; const float sc = scale;
        float rs[2][4];
        if (rss) row_rs8(rs, rss, row0, fq);
#pragma unroll
        for (int ai = 0; ai < 2; ++ai)
#pragma unroll
            for (int m = 0; m < 4; ++m) { bf16_t* rowp = base + (size_t)(row0 + ai * HALF + m * 16) * ldc + col0;
                const float sr = rss ? sc * rs[ai][m] : sc;
#pragma unroll
                for (int bj = 0; bj < 2; ++bj) { const f32x4 v0 = acc[ai][bj][m][0] * sr, v1 = acc[ai][bj][m][1] * sr;
                    u32x4 w; w.x = cvt_pk_bf16(v0[0], v0[1]); w.y = cvt_pk_bf16(v0[2], v0[3]); w.z = cvt_pk_bf16(v1[0], v1[1]); w.w = cvt_pk_bf16(v1[2], v1[3]);
                    *(u32x4*)(rowp + bj * HALF) = w; } }
    }
};
struct EpiBf16Two {
    static constexpr bool PERM = true, AFTER_DRAIN = false, MULTI = false;
    bf16_t* O0; int ld0; bf16_t* O1; int ld1;
    __device__ __forceinline__ void operator()(const f32x4 (&acc)[2][2][4][2], const Unit& u, int wr, int wc, int fr, int fq) const {
        bf16_t* base = u.sub ? O1 : O0; const int ldc = u.sub ? ld1 : ld0;
        const int row0 = u.pm * BM + wr * 64 + fr, col0 = u.pn * BM + wc * 32 + 8 * fq;
#pragma unroll
        for (int ai = 0; ai < 2; ++ai)
#pragma unroll
            for (int m = 0; m < 4; ++m) { bf16_t* rowp = base + (size_t)(row0 + ai * HALF + m * 16) * ldc + col0;
#pragma unroll
                for (int bj = 0; bj < 2; ++bj) { const f32x4 v0 = acc[ai][bj][m][0], v1 = acc[ai][bj][m][1];
                    u32x4 w; w.x = cvt_pk_bf16(v0[0], v0[1]); w.y = cvt_pk_bf16(v0[2], v0[3]); w.z = cvt_pk_bf16(v1[0], v1[1]); w.w = cvt_pk_bf16(v1[2], v1[3]);
                    *(u32x4*)(rowp + bj * HALF) = w; } }
    }
};
struct EpiInProj {
    static constexpr bool PERM = true, AFTER_DRAIN = false, MULTI = false;
    bf16_t* BIG; const float* dcs; const float* rcs; const float* rss;
    __device__ __forceinline__ void operator()(const f32x4 (&acc)[2][2][4][2], const Unit& u, int wr, int wc, int fr, int fq) const {
        const int pn = u.pn; const int row0 = u.pm * BM + wr * 64 + fr; const size_t SEGE = (size_t)16384 * 1024;
        const int cw = wc * 32 + 8 * fq;
        float rs[2][4]; row_rs8(rs, rss, row0, fq);
        if (pn < 8 || (pn >= 20 && pn < 28)) {
            const bool isd = pn < 8; const int seg = isd ? (pn >> 2) : 5 + ((pn - 20) >> 2);
            const float sc = pn < 4 ? 0.125f * 1.4426950408889634f : (pn >= 20 && pn < 24) ? 0.08838834764831845f : 1.0f;
            const int i0 = isd ? ((cw & 63) >> 1) : ((cw & 127) >> 1);
            bf16_t* base = BIG + (size_t)seg * SEGE + (pn & 3) * BM + cw;
#pragma unroll
            for (int ai = 0; ai < 2; ++ai)
#pragma unroll
              for (int mp = 0; mp < 2; ++mp) {
                f32x4 ta[2], tb4[2];
#pragma unroll
                for (int mm = 0; mm < 2; ++mm) { const int t = (row0 + ai * HALF + (2 * mp + mm) * 16) & 2047;
                    const float* tb = isd ? dcs + ((size_t)t * 32 + i0) * 2 : rcs + ((size_t)t * 64 + i0) * 2; ta[mm] = *(const f32x4*)tb; tb4[mm] = *(const f32x4*)(tb + 4); }
#pragma unroll
                for (int mm = 0; mm < 2; ++mm) { const int m = 2 * mp + mm; const int row = row0 + ai * HALF + m * 16; const float sr = sc * rs[ai][m]; const f32x4 t0 = ta[mm], t1 = tb4[mm];
#pragma unroll
                    for (int bj = 0; bj < 2; ++bj) { const f32x4 v0 = acc[ai][bj][m][0], v1 = acc[ai][bj][m][1];
                        const float y0 = (v0[0] * t0[0] - v0[1] * t0[1]) * sr, y1 = (v0[1] * t0[0] + v0[0] * t0[1]) * sr, y2 = (v0[2] * t0[2] - v0[3] * t0[3]) * sr, y3 = (v0[3] * t0[2] + v0[2] * t0[3]) * sr;
                        const float y4 = (v1[0] * t1[0] - v1[1] * t1[1]) * sr, y5 = (v1[1] * t1[0] + v1[0] * t1[1]) * sr, y6 = (v1[2] * t1[2] - v1[3] * t1[3]) * sr, y7 = (v1[3] * t1[2] + v1[2] * t1[3]) * sr;
                        u32x4 w; w.x = cvt_pk_bf16(y0, y1); w.y = cvt_pk_bf16(y2, y3); w.z = cvt_pk_bf16(y4, y5); w.w = cvt_pk_bf16(y6, y7);
                        *(u32x4*)(base + (size_t)row * 1024 + bj * HALF) = w; } }
                asm volatile("" ::: "memory"); }
        } else if (pn >= 12 && pn < 20) {
            bf16_t* base = BIG + 3 * SEGE + (pn - 12) * (BM / 2) + (cw >> 1);
#pragma unroll
            for (int ai = 0; ai < 2; ++ai)
#pragma unroll
                for (int m = 0; m < 4; ++m) { bf16_t* rowp = base + (size_t)(row0 + ai * HALF + m * 16) * 1024; const float sr = rs[ai][m];
#pragma unroll
                    for (int bj = 0; bj < 2; ++bj) { const f32x4 v0 = acc[ai][bj][m][0] * sr, v1 = acc[ai][bj][m][1] * sr;
                        u32x2 w; w.x = cvt_pk_bf16(v0[0] * sigmoidf_(v0[1]), v0[2] * sigmoidf_(v0[3])); w.y = cvt_pk_bf16(v1[0] * sigmoidf_(v1[1]), v1[2] * sigmoidf_(v1[3]));
                        *(u32x2*)(rowp + bj * (HALF / 2)) = w; } }
        } else if (pn >= 36) {
            unsigned char* base8 = (unsigned char*)(BIG + (size_t)(pn >> 2) * SEGE) + (pn & 3) * BM + cw;
#pragma unroll
            for (int ai = 0; ai < 2; ++ai)
#pragma unroll
                for (int m = 0; m < 4; ++m) { unsigned char* rowp = base8 + (size_t)(row0 + ai * HALF + m * 16) * 1024; const float sr = rs[ai][m];
#pragma unroll
                    for (int bj = 0; bj < 2; ++bj) { const f32x4 v0 = acc[ai][bj][m][0] * sr, v1 = acc[ai][bj][m][1] * sr; unsigned q[8];
#pragma unroll
                        for (int e = 0; e < 4; ++e) { q[e] = (unsigned)(__builtin_fmaxf(255.0f * sigmoidf_(v0[e]), 1.0f) + 0.5f); q[4 + e] = (unsigned)(__builtin_fmaxf(255.0f * sigmoidf_(v1[e]), 1.0f) + 0.5f); }
                        u32x2 w; w.x = q[0] | (q[1] << 8) | (q[2] << 16) | (q[3] << 24); w.y = q[4] | (q[5] << 8) | (q[6] << 16) | (q[7] << 24);
                        *(u32x2*)(rowp + bj * HALF) = w; } }
        } else {
            bf16_t* base = BIG + (size_t)(pn >> 2) * SEGE + (pn & 3) * BM + cw; const bool sg = false;
#pragma unroll
            for (int ai = 0; ai < 2; ++ai)
#pragma unroll
                for (int m = 0; m < 4; ++m) { bf16_t* rowp = base + (size_t)(row0 + ai * HALF + m * 16) * 1024; const float sr = rs[ai][m];
#pragma unroll
                    for (int bj = 0; bj < 2; ++bj) { f32x4 v0 = acc[ai][bj][m][0] * sr, v1 = acc[ai][bj][m][1] * sr;
                        if (sg) { v0[0] = sigmoidf_(v0[0]); v0[1] = sigmoidf_(v0[1]); v0[2] = sigmoidf_(v0[2]); v0[3] = sigmoidf_(v0[3]); v1[0] = sigmoidf_(v1[0]); v1[1] = sigmoidf_(v1[1]); v1[2] = sigmoidf_(v1[2]); v1[3] = sigmoidf_(v1[3]); }
                        u32x4 w; w.x = cvt_pk_bf16(v0[0], v0[1]); w.y = cvt_pk_bf16(v0[2], v0[3]); w.z = cvt_pk_bf16(v1[0], v1[1]); w.w = cvt_pk_bf16(v1[2], v1[3]);
                        *(u32x4*)(rowp + bj * HALF) = w; } }
        }
    }
};
struct EpiSoftmax {
    static constexpr bool PERM = true, AFTER_DRAIN = true, MULTI = false;
    bf16_t* P; int ldp; float sc; const float* rss;
    __device__ __forceinline__ void fused(f32x4 (&acc)[2][2][4][2], const Unit& u, int wr, int wc, int fr, int fq, PG8_LAS unsigned char* lds, int wid, int lane) const {
        PG8_LAS float* Ps = (PG8_LAS float*)lds;
        const int row0 = u.pm * BM + wr * 64 + fr;
        float rs[2][4]; row_rs8(rs, rss, row0, fq);
#pragma unroll
        for (int ai = 0; ai < 2; ++ai)
#pragma unroll
            for (int m = 0; m < 4; ++m) { const float k = sc * rs[ai][m]; float t = 0.f;
#pragma unroll
                for (int bj = 0; bj < 2; ++bj)
#pragma unroll
                    for (int n = 0; n < 2; ++n) { f32x4 e = acc[ai][bj][m][n] * k; e[0] = __builtin_amdgcn_exp2f(e[0]); e[1] = __builtin_amdgcn_exp2f(e[1]); e[2] = __builtin_amdgcn_exp2f(e[2]); e[3] = __builtin_amdgcn_exp2f(e[3]);
                        acc[ai][bj][m][n] = e; t += (e[0] + e[1]) + (e[2] + e[3]); }
                t = pg8::xadd<16>(t); t = pg8::xadd<32>(t);
                if (fq == 0) Ps[(ai * HALF + wr * 64 + m * 16 + fr) * 4 + wc] = t; }
        asm volatile("s_waitcnt lgkmcnt(0)" ::: "memory"); __builtin_amdgcn_s_barrier(); asm volatile("" ::: "memory");
#pragma unroll
        for (int ai = 0; ai < 2; ++ai)
#pragma unroll
            for (int m = 0; m < 4; ++m) { const f32x4 q = *(const PG8_LAS f32x4*)(Ps + (ai * HALF + wr * 64 + m * 16 + fr) * 4); const float inv = 1.0f / ((q[0] + q[1]) + (q[2] + q[3]));
                bf16_t* rowp = P + (size_t)(row0 + ai * HALF + m * 16) * ldp + u.pn * BM + wc * 32 + 8 * fq;
#pragma unroll
                for (int bj = 0; bj < 2; ++bj) { const f32x4 v0 = acc[ai][bj][m][0] * inv, v1 = acc[ai][bj][m][1] * inv;
                    u32x4 w; w.x = cvt_pk_bf16(v0[0], v0[1]); w.y = cvt_pk_bf16(v0[2], v0[3]); w.z = cvt_pk_bf16(v1[0], v1[1]); w.w = cvt_pk_bf16(v1[2], v1[3]);
                    *(u32x4*)(rowp + bj * HALF) = w; } }
        asm volatile("s_waitcnt lgkmcnt(0)" ::: "memory"); __builtin_amdgcn_s_barrier(); asm volatile("" ::: "memory");
    }
};
struct EpiRes {
    static constexpr bool PERM = true, AFTER_DRAIN = false, MULTI = false;
    const bf16_t* xo; bf16_t* xb; int ldx; float* rssp;
    __device__ __forceinline__ void operator()(const f32x4 (&acc)[2][2][4][2], const Unit& u, int wr, int wc, int fr, int fq) const {
        const int col0 = u.pn * BM + wc * 32 + 8 * fq;
#pragma unroll
        for (int ai = 0; ai < 2; ++ai) {
            u32x4 ro[4][2];
#pragma unroll
            for (int m = 0; m < 4; ++m)
#pragma unroll
                for (int bj = 0; bj < 2; ++bj) ro[m][bj] = *(const u32x4*)(xo + (size_t)(u.pm * BM + ai * HALF + wr * 64 + m * 16 + fr) * ldx + col0 + bj * HALF);
#pragma unroll
            for (int m = 0; m < 4; ++m) { const int row = u.pm * BM + ai * HALF + wr * 64 + m * 16 + fr; float ss = 0.f;
#pragma unroll
                for (int bj = 0; bj < 2; ++bj) { const u32x4 o = ro[m][bj];
                    f32x4 v0 = acc[ai][bj][m][0], v1 = acc[ai][bj][m][1];
                    v0[0] += bf_lo(o.x); v0[1] += bf_hi(o.x); v0[2] += bf_lo(o.y); v0[3] += bf_hi(o.y); v1[0] += bf_lo(o.z); v1[1] += bf_hi(o.z); v1[2] += bf_lo(o.w); v1[3] += bf_hi(o.w);
                    ss += ((v0[0] * v0[0] + v0[1] * v0[1]) + (v0[2] * v0[2] + v0[3] * v0[3])) + ((v1[0] * v1[0] + v1[1] * v1[1]) + (v1[2] * v1[2] + v1[3] * v1[3]));
                    u32x4 w; w.x = cvt_pk_bf16(v0[0], v0[1]); w.y = cvt_pk_bf16(v0[2], v0[3]); w.z = cvt_pk_bf16(v1[0], v1[1]); w.w = cvt_pk_bf16(v1[2], v1[3]);
                    *(u32x4*)(xb + (size_t)row * ldx + col0 + bj * HALF) = w; }
                ss = pg8::xadd<16>(ss); ss = pg8::xadd<32>(ss);
                if (fq == 0) rssp[((size_t)u.pn * 16384 + (size_t)row) * 4 + wc] = ss; }
            asm volatile("" ::: "memory"); }
    }
};
struct EpiMerge {
    static constexpr bool PERM = true, AFTER_DRAIN = false, MULTI = true;
    const bf16_t* gates; bf16_t* merged;
    __device__ __forceinline__ void step(f32x4 (&acc)[2][2][4][2], const Unit& u, int wr, int wc, int fr, int fq) const {
        const size_t SEGE = (size_t)16384 * 1024; const int sub = u.sub; const bool last = sub == 2;
        const int row0 = u.pm * BM + wr * 64 + fr; const int gcol = (u.pn & 3) * BM + wc * 32 + 8 * fq;
        const unsigned char* ga = (const unsigned char*)(gates + (size_t)(2 * sub + (u.pn >> 2)) * SEGE) + gcol;
        const unsigned char* gb = last ? ga : ga + 4 * SEGE;
#pragma unroll
        for (int ai = 0; ai < 2; ++ai)
#pragma unroll
            for (int m = 0; m < 4; ++m) {
                u32x2 za[2], zb[2];
#pragma unroll
                for (int bj = 0; bj < 2; ++bj) { const size_t p = (size_t)(row0 + ai * HALF + m * 16) * 1024 + bj * HALF; za[bj] = *(const u32x2*)(ga + p); zb[bj] = *(const u32x2*)(gb + p); }
#pragma unroll
                for (int bj = 0; bj < 2; ++bj) { const unsigned aw[2] = {za[bj].x, za[bj].y}; unsigned bw[2] = {zb[bj].x, zb[bj].y};
                    float f[8];
#pragma unroll
                    for (int j = 0; j < 2; ++j) { if (last) bw[j] = 0xffffffffu;
#pragma unroll
                        for (int e = 0; e < 4; ++e) f[4 * j + e] = (float)((aw[j] >> (8 * e)) & 0xffu) * __builtin_amdgcn_rcpf((float)((bw[j] >> (8 * e)) & 0xffu)); }
                    f32x4 v0 = acc[ai][bj][m][0], v1 = acc[ai][bj][m][1];
                    v0[0] *= f[0]; v0[1] *= f[1]; v0[2] *= f[2]; v0[3] *= f[3]; v1[0] *= f[4]; v1[1] *= f[5]; v1[2] *= f[6]; v1[3] *= f[7];
                    acc[ai][bj][m][0] = v0; acc[ai][bj][m][1] = v1;
                    if (last) { u32x4 w; w.x = cvt_pk_bf16(v0[0], v0[1]); w.y = cvt_pk_bf16(v0[2], v0[3]); w.z = cvt_pk_bf16(v1[0], v1[1]); w.w = cvt_pk_bf16(v1[2], v1[3]);
                        *(u32x4*)(merged + (size_t)(row0 + ai * HALF + m * 16) * 2048 + u.pn * BM + wc * 32 + 8 * fq + bj * HALF) = w; } }
                if (m & 1) asm volatile("" ::: "memory"); }
    }
};
struct MergeOrder {
    StaticOrder T; unsigned ystride, wstride;
    __device__ __forceinline__ bool next(int i, Unit& u) const {
        const int ti = i / 3, sub = i - 3 * ti;
        if (!T.next(ti, u)) return false;
        u.sub = sub; u.offA += (unsigned)sub * ystride; u.offB += (unsigned)sub * wstride; return true;
    }
    __device__ __forceinline__ void a_ready(const Unit&) const {}
    __device__ __forceinline__ void done(const Unit&) const {}
};
struct EpiSwiGLU {
    static constexpr bool PERM = true, AFTER_DRAIN = false, MULTI = false;
    bf16_t* O; int ldo; const float* rss;
    __device__ __forceinline__ void operator()(const f32x4 (&acc)[2][2][4][2], const Unit& u, int wr, int wc, int fr, int fq) const {
        const int row0 = u.pm * BM + wr * 64 + fr; const int j0 = (u.pn * BM + wc * 32 + 8 * fq) >> 1;
        float rs[2][4]; row_rs8(rs, rss, row0, fq);
#pragma unroll
        for (int ai = 0; ai < 2; ++ai)
#pragma unroll
            for (int m = 0; m < 4; ++m) { bf16_t* rowp = O + (size_t)(row0 + ai * HALF + m * 16) * ldo + j0; const float sr = rs[ai][m];
#pragma unroll
                for (int bj = 0; bj < 2; ++bj) { const f32x4 v0 = acc[ai][bj][m][0] * sr, v1 = acc[ai][bj][m][1] * sr;
                    const float o0 = v0[0] * sigmoidf_(v0[0]) * v0[1], o1 = v0[2] * sigmoidf_(v0[2]) * v0[3], o2 = v1[0] * sigmoidf_(v1[0]) * v1[1], o3 = v1[2] * sigmoidf_(v1[2]) * v1[3];
                    u32x2 w; w.x = cvt_pk_bf16(o0, o1); w.y = cvt_pk_bf16(o2, o3);
                    *(u32x2*)(rowp + bj * (HALF / 2)) = w; } }
    }
};

template <class Epi, class Sched, bool ALIGN_EPI = false, bool SP2 = false>
__device__ __forceinline__ void gemm_phase(PG8_LAS unsigned char* lds, const Gemm g, const Sched& S, const Epi& E, const int wave_sg) {
    int tid_ = opq(wave_sg) * 64 + lane_id(); asm volatile("" : "+v"(tid_));
    const char* gA = uni_ptr((const char*)g.A); const char* gB = uni_ptr((const char*)g.Bt);
    const int tid = tid_, wid = __builtin_amdgcn_readfirstlane(tid >> 6), lane = tid & 63, wr = wid >> 2, wc = wid & 3, fr = lane & 15, fq = lane >> 4;
    int K_ = g.K; asm volatile("" : "+s"(K_));
    const int K = K_, nt = K / BK;
    unsigned voffA[2], voffB[2];
#pragma unroll
    for (int i = 0; i < 2; ++i) { int R, C; stage_rc(tid * 16 + i * 8192, R, C); const int Rb = Epi::PERM ? ((R & ~31) + perm32(R & 31)) : R;
        voffA[i] = (unsigned)(R * g.lda + C) * 2u; voffB[i] = (unsigned)(Rb * g.ldb + C) * 2u; }
    const size_t kstep = (size_t)(BK * 2);
    const unsigned hsA = (unsigned)HALF * g.lda * 2u, hsB = (unsigned)HALF * g.ldb * 2u;
    const unsigned ldsw = (unsigned)wid * 1024u;
    const int aoff = lds_byte(wr * 64 + fr, fq * 8), boff = lds_byte(wc * 32 + fr, fq * 8);
#define PG8_SA(b, h) (((b) * 2 + (h)) * HTB)
#define PG8_SB(b, h) ((4 + (b) * 2 + (h)) * HTB)
#define PG8_STAGE(bufoff, gbase, voff) do { _Pragma("unroll") for (int _i = 0; _i < 2; ++_i) \
        __builtin_amdgcn_global_load_lds((const unsigned*)((const char*)(gbase) + (voff)[_i]), (PG8_LAS unsigned*)(lds + (bufoff) + ldsw + _i * 8192), 16, 0, 0); } while (0)
#define PG8_LDA(dst, b, h) do { _Pragma("unroll") for (int m = 0; m < 4; ++m) _Pragma("unroll") for (int k = 0; k < 2; ++k) dst[m][k] = *(const PG8_LAS bf16x8*)(lds + PG8_SA(b, h) + aoff + m * 2048 + k * 1024); } while (0)
#define PG8_LDB(dst, b, h) do { _Pragma("unroll") for (int n = 0; n < 2; ++n) _Pragma("unroll") for (int k = 0; k < 2; ++k) dst[n][k] = *(const PG8_LAS bf16x8*)(lds + PG8_SB(b, h) + boff + n * 2048 + k * 1024); } while (0)
#define PG8_MMA(ai, bj, At, Bt) do { __builtin_amdgcn_s_setprio(1); _Pragma("unroll") for (int m = 0; m < 4; ++m) _Pragma("unroll") for (int n = 0; n < 2; ++n) _Pragma("unroll") for (int k = 0; k < 2; ++k) \
        asm volatile("v_mfma_f32_16x16x32_bf16 %0, %1, %2, %0" : "+v"(acc[ai][bj][m][n]) : "v"(Bt[n][k]), "v"(At[m][k])); __builtin_amdgcn_s_setprio(0); } while (0)
#define PG8_WAIT_V(n) asm volatile("s_waitcnt vmcnt(" #n ")" ::: "memory")
#define PG8_PIN_ACC() do { _Pragma("unroll") for (int a_ = 0; a_ < 2; ++a_) _Pragma("unroll") for (int b_ = 0; b_ < 2; ++b_) _Pragma("unroll") for (int m_ = 0; m_ < 4; ++m_) asm volatile("" : "+v"(acc[a_][b_][m_][0]), "+v"(acc[a_][b_][m_][1])); asm volatile("s_nop 7" ::: "memory"); } while (0)
#define PG8_WAIT_L(n) asm volatile("s_waitcnt lgkmcnt(" #n ")" ::: "memory")
#define PG8_BAR __builtin_amdgcn_s_barrier()
#define PG8_SCHED __builtin_amdgcn_sched_barrier(0)
    Unit cur, nxt; int ui = 0;
    if (!S.next(0, cur)) return;
    f32x4 acc[2][2][4][2];
#pragma unroll
    for (int a = 0; a < 2; ++a)
#pragma unroll
        for (int b = 0; b < 2; ++b)
#pragma unroll
            for (int m = 0; m < 4; ++m)
#pragma unroll
                for (int n = 0; n < 2; ++n) acc[a][b][m][n] = (f32x4){0.f, 0.f, 0.f, 0.f};
    PG8_PIN_ACC();
    bf16x8 At[4][2], B0[2][2], B1[2][2];
    const char* cA = gA + cur.offA; const char* cB = gB + cur.offB;
    S.a_ready(cur);
    if constexpr (SP2) {
        PG8_STAGE(PG8_SB(0, 0), cB, voffB); PG8_STAGE(PG8_SB(0, 1), cB + hsB, voffB); PG8_STAGE(PG8_SA(0, 0), cA, voffA); PG8_STAGE(PG8_SA(0, 1), cA + hsA, voffA);
        if (wr == 1) PG8_BAR;
        PG8_WAIT_V(2); PG8_BAR;
        PG8_STAGE(PG8_SB(1, 0), cB + kstep, voffB); PG8_STAGE(PG8_SA(1, 0), cA + kstep, voffA); PG8_STAGE(PG8_SB(1, 1), cB + hsB + kstep, voffB);
        PG8_WAIT_V(6); PG8_BAR;
    } else {
        PG8_STAGE(PG8_SB(0, 0), cB, voffB); PG8_STAGE(PG8_SA(0, 0), cA, voffA); PG8_STAGE(PG8_SB(0, 1), cB + hsB, voffB); PG8_STAGE(PG8_SA(0, 1), cA + hsA, voffA);
        if (wr == 1) PG8_BAR;
        PG8_WAIT_V(4); PG8_BAR;
        PG8_STAGE(PG8_SB(1, 0), cB + kstep, voffB); PG8_STAGE(PG8_SA(1, 0), cA + kstep, voffA); PG8_STAGE(PG8_SB(1, 1), cB + hsB + kstep, voffB);
        PG8_WAIT_V(6); PG8_BAR;
    }
    for (;;) {
        const bool has_next = S.next(ui + 1, nxt);
        const char* nA = has_next ? gA + nxt.offA : cA; const char* nB = has_next ? gB + nxt.offB : cB;
        for (int t = 0; t < nt; t += 2) {
            const bool last = (t == nt - 2);
            const char* a1 = cA + (size_t)(t + 1) * kstep;
            const char* a2 = last ? nA : cA + (size_t)(t + 2) * kstep; const char* b2 = last ? nB : cB + (size_t)(t + 2) * kstep;
            const char* a3 = a2 + kstep; const char* b3 = b2 + kstep;
            if (last && has_next) S.a_ready(nxt);
            if constexpr (SP2) {
            PG8_LDB(B0, 0, 0); PG8_LDB(B1, 0, 1); PG8_SCHED; PG8_LDA(At, 0, 0); PG8_STAGE(PG8_SA(1, 1), a1 + hsA, voffA);
            PG8_WAIT_V(8); PG8_WAIT_L(0); PG8_BAR; PG8_MMA(0, 0, At, B0); PG8_MMA(0, 1, At, B1); PG8_BAR; PG8_SCHED;
            PG8_LDA(At, 0, 1); PG8_STAGE(PG8_SB(0, 0), b2, voffB); PG8_STAGE(PG8_SB(0, 1), b2 + hsB, voffB); PG8_STAGE(PG8_SA(0, 0), a2, voffA);
            PG8_WAIT_V(8); PG8_WAIT_L(0); PG8_BAR; PG8_MMA(1, 0, At, B0); PG8_MMA(1, 1, At, B1); PG8_BAR; PG8_SCHED;
            PG8_LDB(B0, 1, 0); PG8_LDB(B1, 1, 1); PG8_SCHED; PG8_LDA(At, 1, 0); PG8_STAGE(PG8_SA(0, 1), a2 + hsA, voffA);
            PG8_WAIT_V(8); PG8_WAIT_L(0); PG8_BAR; PG8_MMA(0, 0, At, B0); PG8_MMA(0, 1, At, B1); PG8_BAR; PG8_SCHED;
            PG8_LDA(At, 1, 1); PG8_STAGE(PG8_SB(1, 0), b3, voffB); PG8_STAGE(PG8_SB(1, 1), b3 + hsB, voffB); PG8_STAGE(PG8_SA(1, 0), a3, voffA);
            PG8_WAIT_V(8); PG8_WAIT_L(0); PG8_BAR; PG8_MMA(1, 0, At, B0); PG8_MMA(1, 1, At, B1); PG8_BAR; PG8_SCHED;
            } else {
            PG8_LDB(B0, 0, 0); PG8_SCHED; PG8_LDA(At, 0, 0); PG8_STAGE(PG8_SA(1, 1), a1 + hsA, voffA);
            PG8_WAIT_L(8); PG8_BAR; PG8_WAIT_L(0); PG8_MMA(0, 0, At, B0); PG8_BAR; PG8_SCHED;
            PG8_LDB(B1, 0, 1); PG8_STAGE(PG8_SB(0, 0), b2, voffB);
            PG8_BAR; PG8_WAIT_L(0); PG8_MMA(0, 1, At, B1); PG8_BAR;
            PG8_LDA(At, 0, 1); PG8_STAGE(PG8_SA(0, 0), a2, voffA);
            PG8_BAR; PG8_WAIT_L(0); PG8_MMA(1, 0, At, B0); PG8_BAR; PG8_SCHED;
            PG8_STAGE(PG8_SB(0, 1), b2 + hsB, voffB);
            PG8_WAIT_V(6); PG8_BAR; PG8_MMA(1, 1, At, B1); PG8_BAR;
            PG8_LDB(B0, 1, 0); PG8_SCHED; PG8_LDA(At, 1, 0); PG8_STAGE(PG8_SA(0, 1), a2 + hsA, voffA);
            PG8_WAIT_L(8); PG8_BAR; PG8_WAIT_L(0); PG8_MMA(0, 0, At, B0); PG8_BAR; PG8_SCHED;
            PG8_LDB(B1, 1, 1); PG8_STAGE(PG8_SB(1, 0), b3, voffB);
            PG8_BAR; PG8_WAIT_L(0); PG8_MMA(0, 1, At, B1); PG8_BAR;
            PG8_LDA(At, 1, 1); PG8_STAGE(PG8_SA(1, 0), a3, voffA);
            PG8_BAR; PG8_WAIT_L(0); PG8_MMA(1, 0, At, B0); PG8_BAR; PG8_SCHED;
            PG8_STAGE(PG8_SB(1, 1), b3 + hsB, voffB);
            PG8_WAIT_V(6); PG8_BAR; PG8_MMA(1, 1, At, B1); PG8_BAR;
            }
        }
        if constexpr (ALIGN_EPI) { if (wr == 0) PG8_BAR; }
        asm volatile("s_nop 15\n\ts_nop 15" ::: "memory");
        if constexpr (Epi::MULTI) { E.step(acc, cur, wr, wc, fr, fq); S.done(cur); }
        else if constexpr (!Epi::AFTER_DRAIN) { E(acc, cur, wr, wc, fr, fq);
#if defined(EPI_TWICE)
            if constexpr (Epi::PERM) { asm volatile("" ::: "memory"); E(acc, cur, wr, wc, fr, fq); }
#endif
            S.done(cur); }
        if (!has_next) break;
        if (!Epi::MULTI || cur.sub == 2) {
#pragma unroll
        for (int a = 0; a < 2; ++a)
#pragma unroll
            for (int b = 0; b < 2; ++b)
#pragma unroll
                for (int m = 0; m < 4; ++m)
#pragma unroll
                    for (int n = 0; n < 2; ++n) acc[a][b][m][n] = (f32x4){0.f, 0.f, 0.f, 0.f}; }
        PG8_PIN_ACC();
        cur = nxt; cA = nA; cB = nB; ++ui;
        if constexpr (ALIGN_EPI) { if (wr == 1) PG8_BAR; }
    }
    PG8_WAIT_V(0);
    if constexpr (!ALIGN_EPI) { if (wr == 0) PG8_BAR; }
    PG8_BAR;
    if constexpr (Epi::AFTER_DRAIN) { E.fused(acc, cur, wr, wc, fr, fq, lds, wid, lane); S.done(cur); }
#undef PG8_SA
#undef PG8_SB
#undef PG8_STAGE
#undef PG8_LDA
#undef PG8_LDB
#undef PG8_MMA
#undef PG8_WAIT_V
#undef PG8_WAIT_L
#undef PG8_PIN_ACC
#undef PG8_BAR
#undef PG8_SCHED
}
}

#include <hip/hip_bf16.h>
#include <cmath>
namespace attn_body {
using bf16=__hip_bfloat16;
using bf16x8=__attribute__((ext_vector_type(8)))short;
using s16x4=__attribute__((ext_vector_type(4)))short;
using f32x16=__attribute__((ext_vector_type(16)))float;
using u32x4=__attribute__((ext_vector_type(4)))unsigned;
constexpr int BATCH=8,NHEAD=16,SEQ=2048,D=64,DM=NHEAD*D;
constexpr int NW=8,QBLK=32,QB=QBLK*NW,KVBLK=64,NQB=SEQ/QB;
constexpr int ATTN_PITCH=DM, ATTN_UNIT_ROWS=QB;
__device__ __forceinline__ int crow(int r,int hi){return (r&3)+8*(r>>2)+4*hi;}
#define SBAR() __builtin_amdgcn_sched_barrier(0)
__device__ __forceinline__ void cmask(f32x16&p0,f32x16&p1,int jb,int qrel,int hi){
  const float NEG=-INFINITY; int kb=64*jb+4*hi;
  #pragma unroll
  for(int r=0;r<16;++r){int kv=kb+(r&3)+8*(r>>2); if(kv>qrel)p0[r]=NEG; if(kv+32>qrel)p1[r]=NEG;}
}

constexpr int NSLOT=3, SLOTB=8192;
constexpr int LDS_K=0, LDS_V=NSLOT*SLOTB, LDS_WS=2*NSLOT*SLOTB, LDS_OST=LDS_WS+NW*64*4, LDS_BYTES=LDS_OST+NW*4096;
constexpr float C2=0.125f*1.4426950408889634f;
__device__ __forceinline__ void glds16(const void*gsrc,unsigned lds_dst){unsigned keep;
  asm volatile("s_mov_b32 %0, m0\n\ts_mov_b32 m0, %2\n\ts_nop 0\n\tglobal_load_lds_dwordx4 %1, off\n\ts_mov_b32 m0, %0":"=&s"(keep):"v"(gsrc),"s"(lds_dst):"memory");}
__device__ __forceinline__ float max3f(float a,float b,float c){float r;asm("v_max3_f32 %0, %1, %2, %3":"=v"(r):"v"(a),"v"(b),"v"(c));return r;}
__device__ __forceinline__ float max2f(float a,float b){float r;asm("v_max_f32_e32 %0, %1, %2":"=v"(r):"v"(a),"v"(b));return r;}
__device__ __forceinline__ float fadd_s(float a,float b){float r;asm("v_add_f32_e32 %0, %1, %2":"=v"(r):"v"(a),"v"(b));return r;}
__device__ __forceinline__ float fsub_s(float a,float b){float r;asm("v_sub_f32_e32 %0, %1, %2":"=v"(r):"v"(a),"v"(b));return r;}
typedef float f32x2_t __attribute__((ext_vector_type(2))); typedef __bf16 bf16x2_t __attribute__((ext_vector_type(2)));
__device__ __forceinline__ unsigned cvtpk_s(float lo,float hi){f32x2_t v={lo,hi};bf16x2_t b=__builtin_convertvector(v,bf16x2_t);return __builtin_bit_cast(unsigned,b);}
#define WAIT_BAR(N) asm volatile("s_waitcnt vmcnt(" #N ") lgkmcnt(0)\n\ts_barrier":::"memory")

__device__ __forceinline__ void qkt(f32x16&p0,f32x16&p1,const char*Kslot,const bf16x8*qr,const f32x16&negm,int r32,int hi){
  const char*kb=Kslot+hi*1024+r32*16;
  #pragma unroll
  for(int d0=0;d0<4;++d0){
    const bf16x8 b0=*reinterpret_cast<const bf16x8*>(kb+d0*2048);
    const bf16x8 b1=*reinterpret_cast<const bf16x8*>(kb+d0*2048+512);
    if(d0==0){p0=__builtin_amdgcn_mfma_f32_32x32x16_bf16(b0,qr[0],negm,0,0,0);p1=__builtin_amdgcn_mfma_f32_32x32x16_bf16(b1,qr[0],negm,0,0,0);}
    else{p0=__builtin_amdgcn_mfma_f32_32x32x16_bf16(b0,qr[d0],p0,0,0,0);p1=__builtin_amdgcn_mfma_f32_32x32x16_bf16(b1,qr[d0],p1,0,0,0);}}
}
typedef __attribute__((address_space(3))) const char* lds_cptr;
typedef short v4i16_t __attribute__((ext_vector_type(4)));
__device__ __forceinline__ void kload8(bf16x8*kf,lds_cptr kp){
  kf[0]=*(const __attribute__((address_space(3))) bf16x8*)(kp);      kf[1]=*(const __attribute__((address_space(3))) bf16x8*)(kp+512);
  kf[2]=*(const __attribute__((address_space(3))) bf16x8*)(kp+2048); kf[3]=*(const __attribute__((address_space(3))) bf16x8*)(kp+2560);
  kf[4]=*(const __attribute__((address_space(3))) bf16x8*)(kp+4096); kf[5]=*(const __attribute__((address_space(3))) bf16x8*)(kp+4608);
  kf[6]=*(const __attribute__((address_space(3))) bf16x8*)(kp+6144); kf[7]=*(const __attribute__((address_space(3))) bf16x8*)(kp+6656);
}
__device__ __forceinline__ void kload2(bf16x8*kf,lds_cptr kp,int j){ kf[2*j]=*(const __attribute__((address_space(3))) bf16x8*)(kp+j*2048); kf[2*j+1]=*(const __attribute__((address_space(3))) bf16x8*)(kp+j*2048+512); }
__device__ __forceinline__ s16x4 vtr(lds_cptr p){ return __builtin_bit_cast(s16x4,__builtin_amdgcn_ds_read_tr16_b64_v4i16((__attribute__((address_space(3))) v4i16_t*)p)); }
__device__ __forceinline__ float rowmax(const f32x16&p0,const f32x16&p1){
  float a=max3f(p0[0],p0[1],p1[0]),b=max3f(p0[2],p0[3],p1[1]);a=max3f(a,p1[2],p1[3]);
  #pragma unroll
  for(int r=4;r<16;r+=4){a=max3f(a,p0[r],p0[r+1]);b=max3f(b,p0[r+2],p0[r+3]);a=max3f(a,p1[r],p1[r+1]);b=max3f(b,p1[r+2],p1[r+3]);}
  const float m=max2f(a,b);
  auto rr=__builtin_amdgcn_permlane32_swap(__float_as_uint(m),__float_as_uint(m),false,false);
  return max2f(__uint_as_float(rr[0]),__uint_as_float(rr[1]));
}
__device__ __forceinline__ void pv(f32x16*o,int vb,bf16x8 pa0,bf16x8 pa1,bf16x8 pa2,bf16x8 pa3){
  #pragma unroll
  for(int d0=0;d0<2;++d0){s16x4 lo[4],hi[4];
    #pragma unroll
    for(int ks=0;ks<4;++ks){
      asm volatile("ds_read_b64_tr_b16 %0,%1 offset:%c2":"=&v"(lo[ks]):"v"(vb),"i"(d0*4096+ks*1024):"memory");
      asm volatile("ds_read_b64_tr_b16 %0,%1 offset:%c2":"=&v"(hi[ks]):"v"(vb),"i"(d0*4096+ks*1024+512):"memory");}
    asm volatile("s_waitcnt lgkmcnt(0)":::"memory");SBAR();
    #define PK(k) (bf16x8){lo[k][0],lo[k][1],lo[k][2],lo[k][3],hi[k][0],hi[k][1],hi[k][2],hi[k][3]}
    o[d0]=__builtin_amdgcn_mfma_f32_32x32x16_bf16(pa0,PK(0),o[d0],0,0,0);
    o[d0]=__builtin_amdgcn_mfma_f32_32x32x16_bf16(pa1,PK(1),o[d0],0,0,0);
    o[d0]=__builtin_amdgcn_mfma_f32_32x32x16_bf16(pa2,PK(2),o[d0],0,0,0);
    o[d0]=__builtin_amdgcn_mfma_f32_32x32x16_bf16(pa3,PK(3),o[d0],0,0,0);
    #undef PK
  }
}

#ifndef ATTN_STORE16
#define ATTN_STORE16(p,v) (*(u32x4*)(p)=(v))
#endif
template<int THRL> __device__ __forceinline__ void attn_unit(int wave_sg,int b,int h,int hv,int qb,const bf16*Q,const bf16*__restrict__ K,const bf16*__restrict__ V,bf16*O,char*shm){
  int tid_=pg8::opq(wave_sg)*64+pg8::lane_id(); asm volatile("":"+v"(tid_)); const int tid=tid_,lane=tid&63,r32=lane&31,hi=lane>>5; const int wid=__builtin_amdgcn_readfirstlane(tid>>6);
  const long rowbase=(long)b*SEQ; const int q0=qb*QB;
  const bf16*Qw=Q+(rowbase+q0+wid*QBLK)*DM+h*D;
  const bf16*Kh=K+rowbase*DM+h*D,*Vh=V+rowbase*DM+hv*D;
  const unsigned lds0=(unsigned)(uintptr_t)shm;
  float*wsf=(float*)(shm+LDS_WS)+wid*64;
  const bf16*ksrc=Kh+(long)lane*DM+wid*8;
  const bf16*vsrc=Vh+(long)(16*(wid&3)+(lane>>2))*DM+(wid>>2)*32+(lane&3)*8;
  const unsigned kdst=lds0+LDS_K+wid*1024, vdst=lds0+LDS_V+wid*1024;
  #define DMA_K(t,slot) glds16(ksrc+(long)(t)*KVBLK*DM,(unsigned)__builtin_amdgcn_readfirstlane(kdst+(slot)))
  #define DMA_V(t,slot) glds16(vsrc+(long)(t)*KVBLK*DM,(unsigned)__builtin_amdgcn_readfirstlane(vdst+(slot)))
  const int vb0=(int)(lds0+LDS_V)+((lane>>4)&1)*32+(lane&3)*8+(4*hi+((lane&15)>>2))*64;
  const char*Kbase=shm+LDS_K; bf16x8 kf[8];
  const lds_cptr shm3=(lds_cptr)shm; const lds_cptr kp0=shm3+LDS_K+hi*1024+r32*16; const lds_cptr vp0=shm3+LDS_V+((lane>>4)&1)*32+(lane&3)*8+(4*hi+((lane&15)>>2))*64;
  const int NT=(q0+QB)/KVBLK;
  DMA_K(0,0);DMA_V(0,0);DMA_K(1,SLOTB);
  bf16x8 qr[4];
  #pragma unroll
  for(int d0=0;d0<4;++d0)qr[d0]=*reinterpret_cast<const bf16x8*>(&Qw[(long)r32*DM+d0*16+hi*8]);
  float mhat=0.f,l_reg=0.f;f32x16 o[2];o[0]=f32x16{};o[1]=f32x16{};f32x16 negm=f32x16{};asm volatile("":"+v"(negm));
  const int qrel=wid*QBLK+r32;
  #define CMASK(P0,P1,t) do{int jb_=(t)-(NT-4); if(jb_>=0)cmask(P0,P1,jb_,qrel,hi);}while(0)
  bool resc=false;
  #define START(P0,P1) do{ const float rm=rowmax(P0,P1); resc=false; \
    { const float dl=rm; mhat=fadd_s(mhat,dl); \
      _Pragma("unroll") for(int r=0;r<16;++r){P0[r]=fsub_s(P0[r],dl);P1[r]=fsub_s(P1[r],dl);} \
      _Pragma("unroll") for(int r=0;r<16;++r)negm[r]=-mhat; asm volatile("":"+v"(negm)); } \
    _Pragma("unroll") for(int r=0;r<16;++r)P0[r]=__builtin_amdgcn_exp2f(P0[r]); }while(0)
  #define RESC() do{ if(resc){ asm volatile("s_waitcnt lgkmcnt(0)":::"memory"); \
      _Pragma("unroll") for(int d_=0;d_<2;++d_) _Pragma("unroll") for(int r=0;r<16;++r)o[d_][r]*=wsf[crow(r,hi)]; } }while(0)
  f32x16 pA0,pA1,pB0,pB1;
  int sl_prev=0,sl_cur=0,sl_next=SLOTB;
  #define ROT() do{sl_prev=sl_cur;sl_cur=sl_next;sl_next=(sl_next==(NSLOT-1)*SLOTB)?0:sl_next+SLOTB;}while(0)
  DMA_K(2,2*SLOTB);
  WAIT_BAR(3);
  qkt(pA0,pA1,Kbase,qr,negm,r32,hi);asm volatile("s_nop 15\n\ts_nop 7":"+v"(pA0),"+v"(pA1));CMASK(pA0,pA1,0);
  START(pA0,pA1);
  _Pragma("unroll") for(int r=0;r<16;++r)pA1[r]=__builtin_amdgcn_exp2f(pA1[r]);
  WAIT_BAR(0);
  DMA_K(3,0);DMA_V(1,SLOTB);
  ROT();
  kload8(kf,kp0+sl_cur);
  WAIT_BAR(2);
  s16x4 vlo[8],vhi[8]; u32x4 pw0,pw1,pw2,pw3;
  #define PKW(P,B) cvtpk_s(P[B],P[B+1])
  #define PAF(k) __builtin_bit_cast(bf16x8,pw##k)
  #define VFR(i) (bf16x8){vlo[i][0],vlo[i][1],vlo[i][2],vlo[i][3],vhi[i][0],vhi[i][1],vhi[i][2],vhi[i][3]}
  #define PIN(x) asm volatile("":"+v"(x))
  #define MX3(a,b,c) __builtin_fmaxf(__builtin_fmaxf((a),(b)),(c))
  #define GAPA(MF,A0,A1,A2,A3,W0,W1,PW) do{ MF; sacc+=A0; sacc+=A1; sacc+=A2; sacc+=A3; PIN(sacc); W0; W1; PIN(PW); SBAR(); }while(0)
  #define EX(v) __builtin_amdgcn_exp2f(v)
  #define GAPB(MF,X,B) do{ MF; X[B]=EX(X[B]); X[B+1]=EX(X[B+1]); X[B+2]=EX(X[B+2]); X[B+3]=EX(X[B+3]); PIN(X); SBAR(); }while(0)
  #define VRD(i) do{ vlo[i]=vtr(vp_+(((i)>>2)*4096+((i)&3)*1024)); vhi[i]=vtr(vp_+(((i)>>2)*4096+((i)&3)*1024+512)); }while(0)
  #define KRD(G,j) do{ if(G){ kload2(kf,kp0+sl_next,j); SBAR(); } }while(0)
  #define STEP(C0,C1,P0,P1,t,GK,GV,GL) do{ SBAR(); \
    const lds_cptr vp_=vp0+sl_prev; \
    VRD(0); SBAR(); float sacc=(P0[0]+P0[1]); \
    GAPA(C0=__builtin_amdgcn_mfma_f32_32x32x16_bf16(kf[0],qr[0],negm,0,0,0), P0[2],P0[3],P0[4],P0[5],     pw0[0]=PKW(P0,0), pw0[1]=PKW(P0,2), pw0); \
    VRD(4); SBAR(); GAPA(C1=__builtin_amdgcn_mfma_f32_32x32x16_bf16(kf[1],qr[0],negm,0,0,0), P0[6],P0[7],P0[8],P0[9],     pw0[2]=PKW(P0,4), pw0[3]=PKW(P0,6), pw0); \
    VRD(1); SBAR(); GAPA(C0=__builtin_amdgcn_mfma_f32_32x32x16_bf16(kf[2],qr[1],C0,0,0,0),   P0[10],P0[11],P0[12],P0[13], pw1[0]=PKW(P0,8), pw1[1]=PKW(P0,10), pw1); \
    VRD(5); SBAR(); GAPA(C1=__builtin_amdgcn_mfma_f32_32x32x16_bf16(kf[3],qr[1],C1,0,0,0),   P0[14],P0[15],P1[0],P1[1],   pw1[2]=PKW(P0,12),pw1[3]=PKW(P0,14), pw1); \
    VRD(2); SBAR(); GAPA(C0=__builtin_amdgcn_mfma_f32_32x32x16_bf16(kf[4],qr[2],C0,0,0,0),   P1[2],P1[3],P1[4],P1[5],     pw2[0]=PKW(P1,0), pw2[1]=PKW(P1,2), pw2); \
    VRD(6); SBAR(); GAPA(C1=__builtin_amdgcn_mfma_f32_32x32x16_bf16(kf[5],qr[2],C1,0,0,0),   P1[6],P1[7],P1[8],P1[9],     pw2[2]=PKW(P1,4), pw2[3]=PKW(P1,6), pw2); \
    VRD(3); SBAR(); GAPA(C0=__builtin_amdgcn_mfma_f32_32x32x16_bf16(kf[6],qr[3],C0,0,0,0),   P1[10],P1[11],P1[12],P1[13], pw3[0]=PKW(P1,8), pw3[1]=PKW(P1,10), pw3); \
    VRD(7); SBAR(); GAPA(C1=__builtin_amdgcn_mfma_f32_32x32x16_bf16(kf[7],qr[3],C1,0,0,0),   P1[14],P1[15],0.f,0.f,       pw3[2]=PKW(P1,12),pw3[3]=PKW(P1,14), pw3); \
    l_reg+=sacc; \
    if(GK){DMA_K((t)+3,sl_cur);} if(GV){DMA_V((t)+1,sl_next);} \
    CMASK(C0,C1,t); \
    { float a=MX3(C0[0],C0[1],C1[0]),b=MX3(C0[2],C0[3],C1[1]); a=MX3(a,C1[2],C1[3]); \
      _Pragma("unroll") for(int r=4;r<16;r+=4){a=MX3(a,C0[r],C0[r+1]);b=MX3(b,C0[r+2],C0[r+3]);a=MX3(a,C1[r],C1[r+1]);b=MX3(b,C1[r+2],C1[r+3]);} \
      float rm=__builtin_fmaxf(a,b); { auto rr=__builtin_amdgcn_permlane32_swap(__float_as_uint(rm),__float_as_uint(rm),false,false); rm=__builtin_fmaxf(__uint_as_float(rr[0]),__uint_as_float(rr[1])); } \
      resc=false; \
      if(__builtin_expect(__any(rm>(float)THRL),0)){ const float dl=__builtin_fmaxf(rm,0.f); mhat+=dl; \
        _Pragma("unroll") for(int r=0;r<16;++r){C0[r]-=dl;C1[r]-=dl;} \
        _Pragma("unroll") for(int r=0;r<16;++r)negm[r]=-mhat; asm volatile("":"+v"(negm)); \
        const float f=__builtin_amdgcn_exp2f(-dl); l_reg*=f; if(hi==0)wsf[r32]=f; resc=true; } } \
    SBAR(); \
    GAPB(o[0]=__builtin_amdgcn_mfma_f32_32x32x16_bf16(PAF(0),VFR(0),o[0],0,0,0), C0,0); \
    GAPB(o[1]=__builtin_amdgcn_mfma_f32_32x32x16_bf16(PAF(0),VFR(4),o[1],0,0,0), C0,4); \
    KRD(GL,0); GAPB(o[0]=__builtin_amdgcn_mfma_f32_32x32x16_bf16(PAF(1),VFR(1),o[0],0,0,0), C0,8); \
    KRD(GL,1); GAPB(o[1]=__builtin_amdgcn_mfma_f32_32x32x16_bf16(PAF(1),VFR(5),o[1],0,0,0), C0,12); \
    KRD(GL,2); GAPB(o[0]=__builtin_amdgcn_mfma_f32_32x32x16_bf16(PAF(2),VFR(2),o[0],0,0,0), C1,0); \
    KRD(GL,3); GAPB(o[1]=__builtin_amdgcn_mfma_f32_32x32x16_bf16(PAF(2),VFR(6),o[1],0,0,0), C1,4); \
    GAPB(o[0]=__builtin_amdgcn_mfma_f32_32x32x16_bf16(PAF(3),VFR(3),o[0],0,0,0), C1,8); \
    GAPB(o[1]=__builtin_amdgcn_mfma_f32_32x32x16_bf16(PAF(3),VFR(7),o[1],0,0,0), C1,12); \
    }while(0)
  int t=1;
  #undef CMASK
  #define CMASK(P0,P1,t) do{}while(0)
  for(;t+5<NT;t+=2){
    STEP(pB0,pB1,pA0,pA1,t,true,true,true);     WAIT_BAR(2); RESC(); ROT();
    STEP(pA0,pA1,pB0,pB1,t+1,true,true,true);   WAIT_BAR(2); RESC(); ROT();
  }
  #undef CMASK
  #define CMASK(P0,P1,t) do{int jb_=(t)-(NT-4); if(jb_>=0)cmask(P0,P1,jb_,qrel,hi);}while(0)
  #define ENDW(tt) do{ if((tt)+3<NT){WAIT_BAR(2);} else if((tt)+2<NT){WAIT_BAR(1);} else {WAIT_BAR(0);} }while(0)
  for(;t+1<NT;t+=2){
    STEP(pB0,pB1,pA0,pA1,t,(t+3<NT),(t+1<NT),(t+1<NT));       ENDW(t);   RESC(); ROT();
    STEP(pA0,pA1,pB0,pB1,t+1,(t+4<NT),(t+2<NT),(t+2<NT));     ENDW(t+1); RESC(); ROT();
  }
  STEP(pB0,pB1,pA0,pA1,NT-1,false,false,false); RESC();
  { float sacc=pB0[0]+pB0[1]; _Pragma("unroll") for(int r=2;r<16;++r)sacc+=pB0[r]; _Pragma("unroll") for(int r=0;r<16;++r)sacc+=pB1[r]; l_reg+=sacc;
    pw0=(u32x4){PKW(pB0,0),PKW(pB0,2),PKW(pB0,4),PKW(pB0,6)};pw1=(u32x4){PKW(pB0,8),PKW(pB0,10),PKW(pB0,12),PKW(pB0,14)};pw2=(u32x4){PKW(pB1,0),PKW(pB1,2),PKW(pB1,4),PKW(pB1,6)};pw3=(u32x4){PKW(pB1,8),PKW(pB1,10),PKW(pB1,12),PKW(pB1,14)};
    SBAR(); pv(o,vb0+sl_cur,PAF(0),PAF(1),PAF(2),PAF(3)); }
  #undef PKW
  #undef PAF
  #undef VFR
  #undef PIN
  #undef MX3
  #undef GAPA
  #undef GAPB
  #undef EX
  #undef VRD
  #undef KRD
  #undef STEP
  #undef ENDW
  {auto rr=__builtin_amdgcn_permlane32_swap(__float_as_uint(l_reg),__float_as_uint(l_reg),false,false);l_reg=__uint_as_float(rr[0])+__uint_as_float(rr[1]);}
  if(hi==0)wsf[32+r32]=l_reg;asm volatile("s_waitcnt lgkmcnt(0)":::"memory");
  float rli[16];
  #pragma unroll
  for(int r=0;r<16;++r)rli[r]=__builtin_amdgcn_rcpf(wsf[32+crow(r,hi)]);
  bf16*Ow=O+(rowbase+q0+wid*QBLK)*DM+hv*D;
  { bf16*stg=(bf16*)(shm+LDS_OST)+wid*2048;
    #pragma unroll
    for(int r=0;r<16;++r){const int orow=crow(r,hi);
      #pragma unroll
      for(int d0=0;d0<2;++d0)stg[orow*64+d0*32+r32]=__float2bfloat16(o[d0][r]*rli[r]);}
    asm volatile("s_waitcnt lgkmcnt(0)":::"memory");
    #pragma unroll
    for(int i=0;i<4;++i){const int row=i*8+(lane>>3),ch=lane&7; const u32x4 v=*(const u32x4*)(stg+row*64+ch*8); ATTN_STORE16(Ow+(long)row*DM+ch*8,v);} }
  asm volatile("s_waitcnt lgkmcnt(0)\n\ts_barrier":::"memory");
  #undef DMA_K
  #undef DMA_V
  #undef CMASK
  #undef START
  #undef RESC
  #undef ROT
}
constexpr int VSLOTB=16384, LW_K=0, LW_V=NSLOT*SLOTB, LW_WS=LW_V+NSLOT*VSLOTB, LW_BYTES=LW_WS+NW*64*4;
static_assert(NW*8192<=LW_WS,"O stage overlays the K/V rings");
__device__ __forceinline__ void pv4(f32x16*o,int vb,bf16x8 pa0,bf16x8 pa1,bf16x8 pa2,bf16x8 pa3){
  #pragma unroll
  for(int d0=0;d0<4;++d0){s16x4 lo[4],hi[4];
    #pragma unroll
    for(int ks=0;ks<4;++ks){
      asm volatile("ds_read_b64_tr_b16 %0,%1 offset:%c2":"=&v"(lo[ks]):"v"(vb),"i"(d0*4096+ks*1024):"memory");
      asm volatile("ds_read_b64_tr_b16 %0,%1 offset:%c2":"=&v"(hi[ks]):"v"(vb),"i"(d0*4096+ks*1024+512):"memory");}
    asm volatile("s_waitcnt lgkmcnt(0)":::"memory");SBAR();
    #define PK(k) (bf16x8){lo[k][0],lo[k][1],lo[k][2],lo[k][3],hi[k][0],hi[k][1],hi[k][2],hi[k][3]}
    o[d0]=__builtin_amdgcn_mfma_f32_32x32x16_bf16(pa0,PK(0),o[d0],0,0,0);
    o[d0]=__builtin_amdgcn_mfma_f32_32x32x16_bf16(pa1,PK(1),o[d0],0,0,0);
    o[d0]=__builtin_amdgcn_mfma_f32_32x32x16_bf16(pa2,PK(2),o[d0],0,0,0);
    o[d0]=__builtin_amdgcn_mfma_f32_32x32x16_bf16(pa3,PK(3),o[d0],0,0,0);
    #undef PK
  }
}
__device__ __forceinline__ void attn_unit_w(int wave_sg,int b,int h8,int m,int qb,const bf16*Q,const bf16*__restrict__ K,const bf16*__restrict__ V,bf16*O,char*shm,bf16*YAo,const float*fz){
  int tid_=pg8::opq(wave_sg)*64+pg8::lane_id(); asm volatile("":"+v"(tid_)); const int tid=tid_,lane=tid&63,r32=lane&31,hi=lane>>5; const int wid=__builtin_amdgcn_readfirstlane(tid>>6);
  const long rowbase=(long)b*SEQ; const int q0=qb*QB; const int hq=2*h8+m;
  const bf16*Qw=Q+(rowbase+q0+wid*QBLK)*DM+hq*D;
  const bf16*Kh=K+rowbase*DM+hq*D,*Vh=V+rowbase*DM+h8*128;
  const unsigned lds0=(unsigned)(uintptr_t)shm;
  float*wsf=(float*)(shm+LW_WS)+wid*64;
  const bf16*ksrc=Kh+(long)lane*DM+wid*8;
  const bf16*vsrcA=Vh+(long)(16*(wid&3)+(lane>>2))*DM+(wid>>2)*32+(lane&3)*8;
  const bf16*vsrcB=vsrcA+64;
  const unsigned kdst=lds0+LW_K+wid*1024, vdstA=lds0+LW_V+wid*1024, vdstB=vdstA+8192;
  #define DMA_K(t,slot) glds16(ksrc+(long)(t)*KVBLK*DM,(unsigned)__builtin_amdgcn_readfirstlane(kdst+(slot)))
  #define DMA_V(t,slot) do{ glds16(vsrcA+(long)(t)*KVBLK*DM,(unsigned)__builtin_amdgcn_readfirstlane(vdstA+2*(slot))); glds16(vsrcB+(long)(t)*KVBLK*DM,(unsigned)__builtin_amdgcn_readfirstlane(vdstB+2*(slot))); }while(0)
  const int vb0=(int)(lds0+LW_V)+((lane>>4)&1)*32+(lane&3)*8+(4*hi+((lane&15)>>2))*64;
  const char*Kbase=shm+LW_K; bf16x8 kf[8];
  const lds_cptr shm3=(lds_cptr)shm; const lds_cptr kp0=shm3+LW_K+hi*1024+r32*16; const lds_cptr vp0=shm3+LW_V+((lane>>4)&1)*32+(lane&3)*8+(4*hi+((lane&15)>>2))*64;
  const int NT=(q0+QB)/KVBLK;
  DMA_K(0,0);DMA_V(0,0);DMA_K(1,SLOTB);
  bf16x8 qr[4];
  #pragma unroll
  for(int d0=0;d0<4;++d0)qr[d0]=*reinterpret_cast<const bf16x8*>(&Qw[(long)r32*DM+d0*16+hi*8]);
  float l_reg=0.f;f32x16 o[4];o[0]=f32x16{};o[1]=f32x16{};o[2]=f32x16{};o[3]=f32x16{};
  const int qrel=wid*QBLK+r32;
  #define CMASK(P0,P1,t) do{int jb_=(t)-(NT-4); if(jb_>=0)cmask(P0,P1,jb_,qrel,hi);}while(0)
  f32x16 pA0,pA1,pB0,pB1;
  int sl_prev=0,sl_cur=0,sl_next=SLOTB;
  #define ROT() do{sl_prev=sl_cur;sl_cur=sl_next;sl_next=(sl_next==(NSLOT-1)*SLOTB)?0:sl_next+SLOTB;}while(0)
  DMA_K(2,2*SLOTB);
  WAIT_BAR(4);
  { const char*kb=Kbase+hi*1024+r32*16;
    #pragma unroll
    for(int d0=0;d0<4;++d0){
      const bf16x8 b0=*reinterpret_cast<const bf16x8*>(kb+d0*2048);
      const bf16x8 b1=*reinterpret_cast<const bf16x8*>(kb+d0*2048+512);
      if(d0==0){pA0=__builtin_amdgcn_mfma_f32_32x32x16_bf16(b0,qr[0],f32x16{},0,0,0);pA1=__builtin_amdgcn_mfma_f32_32x32x16_bf16(b1,qr[0],f32x16{},0,0,0);}
      else{pA0=__builtin_amdgcn_mfma_f32_32x32x16_bf16(b0,qr[d0],pA0,0,0,0);pA1=__builtin_amdgcn_mfma_f32_32x32x16_bf16(b1,qr[d0],pA1,0,0,0);}} }
  asm volatile("s_nop 15\n\ts_nop 7":"+v"(pA0),"+v"(pA1));CMASK(pA0,pA1,0);
  _Pragma("unroll") for(int r=0;r<16;++r){pA0[r]=__builtin_amdgcn_exp2f(pA0[r]);pA1[r]=__builtin_amdgcn_exp2f(pA1[r]);}
  WAIT_BAR(0);
  DMA_K(3,0);DMA_V(1,SLOTB);
  ROT();
  kload8(kf,kp0+sl_cur);
  WAIT_BAR(3);
  s16x4 vlo[8],vhi[8]; u32x4 pw0,pw1,pw2,pw3;
  #define PKW(P,B) cvtpk_s(P[B],P[B+1])
  #define PAF(k) __builtin_bit_cast(bf16x8,pw##k)
  #define VFR(i) (bf16x8){vlo[i][0],vlo[i][1],vlo[i][2],vlo[i][3],vhi[i][0],vhi[i][1],vhi[i][2],vhi[i][3]}
  #define PIN(x) asm volatile("":"+v"(x))
  #define GAPA(MF,A0,A1,A2,A3,W0,W1,PW) do{ MF; sacc+=A0; sacc+=A1; sacc+=A2; sacc+=A3; PIN(sacc); W0; W1; PIN(PW); SBAR(); }while(0)
  #define EX(v) __builtin_amdgcn_exp2f(v)
  #define GAPB(MF,X,B) do{ MF; X[B]=EX(X[B]); X[B+1]=EX(X[B+1]); PIN(X); SBAR(); }while(0)
  #define VRD(j,i) do{ vlo[j]=vtr(vp_+(((i)>>2)*4096+((i)&3)*1024)); vhi[j]=vtr(vp_+(((i)>>2)*4096+((i)&3)*1024+512)); }while(0)
  #define KRD(G,j) do{ if(G){ kload2(kf,kp0+sl_next,j); SBAR(); } }while(0)
  #define STEP(C0,C1,P0,P1,t,GK,GV,GL) do{ SBAR(); \
    const lds_cptr vp_=vp0+2*sl_prev; \
    VRD(0,0); SBAR(); float sacc=(P0[0]+P0[1]); \
    GAPA(C0=__builtin_amdgcn_mfma_f32_32x32x16_bf16(kf[0],qr[0],f32x16{},0,0,0), P0[2],P0[3],P0[4],P0[5],     pw0[0]=PKW(P0,0), pw0[1]=PKW(P0,2), pw0); \
    VRD(4,4); SBAR(); GAPA(C1=__builtin_amdgcn_mfma_f32_32x32x16_bf16(kf[1],qr[0],f32x16{},0,0,0), P0[6],P0[7],P0[8],P0[9],     pw0[2]=PKW(P0,4), pw0[3]=PKW(P0,6), pw0); \
    VRD(1,1); SBAR(); GAPA(C0=__builtin_amdgcn_mfma_f32_32x32x16_bf16(kf[2],qr[1],C0,0,0,0),   P0[10],P0[11],P0[12],P0[13], pw1[0]=PKW(P0,8), pw1[1]=PKW(P0,10), pw1); \
    VRD(5,5); SBAR(); GAPA(C1=__builtin_amdgcn_mfma_f32_32x32x16_bf16(kf[3],qr[1],C1,0,0,0),   P0[14],P0[15],P1[0],P1[1],   pw1[2]=PKW(P0,12),pw1[3]=PKW(P0,14), pw1); \
    VRD(2,2); SBAR(); GAPA(C0=__builtin_amdgcn_mfma_f32_32x32x16_bf16(kf[4],qr[2],C0,0,0,0),   P1[2],P1[3],P1[4],P1[5],     pw2[0]=PKW(P1,0), pw2[1]=PKW(P1,2), pw2); \
    VRD(6,6); SBAR(); GAPA(C1=__builtin_amdgcn_mfma_f32_32x32x16_bf16(kf[5],qr[2],C1,0,0,0),   P1[6],P1[7],P1[8],P1[9],     pw2[2]=PKW(P1,4), pw2[3]=PKW(P1,6), pw2); \
    VRD(3,3); SBAR(); GAPA(C0=__builtin_amdgcn_mfma_f32_32x32x16_bf16(kf[6],qr[3],C0,0,0,0),   P1[10],P1[11],P1[12],P1[13], pw3[0]=PKW(P1,8), pw3[1]=PKW(P1,10), pw3); \
    VRD(7,7); SBAR(); GAPA(C1=__builtin_amdgcn_mfma_f32_32x32x16_bf16(kf[7],qr[3],C1,0,0,0),   P1[14],P1[15],0.f,0.f,       pw3[2]=PKW(P1,12),pw3[3]=PKW(P1,14), pw3); \
    l_reg+=sacc; \
    if(GK){DMA_K((t)+3,sl_cur);} if(GV){DMA_V((t)+1,sl_next);} \
    CMASK(C0,C1,t); \
    SBAR(); \
    GAPB(o[0]=__builtin_amdgcn_mfma_f32_32x32x16_bf16(PAF(0),VFR(0),o[0],0,0,0), C0,0);  VRD(0,8);  SBAR(); \
    GAPB(o[1]=__builtin_amdgcn_mfma_f32_32x32x16_bf16(PAF(0),VFR(4),o[1],0,0,0), C0,2);  VRD(4,12); SBAR(); \
    KRD(GL,0); GAPB(o[0]=__builtin_amdgcn_mfma_f32_32x32x16_bf16(PAF(1),VFR(1),o[0],0,0,0), C0,4);  VRD(1,9);  SBAR(); \
    KRD(GL,1); GAPB(o[1]=__builtin_amdgcn_mfma_f32_32x32x16_bf16(PAF(1),VFR(5),o[1],0,0,0), C0,6);  VRD(5,13); SBAR(); \
    KRD(GL,2); GAPB(o[0]=__builtin_amdgcn_mfma_f32_32x32x16_bf16(PAF(2),VFR(2),o[0],0,0,0), C0,8);  VRD(2,10); SBAR(); \
    KRD(GL,3); GAPB(o[1]=__builtin_amdgcn_mfma_f32_32x32x16_bf16(PAF(2),VFR(6),o[1],0,0,0), C0,10); VRD(6,14); SBAR(); \
    GAPB(o[0]=__builtin_amdgcn_mfma_f32_32x32x16_bf16(PAF(3),VFR(3),o[0],0,0,0), C0,12); VRD(3,11); SBAR(); \
    GAPB(o[1]=__builtin_amdgcn_mfma_f32_32x32x16_bf16(PAF(3),VFR(7),o[1],0,0,0), C0,14); VRD(7,15); SBAR(); \
    GAPB(o[2]=__builtin_amdgcn_mfma_f32_32x32x16_bf16(PAF(0),VFR(0),o[2],0,0,0), C1,0); \
    GAPB(o[3]=__builtin_amdgcn_mfma_f32_32x32x16_bf16(PAF(0),VFR(4),o[3],0,0,0), C1,2); \
    GAPB(o[2]=__builtin_amdgcn_mfma_f32_32x32x16_bf16(PAF(1),VFR(1),o[2],0,0,0), C1,4); \
    GAPB(o[3]=__builtin_amdgcn_mfma_f32_32x32x16_bf16(PAF(1),VFR(5),o[3],0,0,0), C1,6); \
    GAPB(o[2]=__builtin_amdgcn_mfma_f32_32x32x16_bf16(PAF(2),VFR(2),o[2],0,0,0), C1,8); \
    GAPB(o[3]=__builtin_amdgcn_mfma_f32_32x32x16_bf16(PAF(2),VFR(6),o[3],0,0,0), C1,10); \
    GAPB(o[2]=__builtin_amdgcn_mfma_f32_32x32x16_bf16(PAF(3),VFR(3),o[2],0,0,0), C1,12); \
    GAPB(o[3]=__builtin_amdgcn_mfma_f32_32x32x16_bf16(PAF(3),VFR(7),o[3],0,0,0), C1,14); \
    }while(0)
  int t=1;
  #undef CMASK
  #define CMASK(P0,P1,t) do{}while(0)
  for(;t+5<NT;t+=2){
    STEP(pB0,pB1,pA0,pA1,t,true,true,true);     WAIT_BAR(3); ROT();
    STEP(pA0,pA1,pB0,pB1,t+1,true,true,true);   WAIT_BAR(3); ROT();
  }
  #undef CMASK
  #define CMASK(P0,P1,t) do{int jb_=(t)-(NT-4); if(jb_>=0)cmask(P0,P1,jb_,qrel,hi);}while(0)
  #define ENDW(tt) do{ if((tt)+3<NT){WAIT_BAR(3);} else if((tt)+2<NT){WAIT_BAR(2);} else {WAIT_BAR(0);} }while(0)
  for(;t+1<NT;t+=2){
    STEP(pB0,pB1,pA0,pA1,t,(t+3<NT),(t+1<NT),(t+1<NT));       ENDW(t);   ROT();
    STEP(pA0,pA1,pB0,pB1,t+1,(t+4<NT),(t+2<NT),(t+2<NT));     ENDW(t+1); ROT();
  }
  STEP(pB0,pB1,pA0,pA1,NT-1,false,false,false);
  { float sacc=pB0[0]+pB0[1]; _Pragma("unroll") for(int r=2;r<16;++r)sacc+=pB0[r]; _Pragma("unroll") for(int r=0;r<16;++r)sacc+=pB1[r]; l_reg+=sacc;
    pw0=(u32x4){PKW(pB0,0),PKW(pB0,2),PKW(pB0,4),PKW(pB0,6)};pw1=(u32x4){PKW(pB0,8),PKW(pB0,10),PKW(pB0,12),PKW(pB0,14)};pw2=(u32x4){PKW(pB1,0),PKW(pB1,2),PKW(pB1,4),PKW(pB1,6)};pw3=(u32x4){PKW(pB1,8),PKW(pB1,10),PKW(pB1,12),PKW(pB1,14)};
    SBAR(); pv4(o,vb0+2*sl_cur,PAF(0),PAF(1),PAF(2),PAF(3)); }
  #undef PKW
  #undef PAF
  #undef VFR
  #undef PIN
  #undef GAPA
  #undef GAPB
  #undef EX
  #undef VRD
  #undef KRD
  #undef STEP
  #undef ENDW
  {auto rr=__builtin_amdgcn_permlane32_swap(__float_as_uint(l_reg),__float_as_uint(l_reg),false,false);l_reg=__uint_as_float(rr[0])+__uint_as_float(rr[1]);}
  if(hi==0)wsf[32+r32]=l_reg;
  asm volatile("s_waitcnt lgkmcnt(0)\n\ts_barrier":::"memory");
  float rli[16];
  #pragma unroll
  for(int r=0;r<16;++r)rli[r]=__builtin_amdgcn_rcpf(wsf[32+crow(r,hi)]);
  bf16*Ow=O+(rowbase+q0+wid*QBLK)*DM+h8*128;
  { bf16*stg=(bf16*)shm+wid*4096;
    #pragma unroll
    for(int r=0;r<16;++r){const int orow=crow(r,hi);
      #pragma unroll
      for(int d0=0;d0<4;++d0)stg[orow*128+d0*32+r32]=__float2bfloat16(o[d0][r]*rli[r]);}
    asm volatile("s_waitcnt lgkmcnt(0)":::"memory");
    if(fz==nullptr){
    #pragma unroll
    for(int i=0;i<8;++i){const int row=i*4+(lane>>4),ch=lane&15; const u32x4 v=*(const u32x4*)(stg+row*128+ch*8); ATTN_STORE16(Ow+(long)row*DM+ch*8,v);} }
    else{ const bf16*O0w=Ow; bf16*Yw=YAo+(rowbase+q0+wid*QBLK)*DM+h8*128; const int ch=lane&15; const float lam=fz[0];
      asm volatile("s_waitcnt vmcnt(0)":::"memory");
      u32x4 a0[8];
      #pragma unroll
      for(int i=0;i<8;++i)a0[i]=*(const u32x4*)(O0w+(long)(i*4+(lane>>4))*DM+ch*8);
      float sl8[8];
      #pragma unroll
      for(int e=0;e<8;++e)sl8[e]=fz[2+ch*8+e];
      #pragma unroll
      for(int i=0;i<8;++i){const int row=i*4+(lane>>4); const u32x4 v1=*(const u32x4*)(stg+row*128+ch*8);
        const unsigned aw[4]={a0[i].x,a0[i].y,a0[i].z,a0[i].w},bw[4]={v1.x,v1.y,v1.z,v1.w}; float d[8]; float ss=0.f;
        #pragma unroll
        for(int j=0;j<4;++j){d[2*j]=__uint_as_float(aw[j]<<16)-lam*__uint_as_float(bw[j]<<16); d[2*j+1]=__uint_as_float(aw[j]&0xffff0000u)-lam*__uint_as_float(bw[j]&0xffff0000u); ss+=d[2*j]*d[2*j]+d[2*j+1]*d[2*j+1];}
        ss=pg8::row_sum16(ss);
        const float rr=1.0f/sqrtf(ss*(1.f/128.f)+1e-6f);
        u32x4 w; w.x=cvtpk_s(d[0]*rr*sl8[0],d[1]*rr*sl8[1]); w.y=cvtpk_s(d[2]*rr*sl8[2],d[3]*rr*sl8[3]); w.z=cvtpk_s(d[4]*rr*sl8[4],d[5]*rr*sl8[5]); w.w=cvtpk_s(d[6]*rr*sl8[6],d[7]*rr*sl8[7]);
        ATTN_STORE16(Yw+(long)row*DM+ch*8,w);} } }
  asm volatile("s_waitcnt lgkmcnt(0)\n\ts_barrier":::"memory");
  #undef DMA_K
  #undef DMA_V
  #undef CMASK
  #undef ROT
}
constexpr int ATTN_LDS_BYTES=LDS_BYTES;
struct AttnTensors { const bf16* Q; const bf16* K; const bf16* V; bf16* O; };
struct AttnUnit { int b, hq, hv, m, qb; };
struct StaticOrder {
  int vcu, G;
  __device__ __forceinline__ explicit StaticOrder(int grid,int block):vcu((grid%8==0)?(block%8)*(grid/8)+block/8:block),G(grid){}
  __device__ __forceinline__ bool next(int i,AttnUnit&u)const{ const int g=vcu+(i>>3)*G; if(g>=256)return false; const int vh=g&1,m=(g>>1)&1,h8=(g>>2)&7; u.b=g>>5; u.hq=2*h8+m; u.hv=2*h8+vh; u.m=m; u.qb=7-(i&7); return true; }
  __device__ __forceinline__ void a_ready(const AttnUnit&)const{}
  __device__ __forceinline__ void done(const AttnUnit&)const{}
};
template<class Sched,int THRL=8> __device__ __forceinline__ void attn_phase(char*lds,const AttnTensors&T,const Sched&S,const int wave_sg){
  AttnUnit u; const bf16*Qp=pg8::uni_ptr(T.Q),*Kp=pg8::uni_ptr(T.K),*Vp=pg8::uni_ptr(T.V); bf16*Op=pg8::uni_ptr(T.O);
  for(int i=0;S.next(i,u);++i){ S.a_ready(u); attn_unit<THRL>(wave_sg,u.b,u.hq,u.hv,u.qb,Qp,Kp,Vp,Op+(size_t)u.m*((size_t)BATCH*SEQ*DM),lds); S.done(u); }
}
#undef SBAR
#undef WAIT_BAR
}
#define GAS __attribute__((address_space(1)))
#define LAS __attribute__((address_space(3)))
typedef unsigned short bf16;
typedef unsigned v4u __attribute__((ext_vector_type(4)));
typedef float f32x4 __attribute__((ext_vector_type(4)));
typedef short bf16x8 __attribute__((ext_vector_type(8)));
typedef GAS unsigned gu32;
typedef GAS unsigned long long gu64;
#define RLX_AGENT __ATOMIC_RELAXED, __HIP_MEMORY_SCOPE_AGENT
#define LDS_WAIT() asm volatile("s_waitcnt lgkmcnt(0)" ::: "memory")
#define VM_WAIT() asm volatile("s_waitcnt vmcnt(0)" ::: "memory")
__device__ __forceinline__ unsigned long long rt() { return __builtin_amdgcn_s_memrealtime(); }
__device__ __forceinline__ unsigned f2bf(float f) { unsigned u = __builtin_bit_cast(unsigned, f); return (u + 0x7fffu + ((u >> 16) & 1u)) >> 16; }
__device__ __forceinline__ unsigned pk2(float lo, float hi) { return f2bf(lo) | (f2bf(hi) << 16); }

#define XB_TMO      128
#define XB_XCNT(j)  (256  + 64 * (j))
#define XB_XSUB(j)  (1280 + 64 * (j))
#define XB_XGEN(j)  (2304 + 64 * (j))
#define XB_TOP      3328
#define XB_TOPGEN   3392
#define XCD_BAR_WORDS 3456
#define XB_SPIN_CAP (1u << 18)

__device__ __forceinline__ unsigned xb_ld(unsigned* p)              { return __hip_atomic_load(p, __ATOMIC_RELAXED, __HIP_MEMORY_SCOPE_AGENT); }
__device__ __forceinline__ unsigned xb_add(unsigned* p, unsigned v) { return __hip_atomic_fetch_add(p, v, __ATOMIC_RELAXED, __HIP_MEMORY_SCOPE_AGENT); }
__device__ __forceinline__ unsigned xb_xcc_id() { return (unsigned)__builtin_amdgcn_s_getreg((3 << 11) | 20) & 0xFu; }
#define XB_SPIN(cond, bar) do { unsigned _sp = 0; while (cond) { __builtin_amdgcn_s_sleep(1); \
    if ((++_sp & 255u) == 0u) { if (xb_ld(&(bar)[XB_TMO])) break; if (_sp > XB_SPIN_CAP) { atomicAdd(&(bar)[XB_TMO], 1u); break; } } } } while (0)

struct XcdBarrier {
    unsigned* bar; unsigned x;
    volatile LAS unsigned* st;
};

__device__ __forceinline__ XcdBarrier xcd_barrier_post(unsigned* bar, volatile LAS unsigned* st, const bool t0) {
    XcdBarrier b; b.bar = bar; b.x = xb_xcc_id(); b.st = st;
    if (t0) (void)xb_add(&bar[XB_XCNT(b.x)], 1u);
    return b;
}
__device__ __forceinline__ void xcd_barrier_complete(unsigned* bar, unsigned x, unsigned& nloc, unsigned& nx) {
    const unsigned G = gridDim.x * gridDim.y * gridDim.z;
    unsigned sum, cnt, mine, sp = 0u;
    for (;;) {
        sum = 0u; cnt = 0u; mine = 0u;
#pragma unroll
        for (unsigned j = 0; j < 16; ++j) { const unsigned c = xb_ld(&bar[XB_XCNT(j)]); sum += c; cnt += (c > 0u) ? 1u : 0u; mine = (j == x) ? c : mine; }
        if (sum == G) break;
        __builtin_amdgcn_s_sleep(1);
        if ((++sp & 255u) == 0u) { if (xb_ld(&bar[XB_TMO])) break; if (sp > XB_SPIN_CAP) { atomicAdd(&bar[XB_TMO], 1u); break; } }
    }
    nloc = mine > 0u ? mine : 1u; nx = cnt > 0u ? cnt : 1u;
}

__device__ __forceinline__ void xcd_barrier(const XcdBarrier& b, const bool t0) {
    asm volatile("s_waitcnt vmcnt(0)" ::: "memory");
    __syncthreads();
    if (t0) {
        unsigned* bar = pg8::uni_ptr(b.bar);
        __builtin_amdgcn_s_waitcnt(0);
        unsigned nloc = b.st[0], nx = b.st[1];
        if (nloc == 0u) { xcd_barrier_complete(bar, b.x, nloc, nx); b.st[0] = nloc; b.st[1] = nx; }
        const unsigned old = xb_add(&bar[XB_XSUB(b.x)], 1u);
        const unsigned gen = old / nloc;
        if (old + 1u == (gen + 1u) * nloc) {
            __builtin_amdgcn_fence(__ATOMIC_RELEASE, "agent");
            asm volatile("s_waitcnt vmcnt(0)" ::: "memory");
            const unsigned og = xb_add(&bar[XB_TOP], 1u);
            const unsigned tg = og / nx;
            if (og + 1u == (tg + 1u) * nx) xb_add(&bar[XB_TOPGEN], 1u);
            else XB_SPIN(xb_ld(&bar[XB_TOPGEN]) == tg, bar);
            __builtin_amdgcn_fence(__ATOMIC_ACQUIRE, "agent");
            xb_add(&bar[XB_XGEN(b.x)], 1u);
            asm volatile("s_waitcnt vmcnt(0)" ::: "memory");
        } else {
            XB_SPIN(xb_ld(&bar[XB_XGEN(b.x)]) == gen, bar);
            __builtin_amdgcn_fence(__ATOMIC_ACQUIRE, "agent");
            asm volatile("s_waitcnt vmcnt(0)" ::: "memory");
        }
    }
    __syncthreads();
}

constexpr int NWAVES = 8;
constexpr int NB = 8, NT_ = 2048, DM_ = 2048, M = NB * NT_;
constexpr int MIXW = 1024, INC = 15360, FFH = 5632, MEMROWS = 2048;
constexpr int DEPTH = 2, NPH = 16;
constexpr float EPSN = 1e-6f;
constexpr float LOG2E = 1.4426950408889634f;

constexpr size_t MiB = 1u << 20;
constexpr size_t WS_CTL = 0, CTL_ZERO_BYTES = 1 * MiB;
constexpr size_t WS_LAM = 1 * MiB + 512 * 1024;
constexpr size_t WS_DCS = 1 * MiB, WS_RCS = 2 * MiB;
constexpr size_t WS_W = 4 * MiB;
constexpr int KPAD = 64;
constexpr int LD2K = DM_ + KPAD, LD1K = MIXW + KPAD, LDFF = FFH + KPAD;
constexpr size_t W_IN = WS_W, W_BR = W_IN + 62 * MiB, W_OUT = W_BR + 13 * MiB, W_Q = W_OUT + 9 * MiB, W_KV = W_Q + 9 * MiB, W_O = W_KV + 17 * MiB, W_13 = W_O + 9 * MiB, W_2 = W_13 + 46 * MiB, W_END = W_2 + 23 * MiB;
constexpr size_t WS_XN = W_END;
constexpr size_t WS_MN = WS_XN + 66 * MiB, WS_KM = WS_MN + 8 * MiB, WS_VT = WS_KM + 9 * MiB;
constexpr size_t WS_Y = WS_VT + 8 * MiB;
constexpr size_t WS_YRAW = WS_Y + 96 * MiB;
constexpr size_t WS_BIG = WS_YRAW + 64 * MiB;
constexpr size_t SEG = 32 * MiB, SEG_E = (size_t)16384 * 1024;
constexpr size_t WS_END_BIG = WS_BIG + 15 * SEG;
constexpr size_t RSS_STRIDE = (size_t)16384 * 32;
constexpr size_t WS_END = WS_END_BIG + 7 * RSS_STRIDE * 4;
static_assert(W_END == 192 * MiB && WS_END == 937 * MiB, "d_ws map");
constexpr size_t DO_WKV1 = 64 * MiB, DO_MN1 = 81 * MiB, DO_KV1 = 90 * MiB;
constexpr int CW_TMO = 0, CW_BAR = 4096, CW_Q = 8192;
constexpr size_t WS_RSS = WS_END_BIG;

constexpr int RING_OFF = 0, RING_BYTES = 131072;
constexpr int LDSCTL_OFF = RING_BYTES, MISC_OFF = LDSCTL_OFF + 320;
constexpr int LDS_BYTES = 147456;
static_assert(MISC_OFF + 128 <= LDS_BYTES, "LDS map");

struct Args { const float* in[22]; float* out; unsigned char* ws; int l_lo, l_hi; };
__device__ const float ROPE_INV[96] = {1.0f, 0.749894202f, 0.562341332f, 0.421696514f, 0.316227764f, 0.237137377f, 0.177827939f, 0.133352146f, 0.100000001f, 0.0749894232f, 0.0562341325f, 0.0421696492f, 0.0316227749f, 0.0237137377f, 0.0177827943f, 0.013335214f, 0.00999999978f, 0.00749894232f, 0.00562341325f, 0.00421696482f, 0.00316227763f, 0.00237137382f, 0.00177827943f, 0.00133352145f, 0.00100000005f, 0.000749894185f, 0.000562341302f, 0.000421696517f, 0.000316227757f, 0.00023713737f, 0.00017782794f, 0.00013335215f, 1.0f, 0.863988459f, 0.746476054f, 0.644946694f, 0.557226479f, 0.481437236f, 0.415956229f, 0.359381378f, 0.310501337f, 0.268269569f, 0.231781825f, 0.20025681f, 0.173019573f, 0.149486914f, 0.129154965f, 0.111588396f, 0.0964110866f, 0.0832980648f, 0.0719685704f, 0.0621800125f, 0.05372281f, 0.0464158878f, 0.040102791f, 0.0346483476f, 0.0299357735f, 0.0258641616f, 0.0223463364f, 0.0193069782f, 0.0166810062f, 0.0144121964f, 0.0124519709f, 0.010758359f, 0.00929509755f, 0.00803085696f, 0.00693856785f, 0.00599484239f, 0.0051794746f, 0.00447500637f, 0.00386635377f, 0.00334048504f, 0.00288614049f, 0.00249359198f, 0.0021544348f, 0.00186140672f, 0.0016082339f, 0.00138949545f, 0.00120050809f, 0.00103722513f, 0.000896150479f, 0.000774263695f, 0.000668954861f, 0.000577969302f, 0.000499358808f, 0.000431440218f, 0.000372759358f, 0.000322059786f, 0.000278255931f, 0.000240409921f, 0.00020771139f, 0.000179460243f, 0.000155051574f, 0.000133962778f, 0.000115742288f, 9.99999975e-05f};
struct Frame {
    LAS unsigned char* lds;
    volatile LAS unsigned* MISC;
    int vcu, G, wave;
};
#define PH_ENTER() const int wave = pg8::opq(F.wave), vcu_ = pg8::opq(F.vcu), G_ = pg8::opq(F.G); int tid = wave * 64 + pg8::lane_id(); asm volatile("" : "+v"(tid)); const int lane = tid & 63; (void)vcu_; (void)G_; \
    unsigned char* ws = pg8::uni_ptr(args.ws); (void)lane; (void)wave; (void)tid
__device__ __forceinline__ float wave_sum(float v) {
    v = pg8::xadd<1>(v); v = pg8::xadd<2>(v); v = pg8::xadd<4>(v); v = pg8::xadd<8>(v); v = pg8::xadd<16>(v); v = pg8::xadd<32>(v);
    return v;
}
__device__ __forceinline__ float wave_total(float v) {
#define DPPADD(ctrl, rmask) v += __int_as_float(__builtin_amdgcn_update_dpp(0, __float_as_int(v), ctrl, rmask, 0xf, true))
    DPPADD(0xB1, 0xf); DPPADD(0x4E, 0xf); DPPADD(0x141, 0xf); DPPADD(0x140, 0xf); DPPADD(0x142, 0xa); DPPADD(0x143, 0xc);
#undef DPPADD
    return __int_as_float(__builtin_amdgcn_readlane(__float_as_int(v), 63));
}
__device__ __forceinline__ float bflo(unsigned w) { return __uint_as_float(w << 16); }
__device__ __forceinline__ float bfhi(unsigned w) { return __uint_as_float(w & 0xffff0000u); }
__device__ __forceinline__ float sigm(float x) { return __builtin_amdgcn_rcpf(1.0f + __builtin_amdgcn_exp2f(-LOG2E * x)); }

template <int CMAP> __device__ __forceinline__ void transpose_item(const float* W, int K, int N, bf16* WT, int ldw, LAS float* scr, int item, int lane, const float* gain = nullptr) {
    const int nblk = N / 32, kb = item / nblk, nb = item % nblk, k0 = 64 * kb, n0 = 32 * nb;
    const int nn = n0 + (lane & 31); int sc = nn;
    if (CMAP == 1) sc = (nn & 1) * FFH + (nn >> 1);
    if (CMAP == 2) {
        if (nn < 2048) { const int w = nn & 63; sc = (nn & ~63) + (w & 1) * 32 + (w >> 1); }
        else if (nn >= 3072 && nn < 5120) { const int j = nn - 3072; sc = 3072 + (j & 1) * 1024 + (j >> 1); }
        else if (nn >= 5120 && nn < 7168) { const int w = (nn - 5120) & 127; sc = 5120 + ((nn - 5120) & ~127) + (w & 1) * 64 + (w >> 1); } }
    float wv[32]; const float gv = gain ? gain[k0 + lane] : 1.0f;
#pragma unroll
    for (int i = 0; i < 32; ++i) wv[i] = W[(size_t)(k0 + 2 * i + (lane >> 5)) * N + sc];
#pragma unroll
    for (int i = 0; i < 32; ++i) { const float g0 = __builtin_bit_cast(float, __builtin_amdgcn_readlane(__builtin_bit_cast(int, gv), 2 * i)), g1 = __builtin_bit_cast(float, __builtin_amdgcn_readlane(__builtin_bit_cast(int, gv), 2 * i + 1));
        scr[(2 * i + (lane >> 5)) * 33 + (lane & 31)] = wv[i] * ((lane >> 5) ? g1 : g0); }
    LDS_WAIT(); asm volatile("" ::: "memory");
    const int c = lane & 7;
#pragma unroll
    for (int j = 0; j < 4; ++j) { const int n = (lane >> 3) + 8 * j; const LAS float* s = scr + (8 * c) * 33 + n;
        v4u o; o.x = pk2(s[0 * 33], s[1 * 33]); o.y = pk2(s[2 * 33], s[3 * 33]); o.z = pk2(s[4 * 33], s[5 * 33]); o.w = pk2(s[6 * 33], s[7 * 33]);
        *(GAS v4u*)(WT + (size_t)(n0 + n) * ldw + k0 + 8 * c) = o; }
    LDS_WAIT(); asm volatile("" ::: "memory");
}
template <int CMAP> __device__ __forceinline__ int wt_row(int s) {
    if (CMAP == 1) return s < FFH ? 2 * s : 2 * (s - FFH) + 1;
    if (CMAP == 2) {
        if (s < 2048) { const int ws = s & 63; return (s & ~63) + (ws < 32 ? 2 * ws : 2 * (ws - 32) + 1); }
        if (s >= 3072 && s < 5120) { const int j = s - 3072; return 3072 + (j < 1024 ? 2 * j : 2 * (j - 1024) + 1); }
        if (s >= 5120 && s < 7168) { const int ws = (s - 5120) & 127; return 5120 + ((s - 5120) & ~127) + (ws < 64 ? 2 * ws : 2 * (ws - 64) + 1); } }
    return s;
}
template <int CMAP, int K> __device__ __forceinline__ void transpose_item_w(const float* W, int N, bf16* WT, int ldw, LAS unsigned char* scr, int item, int lane, const float* gain = nullptr) {
    constexpr int nkb = K / 64; const int nb = item / nkb, kb = item % nkb,
        k0 = 64 * kb, h = lane >> 5, cl = lane & 31, s0 = 128 * nb + 4 * cl;
    const float* src = W + (size_t)(k0 + h) * N + s0;
    f32x4 r[32]; const float gv = gain ? gain[k0 + lane] : 1.0f;
#pragma unroll
    for (int i = 0; i < 32; ++i) r[i] = *(const GAS f32x4*)(src + (size_t)(2 * i) * N);
    if (gain) {
#pragma unroll
        for (int i = 0; i < 32; ++i) { const float g0 = __builtin_bit_cast(float, __builtin_amdgcn_readlane(__builtin_bit_cast(int, gv), 2 * i)), g1 = __builtin_bit_cast(float, __builtin_amdgcn_readlane(__builtin_bit_cast(int, gv), 2 * i + 1));
            r[i] *= (h ? g1 : g0); } }
#pragma unroll
    for (int c0 = 0; c0 < 4; c0 += 2) {
#pragma unroll
        for (int d = 0; d < 2; ++d) {
            unsigned p[16];
#pragma unroll
            for (int i = 0; i < 16; ++i) { const auto rr = __builtin_amdgcn_permlane32_swap(__float_as_uint(r[i][c0 + d]), __float_as_uint(r[i + 16][c0 + d]), false, false);
                p[i] = pg8::cvt_pk_bf16(__uint_as_float(rr[0]), __uint_as_float(rr[1])); }
            const int rl = 2 * cl + d;
#pragma unroll
            for (int q = 0; q < 4; ++q) { v4u o; o.x = p[4 * q]; o.y = p[4 * q + 1]; o.z = p[4 * q + 2]; o.w = p[4 * q + 3];
                *(LAS v4u*)(scr + rl * 128 + (((4 * h + q) ^ (rl & 7)) << 4)) = o; }
        }
        LDS_WAIT(); asm volatile("" ::: "memory");
        v4u o[8];
#pragma unroll
        for (int j = 0; j < 8; ++j) { const int rl = (lane >> 3) + 8 * j; o[j] = *(const LAS v4u*)(scr + rl * 128 + (((lane & 7) ^ (rl & 7)) << 4)); }
        LDS_WAIT(); asm volatile("" ::: "memory");
#pragma unroll
        for (int j = 0; j < 8; ++j) { const int rl = (lane >> 3) + 8 * j; const int sc = 128 * nb + 4 * (rl >> 1) + c0 + (rl & 1);
            *(GAS v4u*)(WT + (size_t)wt_row<CMAP>(sc) * ldw + k0 + 8 * (lane & 7)) = o[j]; }
    }
}
__device__ __forceinline__ void convert_item(const float* W, bf16* WO, int ldw, int item, int lane, const float* gain) {
    const int kb = item / 64, nb = item % 64, k0 = 64 * kb, n0 = 32 * nb; const int kk = lane >> 3, c4 = (lane & 7) * 4;
    f32x4 v[8]; float g[8];
#pragma unroll
    for (int i = 0; i < 8; ++i) { const int k = k0 + 8 * i + kk; v[i] = *(const GAS f32x4*)(W + (size_t)k * DM_ + n0 + c4); g[i] = gain[k]; }
#pragma unroll
    for (int i = 0; i < 8; ++i) { const int k = k0 + 8 * i + kk;
        *(GAS unsigned long long*)(WO + (size_t)k * ldw + n0 + c4) = (unsigned long long)pk2(v[i].x * g[i], v[i].y * g[i]) | ((unsigned long long)pk2(v[i].z * g[i], v[i].w * g[i]) << 32); }
}
__device__ __forceinline__ void convert_item_w(const float* W, bf16* WO, int ldw, int item, int lane, const float* gain) {
    const int kb = item / 16, nb = item % 16, k0 = 64 * kb, h = lane >> 5, n0 = 128 * nb + 4 * (lane & 31);
    const float* src = W + (size_t)(k0 + h) * DM_ + n0; bf16* dst = WO + (size_t)(k0 + h) * ldw + n0;
    f32x4 r[32]; const float gv = gain[k0 + lane];
#pragma unroll
    for (int i = 0; i < 32; ++i) r[i] = *(const GAS f32x4*)(src + (size_t)(2 * i) * DM_);
#pragma unroll
    for (int i = 0; i < 32; ++i) { const float g0 = __builtin_bit_cast(float, __builtin_amdgcn_readlane(__builtin_bit_cast(int, gv), 2 * i)), g1 = __builtin_bit_cast(float, __builtin_amdgcn_readlane(__builtin_bit_cast(int, gv), 2 * i + 1));
        const f32x4 v = r[i] * (h ? g1 : g0);
        *(GAS unsigned long long*)(dst + (size_t)(2 * i) * ldw) = (unsigned long long)pg8::cvt_pk_bf16(v.x, v.y) | ((unsigned long long)pg8::cvt_pk_bf16(v.z, v.w) << 32); }
}
constexpr int LATE_ITEMS = 6528, LATE_ITEMS_IN = 3840, CHUNK_ITEMS = 32;
typedef const __attribute__((address_space(4))) unsigned char* kargp_t;
__device__ __forceinline__ const float* karg_in(kargp_t kp, int k) { return *(const float* const __attribute__((address_space(4)))*)(kp + 8 * k); }
__device__ __forceinline__ void late_item(kargp_t kp, unsigned char* ws, int l, int r, LAS unsigned char* scr, int lane) {
    if (r < 768) { const int br = r >> 8; transpose_item_w<0, MIXW>(karg_in(kp, 11) + ((size_t)l * 3 + br) * MIXW * DM_, DM_, (bf16*)(ws + W_BR) + (size_t)br * DM_ * LD1K, LD1K, scr, r & 255, lane); return; } r -= 768;
    if (r < 512) { transpose_item_w<0, DM_>(karg_in(kp, 12) + (size_t)l * DM_ * DM_, DM_, (bf16*)(ws + W_OUT), LD2K, scr, r, lane); return; } r -= 512;
    if (r < 512) { convert_item_w(karg_in(kp, 15) + (size_t)l * DM_ * DM_, (bf16*)(ws + W_Q), LD2K, r, lane, karg_in(kp, 13) + (size_t)l * DM_); return; } r -= 512;
    if (r < 512) { transpose_item_w<0, DM_>(karg_in(kp, 17) + (size_t)l * DM_ * DM_, DM_, (bf16*)(ws + W_O), LD2K, scr, r, lane); return; } r -= 512;
    if (r < 2816) { transpose_item_w<1, DM_>(karg_in(kp, 19) + (size_t)l * DM_ * 2 * FFH, 2 * FFH, (bf16*)(ws + W_13), LD2K, scr, r, lane, karg_in(kp, 18) + (size_t)l * DM_); return; } r -= 2816;
    if (r < 1408) { transpose_item_w<0, FFH>(karg_in(kp, 20) + (size_t)l * FFH * DM_, DM_, (bf16*)(ws + W_2), LDFF, scr, r, lane); return; } r -= 1408;
    transpose_item_w<2, DM_>(karg_in(kp, 3) + (size_t)(l + 1) * DM_ * INC, INC, (bf16*)(ws + W_IN), LD2K, scr, r, lane, karg_in(kp, 2) + (size_t)(l + 1) * DM_);
}
template <bool TOF32> __device__ __forceinline__ void rms_row(int lane, const float* xrow, const float* gain, void* orow) {
    const GAS f32x4* xr = (const GAS f32x4*)xrow + lane; const GAS f32x4* gr = (const GAS f32x4*)gain + lane;
    f32x4 v[8]; float s = 0.f;
#pragma unroll
    for (int j = 0; j < 8; ++j) { v[j] = xr[64 * j]; s += (v[j].x * v[j].x + v[j].y * v[j].y) + (v[j].z * v[j].z + v[j].w * v[j].w); }
    const float r = 1.0f / sqrtf(wave_sum(s) * (1.f / 2048.f) + EPSN);
#pragma unroll
    for (int j = 0; j < 8; ++j) { const f32x4 g = gr[64 * j]; const f32x4 y = v[j] * r * g;
        if (TOF32) ((GAS f32x4*)orow + lane)[64 * j] = y;
        else ((GAS unsigned long long*)orow + lane)[64 * j] = (unsigned long long)pk2(y.x, y.y) | ((unsigned long long)pk2(y.z, y.w) << 32); }
}

__device__ __forceinline__ void ph_prep(Frame& F, const Args& args, int l, const float* xcur) {
    PH_ENTER();
    LAS float* scr = (LAS float*)(F.lds + RING_OFF + wave * 16384);
    const int gw = vcu_ * NWAVES + wave, NGW = G_ * NWAVES;
    constexpr int I_IN = 32 * (INC / 128), I_KV = 32 * 32;
    if (l == 0) for (int it = gw; it < I_IN + I_KV; it += NGW) {
        int r = it;
        if (r < I_IN) { transpose_item_w<2, DM_>(args.in[3], INC, (bf16*)(ws + W_IN), LD2K, (LAS unsigned char*)scr, r, lane, args.in[2]); continue; } r -= I_IN;
        transpose_item_w<0, DM_>(args.in[16], 2 * DM_, (bf16*)(ws + W_KV), LD2K, (LAS unsigned char*)scr, r, lane);
        transpose_item_w<0, DM_>(args.in[16] + (size_t)DM_ * 2 * DM_, 2 * DM_, (bf16*)((unsigned char*)args.out + DO_WKV1), LD2K, (LAS unsigned char*)scr, r, lane);
    }
    if (l == 0) for (int m = gw; m < M; m += NGW) {
        const GAS f32x4* xr = (const GAS f32x4*)(xcur + (size_t)m * DM_) + lane; GAS unsigned long long* orow = (GAS unsigned long long*)((bf16*)(ws + WS_XN) + (size_t)m * LD2K) + lane; float sq = 0.f;
#pragma unroll
        for (int j = 0; j < 8; ++j) { const f32x4 v = xr[64 * j]; sq += (v.x * v.x + v.y * v.y) + (v.z * v.z + v.w * v.w); orow[64 * j] = (unsigned long long)pk2(v.x, v.y) | ((unsigned long long)pk2(v.z, v.w) << 32); }
        sq = wave_sum(sq); if (lane < 32) ((float*)(ws + WS_RSS))[((size_t)(lane >> 2) * M + (size_t)m) * 4 + (lane & 3)] = lane == 0 ? sq : 0.f; }
    if (l == 0) for (int m = gw; m < MEMROWS; m += NGW) { rms_row<false>(lane, args.in[1] + (size_t)m * DM_, args.in[14], (bf16*)(ws + WS_MN) + (size_t)m * DM_);
                                                         rms_row<false>(lane, args.in[1] + (size_t)m * DM_, args.in[14] + DM_, (bf16*)((unsigned char*)args.out + DO_MN1) + (size_t)m * DM_); }
    if (l == 1) { const int gt = vcu_ * (NWAVES * 64) + tid, NGT = G_ * NWAVES * 64;
        const GAS v4u* src = (const GAS v4u*)((const unsigned char*)args.out + DO_KV1); GAS v4u* dst = (GAS v4u*)(ws + WS_KM);
        for (int e = gt; e < 2 * MEMROWS * LD2K / 8; e += NGT) dst[e] = src[e]; }
    if (l == 0 && vcu_ == 0 && wave == 0) {
#pragma unroll
        for (int ll = 0; ll < DEPTH; ++ll) { const float* dl = args.in[4] + (size_t)ll * 256;
            const float s01 = wave_sum(dl[lane] * dl[64 + lane]), s23 = wave_sum(dl[128 + lane] * dl[192 + lane]);
            const float linit = 0.8f - 0.6f * expf(-0.3f * (float)ll);
            float* fz = (float*)(ws + WS_LAM) + 192 * ll;
            if (lane == 0) { fz[0] = expf(s01) - expf(s23) + linit; fz[1] = 1.0f - linit; }
            fz[2 + lane] = args.in[5][(size_t)ll * 128 + lane] * (1.0f - linit); fz[66 + lane] = args.in[5][(size_t)ll * 128 + 64 + lane] * (1.0f - linit); } }
    if (l == 0) {
        const int gt = vcu_ * (NWAVES * 64) + tid, NGT = G_ * NWAVES * 64;
        for (int e = gt; e < 2048 * 96; e += NGT) {
            const int t = e / 96, i = e % 96; float inv; float* dst;
            if (i < 32) { dst = (float*)(ws + WS_DCS) + ((size_t)t * 32 + i) * 2; }
            else { dst = (float*)(ws + WS_RCS) + ((size_t)t * 64 + (i - 32)) * 2; }
            inv = ROPE_INV[i];
            const float ang = (float)t * inv;
            const float CH = 0.15915494f, CL = 6.4206382e-09f;
            const float p = ang * CH, pe = fmaf(ang, CH, -p) + ang * CL; const float fr = (p - floorf(p)) + pe;
            dst[0] = __builtin_amdgcn_cosf(fr); dst[1] = __builtin_amdgcn_sinf(fr);
        }
    }
}

__device__ __forceinline__ void ph_rope(Frame& F, const Args& args) {
    PH_ENTER();
    const int gw = vcu_ * NWAVES + wave, NGW = G_ * NWAVES;
    for (int it = gw; it < 4 * M; it += NGW) {
        const int sel = it / M, row = it % M, t = row % NT_;
        const int seg = sel == 0 ? 0 : sel == 1 ? 1 : sel == 2 ? 5 : 6;
        bf16* base = (bf16*)(ws + WS_BIG + (size_t)seg * SEG) + (size_t)row * 1024;
        int c1, c2; const float* tab; float sc;
        if (sel < 2) { const int blk = lane >> 2, d0 = (lane & 3) * 8; c1 = blk * 64 + d0; c2 = c1 + 32; tab = (const float*)(ws + WS_DCS) + ((size_t)t * 32 + d0) * 2; sc = sel == 0 ? 0.125f * LOG2E : 1.0f; }
        else { const int blk = lane >> 3, d0 = (lane & 7) * 8; c1 = blk * 128 + d0; c2 = c1 + 64; tab = (const float*)(ws + WS_RCS) + ((size_t)t * 64 + d0) * 2; sc = sel == 2 ? 0.08838834764831845f : 1.0f; }
        const v4u a = *(const GAS v4u*)(base + c1), b = *(const GAS v4u*)(base + c2);
        const GAS f32x4* tb = (const GAS f32x4*)tab; const f32x4 t0 = tb[0], t1 = tb[1], t2 = tb[2], t3 = tb[3];
        const float cs[8] = {t0.x, t0.z, t1.x, t1.z, t2.x, t2.z, t3.x, t3.z}, sn[8] = {t0.y, t0.w, t1.y, t1.w, t2.y, t2.w, t3.y, t3.w};
        const unsigned aw[4] = {a.x, a.y, a.z, a.w}, bw[4] = {b.x, b.y, b.z, b.w}; unsigned oa[4], ob[4];
#pragma unroll
        for (int j = 0; j < 4; ++j) {
            const float x1l = bflo(aw[j]), x1h = bfhi(aw[j]), x2l = bflo(bw[j]), x2h = bfhi(bw[j]);
            const float y1l = (x1l * cs[2 * j] - x2l * sn[2 * j]) * sc, y2l = (x2l * cs[2 * j] + x1l * sn[2 * j]) * sc;
            const float y1h = (x1h * cs[2 * j + 1] - x2h * sn[2 * j + 1]) * sc, y2h = (x2h * cs[2 * j + 1] + x1h * sn[2 * j + 1]) * sc;
            oa[j] = pk2(y1l, y1h); ob[j] = pk2(y2l, y2h);
        }
        v4u wa; wa.x = oa[0]; wa.y = oa[1]; wa.z = oa[2]; wa.w = oa[3]; v4u wb; wb.x = ob[0]; wb.y = ob[1]; wb.z = ob[2]; wb.w = ob[3];
        *(GAS v4u*)(base + c1) = wa; *(GAS v4u*)(base + c2) = wb;
    }
}

__device__ __forceinline__ void ph_conv(Frame& F, const Args& args, int l, int ustart, int uend) {
    PH_ENTER();
    const bf16* U = (const bf16*)(ws + WS_BIG + 3 * SEG);
    bf16* YB = (bf16*)(ws + WS_Y) + SEG_E;
    const int c0 = 2 * tid;
    const float* cw = args.in[6] + (size_t)l * 31 * 1024;
    typedef float f32x2c __attribute__((ext_vector_type(2)));
    f32x2c w2[31];
#pragma unroll
    for (int j = 0; j < 31; ++j) { const float2 w = *(const float2*)(cw + j * 1024 + c0); w2[j] = (f32x2c){w.x, w.y}; }
    const float2 bias = *(const float2*)(args.in[7] + (size_t)l * 1024 + c0), lg = *(const float2*)(args.in[8] + (size_t)l * 1024 + c0), lb = *(const float2*)(args.in[9] + (size_t)l * 1024 + c0);
    LAS unsigned char* Us = F.lds + RING_OFF;
    LAS float* red1 = (LAS float*)(F.lds + RING_OFF + 46 * 2048); LAS float* red2 = red1 + 16 * 8;
    for (int unit = ustart; unit < uend; ++unit) {
        const int b = unit >> 7, t0 = (unit & 127) * 16;
#pragma unroll
        for (int i = 0; i < 12; ++i) { const int idx = tid + 512 * i; const int r = idx >> 7, ch = idx & 127;
            if (idx < 46 * 128) { const int tg = t0 - 30 + r; v4u v; v.x = 0u; v.y = 0u; v.z = 0u; v.w = 0u;
                if (tg >= 0) v = *(const GAS v4u*)(U + ((size_t)b * NT_ + tg) * 1024 + ch * 8);
                *(LAS v4u*)(Us + r * 2048 + ch * 16) = v; } }
        __syncthreads();
        f32x2c acc2[16];
#pragma unroll
        for (int t = 0; t < 16; ++t) acc2[t] = (f32x2c){0.f, 0.f};
#pragma unroll
        for (int r = 0; r < 46; ++r) {
            const unsigned uw = *(const LAS unsigned*)(Us + r * 2048 + tid * 4);
            const f32x2c u2 = {bflo(uw), bfhi(uw)};
#pragma unroll
            for (int t = 0; t < 16; ++t) { const int j = r - t; if (j >= 0 && j <= 30) acc2[t] = __builtin_elementwise_fma(u2, w2[j], acc2[t]); }
        }
        float a0[16], a1[16];
#pragma unroll
        for (int t = 0; t < 16; ++t) { a0[t] = acc2[t].x; a1[t] = acc2[t].y; }
        float mu[16];
#pragma unroll
        for (int t = 0; t < 16; ++t) { a0[t] += bias.x; a1[t] += bias.y; const float s = wave_total(a0[t] + a1[t]); if (lane == 0) red1[t * 8 + wave] = s; }
        __syncthreads();
#pragma unroll
        for (int t = 0; t < 16; ++t) { float s = 0.f;
#pragma unroll
            for (int w = 0; w < 8; ++w) s += red1[t * 8 + w];
            mu[t] = s * (1.f / 1024.f); a0[t] -= mu[t]; a1[t] -= mu[t];
            const float q = wave_total(a0[t] * a0[t] + a1[t] * a1[t]); if (lane == 0) red2[t * 8 + wave] = q; }
        __syncthreads();
#pragma unroll
        for (int t = 0; t < 16; ++t) { float q = 0.f;
#pragma unroll
            for (int w = 0; w < 8; ++w) q += red2[t * 8 + w];
            const float rs = 1.0f / sqrtf(q * (1.f / 1024.f) + EPSN);
            const float y0 = a0[t] * rs * lg.x + lb.x, y1 = a1[t] * rs * lg.y + lb.y;
            *(GAS unsigned*)(YB + ((size_t)b * NT_ + t0 + t) * 1024 + c0) = pk2(y0 * sigm(y0), y1 * sigm(y1)); }
    }
    __syncthreads();
}
__device__ __forceinline__ int sw_off(int row, int col) { return row * 256 + ((((col >> 3) ^ (row & 15)) << 4) | ((col & 7) << 1)); }
__device__ __forceinline__ void ph_ret_seq(Frame& F, const Args& args, int l, int bh) {
    PH_ENTER();
    typedef short bf16x8v __attribute__((ext_vector_type(8)));
    LAS unsigned char* Ks = F.lds + RING_OFF; LAS unsigned char* KTs = Ks + 32768; LAS unsigned char* VTs = KTs + 32768; LAS unsigned char* STs = VTs + 32768;
    const bf16* RQ = (const bf16*)(ws + WS_BIG + 5 * SEG); const bf16* RK = (const bf16*)(ws + WS_BIG + 6 * SEG); const bf16* RV = (const bf16*)(ws + WS_BIG + 7 * SEG); const bf16* RG = (const bf16*)(ws + WS_BIG + 8 * SEG);
    bf16* YRo = (bf16*)(ws + WS_Y) + 2 * SEG_E;
    const float* gng = args.in[10] + (size_t)l * 1024;
    const int wid = wave;
    const int b = bh >> 3, h = bh & 7;
    const float lg2 = log2f(1.0f - exp2f(-5.0f - (float)h));
    const float cdec = exp2f(128.0f * lg2);
    f32x4 st[8];
#pragma unroll
    for (int c = 0; c < 8; ++c) st[c] = (f32x4){0.f, 0.f, 0.f, 0.f};
    for (int e = tid; e < 8192; e += NWAVES * 64) ((LAS unsigned*)STs)[e] = 0u;
    bf16x8v qa[4]; v4u kq[4], vq[4];
    { const size_t r0 = (size_t)b * NT_; const int fr0 = lane & 15, fq0 = lane >> 4;
#pragma unroll
      for (int ks = 0; ks < 4; ++ks) qa[ks] = *(const GAS bf16x8v*)(RQ + (r0 + 16 * wid + fr0) * 1024 + h * 128 + ks * 32 + fq0 * 8);
#pragma unroll
      for (int i = 0; i < 4; ++i) { const int r = lane + 64 * (i & 1), cc = 2 * wid + (i >> 1); const size_t go = (r0 + r) * 1024 + h * 128 + cc * 8;
          kq[i] = *(const GAS v4u*)(RK + go); vq[i] = *(const GAS v4u*)(RV + go); } }
    for (int n = 0; n < 16; ++n) {
        const size_t row0 = (size_t)b * NT_ + (size_t)n * 128;
        int lane_n = lane; asm volatile("" : "+v"(lane_n)); const int fr = lane_n & 15, fq = lane_n >> 4;
        float lgn = lg2; asm volatile("" : "+v"(lgn));
#pragma unroll
        for (int i = 0; i < 4; ++i) { const int r = lane_n + 64 * (i & 1), cc = 2 * wid + (i >> 1);
            const v4u k = kq[i], v = vq[i];
            *(LAS v4u*)(Ks + sw_off(r, cc * 8)) = k;
            const float kd = __builtin_amdgcn_exp2f((float)(127 - r) * lgn); const unsigned kw[4] = {k.x, k.y, k.z, k.w}, vw[4] = {v.x, v.y, v.z, v.w};
#pragma unroll
            for (int j = 0; j < 4; ++j) {
                *(LAS bf16*)(KTs + sw_off(cc * 8 + 2 * j, r)) = (bf16)f2bf(bflo(kw[j]) * kd); *(LAS bf16*)(KTs + sw_off(cc * 8 + 2 * j + 1, r)) = (bf16)f2bf(bfhi(kw[j]) * kd);
                *(LAS bf16*)(VTs + sw_off(cc * 8 + 2 * j, r)) = (bf16)(vw[j] & 0xffffu); *(LAS bf16*)(VTs + sw_off(cc * 8 + 2 * j + 1, r)) = (bf16)(vw[j] >> 16); }
            if (i & 1) asm volatile("" ::: "memory"); }
        __syncthreads();
        unsigned Pk[8][2]; f32x4 o[8];
#pragma unroll
        for (int c = 0; c < 8; ++c) { f32x4 Sc = (f32x4){0.f, 0.f, 0.f, 0.f};
#pragma unroll
            for (int ks = 0; ks < 4; ++ks) { const bf16x8v kb = *(const LAS bf16x8v*)(Ks + sw_off(16 * c + fr, ks * 32 + fq * 8));
                Sc = __builtin_amdgcn_mfma_f32_16x16x32_bf16(qa[ks], kb, Sc, 0, 0, 0); }
            float p4[4];
#pragma unroll
            for (int rg = 0; rg < 4; ++rg) { const int tl = 16 * wid + 4 * fq + rg, sl = 16 * c + fr; p4[rg] = sl <= tl ? Sc[rg] * __builtin_amdgcn_exp2f((float)(tl - sl) * lgn) : 0.f; }
            Pk[c][0] = pk2(p4[0], p4[1]); Pk[c][1] = pk2(p4[2], p4[3]);
            asm volatile("" ::: "memory"); }
#pragma unroll
        for (int c = 0; c < 8; ++c) { o[c] = (f32x4){0.f, 0.f, 0.f, 0.f};
#pragma unroll
            for (int ks = 0; ks < 4; ++ks) { const bf16x8v sb = *(const LAS bf16x8v*)(STs + sw_off(16 * c + fr, ks * 32 + fq * 8));
                o[c] = __builtin_amdgcn_mfma_f32_16x16x32_bf16(qa[ks], sb, o[c], 0, 0, 0); }
#pragma unroll
            for (int rg = 0; rg < 4; ++rg) o[c][rg] *= __builtin_amdgcn_exp2f((float)(16 * wid + 4 * fq + rg + 1) * lgn);
            asm volatile("" ::: "memory"); }
        {
            bf16x8v va[4];
#pragma unroll
            for (int ks = 0; ks < 4; ++ks) va[ks] = *(const LAS bf16x8v*)(VTs + sw_off(16 * wid + fr, ks * 32 + fq * 8));
#pragma unroll
            for (int c = 0; c < 8; ++c) { st[c] = st[c] * cdec;
#pragma unroll
                for (int ks = 0; ks < 4; ++ks) { const bf16x8v kb = *(const LAS bf16x8v*)(KTs + sw_off(16 * c + fr, ks * 32 + fq * 8));
                    st[c] = __builtin_amdgcn_mfma_f32_16x16x32_bf16(va[ks], kb, st[c], 0, 0, 0); }
                asm volatile("" ::: "memory"); }
        }
        __syncthreads();
        v4u gq[4];
#pragma unroll
        for (int i = 0; i < 4; ++i) gq[i] = *(const GAS v4u*)(RG + (row0 + 16 * wid + (lane_n >> 4) + 4 * i) * 1024 + h * 128 + (lane_n & 15) * 8);
        bf16x8v qn[4];
        if (n + 1 < 16) { const size_t r1 = row0 + 128;
#pragma unroll
            for (int ks = 0; ks < 4; ++ks) qn[ks] = *(const GAS bf16x8v*)(RQ + (r1 + 16 * wid + fr) * 1024 + h * 128 + ks * 32 + fq * 8);
#pragma unroll
            for (int i = 0; i < 4; ++i) { const int r = lane_n + 64 * (i & 1), cc = 2 * wid + (i >> 1); const size_t go = (r1 + r) * 1024 + h * 128 + cc * 8;
                kq[i] = *(const GAS v4u*)(RK + go); vq[i] = *(const GAS v4u*)(RV + go); } }
        else {
#pragma unroll
            for (int ks = 0; ks < 4; ++ks) qn[ks] = qa[ks]; }
#pragma unroll
        for (int c = 0; c < 8; ++c)
#pragma unroll
            for (int rg = 0; rg < 4; ++rg) { const int tl = 16 * wid + 4 * fq + rg, sl = 16 * c + fr;
                *(LAS bf16*)(Ks + sw_off(tl, sl)) = (bf16)((rg & 1) ? (Pk[c][rg >> 1] >> 16) : (Pk[c][rg >> 1] & 0xffffu));
                *(LAS bf16*)(STs + sw_off(tl, sl)) = (bf16)f2bf(st[c][rg]); }
        LDS_WAIT(); asm volatile("" ::: "memory");
        bf16x8v pa[4];
#pragma unroll
        for (int ks = 0; ks < 4; ++ks) pa[ks] = *(const LAS bf16x8v*)(Ks + sw_off(16 * wid + fr, ks * 32 + fq * 8));
#pragma unroll
        for (int c = 0; c < 8; ++c) {
#pragma unroll
            for (int ks = 0; ks < 4; ++ks) { const bf16x8v vb = *(const LAS bf16x8v*)(VTs + sw_off(16 * c + fr, ks * 32 + fq * 8));
                o[c] = __builtin_amdgcn_mfma_f32_16x16x32_bf16(pa[ks], vb, o[c], 0, 0, 0); }
            asm volatile("" ::: "memory"); }
        float mu[4], rs[4];
#pragma unroll
        for (int rg = 0; rg < 4; ++rg) { float s = 0.f;
#pragma unroll
            for (int c = 0; c < 8; ++c) s += o[c][rg];
            s = pg8::xadd<1>(s); s = pg8::xadd<2>(s); s = pg8::xadd<4>(s); s = pg8::xadd<8>(s); mu[rg] = s * (1.f / 128.f);
            float q = 0.f;
#pragma unroll
            for (int c = 0; c < 8; ++c) { const float d = o[c][rg] - mu[rg]; q += d * d; }
            q = pg8::xadd<1>(q); q = pg8::xadd<2>(q); q = pg8::xadd<4>(q); q = pg8::xadd<8>(q); rs[rg] = 1.0f / sqrtf(q * (1.f / 128.f) + EPSN); }
#pragma unroll
        for (int c = 0; c < 8; ++c)
#pragma unroll
            for (int rg = 0; rg < 4; ++rg) *(LAS bf16*)(Ks + sw_off(16 * wid + 4 * fq + rg, 16 * c + fr)) = (bf16)f2bf((o[c][rg] - mu[rg]) * rs[rg] * gng[h * 128 + 16 * c + fr]);
        LDS_WAIT(); asm volatile("" ::: "memory");
#pragma unroll
        for (int i = 0; i < 4; ++i) { const int r = 16 * wid + (lane_n >> 4) + 4 * i, cc = lane_n & 15;
            const v4u y = *(const LAS v4u*)(Ks + sw_off(r, cc * 8)); const size_t go = (row0 + r) * 1024 + h * 128 + cc * 8;
            const unsigned yw[4] = {y.x, y.y, y.z, y.w}, gw4[4] = {gq[i].x, gq[i].y, gq[i].z, gq[i].w}; unsigned ow[4];
#pragma unroll
            for (int j = 0; j < 4; ++j) { const float ga = bflo(gw4[j]), gb = bfhi(gw4[j]); ow[j] = pk2(ga * sigm(ga) * bflo(yw[j]), gb * sigm(gb) * bfhi(yw[j])); }
            v4u w; w.x = ow[0]; w.y = ow[1]; w.z = ow[2]; w.w = ow[3]; *(GAS v4u*)(YRo + go) = w; }
        __syncthreads();
#pragma unroll
        for (int ks = 0; ks < 4; ++ks) qa[ks] = qn[ks];
    }
}

__device__ __forceinline__ void ph_combine(Frame& F, const Args& args, int l) {
    PH_ENTER();
    const int gw = vcu_ * NWAVES + wave, NGW = G_ * NWAVES;
    const float* dl = args.in[4] + (size_t)l * 256;
    const float s01 = wave_sum(dl[lane] * dl[64 + lane]), s23 = wave_sum(dl[128 + lane] * dl[192 + lane]);
    const float linit = 0.8f - 0.6f * expf(-0.3f * (float)l);
    const float lam = expf(s01) - expf(s23) + linit;
    const float* subln = args.in[5] + (size_t)l * 128 + (lane & 7) * 16;
    float sl[16];
#pragma unroll
    for (int i = 0; i < 16; ++i) sl[i] = subln[i] * (1.0f - linit);
    const bf16* O0 = (const bf16*)args.out; const bf16* O1 = O0 + SEG_E;
    bf16* YA = (bf16*)(ws + WS_Y);
    for (int m = gw; m < M; m += NGW) {
        const size_t off = (size_t)m * 1024 + lane * 16;
        {   const v4u a0 = *(const GAS v4u*)(O0 + off), a1 = *(const GAS v4u*)(O0 + off + 8), b0 = *(const GAS v4u*)(O1 + off), b1 = *(const GAS v4u*)(O1 + off + 8);
            const unsigned aw[8] = {a0.x, a0.y, a0.z, a0.w, a1.x, a1.y, a1.z, a1.w}, bw[8] = {b0.x, b0.y, b0.z, b0.w, b1.x, b1.y, b1.z, b1.w};
            float d[16]; float ss = 0.f;
#pragma unroll
            for (int j = 0; j < 8; ++j) { d[2 * j] = bflo(aw[j]) - lam * bflo(bw[j]); d[2 * j + 1] = bfhi(aw[j]) - lam * bfhi(bw[j]); ss += d[2 * j] * d[2 * j] + d[2 * j + 1] * d[2 * j + 1]; }
            ss = pg8::xadd<1>(ss); ss = pg8::xadd<2>(ss); ss = pg8::xadd<4>(ss);
            const float r = 1.0f / sqrtf(ss * (1.f / 128.f) + EPSN);
            unsigned ow[8];
#pragma unroll
            for (int j = 0; j < 8; ++j) ow[j] = pk2(d[2 * j] * r * sl[2 * j], d[2 * j + 1] * r * sl[2 * j + 1]);
            v4u w0; w0.x = ow[0]; w0.y = ow[1]; w0.z = ow[2]; w0.w = ow[3]; v4u w1; w1.x = ow[4]; w1.y = ow[5]; w1.z = ow[6]; w1.w = ow[7];
            *(GAS v4u*)(YA + off) = w0; *(GAS v4u*)(YA + off + 8) = w1; }
    }
}

#ifndef MK_MULTI
#define MK_MULTI 0
#endif
template <int KLO, int KHI> __global__ void __launch_bounds__(NWAVES * 64, 2) mk_fwd(Args args) {
    extern __shared__ __attribute__((aligned(16))) unsigned char lds[];
    Frame F;
    F.lds = (LAS unsigned char*)lds;
    F.MISC = (volatile LAS unsigned*)(F.lds + MISC_OFF);
    F.wave = __builtin_amdgcn_readfirstlane((int)threadIdx.x >> 6); F.G = gridDim.x; { const int bx = blockIdx.x; F.vcu = (F.G % 8 == 0) ? (bx % 8) * (F.G / 8) + bx / 8 : bx; }
    for (int u = threadIdx.x; u < (LDS_BYTES - LDSCTL_OFF) / 4; u += NWAVES * 64) ((LAS unsigned*)(F.lds + LDSCTL_OFF))[u] = 0u;
    __syncthreads();
    XcdBarrier bar; bar.bar = (unsigned*)(args.ws + WS_CTL) + CW_BAR; bar.x = 0; bar.st = nullptr;
    if (!MK_MULTI) bar = xcd_barrier_post((unsigned*)(args.ws + WS_CTL) + CW_BAR, F.MISC + 8, threadIdx.x == 0);
#ifndef REP_MASK
#define REP_MASK 0u
#endif
#define NREP(k) ((((REP_MASK) >> (k)) & 1u) ? 2 : 1)
#define IN(k) (KLO <= (k) && (k) < KHI)
#define SEAM(k) do { if (!MK_MULTI && IN(k) && IN((k) + 1)) xcd_barrier(bar, F.wave == 0 && pg8::lane_id() == 0); } while (0)
#define PHP() unsigned char* ws = pg8::uni_ptr(args.ws); bf16* const XN = (bf16*)(ws + WS_XN); bf16* const BIGp = (bf16*)(ws + WS_BIG); const int bx = pg8::opq((int)blockIdx.x), G_ = pg8::opq(F.G); (void)XN; (void)BIGp; (void)bx; (void)G_

    for (int l = args.l_lo; l < args.l_hi; ++l) {
        constexpr int pb = 0;
        const float* xcur = args.in[0];
        if (IN(pb + 0)) for (int rep_ = 0; rep_ < NREP(0); ++rep_) ph_prep(F, args, l, xcur);
        SEAM(pb + 0);
        if (IN(pb + 1)) for (int rep_ = 0; rep_ < NREP(1); ++rep_) { PHP();
            { pg8::Gemm g{XN, (const bf16*)(ws + W_IN), LD2K, LD2K, DM_}; pg8::StaticOrder S; S.init(M, INC, G_, bx, LD2K, LD2K);
              pg8::EpiInProj E{BIGp, (const float*)(ws + WS_DCS), (const float*)(ws + WS_RCS), (const float*)(ws + WS_RSS) + (l == 0 ? 0 : 3 * RSS_STRIDE)};
              pg8::gemm_phase<pg8::EpiInProj, pg8::StaticOrder, true, true>(F.lds + RING_OFF, g, S, E, F.wave); }
            if (l == 0) {
            { pg8::Gemm g{(const bf16*)(ws + WS_MN), (const bf16*)(ws + W_KV), DM_, LD2K, DM_}; pg8::StaticOrder S; S.init(MEMROWS, 2 * DM_, G_, (bx + 128) % G_, DM_, LD2K);
              pg8::EpiBf16 E{(bf16*)(ws + WS_KM), LD2K, DM_, (size_t)MEMROWS * LD2K, 1.0f, nullptr};
              pg8::gemm_phase<pg8::EpiBf16, pg8::StaticOrder, true, true>(F.lds + RING_OFF, g, S, E, F.wave); }
            { pg8::Gemm g{(const bf16*)((unsigned char*)args.out + DO_MN1), (const bf16*)((unsigned char*)args.out + DO_WKV1), DM_, LD2K, DM_}; pg8::StaticOrder S; S.init(MEMROWS, 2 * DM_, G_, bx, DM_, LD2K);
              pg8::EpiBf16 E{(bf16*)((unsigned char*)args.out + DO_KV1), LD2K, DM_, (size_t)MEMROWS * LD2K, 1.0f, nullptr};
              pg8::gemm_phase<pg8::EpiBf16, pg8::StaticOrder, true, true>(F.lds + RING_OFF, g, S, E, F.wave); }
            }
        }
        SEAM(pb + 1);
        if (IN(pb + 3)) for (int rep_ = 0; rep_ < NREP(3); ++rep_) { PHP();
            const attn_body::bf16* Qp = (const attn_body::bf16*)BIGp; const attn_body::bf16* Kp = (const attn_body::bf16*)(BIGp + SEG_E); const attn_body::bf16* Vp = (const attn_body::bf16*)(BIGp + 2 * SEG_E);
            attn_body::bf16* Op = (attn_body::bf16*)args.out;
            unsigned* qctr = (unsigned*)(ws + WS_CTL) + CW_Q + 64 * (2 * l + rep_);
            const float* fzl = (const float*)(ws + WS_LAM) + 192 * l;
            const int nch = (LATE_ITEMS + (l + 1 < DEPTH ? LATE_ITEMS_IN : 0)) / CHUNK_ITEMS;
            for (;;) {
                if (F.wave == 0 && pg8::lane_id() == 0) { const unsigned idq = __hip_atomic_fetch_add(qctr, 1u, __ATOMIC_RELAXED, __HIP_MEMORY_SCOPE_AGENT); F.MISC[12] = idq; }
                __syncthreads();
                const int idq = pg8::opq((int)__builtin_amdgcn_readfirstlane((int)F.MISC[12]));
                if (idq >= 1088 + nch) break;
                int id = idq;
                if (idq >= 64) { const int j = idq - 64;
                    if (j < 3 * nch) { const int q = j / 3, rr = j - 3 * q;
                        if (rr == 2) {
                            LAS unsigned char* scr = (LAS unsigned char*)(F.lds + RING_OFF + F.wave * 16384);
                            kargp_t kp = (kargp_t)__builtin_amdgcn_kernarg_segment_ptr(); asm volatile("" : "+s"(kp)); int lane_q = pg8::lane_id(); asm volatile("" : "+v"(lane_q));
                            for (int i = 0; i < CHUNK_ITEMS / NWAVES; ++i) late_item(kp, ws, pg8::opq(l), CHUNK_ITEMS * q + pg8::opq(F.wave) + NWAVES * i, scr, lane_q);
                            __syncthreads(); continue; }
                        id = 64 + 2 * q + rr; }
                    else id = 64 + j - nch; }
                if (id < 64) ph_ret_seq(F, args, l, id);
                else if (id >= 320 && id < 832) { const int k2 = id - 320; ph_conv(F, args, l, 2 * k2, 2 * k2 + 2); }
                else { const int j = id < 320 ? id - 64 : id - 832 + 256;
                    const int qb = 7 - (j >> 6), g = j & 63, h8 = g & 7, b = g >> 3;
                    attn_body::attn_unit_w(F.wave, b, h8, 0, qb, Qp, Kp, Vp, Op, (char*)lds + RING_OFF, nullptr, nullptr);
                    attn_body::attn_unit_w(F.wave, b, h8, 1, qb, Qp, Kp, Vp, Op, (char*)lds + RING_OFF, (attn_body::bf16*)(ws + WS_Y), fzl); }
            }
            __syncthreads();
        }
        SEAM(pb + 3);
        if (IN(pb + 5)) for (int rep_ = 0; rep_ < NREP(5); ++rep_) { PHP();
            bf16* Y = (bf16*)(ws + WS_Y);
            pg8::Gemm g{Y, (const bf16*)(ws + W_BR), MIXW, LD1K, MIXW}; pg8::MergeOrder S; S.T.init(M, DM_, G_, bx, MIXW, LD1K);
            S.ystride = (unsigned)(SEG_E * 2); S.wstride = (unsigned)((size_t)DM_ * LD1K * 2);
            pg8::EpiMerge E{BIGp + 9 * SEG_E, BIGp};
            pg8::gemm_phase<pg8::EpiMerge, pg8::MergeOrder, true, true>(F.lds + RING_OFF, g, S, E, F.wave);
        }
        SEAM(pb + 5);
        if (IN(pb + 6))
#pragma unroll
        for (int rep_ = 0; rep_ < NREP(6); ++rep_) { PHP();
            { pg8::Gemm g{BIGp, (const bf16*)(ws + W_OUT), DM_, LD2K, DM_}; pg8::StaticOrder S; S.init(M, DM_, G_, bx, DM_, LD2K);
              pg8::EpiRes E{XN, rep_ ? BIGp + 11 * SEG_E : BIGp + 8 * SEG_E, LD2K, (float*)(ws + WS_RSS) + (size_t)(rep_ ? 6 : 1 + 3 * l) * RSS_STRIDE};
              pg8::gemm_phase<pg8::EpiRes, pg8::StaticOrder, true, true>(F.lds + RING_OFF, g, S, E, F.wave); }
            { pg8::Gemm g{(const bf16*)ws, (const bf16*)ws, LD2K, LD2K, 512};
              pg8::XprodOrder S{G_, bx, (unsigned)LD2K, (unsigned)WS_KM, (unsigned)(WS_KM + (size_t)MEMROWS * LD2K * 2), (unsigned)W_Q, (unsigned)W_O};
              pg8::EpiBf16Two E{(bf16*)(ws + WS_YRAW), DM_, (bf16*)(ws + WS_YRAW) + SEG_E, 1024};
              pg8::gemm_phase<pg8::EpiBf16Two, pg8::XprodOrder, true, true>(F.lds + RING_OFF, g, S, E, F.wave); }
        }
        SEAM(pb + 6);
        if (IN(pb + 8)) for (int rep_ = 0; rep_ < NREP(8); ++rep_) { PHP();
            pg8::Gemm g{BIGp + 8 * SEG_E, (const bf16*)(ws + WS_YRAW), LD2K, DM_, DM_}; pg8::XsOrder S{G_, bx, LD2K};
            pg8::EpiSoftmax E{BIGp + 2 * SEG_E, 1024, 0.044194173824159216f * LOG2E, (const float*)(ws + WS_RSS) + (size_t)(1 + 3 * l) * RSS_STRIDE};
            pg8::gemm_phase<pg8::EpiSoftmax, pg8::XsOrder, false, true>(F.lds + RING_OFF, g, S, E, F.wave);
        }
        SEAM(pb + 8);
        if (IN(pb + 12))
#pragma unroll
        for (int rep_ = 0; rep_ < NREP(12); ++rep_) { PHP();
            pg8::Gemm g{BIGp + 2 * SEG_E, (const bf16*)(ws + WS_YRAW) + SEG_E, 1024, 1024, 1024}; pg8::XoOrder S{G_, bx};
            pg8::EpiRes E{BIGp + 8 * SEG_E, rep_ ? BIGp + 11 * SEG_E : XN, LD2K, (float*)(ws + WS_RSS) + (size_t)(rep_ ? 6 : 2 + 3 * l) * RSS_STRIDE};
            pg8::gemm_phase<pg8::EpiRes, pg8::XoOrder, true, true>(F.lds + RING_OFF, g, S, E, F.wave);
        }
        SEAM(pb + 12);
        if (IN(pb + 14)) for (int rep_ = 0; rep_ < NREP(14); ++rep_) { PHP();
            pg8::Gemm g{XN, (const bf16*)(ws + W_13), LD2K, LD2K, DM_}; pg8::StaticOrder S; S.init(M, 2 * FFH, G_, bx, LD2K, LD2K);
            pg8::EpiSwiGLU E{BIGp, FFH, (const float*)(ws + WS_RSS) + (size_t)(2 + 3 * l) * RSS_STRIDE};
            pg8::gemm_phase<pg8::EpiSwiGLU, pg8::StaticOrder, true, true>(F.lds + RING_OFF, g, S, E, F.wave);
        }
        SEAM(pb + 14);
        if (IN(pb + 15))
#pragma unroll
        for (int rep_ = 0; rep_ < NREP(15); ++rep_) { PHP();
            pg8::Gemm g{BIGp, (const bf16*)(ws + W_2), FFH, LDFF, FFH}; pg8::StaticOrder S; S.init(M, DM_, G_, bx, FFH, LDFF);
            pg8::EpiRes E{XN, rep_ ? BIGp + 11 * SEG_E : XN, LD2K, (float*)(ws + WS_RSS) + (size_t)(rep_ ? 6 : 3 + 3 * l) * RSS_STRIDE};
            pg8::gemm_phase<pg8::EpiRes, pg8::StaticOrder, true, true>(F.lds + RING_OFF, g, S, E, F.wave);
        }
        SEAM(pb + 15);
    }
    if (IN(NPH)) { PH_ENTER(); const bf16* XB = (const bf16*)(ws + WS_XN); const float* rp = (const float*)(ws + WS_RSS) + (size_t)(3 * DEPTH) * RSS_STRIDE; const int gw = vcu_ * NWAVES + wave, NGW = G_ * NWAVES;
        for (int m = gw; m < M; m += NGW) {
            float sv = lane < 32 ? rp[((size_t)(lane >> 2) * M + (size_t)m) * 4 + (lane & 3)] : 0.f; sv = wave_sum(sv); const float r = 1.0f / sqrtf(sv * (1.f / 2048.f) + EPSN);
            const GAS v4u* xr = (const GAS v4u*)(XB + (size_t)m * LD2K) + lane; const GAS f32x4* gr = (const GAS f32x4*)args.in[21] + 2 * lane; GAS f32x4* orow = (GAS f32x4*)(args.out + (size_t)m * DM_) + 2 * lane;
#pragma unroll
            for (int j = 0; j < 4; ++j) { const v4u x = xr[64 * j]; const f32x4 g0 = gr[128 * j], g1 = gr[128 * j + 1];
                orow[128 * j] = (f32x4){bflo(x.x) * r * g0.x, bfhi(x.x) * r * g0.y, bflo(x.y) * r * g0.z, bfhi(x.y) * r * g0.w};
                orow[128 * j + 1] = (f32x4){bflo(x.z) * r * g1.x, bfhi(x.z) * r * g1.y, bflo(x.w) * r * g1.z, bfhi(x.w) * r * g1.w}; } } }
#undef IN
#undef SEAM
}

extern "C" void kernel_launch(void* const* d_in, const int* in_sizes, int n_in, void* d_out, int out_size, void* d_ws, size_t ws_size, hipStream_t stream) {
    static int grid = 0; static bool first = true;
    if (grid == 0) {
        if (n_in != 22 || in_sizes[0] != M * DM_ || out_size != M * DM_ || ws_size < WS_END) { fprintf(stderr, "kernel_launch: unexpected shapes / workspace (n_in %d, in0 %d, out %d, ws %zu, need %zu); nothing launched\n", n_in, n_in > 0 ? in_sizes[0] : -1, out_size, ws_size, (size_t)WS_END); grid = -1; return; }
        int dev = 0, cus = 0, per_cu = 0;
        if (hipGetDevice(&dev) != hipSuccess || hipDeviceGetAttribute(&cus, hipDeviceAttributeMultiprocessorCount, dev) != hipSuccess) { grid = -1; return; }
        if (hipFuncSetAttribute((const void*)mk_fwd<MK_MULTI ? NPH : 0, NPH + 1>, hipFuncAttributeMaxDynamicSharedMemorySize, LDS_BYTES) != hipSuccess) { fprintf(stderr, "kernel_launch: hipFuncSetAttribute failed\n"); grid = -1; return; }
        if (hipOccupancyMaxActiveBlocksPerMultiprocessor(&per_cu, (const void*)mk_fwd<MK_MULTI ? NPH : 0, NPH + 1>, NWAVES * 64, LDS_BYTES) != hipSuccess || per_cu < 1) fprintf(stderr, "kernel_launch: occupancy query reports %d\n", per_cu);
        (void)hipGetLastError();
        grid = cus;
    }
    if (grid < 0) return;
    if (hipMemsetAsync((char*)d_ws + WS_CTL, 0, CTL_ZERO_BYTES, stream) != hipSuccess) return;
    Args a{};
    for (int i = 0; i < 22; ++i) a.in[i] = (const float*)d_in[i];
    a.out = (float*)d_out; a.ws = (unsigned char*)d_ws;
#if MK_MULTI
#define LAUNCH_K(K) do { if (first) (void)hipFuncSetAttribute((const void*)mk_fwd<K, K + 1>, hipFuncAttributeMaxDynamicSharedMemorySize, LDS_BYTES); hipLaunchKernelGGL((mk_fwd<K, K + 1>), dim3(grid), dim3(NWAVES * 64), LDS_BYTES, stream, a); } while (0)
    for (int l = 0; l < DEPTH; ++l) { a.l_lo = l; a.l_hi = l + 1;
        LAUNCH_K(0); LAUNCH_K(1); LAUNCH_K(2); LAUNCH_K(3); LAUNCH_K(4); LAUNCH_K(5); LAUNCH_K(6); LAUNCH_K(7); LAUNCH_K(8); LAUNCH_K(9); LAUNCH_K(10); LAUNCH_K(11); LAUNCH_K(12); LAUNCH_K(13); LAUNCH_K(14); LAUNCH_K(15); }
    a.l_lo = DEPTH; a.l_hi = DEPTH; LAUNCH_K(16);
    first = false;
#else
    a.l_lo = 0; a.l_hi = DEPTH;
    hipLaunchKernelGGL((mk_fwd<MK_MULTI ? NPH : 0, NPH + 1>), dim3(grid), dim3(NWAVES * 64), LDS_BYTES, stream, a);
#endif
}
```

```cpp
#include <hip/hip_runtime.h>
#include <hip/hip_bf16.h>
#include <cstdio>
#include <cstdint>
#include <cmath>
namespace pg8 {
#define PG8_LAS __attribute__((address_space(3)))
typedef unsigned short bf16_t;
typedef short bf16x8 __attribute__((ext_vector_type(8)));
typedef float f32x4 __attribute__((ext_vector_type(4)));
typedef float f32x2 __attribute__((ext_vector_type(2)));
typedef unsigned u32x4 __attribute__((ext_vector_type(4)));
typedef unsigned u32x2 __attribute__((ext_vector_type(2)));
constexpr int BM = 256, BK = 64, HALF = 128, HTB = HALF * BK * 2  , STAGE_BYTES = 8 * HTB, NXCD = 8, WGM = 8;

__host__ __device__ __forceinline__ int lds_byte(int r, int c) { const int st = (r >> 4) * 2 + (c >> 5), rr = r & 15, cc = c & 31, ob = rr * 64 + cc * 2; return st * 1024 + (ob ^ (((ob >> 9) & 1) << 5)); }
__host__ __device__ __forceinline__ void stage_rc(int b, int& R, int& C) { const int st = b / 1024, sb = b % 1024, swz = sb ^ (((sb >> 9) & 1) << 5); R = (st >> 1) * 16 + swz / 64; C = (st & 1) * 32 + (swz % 64) / 2; }
__host__ __device__ __forceinline__ int perm32(int rho) { const int n = rho >> 4, i = rho & 15; return 8 * (i >> 2) + 4 * n + (i & 3); }

template <class T> __device__ __forceinline__ T* uni_ptr(T* p) { const unsigned long long v = (unsigned long long)p; unsigned lo = (unsigned)v, hi = (unsigned)(v >> 32);
    asm volatile("" : "+s"(lo), "+s"(hi)); return (T*)(((unsigned long long)hi << 32) | lo); }
__device__ __forceinline__ int lane_id() { int l; asm volatile("v_mbcnt_lo_u32_b32 %0, -1, 0\n\tv_mbcnt_hi_u32_b32 %0, -1, %0" : "=v"(l)); return l; }
__device__ __forceinline__ int opq(int x) { asm volatile("" : "+s"(x)); return x; }
template <int M> __device__ __forceinline__ float xadd(float v) {
    if constexpr (M == 32) { const auto rr = __builtin_amdgcn_permlane32_swap(__float_as_uint(v), __float_as_uint(v), false, false); return __uint_as_float(rr[0]) + __uint_as_float(rr[1]); }
    else return v + __int_as_float(__builtin_amdgcn_ds_swizzle(__float_as_int(v), (M << 10) | 0x1f));
}
__device__ __forceinline__ float row_sum16(float v) {
#define PG8_DPPADD(ctrl) v += __int_as_float(__builtin_amdgcn_update_dpp(0, __float_as_int(v), ctrl, 0xf, 0xf, true))
    PG8_DPPADD(0xB1); PG8_DPPADD(0x4E); PG8_DPPADD(0x141); PG8_DPPADD(0x140); return v;
#undef PG8_DPPADD
}
struct Unit { int pm, pn; unsigned offA, offB; int sub = 0; };
struct Gemm { const bf16_t* A; const bf16_t* Bt; int lda, ldb, K; };

struct StaticOrder {
    int nM, nN, nwg, G, c; unsigned tA, tB;
    __device__ void init(int M, int N, int G_, int c_, int lda, int ldb) { nM = M / BM; nN = N / BM; nwg = nM * nN; G = G_; c = c_; tA = (unsigned)BM * lda * 2u; tB = (unsigned)BM * ldb * 2u; }
    __device__ __forceinline__ bool next(int i, Unit& u) const {
        const long L = (long)i * G + c; if (L >= nwg) return false;
        int wgid = (int)L; { const int q = nwg / NXCD, r = nwg % NXCD, xcd = wgid % NXCD, off = wgid / NXCD; wgid = (xcd < r ? xcd * (q + 1) : r * (q + 1) + (xcd - r) * q) + off; }
        const int nig = WGM * nN, gid = wgid / nig, fm = gid * WGM, gsz = (nM - fm) < WGM ? (nM - fm) : WGM;
        u.pm = fm + ((wgid % nig) % gsz); u.pn = (wgid % nig) / gsz; u.offA = (unsigned)u.pm * tA; u.offB = (unsigned)u.pn * tB; return true;
    }
    __device__ __forceinline__ void a_ready(const Unit&) const {}
    __device__ __forceinline__ void done(const Unit&) const {}
};
struct XprodOrder {
    int G, c; unsigned ld, oK, oV, oWq, oWo;
    __device__ __forceinline__ bool next(int i, Unit& u) const {
        const int L = i * G + c; if (L >= 512) return false;
        const int q = L & 255, b = q >> 5, h = (q >> 3) & 3, t = q & 7;
        if (L < 256) { u.sub = 0; u.pm = b * 4 + h; u.pn = t; u.offA = oK + ((unsigned)(b * 256) * ld + h * 512) * 2u; u.offB = oWq + ((unsigned)(t * 256) * ld + h * 512) * 2u; }
        else         { u.sub = 1; u.pm = b * 8 + t; u.pn = h; u.offA = oWo + ((unsigned)(t * 256) * ld + h * 512) * 2u; u.offB = oV + ((unsigned)(b * 256) * ld + h * 512) * 2u; }
        return true;
    }
    __device__ __forceinline__ void a_ready(const Unit&) const {}
    __device__ __forceinline__ void done(const Unit&) const {}
};
struct XsOrder {
    int G, c, lda;
    __device__ __forceinline__ bool next(int i, Unit& u) const {
        const int L = i * G + c; if (L >= 256) return false;
        const int b = L >> 5, rt = (L >> 2) & 7, h = L & 3;
        u.pm = b * 8 + rt; u.pn = h; u.offA = ((unsigned)(b * 2048 + rt * 256) * (unsigned)lda) * 2u; u.offB = ((unsigned)(b * 1024 + h * 256) * 2048u) * 2u; return true;
    }
    __device__ __forceinline__ void a_ready(const Unit&) const {}
    __device__ __forceinline__ void done(const Unit&) const {}
};
struct XoOrder {
    int G, c;
    __device__ __forceinline__ bool next(int i, Unit& u) const {
        const int L = i * G + c; if (L >= 512) return false;
        const int b = L >> 6, rt = (L >> 3) & 7, ct = L & 7;
        u.pm = b * 8 + rt; u.pn = ct; u.offA = ((unsigned)(b * 2048 + rt * 256) * 1024u) * 2u; u.offB = ((unsigned)(b * 2048 + ct * 256) * 1024u) * 2u; return true;
    }
    __device__ __forceinline__ void a_ready(const Unit&) const {}
    __device__ __forceinline__ void done(const Unit&) const {}
};

__device__ __forceinline__ unsigned cvt_pk_bf16(float lo, float hi) { unsigned r; asm volatile("v_cvt_pk_bf16_f32 %0, %1, %2" : "=v"(r) : "v"(lo), "v"(hi)); return r; }
__device__ __forceinline__ float bf_lo(unsigned w) { return __uint_as_float(w << 16); }
__device__ __forceinline__ float bf_hi(unsigned w) { return __uint_as_float(w & 0xffff0000u); }
__device__ __forceinline__ float sigmoidf_(float x) { return __builtin_amdgcn_rcpf(1.0f + __builtin_amdgcn_exp2f(-1.4426950408889634f * x)); }

__device__ __forceinline__ void row_rs8(float (&rs)[2][4], const float* rssp, int row0, int fq) {
    f32x4 a[2][4], b[2][4];
#pragma unroll
    for (int ai = 0; ai < 2; ++ai)
#pragma unroll
        for (int m = 0; m < 4; ++m) { const float* p = rssp + ((size_t)(2 * fq) * 16384 + (size_t)(row0 + ai * HALF + m * 16)) * 4; a[ai][m] = *(const f32x4*)p; b[ai][m] = *(const f32x4*)(p + (size_t)16384 * 4); }
#pragma unroll
    for (int ai = 0; ai < 2; ++ai)
#pragma unroll
        for (int m = 0; m < 4; ++m) { float s = ((a[ai][m][0] + a[ai][m][1]) + (a[ai][m][2] + a[ai][m][3])) + ((b[ai][m][0] + b[ai][m][1]) + (b[ai][m][2] + b[ai][m][3]));
            s = pg8::xadd<16>(s); s = pg8::xadd<32>(s); rs[ai][m] = __builtin_amdgcn_rsqf(s * (1.0f / 2048.0f) + 1e-6f); }
}
struct EpiBf16 {
    static constexpr bool PERM = true, AFTER_DRAIN = false, MULTI = false;
    bf16_t* O; int ldc; int split_cols; size_t split_stride; float scale; const float* rss;
    __device__ __forceinline__ void operator()(const f32x4 (&acc)[2][2][4][2], const Unit& u, int wr, int wc, int fr, int fq) const {
        const int row0 = u.pm * BM + wr * 64 + fr; int colt = u.pn * BM; bf16_t* base = O;
        if (split_cols) { const int t = colt / split_cols; base += (size_t)t * split_stride; colt -= t * split_cols; }
        const int col0 = colt + wc * 32 + 8 * fq; const float sc = scale;
        float rs[2][4];
        if (rss) row_rs8(rs, rss, row0, fq);
#pragma unroll
        for (int ai = 0; ai < 2; ++ai)
#pragma unroll
            for (int m = 0; m < 4; ++m) { bf16_t* rowp = base + (size_t)(row0 + ai * HALF + m * 16) * ldc + col0;
                const float sr = rss ? sc * rs[ai][m] : sc;
#pragma unroll
                for (int bj = 0; bj < 2; ++bj) { const f32x4 v0 = acc[ai][bj][m][0] * sr, v1 = acc[ai][bj][m][1] * sr;
                    u32x4 w; w.x = cvt_pk_bf16(v0[0], v0[1]); w.y = cvt_pk_bf16(v0[2], v0[3]); w.z = cvt_pk_bf16(v1[0], v1[1]); w.w = cvt_pk_bf16(v1[2], v1[3]);
                    *(u32x4*)(rowp + bj * HALF) = w; } }
    }
};
struct EpiBf16Two {
    static constexpr bool PERM = true, AFTER_DRAIN = false, MULTI = false;
    bf16_t* O0; int ld0; bf16_t* O1; int ld1;
    __device__ __forceinline__ void operator()(const f32x4 (&acc)[2][2][4][2], const Unit& u, int wr, int wc, int fr, int fq) const {
        bf16_t* base = u.sub ? O1 : O0; const int ldc = u.sub ? ld1 : ld0;
        const int row0 = u.pm * BM + wr * 64 + fr, col0 = u.pn * BM + wc * 32 + 8 * fq;
#pragma unroll
        for (int ai = 0; ai < 2; ++ai)
#pragma unroll
            for (int m = 0; m < 4; ++m) { bf16_t* rowp = base + (size_t)(row0 + ai * HALF + m * 16) * ldc + col0;
#pragma unroll
                for (int bj = 0; bj < 2; ++bj) { const f32x4 v0 = acc[ai][bj][m][0], v1 = acc[ai][bj][m][1];
                    u32x4 w; w.x = cvt_pk_bf16(v0[0], v0[1]); w.y = cvt_pk_bf16(v0[2], v0[3]); w.z = cvt_pk_bf16(v1[0], v1[1]); w.w = cvt_pk_bf16(v1[2], v1[3]);
                    *(u32x4*)(rowp + bj * HALF) = w; } }
    }
};
struct EpiInProj {
    static constexpr bool PERM = true, AFTER_DRAIN = false, MULTI = false;
    bf16_t* BIG; const float* dcs; const float* rcs; const float* rss;
    __device__ __forceinline__ void operator()(const f32x4 (&acc)[2][2][4][2], const Unit& u, int wr, int wc, int fr, int fq) const {
        const int pn = u.pn; const int row0 = u.pm * BM + wr * 64 + fr; const size_t SEGE = (size_t)16384 * 1024;
        const int cw = wc * 32 + 8 * fq;
        float rs[2][4]; row_rs8(rs, rss, row0, fq);
        if (pn < 8 || (pn >= 20 && pn < 28)) {
            const bool isd = pn < 8; const int seg = isd ? (pn >> 2) : 5 + ((pn - 20) >> 2);
            const float sc = pn < 4 ? 0.125f * 1.4426950408889634f : (pn >= 20 && pn < 24) ? 0.08838834764831845f : 1.0f;
            const int i0 = isd ? ((cw & 63) >> 1) : ((cw & 127) >> 1);
            bf16_t* base = BIG + (size_t)seg * SEGE + (pn & 3) * BM + cw;
#pragma unroll
            for (int ai = 0; ai < 2; ++ai)
#pragma unroll
              for (int mp = 0; mp < 2; ++mp) {
                f32x4 ta[2], tb4[2];
#pragma unroll
                for (int mm = 0; mm < 2; ++mm) { const int t = (row0 + ai * HALF + (2 * mp + mm) * 16) & 2047;
                    const float* tb = isd ? dcs + ((size_t)t * 32 + i0) * 2 : rcs + ((size_t)t * 64 + i0) * 2; ta[mm] = *(const f32x4*)tb; tb4[mm] = *(const f32x4*)(tb + 4); }
#pragma unroll
                for (int mm = 0; mm < 2; ++mm) { const int m = 2 * mp + mm; const int row = row0 + ai * HALF + m * 16; const float sr = sc * rs[ai][m]; const f32x4 t0 = ta[mm], t1 = tb4[mm];
#pragma unroll
                    for (int bj = 0; bj < 2; ++bj) { const f32x4 v0 = acc[ai][bj][m][0], v1 = acc[ai][bj][m][1];
                        const float y0 = (v0[0] * t0[0] - v0[1] * t0[1]) * sr, y1 = (v0[1] * t0[0] + v0[0] * t0[1]) * sr, y2 = (v0[2] * t0[2] - v0[3] * t0[3]) * sr, y3 = (v0[3] * t0[2] + v0[2] * t0[3]) * sr;
                        const float y4 = (v1[0] * t1[0] - v1[1] * t1[1]) * sr, y5 = (v1[1] * t1[0] + v1[0] * t1[1]) * sr, y6 = (v1[2] * t1[2] - v1[3] * t1[3]) * sr, y7 = (v1[3] * t1[2] + v1[2] * t1[3]) * sr;
                        u32x4 w; w.x = cvt_pk_bf16(y0, y1); w.y = cvt_pk_bf16(y2, y3); w.z = cvt_pk_bf16(y4, y5); w.w = cvt_pk_bf16(y6, y7);
                        *(u32x4*)(base + (size_t)row * 1024 + bj * HALF) = w; } }
                asm volatile("" ::: "memory"); }
        } else if (pn >= 12 && pn < 20) {
            bf16_t* base = BIG + 3 * SEGE + (pn - 12) * (BM / 2) + (cw >> 1);
#pragma unroll
            for (int ai = 0; ai < 2; ++ai)
#pragma unroll
                for (int m = 0; m < 4; ++m) { bf16_t* rowp = base + (size_t)(row0 + ai * HALF + m * 16) * 1024; const float sr = rs[ai][m];
#pragma unroll
                    for (int bj = 0; bj < 2; ++bj) { const f32x4 v0 = acc[ai][bj][m][0] * sr, v1 = acc[ai][bj][m][1] * sr;
                        u32x2 w; w.x = cvt_pk_bf16(v0[0] * sigmoidf_(v0[1]), v0[2] * sigmoidf_(v0[3])); w.y = cvt_pk_bf16(v1[0] * sigmoidf_(v1[1]), v1[2] * sigmoidf_(v1[3]));
                        *(u32x2*)(rowp + bj * (HALF / 2)) = w; } }
        } else if (pn >= 36) {
            unsigned char* base8 = (unsigned char*)(BIG + (size_t)(pn >> 2) * SEGE) + (pn & 3) * BM + cw;
#pragma unroll
            for (int ai = 0; ai < 2; ++ai)
#pragma unroll
                for (int m = 0; m < 4; ++m) { unsigned char* rowp = base8 + (size_t)(row0 + ai * HALF + m * 16) * 1024; const float sr = rs[ai][m];
#pragma unroll
                    for (int bj = 0; bj < 2; ++bj) { const f32x4 v0 = acc[ai][bj][m][0] * sr, v1 = acc[ai][bj][m][1] * sr; unsigned q[8];
#pragma unroll
                        for (int e = 0; e < 4; ++e) { q[e] = (unsigned)(__builtin_fmaxf(255.0f * sigmoidf_(v0[e]), 1.0f) + 0.5f); q[4 + e] = (unsigned)(__builtin_fmaxf(255.0f * sigmoidf_(v1[e]), 1.0f) + 0.5f); }
                        u32x2 w; w.x = q[0] | (q[1] << 8) | (q[2] << 16) | (q[3] << 24); w.y = q[4] | (q[5] << 8) | (q[6] << 16) | (q[7] << 24);
                        *(u32x2*)(rowp + bj * HALF) = w; } }
        } else {
            bf16_t* base = BIG + (size_t)(pn >> 2) * SEGE + (pn & 3) * BM + cw; const bool sg = false;
#pragma unroll
            for (int ai = 0; ai < 2; ++ai)
#pragma unroll
                for (int m = 0; m < 4; ++m) { bf16_t* rowp = base + (size_t)(row0 + ai * HALF + m * 16) * 1024; const float sr = rs[ai][m];
#pragma unroll
                    for (int bj = 0; bj < 2; ++bj) { f32x4 v0 = acc[ai][bj][m][0] * sr, v1 = acc[ai][bj][m][1] * sr;
                        if (sg) { v0[0] = sigmoidf_(v0[0]); v0[1] = sigmoidf_(v0[1]); v0[2] = sigmoidf_(v0[2]); v0[3] = sigmoidf_(v0[3]); v1[0] = sigmoidf_(v1[0]); v1[1] = sigmoidf_(v1[1]); v1[2] = sigmoidf_(v1[2]); v1[3] = sigmoidf_(v1[3]); }
                        u32x4 w; w.x = cvt_pk_bf16(v0[0], v0[1]); w.y = cvt_pk_bf16(v0[2], v0[3]); w.z = cvt_pk_bf16(v1[0], v1[1]); w.w = cvt_pk_bf16(v1[2], v1[3]);
                        *(u32x4*)(rowp + bj * HALF) = w; } }
        }
    }
};
struct EpiSoftmax {
    static constexpr bool PERM = true, AFTER_DRAIN = true, MULTI = false;
    bf16_t* P; int ldp; float sc; const float* rss;
    __device__ __forceinline__ void fused(f32x4 (&acc)[2][2][4][2], const Unit& u, int wr, int wc, int fr, int fq, PG8_LAS unsigned char* lds, int wid, int lane) const {
        PG8_LAS float* Ps = (PG8_LAS float*)lds;
        const int row0 = u.pm * BM + wr * 64 + fr;
        float rs[2][4]; row_rs8(rs, rss, row0, fq);
#pragma unroll
        for (int ai = 0; ai < 2; ++ai)
#pragma unroll
            for (int m = 0; m < 4; ++m) { const float k = sc * rs[ai][m]; float t = 0.f;
#pragma unroll
                for (int bj = 0; bj < 2; ++bj)
#pragma unroll
                    for (int n = 0; n < 2; ++n) { f32x4 e = acc[ai][bj][m][n] * k; e[0] = __builtin_amdgcn_exp2f(e[0]); e[1] = __builtin_amdgcn_exp2f(e[1]); e[2] = __builtin_amdgcn_exp2f(e[2]); e[3] = __builtin_amdgcn_exp2f(e[3]);
                        acc[ai][bj][m][n] = e; t += (e[0] + e[1]) + (e[2] + e[3]); }
                t = pg8::xadd<16>(t); t = pg8::xadd<32>(t);
                if (fq == 0) Ps[(ai * HALF + wr * 64 + m * 16 + fr) * 4 + wc] = t; }
        asm volatile("s_waitcnt lgkmcnt(0)" ::: "memory"); __builtin_amdgcn_s_barrier(); asm volatile("" ::: "memory");
#pragma unroll
        for (int ai = 0; ai < 2; ++ai)
#pragma unroll
            for (int m = 0; m < 4; ++m) { const f32x4 q = *(const PG8_LAS f32x4*)(Ps + (ai * HALF + wr * 64 + m * 16 + fr) * 4); const float inv = 1.0f / ((q[0] + q[1]) + (q[2] + q[3]));
                bf16_t* rowp = P + (size_t)(row0 + ai * HALF + m * 16) * ldp + u.pn * BM + wc * 32 + 8 * fq;
#pragma unroll
                for (int bj = 0; bj < 2; ++bj) { const f32x4 v0 = acc[ai][bj][m][0] * inv, v1 = acc[ai][bj][m][1] * inv;
                    u32x4 w; w.x = cvt_pk_bf16(v0[0], v0[1]); w.y = cvt_pk_bf16(v0[2], v0[3]); w.z = cvt_pk_bf16(v1[0], v1[1]); w.w = cvt_pk_bf16(v1[2], v1[3]);
                    *(u32x4*)(rowp + bj * HALF) = w; } }
        asm volatile("s_waitcnt lgkmcnt(0)" ::: "memory"); __builtin_amdgcn_s_barrier(); asm volatile("" ::: "memory");
    }
};
struct EpiRes {
    static constexpr bool PERM = true, AFTER_DRAIN = false, MULTI = false;
    const bf16_t* xo; bf16_t* xb; int ldx; float* rssp;
    __device__ __forceinline__ void operator()(const f32x4 (&acc)[2][2][4][2], const Unit& u, int wr, int wc, int fr, int fq) const {
        const int col0 = u.pn * BM + wc * 32 + 8 * fq;
#pragma unroll
        for (int ai = 0; ai < 2; ++ai) {
            u32x4 ro[4][2];
#pragma unroll
            for (int m = 0; m < 4; ++m)
#pragma unroll
                for (int bj = 0; bj < 2; ++bj) ro[m][bj] = *(const u32x4*)(xo + (size_t)(u.pm * BM + ai * HALF + wr * 64 + m * 16 + fr) * ldx + col0 + bj * HALF);
#pragma unroll
            for (int m = 0; m < 4; ++m) { const int row = u.pm * BM + ai * HALF + wr * 64 + m * 16 + fr; float ss = 0.f;
#pragma unroll
                for (int bj = 0; bj < 2; ++bj) { const u32x4 o = ro[m][bj];
                    f32x4 v0 = acc[ai][bj][m][0], v1 = acc[ai][bj][m][1];
                    v0[0] += bf_lo(o.x); v0[1] += bf_hi(o.x); v0[2] += bf_lo(o.y); v0[3] += bf_hi(o.y); v1[0] += bf_lo(o.z); v1[1] += bf_hi(o.z); v1[2] += bf_lo(o.w); v1[3] += bf_hi(o.w);
                    ss += ((v0[0] * v0[0] + v0[1] * v0[1]) + (v0[2] * v0[2] + v0[3] * v0[3])) + ((v1[0] * v1[0] + v1[1] * v1[1]) + (v1[2] * v1[2] + v1[3] * v1[3]));
                    u32x4 w; w.x = cvt_pk_bf16(v0[0], v0[1]); w.y = cvt_pk_bf16(v0[2], v0[3]); w.z = cvt_pk_bf16(v1[0], v1[1]); w.w = cvt_pk_bf16(v1[2], v1[3]);
                    *(u32x4*)(xb + (size_t)row * ldx + col0 + bj * HALF) = w; }
                ss = pg8::xadd<16>(ss); ss = pg8::xadd<32>(ss);
                if (fq == 0) rssp[((size_t)u.pn * 16384 + (size_t)row) * 4 + wc] = ss; }
            asm volatile("" ::: "memory"); }
    }
};
struct EpiMerge {
    static constexpr bool PERM = true, AFTER_DRAIN = false, MULTI = true;
    const bf16_t* gates; bf16_t* merged;
    struct Carry { u32x2 g[2][4][2]; };
    __device__ __forceinline__ void step(f32x4 (&acc)[2][2][4][2], const Unit& u, int wr, int wc, int fr, int fq, Carry& cy) const {
        const size_t SEGE = (size_t)16384 * 1024; const int sub = u.sub; const bool last = sub == 2, first = sub == 0;
        const int row0 = u.pm * BM + wr * 64 + fr; const int gcol = (u.pn & 3) * BM + wc * 32 + 8 * fq;
        const unsigned char* ga = (const unsigned char*)(gates + (size_t)(2 * sub + (u.pn >> 2)) * SEGE) + gcol;
        const unsigned char* gb = last ? ga : ga + 4 * SEGE;
#pragma unroll
        for (int ai = 0; ai < 2; ++ai)
#pragma unroll
            for (int m = 0; m < 4; ++m) {
                u32x2 za[2], zb[2];
#pragma unroll
                for (int bj = 0; bj < 2; ++bj) { const size_t p = (size_t)(row0 + ai * HALF + m * 16) * 1024 + bj * HALF; za[bj] = cy.g[ai][m][bj]; if (first) za[bj] = *(const u32x2*)(ga + p); zb[bj] = *(const u32x2*)(gb + p); cy.g[ai][m][bj] = zb[bj]; }
#pragma unroll
                for (int bj = 0; bj < 2; ++bj) { const unsigned aw[2] = {za[bj].x, za[bj].y}; unsigned bw[2] = {zb[bj].x, zb[bj].y};
                    float f[8];
#pragma unroll
                    for (int j = 0; j < 2; ++j) { if (last) bw[j] = 0xffffffffu;
#pragma unroll
                        for (int e = 0; e < 4; ++e) f[4 * j + e] = (float)((aw[j] >> (8 * e)) & 0xffu) * __builtin_amdgcn_rcpf((float)((bw[j] >> (8 * e)) & 0xffu)); }
                    f32x4 v0 = acc[ai][bj][m][0], v1 = acc[ai][bj][m][1];
                    v0[0] *= f[0]; v0[1] *= f[1]; v0[2] *= f[2]; v0[3] *= f[3]; v1[0] *= f[4]; v1[1] *= f[5]; v1[2] *= f[6]; v1[3] *= f[7];
                    acc[ai][bj][m][0] = v0; acc[ai][bj][m][1] = v1;
                    if (last) { u32x4 w; w.x = cvt_pk_bf16(v0[0], v0[1]); w.y = cvt_pk_bf16(v0[2], v0[3]); w.z = cvt_pk_bf16(v1[0], v1[1]); w.w = cvt_pk_bf16(v1[2], v1[3]);
                        *(u32x4*)(merged + (size_t)(row0 + ai * HALF + m * 16) * 2048 + u.pn * BM + wc * 32 + 8 * fq + bj * HALF) = w; } }
                if (m & 1) asm volatile("" ::: "memory"); }
    }
};
struct MergeOrder {
    StaticOrder T; unsigned ystride, wstride;
    __device__ __forceinline__ bool next(int i, Unit& u) const {
        const int ti = i / 3, sub = i - 3 * ti;
        if (!T.next(ti, u)) return false;
        u.sub = sub; u.offA += (unsigned)sub * ystride; u.offB += (unsigned)sub * wstride; return true;
    }
    __device__ __forceinline__ void a_ready(const Unit&) const {}
    __device__ __forceinline__ void done(const Unit&) const {}
};
struct EpiSwiGLU {
    static constexpr bool PERM = true, AFTER_DRAIN = false, MULTI = false;
    bf16_t* O; int ldo; const float* rss;
    __device__ __forceinline__ void operator()(const f32x4 (&acc)[2][2][4][2], const Unit& u, int wr, int wc, int fr, int fq) const {
        const int row0 = u.pm * BM + wr * 64 + fr; const int j0 = (u.pn * BM + wc * 32 + 8 * fq) >> 1;
        float rs[2][4]; row_rs8(rs, rss, row0, fq);
#pragma unroll
        for (int ai = 0; ai < 2; ++ai)
#pragma unroll
            for (int m = 0; m < 4; ++m) { bf16_t* rowp = O + (size_t)(row0 + ai * HALF + m * 16) * ldo + j0; const float sr = rs[ai][m];
#pragma unroll
                for (int bj = 0; bj < 2; ++bj) { const f32x4 v0 = acc[ai][bj][m][0] * sr, v1 = acc[ai][bj][m][1] * sr;
                    const float o0 = v0[0] * sigmoidf_(v0[0]) * v0[1], o1 = v0[2] * sigmoidf_(v0[2]) * v0[3], o2 = v1[0] * sigmoidf_(v1[0]) * v1[1], o3 = v1[2] * sigmoidf_(v1[2]) * v1[3];
                    u32x2 w; w.x = cvt_pk_bf16(o0, o1); w.y = cvt_pk_bf16(o2, o3);
                    *(u32x2*)(rowp + bj * (HALF / 2)) = w; } }
    }
};

template <class Epi, bool MULTI> struct CarryOf { struct type {}; };
template <class Epi> struct CarryOf<Epi, true> { typedef typename Epi::Carry type; };
template <class Epi, class Sched, bool ALIGN_EPI = false, bool SP2 = false>
__device__ __forceinline__ void gemm_phase(PG8_LAS unsigned char* lds, const Gemm g, const Sched& S, const Epi& E, const int wave_sg) {
    int tid_ = opq(wave_sg) * 64 + lane_id(); asm volatile("" : "+v"(tid_));
    const char* gA = uni_ptr((const char*)g.A); const char* gB = uni_ptr((const char*)g.Bt);
    const int tid = tid_, wid = __builtin_amdgcn_readfirstlane(tid >> 6), lane = tid & 63, wr = wid >> 2, wc = wid & 3, fr = lane & 15, fq = lane >> 4;
    int K_ = g.K; asm volatile("" : "+s"(K_));
    const int K = K_, nt = K / BK;
    unsigned voffA[2], voffB[2];
#pragma unroll
    for (int i = 0; i < 2; ++i) { int R, C; stage_rc(tid * 16 + i * 8192, R, C); const int Rb = Epi::PERM ? ((R & ~31) + perm32(R & 31)) : R;
        voffA[i] = (unsigned)(R * g.lda + C) * 2u; voffB[i] = (unsigned)(Rb * g.ldb + C) * 2u; }
    const size_t kstep = (size_t)(BK * 2);
    const unsigned hsA = (unsigned)HALF * g.lda * 2u, hsB = (unsigned)HALF * g.ldb * 2u;
    const unsigned ldsw = (unsigned)wid * 1024u;
    const int aoff = lds_byte(wr * 64 + fr, fq * 8), boff = lds_byte(wc * 32 + fr, fq * 8);
#define PG8_SA(b, h) (((b) * 2 + (h)) * HTB)
#define PG8_SB(b, h) ((4 + (b) * 2 + (h)) * HTB)
#define PG8_STAGE(bufoff, gbase, voff) do { _Pragma("unroll") for (int _i = 0; _i < 2; ++_i) \
        __builtin_amdgcn_global_load_lds((const unsigned*)((const char*)(gbase) + (voff)[_i]), (PG8_LAS unsigned*)(lds + (bufoff) + ldsw + _i * 8192), 16, 0, 0); } while (0)
#define PG8_LDA(dst, b, h) do { _Pragma("unroll") for (int m = 0; m < 4; ++m) _Pragma("unroll") for (int k = 0; k < 2; ++k) dst[m][k] = *(const PG8_LAS bf16x8*)(lds + PG8_SA(b, h) + aoff + m * 2048 + k * 1024); } while (0)
#define PG8_LDB(dst, b, h) do { _Pragma("unroll") for (int n = 0; n < 2; ++n) _Pragma("unroll") for (int k = 0; k < 2; ++k) dst[n][k] = *(const PG8_LAS bf16x8*)(lds + PG8_SB(b, h) + boff + n * 2048 + k * 1024); } while (0)
#define PG8_MMA(ai, bj, At, Bt) do { __builtin_amdgcn_s_setprio(1); _Pragma("unroll") for (int m = 0; m < 4; ++m) _Pragma("unroll") for (int n = 0; n < 2; ++n) _Pragma("unroll") for (int k = 0; k < 2; ++k) \
        asm volatile("v_mfma_f32_16x16x32_bf16 %0, %1, %2, %0" : "+v"(acc[ai][bj][m][n]) : "v"(Bt[n][k]), "v"(At[m][k])); __builtin_amdgcn_s_setprio(0); } while (0)
#define PG8_WAIT_V(n) asm volatile("s_waitcnt vmcnt(" #n ")" ::: "memory")
#define PG8_PIN_ACC() do { _Pragma("unroll") for (int a_ = 0; a_ < 2; ++a_) _Pragma("unroll") for (int b_ = 0; b_ < 2; ++b_) _Pragma("unroll") for (int m_ = 0; m_ < 4; ++m_) asm volatile("" : "+v"(acc[a_][b_][m_][0]), "+v"(acc[a_][b_][m_][1])); asm volatile("s_nop 7" ::: "memory"); } while (0)
#define PG8_WAIT_L(n) asm volatile("s_waitcnt lgkmcnt(" #n ")" ::: "memory")
#define PG8_BAR __builtin_amdgcn_s_barrier()
#define PG8_SCHED __builtin_amdgcn_sched_barrier(0)
    Unit cur, nxt; int ui = 0;
    if (!S.next(0, cur)) return;
    typename CarryOf<Epi, Epi::MULTI>::type carry{};
    f32x4 acc[2][2][4][2];
#pragma unroll
    for (int a = 0; a < 2; ++a)
#pragma unroll
        for (int b = 0; b < 2; ++b)
#pragma unroll
            for (int m = 0; m < 4; ++m)
#pragma unroll
                for (int n = 0; n < 2; ++n) acc[a][b][m][n] = (f32x4){0.f, 0.f, 0.f, 0.f};
    PG8_PIN_ACC();
    bf16x8 At[4][2], B0[2][2], B1[2][2];
    const char* cA = gA + cur.offA; const char* cB = gB + cur.offB;
    S.a_ready(cur);
    if constexpr (SP2) {
        PG8_STAGE(PG8_SB(0, 0), cB, voffB); PG8_STAGE(PG8_SB(0, 1), cB + hsB, voffB); PG8_STAGE(PG8_SA(0, 0), cA, voffA); PG8_STAGE(PG8_SA(0, 1), cA + hsA, voffA);
        if (wr == 1) PG8_BAR;
        PG8_WAIT_V(2); PG8_BAR;
        PG8_STAGE(PG8_SB(1, 0), cB + kstep, voffB); PG8_STAGE(PG8_SA(1, 0), cA + kstep, voffA); PG8_STAGE(PG8_SB(1, 1), cB + hsB + kstep, voffB);
        PG8_WAIT_V(6); PG8_BAR;
    } else {
        PG8_STAGE(PG8_SB(0, 0), cB, voffB); PG8_STAGE(PG8_SA(0, 0), cA, voffA); PG8_STAGE(PG8_SB(0, 1), cB + hsB, voffB); PG8_STAGE(PG8_SA(0, 1), cA + hsA, voffA);
        if (wr == 1) PG8_BAR;
        PG8_WAIT_V(4); PG8_BAR;
        PG8_STAGE(PG8_SB(1, 0), cB + kstep, voffB); PG8_STAGE(PG8_SA(1, 0), cA + kstep, voffA); PG8_STAGE(PG8_SB(1, 1), cB + hsB + kstep, voffB);
        PG8_WAIT_V(6); PG8_BAR;
    }
    for (;;) {
        const bool has_next = S.next(ui + 1, nxt);
        const char* nA = has_next ? gA + nxt.offA : cA; const char* nB = has_next ? gB + nxt.offB : cB;
        for (int t = 0; t < nt; t += 2) {
            const bool last = (t == nt - 2);
            const char* a1 = cA + (size_t)(t + 1) * kstep;
            const char* a2 = last ? nA : cA + (size_t)(t + 2) * kstep; const char* b2 = last ? nB : cB + (size_t)(t + 2) * kstep;
            const char* a3 = a2 + kstep; const char* b3 = b2 + kstep;
            if (last && has_next) S.a_ready(nxt);
            if constexpr (SP2) {
            PG8_LDB(B0, 0, 0); PG8_LDB(B1, 0, 1); PG8_SCHED; PG8_LDA(At, 0, 0); PG8_STAGE(PG8_SA(1, 1), a1 + hsA, voffA);
            PG8_WAIT_V(8); PG8_WAIT_L(0); PG8_BAR; PG8_MMA(0, 0, At, B0); PG8_MMA(0, 1, At, B1); PG8_BAR; PG8_SCHED;
            PG8_LDA(At, 0, 1); PG8_STAGE(PG8_SB(0, 0), b2, voffB); PG8_STAGE(PG8_SB(0, 1), b2 + hsB, voffB); PG8_STAGE(PG8_SA(0, 0), a2, voffA);
            PG8_WAIT_V(8); PG8_WAIT_L(0); PG8_BAR; PG8_MMA(1, 0, At, B0); PG8_MMA(1, 1, At, B1); PG8_BAR; PG8_SCHED;
            PG8_LDB(B0, 1, 0); PG8_LDB(B1, 1, 1); PG8_SCHED; PG8_LDA(At, 1, 0); PG8_STAGE(PG8_SA(0, 1), a2 + hsA, voffA);
            PG8_WAIT_V(8); PG8_WAIT_L(0); PG8_BAR; PG8_MMA(0, 0, At, B0); PG8_MMA(0, 1, At, B1); PG8_BAR; PG8_SCHED;
            PG8_LDA(At, 1, 1); PG8_STAGE(PG8_SB(1, 0), b3, voffB); PG8_STAGE(PG8_SB(1, 1), b3 + hsB, voffB); PG8_STAGE(PG8_SA(1, 0), a3, voffA);
            PG8_WAIT_V(8); PG8_WAIT_L(0); PG8_BAR; PG8_MMA(1, 0, At, B0); PG8_MMA(1, 1, At, B1); PG8_BAR; PG8_SCHED;
            } else {
            PG8_LDB(B0, 0, 0); PG8_SCHED; PG8_LDA(At, 0, 0); PG8_STAGE(PG8_SA(1, 1), a1 + hsA, voffA);
            PG8_WAIT_L(8); PG8_BAR; PG8_WAIT_L(0); PG8_MMA(0, 0, At, B0); PG8_BAR; PG8_SCHED;
            PG8_LDB(B1, 0, 1); PG8_STAGE(PG8_SB(0, 0), b2, voffB);
            PG8_BAR; PG8_WAIT_L(0); PG8_MMA(0, 1, At, B1); PG8_BAR;
            PG8_LDA(At, 0, 1); PG8_STAGE(PG8_SA(0, 0), a2, voffA);
            PG8_BAR; PG8_WAIT_L(0); PG8_MMA(1, 0, At, B0); PG8_BAR; PG8_SCHED;
            PG8_STAGE(PG8_SB(0, 1), b2 + hsB, voffB);
            PG8_WAIT_V(6); PG8_BAR; PG8_MMA(1, 1, At, B1); PG8_BAR;
            PG8_LDB(B0, 1, 0); PG8_SCHED; PG8_LDA(At, 1, 0); PG8_STAGE(PG8_SA(0, 1), a2 + hsA, voffA);
            PG8_WAIT_L(8); PG8_BAR; PG8_WAIT_L(0); PG8_MMA(0, 0, At, B0); PG8_BAR; PG8_SCHED;
            PG8_LDB(B1, 1, 1); PG8_STAGE(PG8_SB(1, 0), b3, voffB);
            PG8_BAR; PG8_WAIT_L(0); PG8_MMA(0, 1, At, B1); PG8_BAR;
            PG8_LDA(At, 1, 1); PG8_STAGE(PG8_SA(1, 0), a3, voffA);
            PG8_BAR; PG8_WAIT_L(0); PG8_MMA(1, 0, At, B0); PG8_BAR; PG8_SCHED;
            PG8_STAGE(PG8_SB(1, 1), b3 + hsB, voffB);
            PG8_WAIT_V(6); PG8_BAR; PG8_MMA(1, 1, At, B1); PG8_BAR;
            }
        }
        if constexpr (ALIGN_EPI) { if (wr == 0) PG8_BAR; }
        asm volatile("s_nop 15\n\ts_nop 15" ::: "memory");
        const int elane = lane_id(); const int efr = elane & 15, efq = elane >> 4;
        if constexpr (Epi::MULTI) { E.step(acc, cur, wr, wc, efr, efq, carry); S.done(cur); }
        else if constexpr (!Epi::AFTER_DRAIN) { E(acc, cur, wr, wc, efr, efq);
#if defined(EPI_TWICE)
            if constexpr (Epi::PERM) { asm volatile("" ::: "memory"); E(acc, cur, wr, wc, fr, fq); }
#endif
            S.done(cur); }
        if (!has_next) break;
        if (!Epi::MULTI || cur.sub == 2) {
#pragma unroll
        for (int a = 0; a < 2; ++a)
#pragma unroll
            for (int b = 0; b < 2; ++b)
#pragma unroll
                for (int m = 0; m < 4; ++m)
#pragma unroll
                    for (int n = 0; n < 2; ++n) acc[a][b][m][n] = (f32x4){0.f, 0.f, 0.f, 0.f}; }
        PG8_PIN_ACC();
        cur = nxt; cA = nA; cB = nB; ++ui;
        if constexpr (ALIGN_EPI) { if (wr == 1) PG8_BAR; }
    }
    PG8_WAIT_V(0);
    if constexpr (!ALIGN_EPI) { if (wr == 0) PG8_BAR; }
    PG8_BAR;
    if constexpr (Epi::AFTER_DRAIN) { E.fused(acc, cur, wr, wc, fr, fq, lds, wid, lane); S.done(cur); }
#undef PG8_SA
#undef PG8_SB
#undef PG8_STAGE
#undef PG8_LDA
#undef PG8_LDB
#undef PG8_MMA
#undef PG8_WAIT_V
#undef PG8_WAIT_L
#undef PG8_PIN_ACC
#undef PG8_BAR
#undef PG8_SCHED
}
}

#include <hip/hip_bf16.h>
#include <cmath>
namespace attn_body {
using bf16=__hip_bfloat16;
using bf16x8=__attribute__((ext_vector_type(8)))short;
using s16x4=__attribute__((ext_vector_type(4)))short;
using f32x16=__attribute__((ext_vector_type(16)))float;
using u32x4=__attribute__((ext_vector_type(4)))unsigned;
constexpr int BATCH=8,NHEAD=16,SEQ=2048,D=64,DM=NHEAD*D;
constexpr int NW=8,QBLK=32,QB=QBLK*NW,KVBLK=64,NQB=SEQ/QB;
constexpr int ATTN_PITCH=DM, ATTN_UNIT_ROWS=QB;
__device__ __forceinline__ int crow(int r,int hi){return (r&3)+8*(r>>2)+4*hi;}
#define SBAR() __builtin_amdgcn_sched_barrier(0)
__device__ __forceinline__ void cmask(f32x16&p0,f32x16&p1,int jb,int qrel,int hi){
  const float NEG=-INFINITY; int kb=64*jb+4*hi;
  #pragma unroll
  for(int r=0;r<16;++r){int kv=kb+(r&3)+8*(r>>2); if(kv>qrel)p0[r]=NEG; if(kv+32>qrel)p1[r]=NEG;}
}

constexpr int NSLOT=3, SLOTB=8192;
constexpr int LDS_K=0, LDS_V=NSLOT*SLOTB, LDS_WS=2*NSLOT*SLOTB, LDS_OST=LDS_WS+NW*64*4, LDS_BYTES=LDS_OST+NW*4096;
constexpr float C2=0.125f*1.4426950408889634f;
__device__ __forceinline__ void glds16(const void*gsrc,unsigned lds_dst){unsigned keep;
  asm volatile("s_mov_b32 %0, m0\n\ts_mov_b32 m0, %2\n\ts_nop 0\n\tglobal_load_lds_dwordx4 %1, off\n\ts_mov_b32 m0, %0":"=&s"(keep):"v"(gsrc),"s"(lds_dst):"memory");}
__device__ __forceinline__ float max3f(float a,float b,float c){float r;asm("v_max3_f32 %0, %1, %2, %3":"=v"(r):"v"(a),"v"(b),"v"(c));return r;}
__device__ __forceinline__ float max2f(float a,float b){float r;asm("v_max_f32_e32 %0, %1, %2":"=v"(r):"v"(a),"v"(b));return r;}
__device__ __forceinline__ float fadd_s(float a,float b){float r;asm("v_add_f32_e32 %0, %1, %2":"=v"(r):"v"(a),"v"(b));return r;}
__device__ __forceinline__ float fsub_s(float a,float b){float r;asm("v_sub_f32_e32 %0, %1, %2":"=v"(r):"v"(a),"v"(b));return r;}
typedef float f32x2_t __attribute__((ext_vector_type(2))); typedef __bf16 bf16x2_t __attribute__((ext_vector_type(2)));
__device__ __forceinline__ unsigned cvtpk_s(float lo,float hi){f32x2_t v={lo,hi};bf16x2_t b=__builtin_convertvector(v,bf16x2_t);return __builtin_bit_cast(unsigned,b);}
#define WAIT_BAR(N) asm volatile("s_waitcnt vmcnt(" #N ") lgkmcnt(0)\n\ts_barrier":::"memory")

__device__ __forceinline__ void qkt(f32x16&p0,f32x16&p1,const char*Kslot,const bf16x8*qr,const f32x16&negm,int r32,int hi){
  const char*kb=Kslot+hi*1024+r32*16;
  #pragma unroll
  for(int d0=0;d0<4;++d0){
    const bf16x8 b0=*reinterpret_cast<const bf16x8*>(kb+d0*2048);
    const bf16x8 b1=*reinterpret_cast<const bf16x8*>(kb+d0*2048+512);
    if(d0==0){p0=__builtin_amdgcn_mfma_f32_32x32x16_bf16(b0,qr[0],negm,0,0,0);p1=__builtin_amdgcn_mfma_f32_32x32x16_bf16(b1,qr[0],negm,0,0,0);}
    else{p0=__builtin_amdgcn_mfma_f32_32x32x16_bf16(b0,qr[d0],p0,0,0,0);p1=__builtin_amdgcn_mfma_f32_32x32x16_bf16(b1,qr[d0],p1,0,0,0);}}
}
typedef __attribute__((address_space(3))) const char* lds_cptr;
typedef short v4i16_t __attribute__((ext_vector_type(4)));
__device__ __forceinline__ void kload8(bf16x8*kf,lds_cptr kp){
  kf[0]=*(const __attribute__((address_space(3))) bf16x8*)(kp);      kf[1]=*(const __attribute__((address_space(3))) bf16x8*)(kp+512);
  kf[2]=*(const __attribute__((address_space(3))) bf16x8*)(kp+2048); kf[3]=*(const __attribute__((address_space(3))) bf16x8*)(kp+2560);
  kf[4]=*(const __attribute__((address_space(3))) bf16x8*)(kp+4096); kf[5]=*(const __attribute__((address_space(3))) bf16x8*)(kp+4608);
  kf[6]=*(const __attribute__((address_space(3))) bf16x8*)(kp+6144); kf[7]=*(const __attribute__((address_space(3))) bf16x8*)(kp+6656);
}
__device__ __forceinline__ void kload2(bf16x8*kf,lds_cptr kp,int j){ kf[2*j]=*(const __attribute__((address_space(3))) bf16x8*)(kp+j*2048); kf[2*j+1]=*(const __attribute__((address_space(3))) bf16x8*)(kp+j*2048+512); }
__device__ __forceinline__ s16x4 vtr(lds_cptr p){ return __builtin_bit_cast(s16x4,__builtin_amdgcn_ds_read_tr16_b64_v4i16((__attribute__((address_space(3))) v4i16_t*)p)); }
__device__ __forceinline__ float rowmax(const f32x16&p0,const f32x16&p1){
  float a=max3f(p0[0],p0[1],p1[0]),b=max3f(p0[2],p0[3],p1[1]);a=max3f(a,p1[2],p1[3]);
  #pragma unroll
  for(int r=4;r<16;r+=4){a=max3f(a,p0[r],p0[r+1]);b=max3f(b,p0[r+2],p0[r+3]);a=max3f(a,p1[r],p1[r+1]);b=max3f(b,p1[r+2],p1[r+3]);}
  const float m=max2f(a,b);
  auto rr=__builtin_amdgcn_permlane32_swap(__float_as_uint(m),__float_as_uint(m),false,false);
  return max2f(__uint_as_float(rr[0]),__uint_as_float(rr[1]));
}
__device__ __forceinline__ void pv(f32x16*o,int vb,bf16x8 pa0,bf16x8 pa1,bf16x8 pa2,bf16x8 pa3){
  #pragma unroll
  for(int d0=0;d0<2;++d0){s16x4 lo[4],hi[4];
    #pragma unroll
    for(int ks=0;ks<4;++ks){
      asm volatile("ds_read_b64_tr_b16 %0,%1 offset:%c2":"=&v"(lo[ks]):"v"(vb),"i"(d0*4096+ks*1024):"memory");
      asm volatile("ds_read_b64_tr_b16 %0,%1 offset:%c2":"=&v"(hi[ks]):"v"(vb),"i"(d0*4096+ks*1024+512):"memory");}
    asm volatile("s_waitcnt lgkmcnt(0)":::"memory");SBAR();
    #define PK(k) (bf16x8){lo[k][0],lo[k][1],lo[k][2],lo[k][3],hi[k][0],hi[k][1],hi[k][2],hi[k][3]}
    o[d0]=__builtin_amdgcn_mfma_f32_32x32x16_bf16(pa0,PK(0),o[d0],0,0,0);
    o[d0]=__builtin_amdgcn_mfma_f32_32x32x16_bf16(pa1,PK(1),o[d0],0,0,0);
    o[d0]=__builtin_amdgcn_mfma_f32_32x32x16_bf16(pa2,PK(2),o[d0],0,0,0);
    o[d0]=__builtin_amdgcn_mfma_f32_32x32x16_bf16(pa3,PK(3),o[d0],0,0,0);
    #undef PK
  }
}

#ifndef ATTN_STORE16
#define ATTN_STORE16(p,v) (*(u32x4*)(p)=(v))
#endif
template<int THRL> __device__ __forceinline__ void attn_unit(int wave_sg,int b,int h,int hv,int qb,const bf16*Q,const bf16*__restrict__ K,const bf16*__restrict__ V,bf16*O,char*shm){
  int tid_=pg8::opq(wave_sg)*64+pg8::lane_id(); asm volatile("":"+v"(tid_)); const int tid=tid_,lane=tid&63,r32=lane&31,hi=lane>>5; const int wid=__builtin_amdgcn_readfirstlane(tid>>6);
  const long rowbase=(long)b*SEQ; const int q0=qb*QB;
  const bf16*Qw=Q+(rowbase+q0+wid*QBLK)*DM+h*D;
  const bf16*Kh=K+rowbase*DM+h*D,*Vh=V+rowbase*DM+hv*D;
  const unsigned lds0=(unsigned)(uintptr_t)shm;
  float*wsf=(float*)(shm+LDS_WS)+wid*64;
  const bf16*ksrc=Kh+(long)lane*DM+wid*8;
  const bf16*vsrc=Vh+(long)(16*(wid&3)+(lane>>2))*DM+(wid>>2)*32+(lane&3)*8;
  const unsigned kdst=lds0+LDS_K+wid*1024, vdst=lds0+LDS_V+wid*1024;
  #define DMA_K(t,slot) glds16(ksrc+(long)(t)*KVBLK*DM,(unsigned)__builtin_amdgcn_readfirstlane(kdst+(slot)))
  #define DMA_V(t,slot) glds16(vsrc+(long)(t)*KVBLK*DM,(unsigned)__builtin_amdgcn_readfirstlane(vdst+(slot)))
  const int vb0=(int)(lds0+LDS_V)+((lane>>4)&1)*32+(lane&3)*8+(4*hi+((lane&15)>>2))*64;
  const char*Kbase=shm+LDS_K; bf16x8 kf[8];
  const lds_cptr shm3=(lds_cptr)shm; const lds_cptr kp0=shm3+LDS_K+hi*1024+r32*16; const lds_cptr vp0=shm3+LDS_V+((lane>>4)&1)*32+(lane&3)*8+(4*hi+((lane&15)>>2))*64;
  const int NT=(q0+QB)/KVBLK;
  DMA_K(0,0);DMA_V(0,0);DMA_K(1,SLOTB);
  bf16x8 qr[4];
  #pragma unroll
  for(int d0=0;d0<4;++d0)qr[d0]=*reinterpret_cast<const bf16x8*>(&Qw[(long)r32*DM+d0*16+hi*8]);
  float mhat=0.f,l_reg=0.f;f32x16 o[2];o[0]=f32x16{};o[1]=f32x16{};f32x16 negm=f32x16{};asm volatile("":"+v"(negm));
  const int qrel=wid*QBLK+r32;
  #define CMASK(P0,P1,t) do{int jb_=(t)-(NT-4); if(jb_>=0)cmask(P0,P1,jb_,qrel,hi);}while(0)
  bool resc=false;
  #define START(P0,P1) do{ const float rm=rowmax(P0,P1); resc=false; \
    { const float dl=rm; mhat=fadd_s(mhat,dl); \
      _Pragma("unroll") for(int r=0;r<16;++r){P0[r]=fsub_s(P0[r],dl);P1[r]=fsub_s(P1[r],dl);} \
      _Pragma("unroll") for(int r=0;r<16;++r)negm[r]=-mhat; asm volatile("":"+v"(negm)); } \
    _Pragma("unroll") for(int r=0;r<16;++r)P0[r]=__builtin_amdgcn_exp2f(P0[r]); }while(0)
  #define RESC() do{ if(resc){ asm volatile("s_waitcnt lgkmcnt(0)":::"memory"); \
      _Pragma("unroll") for(int d_=0;d_<2;++d_) _Pragma("unroll") for(int r=0;r<16;++r)o[d_][r]*=wsf[crow(r,hi)]; } }while(0)
  f32x16 pA0,pA1,pB0,pB1;
  int sl_prev=0,sl_cur=0,sl_next=SLOTB;
  #define ROT() do{sl_prev=sl_cur;sl_cur=sl_next;sl_next=(sl_next==(NSLOT-1)*SLOTB)?0:sl_next+SLOTB;}while(0)
  DMA_K(2,2*SLOTB);
  WAIT_BAR(3);
  qkt(pA0,pA1,Kbase,qr,negm,r32,hi);asm volatile("s_nop 15\n\ts_nop 7":"+v"(pA0),"+v"(pA1));CMASK(pA0,pA1,0);
  START(pA0,pA1);
  _Pragma("unroll") for(int r=0;r<16;++r)pA1[r]=__builtin_amdgcn_exp2f(pA1[r]);
  WAIT_BAR(0);
  DMA_K(3,0);DMA_V(1,SLOTB);
  ROT();
  kload8(kf,kp0+sl_cur);
  WAIT_BAR(2);
  s16x4 vlo[8],vhi[8]; u32x4 pw0,pw1,pw2,pw3;
  #define PKW(P,B) cvtpk_s(P[B],P[B+1])
  #define PAF(k) __builtin_bit_cast(bf16x8,pw##k)
  #define VFR(i) (bf16x8){vlo[i][0],vlo[i][1],vlo[i][2],vlo[i][3],vhi[i][0],vhi[i][1],vhi[i][2],vhi[i][3]}
  #define PIN(x) asm volatile("":"+v"(x))
  #define MX3(a,b,c) __builtin_fmaxf(__builtin_fmaxf((a),(b)),(c))
  #define GAPA(MF,A0,A1,A2,A3,W0,W1,PW) do{ MF; sacc+=A0; sacc+=A1; sacc+=A2; sacc+=A3; PIN(sacc); W0; W1; PIN(PW); SBAR(); }while(0)
  #define EX(v) __builtin_amdgcn_exp2f(v)
  #define GAPB(MF,X,B) do{ MF; X[B]=EX(X[B]); X[B+1]=EX(X[B+1]); X[B+2]=EX(X[B+2]); X[B+3]=EX(X[B+3]); PIN(X); SBAR(); }while(0)
  #define VRD(i) do{ vlo[i]=vtr(vp_+(((i)>>2)*4096+((i)&3)*1024)); vhi[i]=vtr(vp_+(((i)>>2)*4096+((i)&3)*1024+512)); }while(0)
  #define KRD(G,j) do{ if(G){ kload2(kf,kp0+sl_next,j); SBAR(); } }while(0)
  #define STEP(C0,C1,P0,P1,t,GK,GV,GL) do{ SBAR(); \
    const lds_cptr vp_=vp0+sl_prev; \
    VRD(0); SBAR(); float sacc=(P0[0]+P0[1]); \
    GAPA(C0=__builtin_amdgcn_mfma_f32_32x32x16_bf16(kf[0],qr[0],negm,0,0,0), P0[2],P0[3],P0[4],P0[5],     pw0[0]=PKW(P0,0), pw0[1]=PKW(P0,2), pw0); \
    VRD(4); SBAR(); GAPA(C1=__builtin_amdgcn_mfma_f32_32x32x16_bf16(kf[1],qr[0],negm,0,0,0), P0[6],P0[7],P0[8],P0[9],     pw0[2]=PKW(P0,4), pw0[3]=PKW(P0,6), pw0); \
    VRD(1); SBAR(); GAPA(C0=__builtin_amdgcn_mfma_f32_32x32x16_bf16(kf[2],qr[1],C0,0,0,0),   P0[10],P0[11],P0[12],P0[13], pw1[0]=PKW(P0,8), pw1[1]=PKW(P0,10), pw1); \
    VRD(5); SBAR(); GAPA(C1=__builtin_amdgcn_mfma_f32_32x32x16_bf16(kf[3],qr[1],C1,0,0,0),   P0[14],P0[15],P1[0],P1[1],   pw1[2]=PKW(P0,12),pw1[3]=PKW(P0,14), pw1); \
    VRD(2); SBAR(); GAPA(C0=__builtin_amdgcn_mfma_f32_32x32x16_bf16(kf[4],qr[2],C0,0,0,0),   P1[2],P1[3],P1[4],P1[5],     pw2[0]=PKW(P1,0), pw2[1]=PKW(P1,2), pw2); \
    VRD(6); SBAR(); GAPA(C1=__builtin_amdgcn_mfma_f32_32x32x16_bf16(kf[5],qr[2],C1,0,0,0),   P1[6],P1[7],P1[8],P1[9],     pw2[2]=PKW(P1,4), pw2[3]=PKW(P1,6), pw2); \
    VRD(3); SBAR(); GAPA(C0=__builtin_amdgcn_mfma_f32_32x32x16_bf16(kf[6],qr[3],C0,0,0,0),   P1[10],P1[11],P1[12],P1[13], pw3[0]=PKW(P1,8), pw3[1]=PKW(P1,10), pw3); \
    VRD(7); SBAR(); GAPA(C1=__builtin_amdgcn_mfma_f32_32x32x16_bf16(kf[7],qr[3],C1,0,0,0),   P1[14],P1[15],0.f,0.f,       pw3[2]=PKW(P1,12),pw3[3]=PKW(P1,14), pw3); \
    l_reg+=sacc; \
    if(GK){DMA_K((t)+3,sl_cur);} if(GV){DMA_V((t)+1,sl_next);} \
    CMASK(C0,C1,t); \
    { float a=MX3(C0[0],C0[1],C1[0]),b=MX3(C0[2],C0[3],C1[1]); a=MX3(a,C1[2],C1[3]); \
      _Pragma("unroll") for(int r=4;r<16;r+=4){a=MX3(a,C0[r],C0[r+1]);b=MX3(b,C0[r+2],C0[r+3]);a=MX3(a,C1[r],C1[r+1]);b=MX3(b,C1[r+2],C1[r+3]);} \
      float rm=__builtin_fmaxf(a,b); { auto rr=__builtin_amdgcn_permlane32_swap(__float_as_uint(rm),__float_as_uint(rm),false,false); rm=__builtin_fmaxf(__uint_as_float(rr[0]),__uint_as_float(rr[1])); } \
      resc=false; \
      if(__builtin_expect(__any(rm>(float)THRL),0)){ const float dl=__builtin_fmaxf(rm,0.f); mhat+=dl; \
        _Pragma("unroll") for(int r=0;r<16;++r){C0[r]-=dl;C1[r]-=dl;} \
        _Pragma("unroll") for(int r=0;r<16;++r)negm[r]=-mhat; asm volatile("":"+v"(negm)); \
        const float f=__builtin_amdgcn_exp2f(-dl); l_reg*=f; if(hi==0)wsf[r32]=f; resc=true; } } \
    SBAR(); \
    GAPB(o[0]=__builtin_amdgcn_mfma_f32_32x32x16_bf16(PAF(0),VFR(0),o[0],0,0,0), C0,0); \
    GAPB(o[1]=__builtin_amdgcn_mfma_f32_32x32x16_bf16(PAF(0),VFR(4),o[1],0,0,0), C0,4); \
    KRD(GL,0); GAPB(o[0]=__builtin_amdgcn_mfma_f32_32x32x16_bf16(PAF(1),VFR(1),o[0],0,0,0), C0,8); \
    KRD(GL,1); GAPB(o[1]=__builtin_amdgcn_mfma_f32_32x32x16_bf16(PAF(1),VFR(5),o[1],0,0,0), C0,12); \
    KRD(GL,2); GAPB(o[0]=__builtin_amdgcn_mfma_f32_32x32x16_bf16(PAF(2),VFR(2),o[0],0,0,0), C1,0); \
    KRD(GL,3); GAPB(o[1]=__builtin_amdgcn_mfma_f32_32x32x16_bf16(PAF(2),VFR(6),o[1],0,0,0), C1,4); \
    GAPB(o[0]=__builtin_amdgcn_mfma_f32_32x32x16_bf16(PAF(3),VFR(3),o[0],0,0,0), C1,8); \
    GAPB(o[1]=__builtin_amdgcn_mfma_f32_32x32x16_bf16(PAF(3),VFR(7),o[1],0,0,0), C1,12); \
    }while(0)
  int t=1;
  #undef CMASK
  #define CMASK(P0,P1,t) do{}while(0)
  for(;t+5<NT;t+=2){
    STEP(pB0,pB1,pA0,pA1,t,true,true,true);     WAIT_BAR(2); RESC(); ROT();
    STEP(pA0,pA1,pB0,pB1,t+1,true,true,true);   WAIT_BAR(2); RESC(); ROT();
  }
  #undef CMASK
  #define CMASK(P0,P1,t) do{int jb_=(t)-(NT-4); if(jb_>=0)cmask(P0,P1,jb_,qrel,hi);}while(0)
  #define ENDW(tt) do{ if((tt)+3<NT){WAIT_BAR(2);} else if((tt)+2<NT){WAIT_BAR(1);} else {WAIT_BAR(0);} }while(0)
  for(;t+1<NT;t+=2){
    STEP(pB0,pB1,pA0,pA1,t,(t+3<NT),(t+1<NT),(t+1<NT));       ENDW(t);   RESC(); ROT();
    STEP(pA0,pA1,pB0,pB1,t+1,(t+4<NT),(t+2<NT),(t+2<NT));     ENDW(t+1); RESC(); ROT();
  }
  STEP(pB0,pB1,pA0,pA1,NT-1,false,false,false); RESC();
  { float sacc=pB0[0]+pB0[1]; _Pragma("unroll") for(int r=2;r<16;++r)sacc+=pB0[r]; _Pragma("unroll") for(int r=0;r<16;++r)sacc+=pB1[r]; l_reg+=sacc;
    pw0=(u32x4){PKW(pB0,0),PKW(pB0,2),PKW(pB0,4),PKW(pB0,6)};pw1=(u32x4){PKW(pB0,8),PKW(pB0,10),PKW(pB0,12),PKW(pB0,14)};pw2=(u32x4){PKW(pB1,0),PKW(pB1,2),PKW(pB1,4),PKW(pB1,6)};pw3=(u32x4){PKW(pB1,8),PKW(pB1,10),PKW(pB1,12),PKW(pB1,14)};
    SBAR(); pv(o,vb0+sl_cur,PAF(0),PAF(1),PAF(2),PAF(3)); }
  #undef PKW
  #undef PAF
  #undef VFR
  #undef PIN
  #undef MX3
  #undef GAPA
  #undef GAPB
  #undef EX
  #undef VRD
  #undef KRD
  #undef STEP
  #undef ENDW
  {auto rr=__builtin_amdgcn_permlane32_swap(__float_as_uint(l_reg),__float_as_uint(l_reg),false,false);l_reg=__uint_as_float(rr[0])+__uint_as_float(rr[1]);}
  if(hi==0)wsf[32+r32]=l_reg;asm volatile("s_waitcnt lgkmcnt(0)":::"memory");
  float rli[16];
  #pragma unroll
  for(int r=0;r<16;++r)rli[r]=__builtin_amdgcn_rcpf(wsf[32+crow(r,hi)]);
  bf16*Ow=O+(rowbase+q0+wid*QBLK)*DM+hv*D;
  { bf16*stg=(bf16*)(shm+LDS_OST)+wid*2048;
    #pragma unroll
    for(int r=0;r<16;++r){const int orow=crow(r,hi);
      #pragma unroll
      for(int d0=0;d0<2;++d0)stg[orow*64+d0*32+r32]=__float2bfloat16(o[d0][r]*rli[r]);}
    asm volatile("s_waitcnt lgkmcnt(0)":::"memory");
    #pragma unroll
    for(int i=0;i<4;++i){const int row=i*8+(lane>>3),ch=lane&7; const u32x4 v=*(const u32x4*)(stg+row*64+ch*8); ATTN_STORE16(Ow+(long)row*DM+ch*8,v);} }
  asm volatile("s_waitcnt lgkmcnt(0)\n\ts_barrier":::"memory");
  #undef DMA_K
  #undef DMA_V
  #undef CMASK
  #undef START
  #undef RESC
  #undef ROT
}
constexpr int VSLOTB=16384, LW_K=0, LW_V=NSLOT*SLOTB, LW_WS=LW_V+NSLOT*VSLOTB, LW_BYTES=LW_WS+NW*64*4;
static_assert(NW*8192<=LW_WS,"O stage overlays the K/V rings");
__device__ __forceinline__ void pv4(f32x16*o,int vb,bf16x8 pa0,bf16x8 pa1,bf16x8 pa2,bf16x8 pa3){
  #pragma unroll
  for(int d0=0;d0<4;++d0){s16x4 lo[4],hi[4];
    #pragma unroll
    for(int ks=0;ks<4;++ks){
      asm volatile("ds_read_b64_tr_b16 %0,%1 offset:%c2":"=&v"(lo[ks]):"v"(vb),"i"(d0*4096+ks*1024):"memory");
      asm volatile("ds_read_b64_tr_b16 %0,%1 offset:%c2":"=&v"(hi[ks]):"v"(vb),"i"(d0*4096+ks*1024+512):"memory");}
    asm volatile("s_waitcnt lgkmcnt(0)":::"memory");SBAR();
    #define PK(k) (bf16x8){lo[k][0],lo[k][1],lo[k][2],lo[k][3],hi[k][0],hi[k][1],hi[k][2],hi[k][3]}
    o[d0]=__builtin_amdgcn_mfma_f32_32x32x16_bf16(pa0,PK(0),o[d0],0,0,0);
    o[d0]=__builtin_amdgcn_mfma_f32_32x32x16_bf16(pa1,PK(1),o[d0],0,0,0);
    o[d0]=__builtin_amdgcn_mfma_f32_32x32x16_bf16(pa2,PK(2),o[d0],0,0,0);
    o[d0]=__builtin_amdgcn_mfma_f32_32x32x16_bf16(pa3,PK(3),o[d0],0,0,0);
    #undef PK
  }
}
__device__ __forceinline__ void attn_unit_w(int wave_sg,int b,int h8,int m,int qb,const bf16*Q,const bf16*__restrict__ K,const bf16*__restrict__ V,bf16*O,char*shm,bf16*YAo,const float*fz){
  int tid_=pg8::opq(wave_sg)*64+pg8::lane_id(); asm volatile("":"+v"(tid_)); const int tid=tid_,lane=tid&63,r32=lane&31,hi=lane>>5; const int wid=__builtin_amdgcn_readfirstlane(tid>>6);
  const long rowbase=(long)b*SEQ; const int q0=qb*QB; const int hq=2*h8+m;
  const bf16*Qw=Q+(rowbase+q0+wid*QBLK)*DM+hq*D;
  const bf16*Kh=K+rowbase*DM+hq*D,*Vh=V+rowbase*DM+h8*128;
  const unsigned lds0=(unsigned)(uintptr_t)shm;
  float*wsf=(float*)(shm+LW_WS)+wid*64;
  const bf16*ksrc=Kh+(long)lane*DM+wid*8;
  const bf16*vsrcA=Vh+(long)(16*(wid&3)+(lane>>2))*DM+(wid>>2)*32+(lane&3)*8;
  const bf16*vsrcB=vsrcA+64;
  const unsigned kdst=lds0+LW_K+wid*1024, vdstA=lds0+LW_V+wid*1024, vdstB=vdstA+8192;
  #define DMA_K(t,slot) glds16(ksrc+(long)(t)*KVBLK*DM,(unsigned)__builtin_amdgcn_readfirstlane(kdst+(slot)))
  #define DMA_V(t,slot) do{ glds16(vsrcA+(long)(t)*KVBLK*DM,(unsigned)__builtin_amdgcn_readfirstlane(vdstA+2*(slot))); glds16(vsrcB+(long)(t)*KVBLK*DM,(unsigned)__builtin_amdgcn_readfirstlane(vdstB+2*(slot))); }while(0)
  const int vb0=(int)(lds0+LW_V)+((lane>>4)&1)*32+(lane&3)*8+(4*hi+((lane&15)>>2))*64;
  const char*Kbase=shm+LW_K; bf16x8 kf[8];
  const lds_cptr shm3=(lds_cptr)shm; const lds_cptr kp0=shm3+LW_K+hi*1024+r32*16; const lds_cptr vp0=shm3+LW_V+((lane>>4)&1)*32+(lane&3)*8+(4*hi+((lane&15)>>2))*64;
  const int NT=(q0+QB)/KVBLK;
  DMA_K(0,0);DMA_V(0,0);DMA_K(1,SLOTB);
  bf16x8 qr[4];
  #pragma unroll
  for(int d0=0;d0<4;++d0)qr[d0]=*reinterpret_cast<const bf16x8*>(&Qw[(long)r32*DM+d0*16+hi*8]);
  float l_reg=0.f;f32x16 o[4];o[0]=f32x16{};o[1]=f32x16{};o[2]=f32x16{};o[3]=f32x16{};
  const int qrel=wid*QBLK+r32;
  #define CMASK(P0,P1,t) do{int jb_=(t)-(NT-4); if(jb_>=0)cmask(P0,P1,jb_,qrel,hi);}while(0)
  f32x16 pA0,pA1,pB0,pB1;
  int sl_prev=0,sl_cur=0,sl_next=SLOTB;
  #define ROT() do{sl_prev=sl_cur;sl_cur=sl_next;sl_next=(sl_next==(NSLOT-1)*SLOTB)?0:sl_next+SLOTB;}while(0)
  DMA_K(2,2*SLOTB);
  WAIT_BAR(4);
  { const char*kb=Kbase+hi*1024+r32*16;
    #pragma unroll
    for(int d0=0;d0<4;++d0){
      const bf16x8 b0=*reinterpret_cast<const bf16x8*>(kb+d0*2048);
      const bf16x8 b1=*reinterpret_cast<const bf16x8*>(kb+d0*2048+512);
      if(d0==0){pA0=__builtin_amdgcn_mfma_f32_32x32x16_bf16(b0,qr[0],f32x16{},0,0,0);pA1=__builtin_amdgcn_mfma_f32_32x32x16_bf16(b1,qr[0],f32x16{},0,0,0);}
      else{pA0=__builtin_amdgcn_mfma_f32_32x32x16_bf16(b0,qr[d0],pA0,0,0,0);pA1=__builtin_amdgcn_mfma_f32_32x32x16_bf16(b1,qr[d0],pA1,0,0,0);}} }
  asm volatile("s_nop 15\n\ts_nop 7":"+v"(pA0),"+v"(pA1));CMASK(pA0,pA1,0);
  _Pragma("unroll") for(int r=0;r<16;++r){pA0[r]=__builtin_amdgcn_exp2f(pA0[r]);pA1[r]=__builtin_amdgcn_exp2f(pA1[r]);}
  WAIT_BAR(0);
  DMA_K(3,0);DMA_V(1,SLOTB);
  ROT();
  kload8(kf,kp0+sl_cur);
  WAIT_BAR(3);
  s16x4 vlo[8],vhi[8]; u32x4 pw0,pw1,pw2,pw3;
  #define PKW(P,B) cvtpk_s(P[B],P[B+1])
  #define PAF(k) __builtin_bit_cast(bf16x8,pw##k)
  #define VFR(i) (bf16x8){vlo[i][0],vlo[i][1],vlo[i][2],vlo[i][3],vhi[i][0],vhi[i][1],vhi[i][2],vhi[i][3]}
  #define PIN(x) asm volatile("":"+v"(x))
  #define GAPA(MF,A0,A1,A2,A3,W0,W1,PW) do{ MF; sacc+=A0; sacc+=A1; sacc+=A2; sacc+=A3; PIN(sacc); W0; W1; PIN(PW); SBAR(); }while(0)
  #define EX(v) __builtin_amdgcn_exp2f(v)
  #define GAPB(MF,X,B) do{ MF; X[B]=EX(X[B]); X[B+1]=EX(X[B+1]); PIN(X); SBAR(); }while(0)
  #define VRD(j,i) do{ vlo[j]=vtr(vp_+(((i)>>2)*4096+((i)&3)*1024)); vhi[j]=vtr(vp_+(((i)>>2)*4096+((i)&3)*1024+512)); }while(0)
  #define KRD(G,j) do{ if(G){ kload2(kf,kp0+sl_next,j); SBAR(); } }while(0)
  #define STEP(C0,C1,P0,P1,t,GK,GV,GL) do{ SBAR(); \
    const lds_cptr vp_=vp0+2*sl_prev; \
    VRD(0,0); SBAR(); float sacc=(P0[0]+P0[1]); \
    GAPA(C0=__builtin_amdgcn_mfma_f32_32x32x16_bf16(kf[0],qr[0],f32x16{},0,0,0), P0[2],P0[3],P0[4],P0[5],     pw0[0]=PKW(P0,0), pw0[1]=PKW(P0,2), pw0); \
    VRD(4,4); SBAR(); GAPA(C1=__builtin_amdgcn_mfma_f32_32x32x16_bf16(kf[1],qr[0],f32x16{},0,0,0), P0[6],P0[7],P0[8],P0[9],     pw0[2]=PKW(P0,4), pw0[3]=PKW(P0,6), pw0); \
    VRD(1,1); SBAR(); GAPA(C0=__builtin_amdgcn_mfma_f32_32x32x16_bf16(kf[2],qr[1],C0,0,0,0),   P0[10],P0[11],P0[12],P0[13], pw1[0]=PKW(P0,8), pw1[1]=PKW(P0,10), pw1); \
    VRD(5,5); SBAR(); GAPA(C1=__builtin_amdgcn_mfma_f32_32x32x16_bf16(kf[3],qr[1],C1,0,0,0),   P0[14],P0[15],P1[0],P1[1],   pw1[2]=PKW(P0,12),pw1[3]=PKW(P0,14), pw1); \
    VRD(2,2); SBAR(); GAPA(C0=__builtin_amdgcn_mfma_f32_32x32x16_bf16(kf[4],qr[2],C0,0,0,0),   P1[2],P1[3],P1[4],P1[5],     pw2[0]=PKW(P1,0), pw2[1]=PKW(P1,2), pw2); \
    VRD(6,6); SBAR(); GAPA(C1=__builtin_amdgcn_mfma_f32_32x32x16_bf16(kf[5],qr[2],C1,0,0,0),   P1[6],P1[7],P1[8],P1[9],     pw2[2]=PKW(P1,4), pw2[3]=PKW(P1,6), pw2); \
    VRD(3,3); SBAR(); GAPA(C0=__builtin_amdgcn_mfma_f32_32x32x16_bf16(kf[6],qr[3],C0,0,0,0),   P1[10],P1[11],P1[12],P1[13], pw3[0]=PKW(P1,8), pw3[1]=PKW(P1,10), pw3); \
    VRD(7,7); SBAR(); GAPA(C1=__builtin_amdgcn_mfma_f32_32x32x16_bf16(kf[7],qr[3],C1,0,0,0),   P1[14],P1[15],0.f,0.f,       pw3[2]=PKW(P1,12),pw3[3]=PKW(P1,14), pw3); \
    l_reg+=sacc; \
    if(GK){DMA_K((t)+3,sl_cur);} if(GV){DMA_V((t)+1,sl_next);} \
    CMASK(C0,C1,t); \
    SBAR(); \
    GAPB(o[0]=__builtin_amdgcn_mfma_f32_32x32x16_bf16(PAF(0),VFR(0),o[0],0,0,0), C0,0);  VRD(0,8);  SBAR(); \
    GAPB(o[1]=__builtin_amdgcn_mfma_f32_32x32x16_bf16(PAF(0),VFR(4),o[1],0,0,0), C0,2);  VRD(4,12); SBAR(); \
    KRD(GL,0); GAPB(o[0]=__builtin_amdgcn_mfma_f32_32x32x16_bf16(PAF(1),VFR(1),o[0],0,0,0), C0,4);  VRD(1,9);  SBAR(); \
    KRD(GL,1); GAPB(o[1]=__builtin_amdgcn_mfma_f32_32x32x16_bf16(PAF(1),VFR(5),o[1],0,0,0), C0,6);  VRD(5,13); SBAR(); \
    KRD(GL,2); GAPB(o[0]=__builtin_amdgcn_mfma_f32_32x32x16_bf16(PAF(2),VFR(2),o[0],0,0,0), C0,8);  VRD(2,10); SBAR(); \
    KRD(GL,3); GAPB(o[1]=__builtin_amdgcn_mfma_f32_32x32x16_bf16(PAF(2),VFR(6),o[1],0,0,0), C0,10); VRD(6,14); SBAR(); \
    GAPB(o[0]=__builtin_amdgcn_mfma_f32_32x32x16_bf16(PAF(3),VFR(3),o[0],0,0,0), C0,12); VRD(3,11); SBAR(); \
    GAPB(o[1]=__builtin_amdgcn_mfma_f32_32x32x16_bf16(PAF(3),VFR(7),o[1],0,0,0), C0,14); VRD(7,15); SBAR(); \
    GAPB(o[2]=__builtin_amdgcn_mfma_f32_32x32x16_bf16(PAF(0),VFR(0),o[2],0,0,0), C1,0); \
    GAPB(o[3]=__builtin_amdgcn_mfma_f32_32x32x16_bf16(PAF(0),VFR(4),o[3],0,0,0), C1,2); \
    GAPB(o[2]=__builtin_amdgcn_mfma_f32_32x32x16_bf16(PAF(1),VFR(1),o[2],0,0,0), C1,4); \
    GAPB(o[3]=__builtin_amdgcn_mfma_f32_32x32x16_bf16(PAF(1),VFR(5),o[3],0,0,0), C1,6); \
    GAPB(o[2]=__builtin_amdgcn_mfma_f32_32x32x16_bf16(PAF(2),VFR(2),o[2],0,0,0), C1,8); \
    GAPB(o[3]=__builtin_amdgcn_mfma_f32_32x32x16_bf16(PAF(2),VFR(6),o[3],0,0,0), C1,10); \
    GAPB(o[2]=__builtin_amdgcn_mfma_f32_32x32x16_bf16(PAF(3),VFR(3),o[2],0,0,0), C1,12); \
    GAPB(o[3]=__builtin_amdgcn_mfma_f32_32x32x16_bf16(PAF(3),VFR(7),o[3],0,0,0), C1,14); \
    }while(0)
  int t=1;
  #undef CMASK
  #define CMASK(P0,P1,t) do{}while(0)
  for(;t+5<NT;t+=2){
    STEP(pB0,pB1,pA0,pA1,t,true,true,true);     WAIT_BAR(3); ROT();
    STEP(pA0,pA1,pB0,pB1,t+1,true,true,true);   WAIT_BAR(3); ROT();
  }
  #undef CMASK
  #define CMASK(P0,P1,t) do{int jb_=(t)-(NT-4); if(jb_>=0)cmask(P0,P1,jb_,qrel,hi);}while(0)
  #define ENDW(tt) do{ if((tt)+3<NT){WAIT_BAR(3);} else if((tt)+2<NT){WAIT_BAR(2);} else {WAIT_BAR(0);} }while(0)
  for(;t+1<NT;t+=2){
    STEP(pB0,pB1,pA0,pA1,t,(t+3<NT),(t+1<NT),(t+1<NT));       ENDW(t);   ROT();
    STEP(pA0,pA1,pB0,pB1,t+1,(t+4<NT),(t+2<NT),(t+2<NT));     ENDW(t+1); ROT();
  }
  STEP(pB0,pB1,pA0,pA1,NT-1,false,false,false);
  { float sacc=pB0[0]+pB0[1]; _Pragma("unroll") for(int r=2;r<16;++r)sacc+=pB0[r]; _Pragma("unroll") for(int r=0;r<16;++r)sacc+=pB1[r]; l_reg+=sacc;
    pw0=(u32x4){PKW(pB0,0),PKW(pB0,2),PKW(pB0,4),PKW(pB0,6)};pw1=(u32x4){PKW(pB0,8),PKW(pB0,10),PKW(pB0,12),PKW(pB0,14)};pw2=(u32x4){PKW(pB1,0),PKW(pB1,2),PKW(pB1,4),PKW(pB1,6)};pw3=(u32x4){PKW(pB1,8),PKW(pB1,10),PKW(pB1,12),PKW(pB1,14)};
    SBAR(); pv4(o,vb0+2*sl_cur,PAF(0),PAF(1),PAF(2),PAF(3)); }
  #undef PKW
  #undef PAF
  #undef VFR
  #undef PIN
  #undef GAPA
  #undef GAPB
  #undef EX
  #undef VRD
  #undef KRD
  #undef STEP
  #undef ENDW
  {auto rr=__builtin_amdgcn_permlane32_swap(__float_as_uint(l_reg),__float_as_uint(l_reg),false,false);l_reg=__uint_as_float(rr[0])+__uint_as_float(rr[1]);}
  if(hi==0)wsf[32+r32]=l_reg;
  asm volatile("s_waitcnt lgkmcnt(0)\n\ts_barrier":::"memory");
  float rli[16];
  #pragma unroll
  for(int r=0;r<16;++r)rli[r]=__builtin_amdgcn_rcpf(wsf[32+crow(r,hi)]);
  bf16*Ow=O+(rowbase+q0+wid*QBLK)*DM+h8*128;
  { bf16*stg=(bf16*)shm+wid*4096;
    #pragma unroll
    for(int r=0;r<16;++r){const int orow=crow(r,hi);
      #pragma unroll
      for(int d0=0;d0<4;++d0)stg[orow*128+d0*32+r32]=__float2bfloat16(o[d0][r]*rli[r]);}
    asm volatile("s_waitcnt lgkmcnt(0)":::"memory");
    if(fz==nullptr){
    #pragma unroll
    for(int i=0;i<8;++i){const int row=i*4+(lane>>4),ch=lane&15; const u32x4 v=*(const u32x4*)(stg+row*128+ch*8); ATTN_STORE16(Ow+(long)row*DM+ch*8,v);} }
    else{ const bf16*O0w=Ow; bf16*Yw=YAo+(rowbase+q0+wid*QBLK)*DM+h8*128; const int ch=lane&15; const float lam=fz[0];
      asm volatile("s_waitcnt vmcnt(0)":::"memory");
      u32x4 a0[8];
      #pragma unroll
      for(int i=0;i<8;++i)a0[i]=*(const u32x4*)(O0w+(long)(i*4+(lane>>4))*DM+ch*8);
      float sl8[8];
      #pragma unroll
      for(int e=0;e<8;++e)sl8[e]=fz[2+ch*8+e];
      #pragma unroll
      for(int i=0;i<8;++i){const int row=i*4+(lane>>4); const u32x4 v1=*(const u32x4*)(stg+row*128+ch*8);
        const unsigned aw[4]={a0[i].x,a0[i].y,a0[i].z,a0[i].w},bw[4]={v1.x,v1.y,v1.z,v1.w}; float d[8]; float ss=0.f;
        #pragma unroll
        for(int j=0;j<4;++j){d[2*j]=__uint_as_float(aw[j]<<16)-lam*__uint_as_float(bw[j]<<16); d[2*j+1]=__uint_as_float(aw[j]&0xffff0000u)-lam*__uint_as_float(bw[j]&0xffff0000u); ss+=d[2*j]*d[2*j]+d[2*j+1]*d[2*j+1];}
        ss=pg8::row_sum16(ss);
        const float rr=1.0f/sqrtf(ss*(1.f/128.f)+1e-6f);
        u32x4 w; w.x=cvtpk_s(d[0]*rr*sl8[0],d[1]*rr*sl8[1]); w.y=cvtpk_s(d[2]*rr*sl8[2],d[3]*rr*sl8[3]); w.z=cvtpk_s(d[4]*rr*sl8[4],d[5]*rr*sl8[5]); w.w=cvtpk_s(d[6]*rr*sl8[6],d[7]*rr*sl8[7]);
        ATTN_STORE16(Yw+(long)row*DM+ch*8,w);} } }
  asm volatile("s_waitcnt lgkmcnt(0)\n\ts_barrier":::"memory");
  #undef DMA_K
  #undef DMA_V
  #undef CMASK
  #undef ROT
}
constexpr int ATTN_LDS_BYTES=LDS_BYTES;
struct AttnTensors { const bf16* Q; const bf16* K; const bf16* V; bf16* O; };
struct AttnUnit { int b, hq, hv, m, qb; };
struct StaticOrder {
  int vcu, G;
  __device__ __forceinline__ explicit StaticOrder(int grid,int block):vcu((grid%8==0)?(block%8)*(grid/8)+block/8:block),G(grid){}
  __device__ __forceinline__ bool next(int i,AttnUnit&u)const{ const int g=vcu+(i>>3)*G; if(g>=256)return false; const int vh=g&1,m=(g>>1)&1,h8=(g>>2)&7; u.b=g>>5; u.hq=2*h8+m; u.hv=2*h8+vh; u.m=m; u.qb=7-(i&7); return true; }
  __device__ __forceinline__ void a_ready(const AttnUnit&)const{}
  __device__ __forceinline__ void done(const AttnUnit&)const{}
};
template<class Sched,int THRL=8> __device__ __forceinline__ void attn_phase(char*lds,const AttnTensors&T,const Sched&S,const int wave_sg){
  AttnUnit u; const bf16*Qp=pg8::uni_ptr(T.Q),*Kp=pg8::uni_ptr(T.K),*Vp=pg8::uni_ptr(T.V); bf16*Op=pg8::uni_ptr(T.O);
  for(int i=0;S.next(i,u);++i){ S.a_ready(u); attn_unit<THRL>(wave_sg,u.b,u.hq,u.hv,u.qb,Qp,Kp,Vp,Op+(size_t)u.m*((size_t)BATCH*SEQ*DM),lds); S.done(u); }
}
#undef SBAR
#undef WAIT_BAR
}
#define GAS __attribute__((address_space(1)))
#define LAS __attribute__((address_space(3)))
typedef unsigned short bf16;
typedef unsigned v4u __attribute__((ext_vector_type(4)));
typedef float f32x4 __attribute__((ext_vector_type(4)));
typedef short bf16x8 __attribute__((ext_vector_type(8)));
typedef GAS unsigned gu32;
typedef GAS unsigned long long gu64;
#define RLX_AGENT __ATOMIC_RELAXED, __HIP_MEMORY_SCOPE_AGENT
#define LDS_WAIT() asm volatile("s_waitcnt lgkmcnt(0)" ::: "memory")
#define VM_WAIT() asm volatile("s_waitcnt vmcnt(0)" ::: "memory")
__device__ __forceinline__ unsigned long long rt() { return __builtin_amdgcn_s_memrealtime(); }
__device__ __forceinline__ unsigned f2bf(float f) { unsigned u = __builtin_bit_cast(unsigned, f); return (u + 0x7fffu + ((u >> 16) & 1u)) >> 16; }
__device__ __forceinline__ unsigned pk2(float lo, float hi) { return f2bf(lo) | (f2bf(hi) << 16); }

#define XB_TMO      128
#define XB_XCNT(j)  (256  + 64 * (j))
#define XB_XSUB(j)  (1280 + 64 * (j))
#define XB_XGEN(j)  (2304 + 64 * (j))
#define XB_TOP      3328
#define XB_TOPGEN   3392
#define XCD_BAR_WORDS 3456
#define XB_SPIN_CAP (1u << 18)

__device__ __forceinline__ unsigned xb_ld(unsigned* p)              { return __hip_atomic_load(p, __ATOMIC_RELAXED, __HIP_MEMORY_SCOPE_AGENT); }
__device__ __forceinline__ unsigned xb_add(unsigned* p, unsigned v) { return __hip_atomic_fetch_add(p, v, __ATOMIC_RELAXED, __HIP_MEMORY_SCOPE_AGENT); }
__device__ __forceinline__ unsigned xb_xcc_id() { return (unsigned)__builtin_amdgcn_s_getreg((3 << 11) | 20) & 0xFu; }
#define XB_SPIN(cond, bar) do { unsigned _sp = 0; while (cond) { __builtin_amdgcn_s_sleep(1); \
    if ((++_sp & 255u) == 0u) { if (xb_ld(&(bar)[XB_TMO])) break; if (_sp > XB_SPIN_CAP) { atomicAdd(&(bar)[XB_TMO], 1u); break; } } } } while (0)

struct XcdBarrier {
    unsigned* bar; unsigned x;
    volatile LAS unsigned* st;
};

__device__ __forceinline__ XcdBarrier xcd_barrier_post(unsigned* bar, volatile LAS unsigned* st, const bool t0) {
    XcdBarrier b; b.bar = bar; b.x = xb_xcc_id(); b.st = st;
    if (t0) (void)xb_add(&bar[XB_XCNT(b.x)], 1u);
    return b;
}
__device__ __forceinline__ void xcd_barrier_complete(unsigned* bar, unsigned x, unsigned& nloc, unsigned& nx) {
    const unsigned G = gridDim.x * gridDim.y * gridDim.z;
    unsigned sum, cnt, mine, sp = 0u;
    for (;;) {
        sum = 0u; cnt = 0u; mine = 0u;
#pragma unroll
        for (unsigned j = 0; j < 16; ++j) { const unsigned c = xb_ld(&bar[XB_XCNT(j)]); sum += c; cnt += (c > 0u) ? 1u : 0u; mine = (j == x) ? c : mine; }
        if (sum == G) break;
        __builtin_amdgcn_s_sleep(1);
        if ((++sp & 255u) == 0u) { if (xb_ld(&bar[XB_TMO])) break; if (sp > XB_SPIN_CAP) { atomicAdd(&bar[XB_TMO], 1u); break; } }
    }
    nloc = mine > 0u ? mine : 1u; nx = cnt > 0u ? cnt : 1u;
}

__device__ __forceinline__ void xcd_barrier(const XcdBarrier& b, const bool t0) {
    asm volatile("s_waitcnt vmcnt(0)" ::: "memory");
    __syncthreads();
    if (t0) {
        unsigned* bar = pg8::uni_ptr(b.bar);
        __builtin_amdgcn_s_waitcnt(0);
        unsigned nloc = b.st[0], nx = b.st[1];
        if (nloc == 0u) { xcd_barrier_complete(bar, b.x, nloc, nx); b.st[0] = nloc; b.st[1] = nx; }
        const unsigned old = xb_add(&bar[XB_XSUB(b.x)], 1u);
        const unsigned gen = old / nloc;
        if (old + 1u == (gen + 1u) * nloc) {
            __builtin_amdgcn_fence(__ATOMIC_RELEASE, "agent");
            asm volatile("s_waitcnt vmcnt(0)" ::: "memory");
            const unsigned og = xb_add(&bar[XB_TOP], 1u);
            const unsigned tg = og / nx;
            if (og + 1u == (tg + 1u) * nx) xb_add(&bar[XB_TOPGEN], 1u);
            else XB_SPIN(xb_ld(&bar[XB_TOPGEN]) == tg, bar);
            __builtin_amdgcn_fence(__ATOMIC_ACQUIRE, "agent");
            xb_add(&bar[XB_XGEN(b.x)], 1u);
            asm volatile("s_waitcnt vmcnt(0)" ::: "memory");
        } else {
            XB_SPIN(xb_ld(&bar[XB_XGEN(b.x)]) == gen, bar);
            __builtin_amdgcn_fence(__ATOMIC_ACQUIRE, "agent");
            asm volatile("s_waitcnt vmcnt(0)" ::: "memory");
        }
    }
    __syncthreads();
}

constexpr int NWAVES = 8;
constexpr int NB = 8, NT_ = 2048, DM_ = 2048, M = NB * NT_;
constexpr int MIXW = 1024, INC = 15360, FFH = 5632, MEMROWS = 2048;
constexpr int DEPTH = 2, NPH = 16;
constexpr float EPSN = 1e-6f;
constexpr float LOG2E = 1.4426950408889634f;

constexpr size_t MiB = 1u << 20;
constexpr size_t WS_CTL = 0, CTL_ZERO_BYTES = 1 * MiB;
constexpr size_t WS_LAM = 1 * MiB + 512 * 1024;
constexpr size_t WS_DCS = 1 * MiB, WS_RCS = 2 * MiB;
constexpr size_t WS_W = 4 * MiB;
constexpr int KPAD = 64;
constexpr int LD2K = DM_ + KPAD, LD1K = MIXW + KPAD, LDFF = FFH + KPAD;
constexpr size_t W_IN = WS_W, W_BR = W_IN + 62 * MiB, W_OUT = W_BR + 13 * MiB, W_Q = W_OUT + 9 * MiB, W_KV = W_Q + 9 * MiB, W_O = W_KV + 17 * MiB, W_13 = W_O + 9 * MiB, W_2 = W_13 + 46 * MiB, W_END = W_2 + 23 * MiB;
constexpr size_t WS_XN = W_END;
constexpr size_t WS_MN = WS_XN + 66 * MiB, WS_KM = WS_MN + 8 * MiB, WS_VT = WS_KM + 9 * MiB;
constexpr size_t WS_Y = WS_VT + 8 * MiB;
constexpr size_t WS_YRAW = WS_Y + 96 * MiB;
constexpr size_t WS_BIG = WS_YRAW + 64 * MiB;
constexpr size_t SEG = 32 * MiB, SEG_E = (size_t)16384 * 1024;
constexpr size_t WS_END_BIG = WS_BIG + 15 * SEG;
constexpr size_t RSS_STRIDE = (size_t)16384 * 32;
constexpr size_t WS_END = WS_END_BIG + 7 * RSS_STRIDE * 4;
static_assert(W_END == 192 * MiB && WS_END == 937 * MiB, "d_ws map");
constexpr size_t DO_WKV1 = 64 * MiB, DO_MN1 = 81 * MiB, DO_KV1 = 90 * MiB;
constexpr int CW_TMO = 0, CW_BAR = 4096, CW_Q = 8192;
constexpr size_t WS_RSS = WS_END_BIG;

constexpr int RING_OFF = 0, RING_BYTES = 131072;
constexpr int LDSCTL_OFF = RING_BYTES, MISC_OFF = LDSCTL_OFF + 320;
constexpr int LDS_BYTES = 147456;
static_assert(MISC_OFF + 128 <= LDS_BYTES, "LDS map");

struct Args { const float* in[22]; float* out; unsigned char* ws; int l_lo, l_hi; };
__device__ const float ROPE_INV[96] = {1.0f, 0.749894202f, 0.562341332f, 0.421696514f, 0.316227764f, 0.237137377f, 0.177827939f, 0.133352146f, 0.100000001f, 0.0749894232f, 0.0562341325f, 0.0421696492f, 0.0316227749f, 0.0237137377f, 0.0177827943f, 0.013335214f, 0.00999999978f, 0.00749894232f, 0.00562341325f, 0.00421696482f, 0.00316227763f, 0.00237137382f, 0.00177827943f, 0.00133352145f, 0.00100000005f, 0.000749894185f, 0.000562341302f, 0.000421696517f, 0.000316227757f, 0.00023713737f, 0.00017782794f, 0.00013335215f, 1.0f, 0.863988459f, 0.746476054f, 0.644946694f, 0.557226479f, 0.481437236f, 0.415956229f, 0.359381378f, 0.310501337f, 0.268269569f, 0.231781825f, 0.20025681f, 0.173019573f, 0.149486914f, 0.129154965f, 0.111588396f, 0.0964110866f, 0.0832980648f, 0.0719685704f, 0.0621800125f, 0.05372281f, 0.0464158878f, 0.040102791f, 0.0346483476f, 0.0299357735f, 0.0258641616f, 0.0223463364f, 0.0193069782f, 0.0166810062f, 0.0144121964f, 0.0124519709f, 0.010758359f, 0.00929509755f, 0.00803085696f, 0.00693856785f, 0.00599484239f, 0.0051794746f, 0.00447500637f, 0.00386635377f, 0.00334048504f, 0.00288614049f, 0.00249359198f, 0.0021544348f, 0.00186140672f, 0.0016082339f, 0.00138949545f, 0.00120050809f, 0.00103722513f, 0.000896150479f, 0.000774263695f, 0.000668954861f, 0.000577969302f, 0.000499358808f, 0.000431440218f, 0.000372759358f, 0.000322059786f, 0.000278255931f, 0.000240409921f, 0.00020771139f, 0.000179460243f, 0.000155051574f, 0.000133962778f, 0.000115742288f, 9.99999975e-05f};
struct Frame {
    LAS unsigned char* lds;
    volatile LAS unsigned* MISC;
    int vcu, G, wave;
};
#define PH_ENTER() const int wave = pg8::opq(F.wave), vcu_ = pg8::opq(F.vcu), G_ = pg8::opq(F.G); int tid = wave * 64 + pg8::lane_id(); asm volatile("" : "+v"(tid)); const int lane = tid & 63; (void)vcu_; (void)G_; \
    unsigned char* ws = pg8::uni_ptr(args.ws); (void)lane; (void)wave; (void)tid
__device__ __forceinline__ float wave_sum(float v) {
    v = pg8::xadd<1>(v); v = pg8::xadd<2>(v); v = pg8::xadd<4>(v); v = pg8::xadd<8>(v); v = pg8::xadd<16>(v); v = pg8::xadd<32>(v);
    return v;
}
__device__ __forceinline__ float wave_total(float v) {
#define DPPADD(ctrl, rmask) v += __int_as_float(__builtin_amdgcn_update_dpp(0, __float_as_int(v), ctrl, rmask, 0xf, true))
    DPPADD(0xB1, 0xf); DPPADD(0x4E, 0xf); DPPADD(0x141, 0xf); DPPADD(0x140, 0xf); DPPADD(0x142, 0xa); DPPADD(0x143, 0xc);
#undef DPPADD
    return __int_as_float(__builtin_amdgcn_readlane(__float_as_int(v), 63));
}
__device__ __forceinline__ float bflo(unsigned w) { return __uint_as_float(w << 16); }
__device__ __forceinline__ float bfhi(unsigned w) { return __uint_as_float(w & 0xffff0000u); }
__device__ __forceinline__ float sigm(float x) { return __builtin_amdgcn_rcpf(1.0f + __builtin_amdgcn_exp2f(-LOG2E * x)); }

template <int CMAP> __device__ __forceinline__ void transpose_item(const float* W, int K, int N, bf16* WT, int ldw, LAS float* scr, int item, int lane, const float* gain = nullptr) {
    const int nblk = N / 32, kb = item / nblk, nb = item % nblk, k0 = 64 * kb, n0 = 32 * nb;
    const int nn = n0 + (lane & 31); int sc = nn;
    if (CMAP == 1) sc = (nn & 1) * FFH + (nn >> 1);
    if (CMAP == 2) {
        if (nn < 2048) { const int w = nn & 63; sc = (nn & ~63) + (w & 1) * 32 + (w >> 1); }
        else if (nn >= 3072 && nn < 5120) { const int j = nn - 3072; sc = 3072 + (j & 1) * 1024 + (j >> 1); }
        else if (nn >= 5120 && nn < 7168) { const int w = (nn - 5120) & 127; sc = 5120 + ((nn - 5120) & ~127) + (w & 1) * 64 + (w >> 1); } }
    float wv[32]; const float gv = gain ? gain[k0 + lane] : 1.0f;
#pragma unroll
    for (int i = 0; i < 32; ++i) wv[i] = W[(size_t)(k0 + 2 * i + (lane >> 5)) * N + sc];
#pragma unroll
    for (int i = 0; i < 32; ++i) { const float g0 = __builtin_bit_cast(float, __builtin_amdgcn_readlane(__builtin_bit_cast(int, gv), 2 * i)), g1 = __builtin_bit_cast(float, __builtin_amdgcn_readlane(__builtin_bit_cast(int, gv), 2 * i + 1));
        scr[(2 * i + (lane >> 5)) * 33 + (lane & 31)] = wv[i] * ((lane >> 5) ? g1 : g0); }
    LDS_WAIT(); asm volatile("" ::: "memory");
    const int c = lane & 7;
#pragma unroll
    for (int j = 0; j < 4; ++j) { const int n = (lane >> 3) + 8 * j; const LAS float* s = scr + (8 * c) * 33 + n;
        v4u o; o.x = pk2(s[0 * 33], s[1 * 33]); o.y = pk2(s[2 * 33], s[3 * 33]); o.z = pk2(s[4 * 33], s[5 * 33]); o.w = pk2(s[6 * 33], s[7 * 33]);
        *(GAS v4u*)(WT + (size_t)(n0 + n) * ldw + k0 + 8 * c) = o; }
    LDS_WAIT(); asm volatile("" ::: "memory");
}
template <int CMAP> __device__ __forceinline__ int wt_row(int s) {
    if (CMAP == 1) return s < FFH ? 2 * s : 2 * (s - FFH) + 1;
    if (CMAP == 2) {
        if (s < 2048) { const int ws = s & 63; return (s & ~63) + (ws < 32 ? 2 * ws : 2 * (ws - 32) + 1); }
        if (s >= 3072 && s < 5120) { const int j = s - 3072; return 3072 + (j < 1024 ? 2 * j : 2 * (j - 1024) + 1); }
        if (s >= 5120 && s < 7168) { const int ws = (s - 5120) & 127; return 5120 + ((s - 5120) & ~127) + (ws < 64 ? 2 * ws : 2 * (ws - 64) + 1); } }
    return s;
}
template <int CMAP, int K> __device__ __forceinline__ void transpose_item_w(const float* W, int N, bf16* WT, int ldw, LAS unsigned char* scr, int item, int lane, const float* gain = nullptr) {
    constexpr int nkb = K / 64; const int nb = item / nkb, kb = item % nkb,
        k0 = 64 * kb, h = lane >> 5, cl = lane & 31, s0 = 128 * nb + 4 * cl;
    const float* src = W + (size_t)(k0 + h) * N + s0;
    f32x4 r[32]; const float gv = gain ? gain[k0 + lane] : 1.0f;
#pragma unroll
    for (int i = 0; i < 32; ++i) r[i] = *(const GAS f32x4*)(src + (size_t)(2 * i) * N);
    if (gain) {
#pragma unroll
        for (int i = 0; i < 32; ++i) { const float g0 = __builtin_bit_cast(float, __builtin_amdgcn_readlane(__builtin_bit_cast(int, gv), 2 * i)), g1 = __builtin_bit_cast(float, __builtin_amdgcn_readlane(__builtin_bit_cast(int, gv), 2 * i + 1));
            r[i] *= (h ? g1 : g0); } }
#pragma unroll
    for (int c0 = 0; c0 < 4; c0 += 2) {
#pragma unroll
        for (int d = 0; d < 2; ++d) {
            unsigned p[16];
#pragma unroll
            for (int i = 0; i < 16; ++i) { const auto rr = __builtin_amdgcn_permlane32_swap(__float_as_uint(r[i][c0 + d]), __float_as_uint(r[i + 16][c0 + d]), false, false);
                p[i] = pg8::cvt_pk_bf16(__uint_as_float(rr[0]), __uint_as_float(rr[1])); }
            const int rl = 2 * cl + d;
#pragma unroll
            for (int q = 0; q < 4; ++q) { v4u o; o.x = p[4 * q]; o.y = p[4 * q + 1]; o.z = p[4 * q + 2]; o.w = p[4 * q + 3];
                *(LAS v4u*)(scr + rl * 128 + (((4 * h + q) ^ (rl & 7)) << 4)) = o; }
        }
        LDS_WAIT(); asm volatile("" ::: "memory");
        v4u o[8];
#pragma unroll
        for (int j = 0; j < 8; ++j) { const int rl = (lane >> 3) + 8 * j; o[j] = *(const LAS v4u*)(scr + rl * 128 + (((lane & 7) ^ (rl & 7)) << 4)); }
        LDS_WAIT(); asm volatile("" ::: "memory");
#pragma unroll
        for (int j = 0; j < 8; ++j) { const int rl = (lane >> 3) + 8 * j; const int sc = 128 * nb + 4 * (rl >> 1) + c0 + (rl & 1);
            *(GAS v4u*)(WT + (size_t)wt_row<CMAP>(sc) * ldw + k0 + 8 * (lane & 7)) = o[j]; }
    }
}
__device__ __forceinline__ void convert_item(const float* W, bf16* WO, int ldw, int item, int lane, const float* gain) {
    const int kb = item / 64, nb = item % 64, k0 = 64 * kb, n0 = 32 * nb; const int kk = lane >> 3, c4 = (lane & 7) * 4;
    f32x4 v[8]; float g[8];
#pragma unroll
    for (int i = 0; i < 8; ++i) { const int k = k0 + 8 * i + kk; v[i] = *(const GAS f32x4*)(W + (size_t)k * DM_ + n0 + c4); g[i] = gain[k]; }
#pragma unroll
    for (int i = 0; i < 8; ++i) { const int k = k0 + 8 * i + kk;
        *(GAS unsigned long long*)(WO + (size_t)k * ldw + n0 + c4) = (unsigned long long)pk2(v[i].x * g[i], v[i].y * g[i]) | ((unsigned long long)pk2(v[i].z * g[i], v[i].w * g[i]) << 32); }
}
__device__ __forceinline__ void convert_item_w(const float* W, bf16* WO, int ldw, int item, int lane, const float* gain) {
    const int kb = item / 16, nb = item % 16, k0 = 64 * kb, h = lane >> 5, n0 = 128 * nb + 4 * (lane & 31);
    const float* src = W + (size_t)(k0 + h) * DM_ + n0; bf16* dst = WO + (size_t)(k0 + h) * ldw + n0;
    f32x4 r[32]; const float gv = gain[k0 + lane];
#pragma unroll
    for (int i = 0; i < 32; ++i) r[i] = *(const GAS f32x4*)(src + (size_t)(2 * i) * DM_);
#pragma unroll
    for (int i = 0; i < 32; ++i) { const float g0 = __builtin_bit_cast(float, __builtin_amdgcn_readlane(__builtin_bit_cast(int, gv), 2 * i)), g1 = __builtin_bit_cast(float, __builtin_amdgcn_readlane(__builtin_bit_cast(int, gv), 2 * i + 1));
        const f32x4 v = r[i] * (h ? g1 : g0);
        *(GAS unsigned long long*)(dst + (size_t)(2 * i) * ldw) = (unsigned long long)pg8::cvt_pk_bf16(v.x, v.y) | ((unsigned long long)pg8::cvt_pk_bf16(v.z, v.w) << 32); }
}
constexpr int LATE_ITEMS = 6528, LATE_ITEMS_IN = 3840, CHUNK_ITEMS = 32;
typedef const __attribute__((address_space(4))) unsigned char* kargp_t;
__device__ __forceinline__ const float* karg_in(kargp_t kp, int k) { return *(const float* const __attribute__((address_space(4)))*)(kp + 8 * k); }
__device__ __forceinline__ void late_item(kargp_t kp, unsigned char* ws, int l, int r, LAS unsigned char* scr, int lane) {
    if (r < 768) { const int br = r >> 8; transpose_item_w<0, MIXW>(karg_in(kp, 11) + ((size_t)l * 3 + br) * MIXW * DM_, DM_, (bf16*)(ws + W_BR) + (size_t)br * DM_ * LD1K, LD1K, scr, r & 255, lane); return; } r -= 768;
    if (r < 512) { transpose_item_w<0, DM_>(karg_in(kp, 12) + (size_t)l * DM_ * DM_, DM_, (bf16*)(ws + W_OUT), LD2K, scr, r, lane); return; } r -= 512;
    if (r < 512) { convert_item_w(karg_in(kp, 15) + (size_t)l * DM_ * DM_, (bf16*)(ws + W_Q), LD2K, r, lane, karg_in(kp, 13) + (size_t)l * DM_); return; } r -= 512;
    if (r < 512) { transpose_item_w<0, DM_>(karg_in(kp, 17) + (size_t)l * DM_ * DM_, DM_, (bf16*)(ws + W_O), LD2K, scr, r, lane); return; } r -= 512;
    if (r < 2816) { transpose_item_w<1, DM_>(karg_in(kp, 19) + (size_t)l * DM_ * 2 * FFH, 2 * FFH, (bf16*)(ws + W_13), LD2K, scr, r, lane, karg_in(kp, 18) + (size_t)l * DM_); return; } r -= 2816;
    if (r < 1408) { transpose_item_w<0, FFH>(karg_in(kp, 20) + (size_t)l * FFH * DM_, DM_, (bf16*)(ws + W_2), LDFF, scr, r, lane); return; } r -= 1408;
    transpose_item_w<2, DM_>(karg_in(kp, 3) + (size_t)(l + 1) * DM_ * INC, INC, (bf16*)(ws + W_IN), LD2K, scr, r, lane, karg_in(kp, 2) + (size_t)(l + 1) * DM_);
}
template <bool TOF32> __device__ __forceinline__ void rms_row(int lane, const float* xrow, const float* gain, void* orow) {
    const GAS f32x4* xr = (const GAS f32x4*)xrow + lane; const GAS f32x4* gr = (const GAS f32x4*)gain + lane;
    f32x4 v[8]; float s = 0.f;
#pragma unroll
    for (int j = 0; j < 8; ++j) { v[j] = xr[64 * j]; s += (v[j].x * v[j].x + v[j].y * v[j].y) + (v[j].z * v[j].z + v[j].w * v[j].w); }
    const float r = 1.0f / sqrtf(wave_sum(s) * (1.f / 2048.f) + EPSN);
#pragma unroll
    for (int j = 0; j < 8; ++j) { const f32x4 g = gr[64 * j]; const f32x4 y = v[j] * r * g;
        if (TOF32) ((GAS f32x4*)orow + lane)[64 * j] = y;
        else ((GAS unsigned long long*)orow + lane)[64 * j] = (unsigned long long)pk2(y.x, y.y) | ((unsigned long long)pk2(y.z, y.w) << 32); }
}

__device__ __forceinline__ void ph_prep(Frame& F, const Args& args, int l, const float* xcur) {
    PH_ENTER();
    LAS float* scr = (LAS float*)(F.lds + RING_OFF + wave * 16384);
    const int gw = vcu_ * NWAVES + wave, NGW = G_ * NWAVES;
    constexpr int I_IN = 32 * (INC / 128), I_KV = 32 * 32;
    if (l == 0) for (int it = gw; it < I_IN + I_KV; it += NGW) {
        int r = it;
        if (r < I_IN) { transpose_item_w<2, DM_>(args.in[3], INC, (bf16*)(ws + W_IN), LD2K, (LAS unsigned char*)scr, r, lane, args.in[2]); continue; } r -= I_IN;
        transpose_item_w<0, DM_>(args.in[16], 2 * DM_, (bf16*)(ws + W_KV), LD2K, (LAS unsigned char*)scr, r, lane);
        transpose_item_w<0, DM_>(args.in[16] + (size_t)DM_ * 2 * DM_, 2 * DM_, (bf16*)((unsigned char*)args.out + DO_WKV1), LD2K, (LAS unsigned char*)scr, r, lane);
    }
    if (l == 0) for (int m = gw; m < M; m += NGW) {
        const GAS f32x4* xr = (const GAS f32x4*)(xcur + (size_t)m * DM_) + lane; GAS unsigned long long* orow = (GAS unsigned long long*)((bf16*)(ws + WS_XN) + (size_t)m * LD2K) + lane; float sq = 0.f;
#pragma unroll
        for (int j = 0; j < 8; ++j) { const f32x4 v = xr[64 * j]; sq += (v.x * v.x + v.y * v.y) + (v.z * v.z + v.w * v.w); orow[64 * j] = (unsigned long long)pk2(v.x, v.y) | ((unsigned long long)pk2(v.z, v.w) << 32); }
        sq = wave_sum(sq); if (lane < 32) ((float*)(ws + WS_RSS))[((size_t)(lane >> 2) * M + (size_t)m) * 4 + (lane & 3)] = lane == 0 ? sq : 0.f; }
    if (l == 0) for (int m = gw; m < MEMROWS; m += NGW) { rms_row<false>(lane, args.in[1] + (size_t)m * DM_, args.in[14], (bf16*)(ws + WS_MN) + (size_t)m * DM_);
                                                         rms_row<false>(lane, args.in[1] + (size_t)m * DM_, args.in[14] + DM_, (bf16*)((unsigned char*)args.out + DO_MN1) + (size_t)m * DM_); }
    if (l == 1) { const int gt = vcu_ * (NWAVES * 64) + tid, NGT = G_ * NWAVES * 64;
        const GAS v4u* src = (const GAS v4u*)((const unsigned char*)args.out + DO_KV1); GAS v4u* dst = (GAS v4u*)(ws + WS_KM);
        for (int e = gt; e < 2 * MEMROWS * LD2K / 8; e += NGT) dst[e] = src[e]; }
    if (l == 0 && vcu_ == 0 && wave == 0) {
#pragma unroll
        for (int ll = 0; ll < DEPTH; ++ll) { const float* dl = args.in[4] + (size_t)ll * 256;
            const float s01 = wave_sum(dl[lane] * dl[64 + lane]), s23 = wave_sum(dl[128 + lane] * dl[192 + lane]);
            const float linit = 0.8f - 0.6f * expf(-0.3f * (float)ll);
            float* fz = (float*)(ws + WS_LAM) + 192 * ll;
            if (lane == 0) { fz[0] = expf(s01) - expf(s23) + linit; fz[1] = 1.0f - linit; }
            fz[2 + lane] = args.in[5][(size_t)ll * 128 + lane] * (1.0f - linit); fz[66 + lane] = args.in[5][(size_t)ll * 128 + 64 + lane] * (1.0f - linit); } }
    if (l == 0) {
        const int gt = vcu_ * (NWAVES * 64) + tid, NGT = G_ * NWAVES * 64;
        for (int e = gt; e < 2048 * 96; e += NGT) {
            const int t = e / 96, i = e % 96; float inv; float* dst;
            if (i < 32) { dst = (float*)(ws + WS_DCS) + ((size_t)t * 32 + i) * 2; }
            else { dst = (float*)(ws + WS_RCS) + ((size_t)t * 64 + (i - 32)) * 2; }
            inv = ROPE_INV[i];
            const float ang = (float)t * inv;
            const float CH = 0.15915494f, CL = 6.4206382e-09f;
            const float p = ang * CH, pe = fmaf(ang, CH, -p) + ang * CL; const float fr = (p - floorf(p)) + pe;
            dst[0] = __builtin_amdgcn_cosf(fr); dst[1] = __builtin_amdgcn_sinf(fr);
        }
    }
}

__device__ __forceinline__ void ph_rope(Frame& F, const Args& args) {
    PH_ENTER();
    const int gw = vcu_ * NWAVES + wave, NGW = G_ * NWAVES;
    for (int it = gw; it < 4 * M; it += NGW) {
        const int sel = it / M, row = it % M, t = row % NT_;
        const int seg = sel == 0 ? 0 : sel == 1 ? 1 : sel == 2 ? 5 : 6;
        bf16* base = (bf16*)(ws + WS_BIG + (size_t)seg * SEG) + (size_t)row * 1024;
        int c1, c2; const float* tab; float sc;
        if (sel < 2) { const int blk = lane >> 2, d0 = (lane & 3) * 8; c1 = blk * 64 + d0; c2 = c1 + 32; tab = (const float*)(ws + WS_DCS) + ((size_t)t * 32 + d0) * 2; sc = sel == 0 ? 0.125f * LOG2E : 1.0f; }
        else { const int blk = lane >> 3, d0 = (lane & 7) * 8; c1 = blk * 128 + d0; c2 = c1 + 64; tab = (const float*)(ws + WS_RCS) + ((size_t)t * 64 + d0) * 2; sc = sel == 2 ? 0.08838834764831845f : 1.0f; }
        const v4u a = *(const GAS v4u*)(base + c1), b = *(const GAS v4u*)(base + c2);
        const GAS f32x4* tb = (const GAS f32x4*)tab; const f32x4 t0 = tb[0], t1 = tb[1], t2 = tb[2], t3 = tb[3];
        const float cs[8] = {t0.x, t0.z, t1.x, t1.z, t2.x, t2.z, t3.x, t3.z}, sn[8] = {t0.y, t0.w, t1.y, t1.w, t2.y, t2.w, t3.y, t3.w};
        const unsigned aw[4] = {a.x, a.y, a.z, a.w}, bw[4] = {b.x, b.y, b.z, b.w}; unsigned oa[4], ob[4];
#pragma unroll
        for (int j = 0; j < 4; ++j) {
            const float x1l = bflo(aw[j]), x1h = bfhi(aw[j]), x2l = bflo(bw[j]), x2h = bfhi(bw[j]);
            const float y1l = (x1l * cs[2 * j] - x2l * sn[2 * j]) * sc, y2l = (x2l * cs[2 * j] + x1l * sn[2 * j]) * sc;
            const float y1h = (x1h * cs[2 * j + 1] - x2h * sn[2 * j + 1]) * sc, y2h = (x2h * cs[2 * j + 1] + x1h * sn[2 * j + 1]) * sc;
            oa[j] = pk2(y1l, y1h); ob[j] = pk2(y2l, y2h);
        }
        v4u wa; wa.x = oa[0]; wa.y = oa[1]; wa.z = oa[2]; wa.w = oa[3]; v4u wb; wb.x = ob[0]; wb.y = ob[1]; wb.z = ob[2]; wb.w = ob[3];
        *(GAS v4u*)(base + c1) = wa; *(GAS v4u*)(base + c2) = wb;
    }
}

__device__ __forceinline__ void ph_conv(Frame& F, const Args& args, int l, int ustart, int uend) {
    PH_ENTER();
    const bf16* U = (const bf16*)(ws + WS_BIG + 3 * SEG);
    bf16* YB = (bf16*)(ws + WS_Y) + SEG_E;
    const int c0 = 2 * tid;
    const float* cw = args.in[6] + (size_t)l * 31 * 1024;
    typedef float f32x2c __attribute__((ext_vector_type(2)));
    f32x2c w2[31];
#pragma unroll
    for (int j = 0; j < 31; ++j) { const float2 w = *(const float2*)(cw + j * 1024 + c0); w2[j] = (f32x2c){w.x, w.y}; }
    const float2 bias = *(const float2*)(args.in[7] + (size_t)l * 1024 + c0), lg = *(const float2*)(args.in[8] + (size_t)l * 1024 + c0), lb = *(const float2*)(args.in[9] + (size_t)l * 1024 + c0);
    LAS unsigned char* Us = F.lds + RING_OFF;
    LAS float* red1 = (LAS float*)(F.lds + RING_OFF + 46 * 2048); LAS float* red2 = red1 + 16 * 8;
    for (int unit = ustart; unit < uend; ++unit) {
        const int b = unit >> 7, t0 = (unit & 127) * 16;
#pragma unroll
        for (int i = 0; i < 12; ++i) { const int idx = tid + 512 * i; const int r = idx >> 7, ch = idx & 127;
            if (idx < 46 * 128) { const int tg = t0 - 30 + r; v4u v; v.x = 0u; v.y = 0u; v.z = 0u; v.w = 0u;
                if (tg >= 0) v = *(const GAS v4u*)(U + ((size_t)b * NT_ + tg) * 1024 + ch * 8);
                *(LAS v4u*)(Us + r * 2048 + ch * 16) = v; } }
        __syncthreads();
        f32x2c acc2[16];
#pragma unroll
        for (int t = 0; t < 16; ++t) acc2[t] = (f32x2c){0.f, 0.f};
#pragma unroll
        for (int r = 0; r < 46; ++r) {
            const unsigned uw = *(const LAS unsigned*)(Us + r * 2048 + tid * 4);
            const f32x2c u2 = {bflo(uw), bfhi(uw)};
#pragma unroll
            for (int t = 0; t < 16; ++t) { const int j = r - t; if (j >= 0 && j <= 30) acc2[t] = __builtin_elementwise_fma(u2, w2[j], acc2[t]); }
        }
        float a0[16], a1[16];
#pragma unroll
        for (int t = 0; t < 16; ++t) { a0[t] = acc2[t].x; a1[t] = acc2[t].y; }
        float mu[16];
#pragma unroll
        for (int t = 0; t < 16; ++t) { a0[t] += bias.x; a1[t] += bias.y; const float s = wave_total(a0[t] + a1[t]); if (lane == 0) red1[t * 8 + wave] = s; }
        __syncthreads();
#pragma unroll
        for (int t = 0; t < 16; ++t) { float s = 0.f;
#pragma unroll
            for (int w = 0; w < 8; ++w) s += red1[t * 8 + w];
            mu[t] = s * (1.f / 1024.f); a0[t] -= mu[t]; a1[t] -= mu[t];
            const float q = wave_total(a0[t] * a0[t] + a1[t] * a1[t]); if (lane == 0) red2[t * 8 + wave] = q; }
        __syncthreads();
#pragma unroll
        for (int t = 0; t < 16; ++t) { float q = 0.f;
#pragma unroll
            for (int w = 0; w < 8; ++w) q += red2[t * 8 + w];
            const float rs = 1.0f / sqrtf(q * (1.f / 1024.f) + EPSN);
            const float y0 = a0[t] * rs * lg.x + lb.x, y1 = a1[t] * rs * lg.y + lb.y;
            *(GAS unsigned*)(YB + ((size_t)b * NT_ + t0 + t) * 1024 + c0) = pk2(y0 * sigm(y0), y1 * sigm(y1)); }
    }
    __syncthreads();
}
__device__ __forceinline__ int sw_off(int row, int col) { return row * 256 + ((((col >> 3) ^ (row & 15)) << 4) | ((col & 7) << 1)); }
__device__ __forceinline__ void ph_ret_seq(Frame& F, const Args& args, int l, int bh) {
    PH_ENTER();
    typedef short bf16x8v __attribute__((ext_vector_type(8)));
    LAS unsigned char* Ks = F.lds + RING_OFF; LAS unsigned char* KTs = Ks + 32768; LAS unsigned char* VTs = KTs + 32768; LAS unsigned char* STs = VTs + 32768;
    const bf16* RQ = (const bf16*)(ws + WS_BIG + 5 * SEG); const bf16* RK = (const bf16*)(ws + WS_BIG + 6 * SEG); const bf16* RV = (const bf16*)(ws + WS_BIG + 7 * SEG); const bf16* RG = (const bf16*)(ws + WS_BIG + 8 * SEG);
    bf16* YRo = (bf16*)(ws + WS_Y) + 2 * SEG_E;
    const float* gng = args.in[10] + (size_t)l * 1024;
    const int wid = wave;
    const int b = bh >> 3, h = bh & 7;
    const float lg2 = log2f(1.0f - exp2f(-5.0f - (float)h));
    const float cdec = exp2f(128.0f * lg2);
    f32x4 st[8];
#pragma unroll
    for (int c = 0; c < 8; ++c) st[c] = (f32x4){0.f, 0.f, 0.f, 0.f};
    for (int e = tid; e < 8192; e += NWAVES * 64) ((LAS unsigned*)STs)[e] = 0u;
    bf16x8v qa[4]; v4u kq[4], vq[4];
    { const size_t r0 = (size_t)b * NT_; const int fr0 = lane & 15, fq0 = lane >> 4;
#pragma unroll
      for (int ks = 0; ks < 4; ++ks) qa[ks] = *(const GAS bf16x8v*)(RQ + (r0 + 16 * wid + fr0) * 1024 + h * 128 + ks * 32 + fq0 * 8);
#pragma unroll
      for (int i = 0; i < 4; ++i) { const int r = lane + 64 * (i & 1), cc = 2 * wid + (i >> 1); const size_t go = (r0 + r) * 1024 + h * 128 + cc * 8;
          kq[i] = *(const GAS v4u*)(RK + go); vq[i] = *(const GAS v4u*)(RV + go); } }
    for (int n = 0; n < 16; ++n) {
        const size_t row0 = (size_t)b * NT_ + (size_t)n * 128;
        int lane_n = lane; asm volatile("" : "+v"(lane_n)); const int fr = lane_n & 15, fq = lane_n >> 4;
        float lgn = lg2; asm volatile("" : "+v"(lgn));
#pragma unroll
        for (int i = 0; i < 4; ++i) { const int r = lane_n + 64 * (i & 1), cc = 2 * wid + (i >> 1);
            const v4u k = kq[i], v = vq[i];
            *(LAS v4u*)(Ks + sw_off(r, cc * 8)) = k;
            const float kd = __builtin_amdgcn_exp2f((float)(127 - r) * lgn); const unsigned kw[4] = {k.x, k.y, k.z, k.w}, vw[4] = {v.x, v.y, v.z, v.w};
#pragma unroll
            for (int j = 0; j < 4; ++j) {
                *(LAS bf16*)(KTs + sw_off(cc * 8 + 2 * j, r)) = (bf16)f2bf(bflo(kw[j]) * kd); *(LAS bf16*)(KTs + sw_off(cc * 8 + 2 * j + 1, r)) = (bf16)f2bf(bfhi(kw[j]) * kd);
                *(LAS bf16*)(VTs + sw_off(cc * 8 + 2 * j, r)) = (bf16)(vw[j] & 0xffffu); *(LAS bf16*)(VTs + sw_off(cc * 8 + 2 * j + 1, r)) = (bf16)(vw[j] >> 16); }
            if (i & 1) asm volatile("" ::: "memory"); }
        __syncthreads();
        unsigned Pk[8][2]; f32x4 o[8];
#pragma unroll
        for (int c = 0; c < 8; ++c) { f32x4 Sc = (f32x4){0.f, 0.f, 0.f, 0.f};
#pragma unroll
            for (int ks = 0; ks < 4; ++ks) { const bf16x8v kb = *(const LAS bf16x8v*)(Ks + sw_off(16 * c + fr, ks * 32 + fq * 8));
                Sc = __builtin_amdgcn_mfma_f32_16x16x32_bf16(qa[ks], kb, Sc, 0, 0, 0); }
            float p4[4];
#pragma unroll
            for (int rg = 0; rg < 4; ++rg) { const int tl = 16 * wid + 4 * fq + rg, sl = 16 * c + fr; p4[rg] = sl <= tl ? Sc[rg] * __builtin_amdgcn_exp2f((float)(tl - sl) * lgn) : 0.f; }
            Pk[c][0] = pk2(p4[0], p4[1]); Pk[c][1] = pk2(p4[2], p4[3]);
            asm volatile("" ::: "memory"); }
#pragma unroll
        for (int c = 0; c < 8; ++c) { o[c] = (f32x4){0.f, 0.f, 0.f, 0.f};
#pragma unroll
            for (int ks = 0; ks < 4; ++ks) { const bf16x8v sb = *(const LAS bf16x8v*)(STs + sw_off(16 * c + fr, ks * 32 + fq * 8));
                o[c] = __builtin_amdgcn_mfma_f32_16x16x32_bf16(qa[ks], sb, o[c], 0, 0, 0); }
#pragma unroll
            for (int rg = 0; rg < 4; ++rg) o[c][rg] *= __builtin_amdgcn_exp2f((float)(16 * wid + 4 * fq + rg + 1) * lgn);
            asm volatile("" ::: "memory"); }
        {
            bf16x8v va[4];
#pragma unroll
            for (int ks = 0; ks < 4; ++ks) va[ks] = *(const LAS bf16x8v*)(VTs + sw_off(16 * wid + fr, ks * 32 + fq * 8));
#pragma unroll
            for (int c = 0; c < 8; ++c) { st[c] = st[c] * cdec;
#pragma unroll
                for (int ks = 0; ks < 4; ++ks) { const bf16x8v kb = *(const LAS bf16x8v*)(KTs + sw_off(16 * c + fr, ks * 32 + fq * 8));
                    st[c] = __builtin_amdgcn_mfma_f32_16x16x32_bf16(va[ks], kb, st[c], 0, 0, 0); }
                asm volatile("" ::: "memory"); }
        }
        __syncthreads();
        v4u gq[4];
#pragma unroll
        for (int i = 0; i < 4; ++i) gq[i] = *(const GAS v4u*)(RG + (row0 + 16 * wid + (lane_n >> 4) + 4 * i) * 1024 + h * 128 + (lane_n & 15) * 8);
        bf16x8v qn[4];
        if (n + 1 < 16) { const size_t r1 = row0 + 128;
#pragma unroll
            for (int ks = 0; ks < 4; ++ks) qn[ks] = *(const GAS bf16x8v*)(RQ + (r1 + 16 * wid + fr) * 1024 + h * 128 + ks * 32 + fq * 8);
#pragma unroll
            for (int i = 0; i < 4; ++i) { const int r = lane_n + 64 * (i & 1), cc = 2 * wid + (i >> 1); const size_t go = (r1 + r) * 1024 + h * 128 + cc * 8;
                kq[i] = *(const GAS v4u*)(RK + go); vq[i] = *(const GAS v4u*)(RV + go); } }
        else {
#pragma unroll
            for (int ks = 0; ks < 4; ++ks) qn[ks] = qa[ks]; }
#pragma unroll
        for (int c = 0; c < 8; ++c)
#pragma unroll
            for (int rg = 0; rg < 4; ++rg) { const int tl = 16 * wid + 4 * fq + rg, sl = 16 * c + fr;
                *(LAS bf16*)(Ks + sw_off(tl, sl)) = (bf16)((rg & 1) ? (Pk[c][rg >> 1] >> 16) : (Pk[c][rg >> 1] & 0xffffu));
                *(LAS bf16*)(STs + sw_off(tl, sl)) = (bf16)f2bf(st[c][rg]); }
        LDS_WAIT(); asm volatile("" ::: "memory");
        bf16x8v pa[4];
#pragma unroll
        for (int ks = 0; ks < 4; ++ks) pa[ks] = *(const LAS bf16x8v*)(Ks + sw_off(16 * wid + fr, ks * 32 + fq * 8));
#pragma unroll
        for (int c = 0; c < 8; ++c) {
#pragma unroll
            for (int ks = 0; ks < 4; ++ks) { const bf16x8v vb = *(const LAS bf16x8v*)(VTs + sw_off(16 * c + fr, ks * 32 + fq * 8));
                o[c] = __builtin_amdgcn_mfma_f32_16x16x32_bf16(pa[ks], vb, o[c], 0, 0, 0); }
            asm volatile("" ::: "memory"); }
        float mu[4], rs[4];
#pragma unroll
        for (int rg = 0; rg < 4; ++rg) { float s = 0.f;
#pragma unroll
            for (int c = 0; c < 8; ++c) s += o[c][rg];
            s = pg8::xadd<1>(s); s = pg8::xadd<2>(s); s = pg8::xadd<4>(s); s = pg8::xadd<8>(s); mu[rg] = s * (1.f / 128.f);
            float q = 0.f;
#pragma unroll
            for (int c = 0; c < 8; ++c) { const float d = o[c][rg] - mu[rg]; q += d * d; }
            q = pg8::xadd<1>(q); q = pg8::xadd<2>(q); q = pg8::xadd<4>(q); q = pg8::xadd<8>(q); rs[rg] = 1.0f / sqrtf(q * (1.f / 128.f) + EPSN); }
#pragma unroll
        for (int c = 0; c < 8; ++c)
#pragma unroll
            for (int rg = 0; rg < 4; ++rg) *(LAS bf16*)(Ks + sw_off(16 * wid + 4 * fq + rg, 16 * c + fr)) = (bf16)f2bf((o[c][rg] - mu[rg]) * rs[rg] * gng[h * 128 + 16 * c + fr]);
        LDS_WAIT(); asm volatile("" ::: "memory");
#pragma unroll
        for (int i = 0; i < 4; ++i) { const int r = 16 * wid + (lane_n >> 4) + 4 * i, cc = lane_n & 15;
            const v4u y = *(const LAS v4u*)(Ks + sw_off(r, cc * 8)); const size_t go = (row0 + r) * 1024 + h * 128 + cc * 8;
            const unsigned yw[4] = {y.x, y.y, y.z, y.w}, gw4[4] = {gq[i].x, gq[i].y, gq[i].z, gq[i].w}; unsigned ow[4];
#pragma unroll
            for (int j = 0; j < 4; ++j) { const float ga = bflo(gw4[j]), gb = bfhi(gw4[j]); ow[j] = pk2(ga * sigm(ga) * bflo(yw[j]), gb * sigm(gb) * bfhi(yw[j])); }
            v4u w; w.x = ow[0]; w.y = ow[1]; w.z = ow[2]; w.w = ow[3]; *(GAS v4u*)(YRo + go) = w; }
        __syncthreads();
#pragma unroll
        for (int ks = 0; ks < 4; ++ks) qa[ks] = qn[ks];
    }
}

__device__ __forceinline__ void ph_combine(Frame& F, const Args& args, int l) {
    PH_ENTER();
    const int gw = vcu_ * NWAVES + wave, NGW = G_ * NWAVES;
    const float* dl = args.in[4] + (size_t)l * 256;
    const float s01 = wave_sum(dl[lane] * dl[64 + lane]), s23 = wave_sum(dl[128 + lane] * dl[192 + lane]);
    const float linit = 0.8f - 0.6f * expf(-0.3f * (float)l);
    const float lam = expf(s01) - expf(s23) + linit;
    const float* subln = args.in[5] + (size_t)l * 128 + (lane & 7) * 16;
    float sl[16];
#pragma unroll
    for (int i = 0; i < 16; ++i) sl[i] = subln[i] * (1.0f - linit);
    const bf16* O0 = (const bf16*)args.out; const bf16* O1 = O0 + SEG_E;
    bf16* YA = (bf16*)(ws + WS_Y);
    for (int m = gw; m < M; m += NGW) {
        const size_t off = (size_t)m * 1024 + lane * 16;
        {   const v4u a0 = *(const GAS v4u*)(O0 + off), a1 = *(const GAS v4u*)(O0 + off + 8), b0 = *(const GAS v4u*)(O1 + off), b1 = *(const GAS v4u*)(O1 + off + 8);
            const unsigned aw[8] = {a0.x, a0.y, a0.z, a0.w, a1.x, a1.y, a1.z, a1.w}, bw[8] = {b0.x, b0.y, b0.z, b0.w, b1.x, b1.y, b1.z, b1.w};
            float d[16]; float ss = 0.f;
#pragma unroll
            for (int j = 0; j < 8; ++j) { d[2 * j] = bflo(aw[j]) - lam * bflo(bw[j]); d[2 * j + 1] = bfhi(aw[j]) - lam * bfhi(bw[j]); ss += d[2 * j] * d[2 * j] + d[2 * j + 1] * d[2 * j + 1]; }
            ss = pg8::xadd<1>(ss); ss = pg8::xadd<2>(ss); ss = pg8::xadd<4>(ss);
            const float r = 1.0f / sqrtf(ss * (1.f / 128.f) + EPSN);
            unsigned ow[8];
#pragma unroll
            for (int j = 0; j < 8; ++j) ow[j] = pk2(d[2 * j] * r * sl[2 * j], d[2 * j + 1] * r * sl[2 * j + 1]);
            v4u w0; w0.x = ow[0]; w0.y = ow[1]; w0.z = ow[2]; w0.w = ow[3]; v4u w1; w1.x = ow[4]; w1.y = ow[5]; w1.z = ow[6]; w1.w = ow[7];
            *(GAS v4u*)(YA + off) = w0; *(GAS v4u*)(YA + off + 8) = w1; }
    }
}

#ifndef MK_MULTI
#define MK_MULTI 0
#endif
template <int KLO, int KHI> __global__ void __launch_bounds__(NWAVES * 64, 2) mk_fwd(Args args) {
    extern __shared__ __attribute__((aligned(16))) unsigned char lds[];
    Frame F;
    F.lds = (LAS unsigned char*)lds;
    F.MISC = (volatile LAS unsigned*)(F.lds + MISC_OFF);
    F.wave = __builtin_amdgcn_readfirstlane((int)threadIdx.x >> 6); F.G = gridDim.x; { const int bx = blockIdx.x; F.vcu = (F.G % 8 == 0) ? (bx % 8) * (F.G / 8) + bx / 8 : bx; }
    for (int u = threadIdx.x; u < (LDS_BYTES - LDSCTL_OFF) / 4; u += NWAVES * 64) ((LAS unsigned*)(F.lds + LDSCTL_OFF))[u] = 0u;
    __syncthreads();
    XcdBarrier bar; bar.bar = (unsigned*)(args.ws + WS_CTL) + CW_BAR; bar.x = 0; bar.st = nullptr;
    if (!MK_MULTI) bar = xcd_barrier_post((unsigned*)(args.ws + WS_CTL) + CW_BAR, F.MISC + 8, threadIdx.x == 0);
#ifndef REP_MASK
#define REP_MASK 0u
#endif
#define NREP(k) ((((REP_MASK) >> (k)) & 1u) ? 2 : 1)
#define IN(k) (KLO <= (k) && (k) < KHI)
#define SEAM(k) do { if (!MK_MULTI && IN(k) && IN((k) + 1)) xcd_barrier(bar, F.wave == 0 && pg8::lane_id() == 0); } while (0)
#define PHP() unsigned char* ws = pg8::uni_ptr(args.ws); bf16* const XN = (bf16*)(ws + WS_XN); bf16* const BIGp = (bf16*)(ws + WS_BIG); const int bx = pg8::opq((int)blockIdx.x), G_ = pg8::opq(F.G); (void)XN; (void)BIGp; (void)bx; (void)G_

    for (int l = args.l_lo; l < args.l_hi; ++l) {
        constexpr int pb = 0;
        const float* xcur = args.in[0];
        if (IN(pb + 0)) for (int rep_ = 0; rep_ < NREP(0); ++rep_) ph_prep(F, args, l, xcur);
        SEAM(pb + 0);
        if (IN(pb + 1)) for (int rep_ = 0; rep_ < NREP(1); ++rep_) { PHP();
            { pg8::Gemm g{XN, (const bf16*)(ws + W_IN), LD2K, LD2K, DM_}; pg8::StaticOrder S; S.init(M, INC, G_, bx, LD2K, LD2K);
              pg8::EpiInProj E{BIGp, (const float*)(ws + WS_DCS), (const float*)(ws + WS_RCS), (const float*)(ws + WS_RSS) + (l == 0 ? 0 : 3 * RSS_STRIDE)};
              pg8::gemm_phase<pg8::EpiInProj, pg8::StaticOrder, true, true>(F.lds + RING_OFF, g, S, E, F.wave); }
            if (l == 0) {
            { pg8::Gemm g{(const bf16*)(ws + WS_MN), (const bf16*)(ws + W_KV), DM_, LD2K, DM_}; pg8::StaticOrder S; S.init(MEMROWS, 2 * DM_, G_, (bx + 128) % G_, DM_, LD2K);
              pg8::EpiBf16 E{(bf16*)(ws + WS_KM), LD2K, DM_, (size_t)MEMROWS * LD2K, 1.0f, nullptr};
              pg8::gemm_phase<pg8::EpiBf16, pg8::StaticOrder, true, true>(F.lds + RING_OFF, g, S, E, F.wave); }
            { pg8::Gemm g{(const bf16*)((unsigned char*)args.out + DO_MN1), (const bf16*)((unsigned char*)args.out + DO_WKV1), DM_, LD2K, DM_}; pg8::StaticOrder S; S.init(MEMROWS, 2 * DM_, G_, bx, DM_, LD2K);
              pg8::EpiBf16 E{(bf16*)((unsigned char*)args.out + DO_KV1), LD2K, DM_, (size_t)MEMROWS * LD2K, 1.0f, nullptr};
              pg8::gemm_phase<pg8::EpiBf16, pg8::StaticOrder, true, true>(F.lds + RING_OFF, g, S, E, F.wave); }
            }
        }
        SEAM(pb + 1);
        if (IN(pb + 3)) for (int rep_ = 0; rep_ < NREP(3); ++rep_) { PHP();
            const attn_body::bf16* Qp = (const attn_body::bf16*)BIGp; const attn_body::bf16* Kp = (const attn_body::bf16*)(BIGp + SEG_E); const attn_body::bf16* Vp = (const attn_body::bf16*)(BIGp + 2 * SEG_E);
            attn_body::bf16* Op = (attn_body::bf16*)args.out;
            unsigned* qctr = (unsigned*)(ws + WS_CTL) + CW_Q + 64 * (2 * l + rep_);
            const float* fzl = (const float*)(ws + WS_LAM) + 192 * l;
            const int nch = (LATE_ITEMS + (l + 1 < DEPTH ? LATE_ITEMS_IN : 0)) / CHUNK_ITEMS;
            for (;;) {
                if (F.wave == 0 && pg8::lane_id() == 0) { const unsigned idq = __hip_atomic_fetch_add(qctr, 1u, __ATOMIC_RELAXED, __HIP_MEMORY_SCOPE_AGENT); F.MISC[12] = idq; }
                __syncthreads();
                const int idq = pg8::opq((int)__builtin_amdgcn_readfirstlane((int)F.MISC[12]));
                if (idq >= 1088 + nch) break;
                int id = idq;
                if (idq >= 64) { const int j = idq - 64;
                    if (j < 3 * nch) { const int q = j / 3, rr = j - 3 * q;
                        if (rr == 2) {
                            LAS unsigned char* scr = (LAS unsigned char*)(F.lds + RING_OFF + F.wave * 16384);
                            kargp_t kp = (kargp_t)__builtin_amdgcn_kernarg_segment_ptr(); asm volatile("" : "+s"(kp)); int lane_q = pg8::lane_id(); asm volatile("" : "+v"(lane_q));
                            for (int i = 0; i < CHUNK_ITEMS / NWAVES; ++i) late_item(kp, ws, pg8::opq(l), CHUNK_ITEMS * q + pg8::opq(F.wave) + NWAVES * i, scr, lane_q);
                            __syncthreads(); continue; }
                        id = 64 + 2 * q + rr; }
                    else id = 64 + j - nch; }
                if (id < 64) ph_ret_seq(F, args, l, id);
                else if (id >= 320 && id < 832) { const int k2 = id - 320; ph_conv(F, args, l, 2 * k2, 2 * k2 + 2); }
                else { const int j = id < 320 ? id - 64 : id - 832 + 256;
                    const int qb = 7 - (j >> 6), g = j & 63, h8 = g & 7, b = g >> 3;
                    attn_body::attn_unit_w(F.wave, b, h8, 0, qb, Qp, Kp, Vp, Op, (char*)lds + RING_OFF, nullptr, nullptr);
                    attn_body::attn_unit_w(F.wave, b, h8, 1, qb, Qp, Kp, Vp, Op, (char*)lds + RING_OFF, (attn_body::bf16*)(ws + WS_Y), fzl); }
            }
            __syncthreads();
        }
        SEAM(pb + 3);
        if (IN(pb + 5)) for (int rep_ = 0; rep_ < NREP(5); ++rep_) { PHP();
            bf16* Y = (bf16*)(ws + WS_Y);
            pg8::Gemm g{Y, (const bf16*)(ws + W_BR), MIXW, LD1K, MIXW}; pg8::MergeOrder S; S.T.init(M, DM_, G_, bx, MIXW, LD1K);
            S.ystride = (unsigned)(SEG_E * 2); S.wstride = (unsigned)((size_t)DM_ * LD1K * 2);
            pg8::EpiMerge E{BIGp + 9 * SEG_E, BIGp};
            pg8::gemm_phase<pg8::EpiMerge, pg8::MergeOrder, true, true>(F.lds + RING_OFF, g, S, E, F.wave);
        }
        SEAM(pb + 5);
        if (IN(pb + 6))
#pragma unroll
        for (int rep_ = 0; rep_ < NREP(6); ++rep_) { PHP();
            { pg8::Gemm g{BIGp, (const bf16*)(ws + W_OUT), DM_, LD2K, DM_}; pg8::StaticOrder S; S.init(M, DM_, G_, bx, DM_, LD2K);
              pg8::EpiRes E{XN, rep_ ? BIGp + 11 * SEG_E : BIGp + 8 * SEG_E, LD2K, (float*)(ws + WS_RSS) + (size_t)(rep_ ? 6 : 1 + 3 * l) * RSS_STRIDE};
              pg8::gemm_phase<pg8::EpiRes, pg8::StaticOrder, true, true>(F.lds + RING_OFF, g, S, E, F.wave); }
            { pg8::Gemm g{(const bf16*)ws, (const bf16*)ws, LD2K, LD2K, 512};
              pg8::XprodOrder S{G_, bx, (unsigned)LD2K, (unsigned)WS_KM, (unsigned)(WS_KM + (size_t)MEMROWS * LD2K * 2), (unsigned)W_Q, (unsigned)W_O};
              pg8::EpiBf16Two E{(bf16*)(ws + WS_YRAW), DM_, (bf16*)(ws + WS_YRAW) + SEG_E, 1024};
              pg8::gemm_phase<pg8::EpiBf16Two, pg8::XprodOrder, true, true>(F.lds + RING_OFF, g, S, E, F.wave); }
        }
        SEAM(pb + 6);
        if (IN(pb + 8)) for (int rep_ = 0; rep_ < NREP(8); ++rep_) { PHP();
            pg8::Gemm g{BIGp + 8 * SEG_E, (const bf16*)(ws + WS_YRAW), LD2K, DM_, DM_}; pg8::XsOrder S{G_, bx, LD2K};
            pg8::EpiSoftmax E{BIGp + 2 * SEG_E, 1024, 0.044194173824159216f * LOG2E, (const float*)(ws + WS_RSS) + (size_t)(1 + 3 * l) * RSS_STRIDE};
            pg8::gemm_phase<pg8::EpiSoftmax, pg8::XsOrder, false, true>(F.lds + RING_OFF, g, S, E, F.wave);
        }
        SEAM(pb + 8);
        if (IN(pb + 12))
#pragma unroll
        for (int rep_ = 0; rep_ < NREP(12); ++rep_) { PHP();
            pg8::Gemm g{BIGp + 2 * SEG_E, (const bf16*)(ws + WS_YRAW) + SEG_E, 1024, 1024, 1024}; pg8::XoOrder S{G_, bx};
            pg8::EpiRes E{BIGp + 8 * SEG_E, rep_ ? BIGp + 11 * SEG_E : XN, LD2K, (float*)(ws + WS_RSS) + (size_t)(rep_ ? 6 : 2 + 3 * l) * RSS_STRIDE};
            pg8::gemm_phase<pg8::EpiRes, pg8::XoOrder, true, true>(F.lds + RING_OFF, g, S, E, F.wave);
        }
        SEAM(pb + 12);
        if (IN(pb + 14)) for (int rep_ = 0; rep_ < NREP(14); ++rep_) { PHP();
            pg8::Gemm g{XN, (const bf16*)(ws + W_13), LD2K, LD2K, DM_}; pg8::StaticOrder S; S.init(M, 2 * FFH, G_, bx, LD2K, LD2K);
            pg8::EpiSwiGLU E{BIGp, FFH, (const float*)(ws + WS_RSS) + (size_t)(2 + 3 * l) * RSS_STRIDE};
            pg8::gemm_phase<pg8::EpiSwiGLU, pg8::StaticOrder, true, true>(F.lds + RING_OFF, g, S, E, F.wave);
        }
        SEAM(pb + 14);
        if (IN(pb + 15))
#pragma unroll
        for (int rep_ = 0; rep_ < NREP(15); ++rep_) { PHP();
            pg8::Gemm g{BIGp, (const bf16*)(ws + W_2), FFH, LDFF, FFH}; pg8::StaticOrder S; S.init(M, DM_, G_, bx, FFH, LDFF);
            pg8::EpiRes E{XN, rep_ ? BIGp + 11 * SEG_E : XN, LD2K, (float*)(ws + WS_RSS) + (size_t)(rep_ ? 6 : 3 + 3 * l) * RSS_STRIDE};
            pg8::gemm_phase<pg8::EpiRes, pg8::StaticOrder, true, true>(F.lds + RING_OFF, g, S, E, F.wave);
        }
        SEAM(pb + 15);
    }
    if (IN(NPH)) { PH_ENTER(); const bf16* XB = (const bf16*)(ws + WS_XN); const float* rp = (const float*)(ws + WS_RSS) + (size_t)(3 * DEPTH) * RSS_STRIDE; const int gw = vcu_ * NWAVES + wave, NGW = G_ * NWAVES;
        for (int m = gw; m < M; m += NGW) {
            float sv = lane < 32 ? rp[((size_t)(lane >> 2) * M + (size_t)m) * 4 + (lane & 3)] : 0.f; sv = wave_sum(sv); const float r = 1.0f / sqrtf(sv * (1.f / 2048.f) + EPSN);
            const GAS v4u* xr = (const GAS v4u*)(XB + (size_t)m * LD2K) + lane; const GAS f32x4* gr = (const GAS f32x4*)args.in[21] + 2 * lane; GAS f32x4* orow = (GAS f32x4*)(args.out + (size_t)m * DM_) + 2 * lane;
#pragma unroll
            for (int j = 0; j < 4; ++j) { const v4u x = xr[64 * j]; const f32x4 g0 = gr[128 * j], g1 = gr[128 * j + 1];
                orow[128 * j] = (f32x4){bflo(x.x) * r * g0.x, bfhi(x.x) * r * g0.y, bflo(x.y) * r * g0.z, bfhi(x.y) * r * g0.w};
                orow[128 * j + 1] = (f32x4){bflo(x.z) * r * g1.x, bfhi(x.z) * r * g1.y, bflo(x.w) * r * g1.z, bfhi(x.w) * r * g1.w}; } } }
#undef IN
#undef SEAM
}

extern "C" void kernel_launch(void* const* d_in, const int* in_sizes, int n_in, void* d_out, int out_size, void* d_ws, size_t ws_size, hipStream_t stream) {
    static int grid = 0; static bool first = true;
    if (grid == 0) {
        if (n_in != 22 || in_sizes[0] != M * DM_ || out_size != M * DM_ || ws_size < WS_END) { fprintf(stderr, "kernel_launch: unexpected shapes / workspace (n_in %d, in0 %d, out %d, ws %zu, need %zu); nothing launched\n", n_in, n_in > 0 ? in_sizes[0] : -1, out_size, ws_size, (size_t)WS_END); grid = -1; return; }
        int dev = 0, cus = 0, per_cu = 0;
        if (hipGetDevice(&dev) != hipSuccess || hipDeviceGetAttribute(&cus, hipDeviceAttributeMultiprocessorCount, dev) != hipSuccess) { grid = -1; return; }
        if (hipFuncSetAttribute((const void*)mk_fwd<MK_MULTI ? NPH : 0, NPH + 1>, hipFuncAttributeMaxDynamicSharedMemorySize, LDS_BYTES) != hipSuccess) { fprintf(stderr, "kernel_launch: hipFuncSetAttribute failed\n"); grid = -1; return; }
        if (hipOccupancyMaxActiveBlocksPerMultiprocessor(&per_cu, (const void*)mk_fwd<MK_MULTI ? NPH : 0, NPH + 1>, NWAVES * 64, LDS_BYTES) != hipSuccess || per_cu < 1) fprintf(stderr, "kernel_launch: occupancy query reports %d\n", per_cu);
        (void)hipGetLastError();
        grid = cus;
    }
    if (grid < 0) return;
    if (hipMemsetAsync((char*)d_ws + WS_CTL, 0, CTL_ZERO_BYTES, stream) != hipSuccess) return;
    Args a{};
    for (int i = 0; i < 22; ++i) a.in[i] = (const float*)d_in[i];
    a.out = (float*)d_out; a.ws = (unsigned char*)d_ws;
#if MK_MULTI
#define LAUNCH_K(K) do { if (first) (void)hipFuncSetAttribute((const void*)mk_fwd<K, K + 1>, hipFuncAttributeMaxDynamicSharedMemorySize, LDS_BYTES); hipLaunchKernelGGL((mk_fwd<K, K + 1>), dim3(grid), dim3(NWAVES * 64), LDS_BYTES, stream, a); } while (0)
    for (int l = 0; l < DEPTH; ++l) { a.l_lo = l; a.l_hi = l + 1;
        LAUNCH_K(0); LAUNCH_K(1); LAUNCH_K(2); LAUNCH_K(3); LAUNCH_K(4); LAUNCH_K(5); LAUNCH_K(6); LAUNCH_K(7); LAUNCH_K(8); LAUNCH_K(9); LAUNCH_K(10); LAUNCH_K(11); LAUNCH_K(12); LAUNCH_K(13); LAUNCH_K(14); LAUNCH_K(15); }
    a.l_lo = DEPTH; a.l_hi = DEPTH; LAUNCH_K(16);
    first = false;
#else
    a.l_lo = 0; a.l_hi = DEPTH;
    hipLaunchKernelGGL((mk_fwd<MK_MULTI ? NPH : 0, NPH + 1>), dim3(grid), dim3(NWAVES * 64), LDS_BYTES, stream, a);
#endif
}
```
